# Optimizing an MI355X kernel written in HIP

```python
import jax
import jax.numpy as jnp
from jax import lax
import numpy as np

D_MODEL = 2048
BATCH = 4
SEQ = 4096
DEPTH = 2

D_MIX = D_MODEL
ATTN_HEAD_DIM = 64
ATTN_Q_HEADS = (D_MIX // 2) // ATTN_HEAD_DIM
ATTN_KV_HEADS = ATTN_Q_HEADS // 8
ATTN_Q_WIDTH = ATTN_Q_HEADS * ATTN_HEAD_DIM
ATTN_KV_WIDTH = ATTN_KV_HEADS * ATTN_HEAD_DIM
WINDOW = 128
ATTN_BLOCK = WINDOW
ROPE_THETA = 10000.0
HGRN_HEAD_DIM = 128
HGRN_HEADS = (D_MIX // 4) // HGRN_HEAD_DIM
HGRN_WIDTH = HGRN_HEADS * HGRN_HEAD_DIM
MLSTM_HEAD_DIM = 128
MLSTM_HEADS = (D_MIX // 4) // MLSTM_HEAD_DIM
MLSTM_WIDTH = MLSTM_HEADS * MLSTM_HEAD_DIM
MLSTM_CONV = 4
CHUNK = 64
IN_SIZES = (ATTN_Q_WIDTH, ATTN_KV_WIDTH, ATTN_KV_WIDTH,
            HGRN_WIDTH, HGRN_WIDTH, HGRN_WIDTH, HGRN_WIDTH,
            2 * MLSTM_WIDTH, MLSTM_WIDTH, MLSTM_WIDTH, MLSTM_HEADS, MLSTM_HEADS)
IN_DIM = sum(IN_SIZES)
MIX_OUT = ATTN_Q_WIDTH + HGRN_WIDTH + MLSTM_WIDTH
PEER_HEADS = 8
PEER_NKEYS = 128
PEER_EXPERTS = PEER_NKEYS * PEER_NKEYS
PEER_TOPK = 16
PEER_KEY_DIM = 256
PEER_TOKEN_BLOCK = 128
NORM_EPS = 1e-6
NEG_BIG = -1e30
TINY = 1e-30

kernel_name = "hymba_hgrn2_mlstm_swa_peer_trunk"


def rms_norm(x, g):
    xf = x.astype(jnp.float32)
    y = xf * lax.rsqrt(jnp.mean(xf * xf, axis=-1, keepdims=True) + NORM_EPS)
    return (y * g.astype(jnp.float32)).astype(x.dtype)


def split_cols(t, sizes):
    return jnp.split(t, np.cumsum(sizes)[:-1].tolist(), axis=-1)


def rotary(x, pos):
    half = x.shape[-1] // 2
    inv = ROPE_THETA ** (-jnp.arange(half, dtype=jnp.float32) / half)
    ang = pos.astype(jnp.float32)[:, None] * inv[None, :]
    cos = jnp.cos(ang)[None, :, None, :]
    sin = jnp.sin(ang)[None, :, None, :]
    xf = x.astype(jnp.float32)
    x1, x2 = xf[..., :half], xf[..., half:]
    return jnp.concatenate([x1 * cos - x2 * sin, x2 * cos + x1 * sin], axis=-1).astype(x.dtype)


def causal_depthwise_conv(x, w):
    k_width, s = w.shape[0], x.shape[1]
    xp = jnp.pad(x, ((0, 0), (k_width - 1, 0), (0, 0)))
    return sum(xp[:, j:j + s] * w[j] for j in range(k_width))


def to_chunks(t, c):
    b, s, h = t.shape[:3]
    t = t.reshape((b, s // c, c, h) + t.shape[3:])
    return jnp.moveaxis(t, (1, 3), (0, 2))


def from_chunks(t):
    t = jnp.moveaxis(t, (0, 2), (1, 3))
    b, n, c, h, d = t.shape
    return t.reshape(b, n * c, h, d)


def sliding_window_attention(q, k, v, sinks):
    b, s, hq, dh = q.shape
    hkv = k.shape[2]
    g = hq // hkv
    w = ATTN_BLOCK
    n = s // w
    qb = q.reshape(b, n, w, hkv, g, dh)

    def band(t):
        tb = t.reshape(b, n, w, hkv, dh)
        prev = jnp.pad(tb, ((0, 0), (1, 0), (0, 0), (0, 0), (0, 0)))[:, :-1]
        return jnp.concatenate([prev, tb], axis=2)

    kb, vb = band(k), band(v)
    logits = jnp.einsum('bnqhgd,bnkhd->bnhgqk', qb, kb).astype(jnp.float32) * (dh ** -0.5)
    qi = jnp.arange(w)[:, None]
    kj = jnp.arange(2 * w)[None, :]
    rel = qi + w - kj
    blk = jnp.arange(n)[:, None, None]
    valid = (rel >= 0) & (rel < WINDOW) & (blk * w - w + kj >= 0)
    logits = jnp.where(valid[None, :, None, None], logits, NEG_BIG)
    sink = jnp.broadcast_to(sinks.astype(jnp.float32).reshape(1, 1, hkv, g, 1, 1),
                            logits.shape[:-1] + (1,))
    probs = jax.nn.softmax(jnp.concatenate([logits, sink], axis=-1), axis=-1)[..., :-1]
    out = jnp.einsum('bnhgqk,bnkhd->bnqhgd', probs.astype(v.dtype), vb)
    return out.reshape(b, s, hq * dh)


def hgrn2_chunkwise(q, k, v, log_f):
    b, s, h, dk = q.shape
    dv = v.shape[-1]
    qc, kc, vc, ac = (to_chunks(t.astype(jnp.float32), CHUNK) for t in (q, k, v, log_f))
    causal = jnp.tril(jnp.ones((CHUNK, CHUNK), dtype=bool))[:, :, None]

    def step(state, inp):
        qi, ki, vi, ai = inp
        cum = jnp.cumsum(ai, axis=2)
        o_inter = jnp.einsum('bhtk,bhkv->bhtv', qi * jnp.exp(cum), state)
        rel = jnp.where(causal, cum[:, :, :, None, :] - cum[:, :, None, :, :], NEG_BIG)
        scores = jnp.einsum('bhtk,bhsk,bhtsk->bhts', qi, ki, jnp.exp(rel))
        o_intra = jnp.einsum('bhts,bhsv->bhtv', scores, vi)
        last = cum[:, :, -1]
        k_dec = ki * jnp.exp(last[:, :, None, :] - cum)
        state = jnp.exp(last)[..., None] * state + jnp.einsum('bhsk,bhsv->bhkv', k_dec, vi)
        return state, o_inter + o_intra

    init = jnp.zeros((b, h, dk, dv), jnp.float32)
    _, out = lax.scan(step, init, (qc, kc, vc, ac))
    return from_chunks(out)


def mlstm_chunkwise(q, k, v, i_pre, log_f):
    b, s, h, dk = q.shape
    dv = v.shape[-1]
    qc, kc, vc, ic, fc = (to_chunks(t.astype(jnp.float32), CHUNK) for t in (q, k, v, i_pre, log_f))
    causal = jnp.tril(jnp.ones((CHUNK, CHUNK), dtype=bool))

    def step(carry, inp):
        c_st, n_st, m = carry
        qi, ki, vi, ii, fi = inp
        cum = jnp.cumsum(fi, axis=-1)
        log_d = jnp.where(causal, cum[..., :, None] - cum[..., None, :] + ii[..., None, :], NEG_BIG)
        log_inter = cum + m[..., None]
        m_t = jnp.maximum(jnp.max(log_d, axis=-1), log_inter)
        w_intra = jnp.exp(log_d - m_t[..., None])
        w_inter = jnp.exp(log_inter - m_t)
        qk = jnp.einsum('bhtd,bhsd->bhts', qi, ki) * w_intra
        num = jnp.einsum('bhts,bhsv->bhtv', qk, vi) \
            + w_inter[..., None] * jnp.einsum('bhtd,bhdv->bhtv', qi, c_st)
        den = jnp.sum(qk, axis=-1) + w_inter * jnp.einsum('bhtd,bhd->bht', qi, n_st)
        h_out = num / jnp.maximum(jnp.abs(den), jnp.exp(-m_t))[..., None]
        last = cum[..., -1]
        log_w = last[..., None] - cum + ii
        m_new = jnp.maximum(last + m, jnp.max(log_w, axis=-1))
        w_s = jnp.exp(log_w - m_new[..., None])
        decay = jnp.exp(last + m - m_new)
        c_new = decay[..., None, None] * c_st + jnp.einsum('bhs,bhsd,bhsv->bhdv', w_s, ki, vi)
        n_new = decay[..., None] * n_st + jnp.einsum('bhs,bhsd->bhd', w_s, ki)
        return (c_new, n_new, m_new), h_out

    init = (jnp.zeros((b, h, dk, dv), jnp.float32), jnp.zeros((b, h, dk), jnp.float32),
            jnp.zeros((b, h), jnp.float32))
    _, out = lax.scan(step, init, (qc, kc, vc, ic, fc))
    return from_chunks(out)


def hybrid_mixer(h, w_in, w_out, sinks, lower_bound, hgrn_gain, conv_w, i_bias, f_bias):
    b, s, _ = h.shape
    pos = jnp.arange(s)
    (qa, ka, va, qh, fh, ih, gh, qkm, vm, om, im, fm) = split_cols(h @ w_in, IN_SIZES)

    qa = rotary(qa.reshape(b, s, ATTN_Q_HEADS, ATTN_HEAD_DIM), pos)
    ka = rotary(ka.reshape(b, s, ATTN_KV_HEADS, ATTN_HEAD_DIM), pos)
    va = va.reshape(b, s, ATTN_KV_HEADS, ATTN_HEAD_DIM)
    y_attn = sliding_window_attention(qa, ka, va, sinks)

    hs = (b, s, HGRN_HEADS, HGRN_HEAD_DIM)
    fz = fh.astype(jnp.float32)
    lb = lower_bound.astype(jnp.float32)
    f_gate = lb + (1.0 - lb) * jax.nn.sigmoid(fz)
    log_f = jnp.log(jnp.maximum(f_gate, TINY))
    k_h = (1.0 - lb) * jax.nn.sigmoid(-fz)
    o_h = hgrn2_chunkwise(jax.nn.silu(qh).reshape(hs), k_h.reshape(hs), ih.reshape(hs), log_f.reshape(hs))
    y_hgrn = rms_norm(o_h.astype(h.dtype), hgrn_gain.reshape(HGRN_HEADS, HGRN_HEAD_DIM))
    y_hgrn = y_hgrn.reshape(b, s, HGRN_WIDTH) * jax.nn.silu(gh)

    qk = jax.nn.silu(causal_depthwise_conv(qkm, conv_w))
    qm, km = jnp.split(qk, 2, axis=-1)
    ms = (b, s, MLSTM_HEADS, MLSTM_HEAD_DIM)
    o_m = mlstm_chunkwise(qm.reshape(ms), (km * MLSTM_HEAD_DIM ** -0.5).reshape(ms), vm.reshape(ms),
                          im + i_bias, jax.nn.log_sigmoid((fm + f_bias).astype(jnp.float32)))
    y_mlstm = jax.nn.sigmoid(om) * o_m.reshape(b, s, MLSTM_WIDTH).astype(h.dtype)

    y = jnp.concatenate([y_attn, y_hgrn, y_mlstm], axis=-1)
    return y @ w_out


def peer_ffn(x, w_query, sub_keys, expert_u, expert_v):
    b, s, d = x.shape
    xt = x.reshape(-1, d)
    t = xt.shape[0]
    q = (xt @ w_query).reshape(t, PEER_HEADS, 2, PEER_KEY_DIM // 2)
    s1 = jnp.einsum('thd,hnd->thn', q[:, :, 0], sub_keys[0]).astype(jnp.float32)
    s2 = jnp.einsum('thd,hnd->thn', q[:, :, 1], sub_keys[1]).astype(jnp.float32)
    v1, i1 = lax.top_k(s1, PEER_TOPK)
    v2, i2 = lax.top_k(s2, PEER_TOPK)
    cand = (v1[..., :, None] + v2[..., None, :]).reshape(t, PEER_HEADS, PEER_TOPK * PEER_TOPK)
    cidx = (i1[..., :, None] * PEER_NKEYS + i2[..., None, :]).reshape(t, PEER_HEADS, PEER_TOPK * PEER_TOPK)
    top_s, sel = lax.top_k(cand, PEER_TOPK)
    idx = jnp.take_along_axis(cidx, sel, axis=-1)
    gate = jax.nn.softmax(top_s, axis=-1)

    def block(args):
        xb, ib, gb = args
        pre = jnp.einsum('td,thkd->thk', xb, expert_u[ib])
        act = jax.nn.gelu(pre.astype(jnp.float32), approximate=False) * gb
        return jnp.einsum('thk,thkd->td', act.astype(xb.dtype), expert_v[ib])

    nb = t // PEER_TOKEN_BLOCK
    out = lax.map(block, (xt.reshape(nb, PEER_TOKEN_BLOCK, d),
                          idx.reshape(nb, PEER_TOKEN_BLOCK, PEER_HEADS, PEER_TOPK),
                          gate.reshape(nb, PEER_TOKEN_BLOCK, PEER_HEADS, PEER_TOPK)))
    return out.reshape(b, s, d)


def setup_inputs(seed: int = 0) -> dict:
    key = jax.random.key(seed)
    ks = jax.random.split(key, 17)

    def nrm(k, shape, scale):
        return jax.random.normal(k, shape, jnp.float32) * scale

    return {
        'x': nrm(ks[0], (BATCH, SEQ, D_MODEL), 1.0),
        'norm_mix': 1.0 + nrm(ks[1], (DEPTH, D_MODEL), 0.02),
        'w_in': nrm(ks[2], (DEPTH, D_MODEL, IN_DIM), D_MODEL ** -0.5),
        'w_out': nrm(ks[3], (DEPTH, MIX_OUT, D_MODEL), MIX_OUT ** -0.5),
        'attn_sinks': nrm(ks[4], (DEPTH, ATTN_Q_HEADS), 0.5),
        'hgrn_lb_logits': nrm(ks[5], (DEPTH, HGRN_WIDTH), 0.5),
        'hgrn_out_norm': 1.0 + nrm(ks[6], (DEPTH, HGRN_WIDTH), 0.02),
        'mlstm_conv': nrm(ks[7], (DEPTH, MLSTM_CONV, 2 * MLSTM_WIDTH), MLSTM_CONV ** -0.5),
        'mlstm_i_bias': nrm(ks[8], (DEPTH, MLSTM_HEADS), 0.1),
        'mlstm_f_bias': jnp.linspace(3.0, 6.0, MLSTM_HEADS, dtype=jnp.float32)[None, :]
                        + nrm(ks[9], (DEPTH, MLSTM_HEADS), 0.1),
        'norm_ffn': 1.0 + nrm(ks[10], (DEPTH, D_MODEL), 0.02),
        'peer_query': nrm(ks[11], (DEPTH, D_MODEL, PEER_HEADS * PEER_KEY_DIM), D_MODEL ** -0.5),
        'peer_sub_keys': nrm(ks[12], (DEPTH, 2, PEER_HEADS, PEER_NKEYS, PEER_KEY_DIM // 2),
                             (PEER_KEY_DIM // 2) ** -0.5),
        'peer_u': nrm(ks[13], (DEPTH, PEER_EXPERTS, D_MODEL), D_MODEL ** -0.5),
        'peer_v': nrm(ks[14], (DEPTH, PEER_EXPERTS, D_MODEL), PEER_TOPK ** -0.5),
        'norm_final': 1.0 + nrm(ks[15], (D_MODEL,), 0.02),
    }


def reference(x, norm_mix, w_in, w_out, attn_sinks, hgrn_lb_logits, hgrn_out_norm, mlstm_conv,
              mlstm_i_bias, mlstm_f_bias, norm_ffn, peer_query, peer_sub_keys, peer_u, peer_v,
              norm_final):
    p = jax.nn.softmax(hgrn_lb_logits.astype(jnp.float32), axis=0)
    lower_bounds = jnp.cumsum(p, axis=0) - p[0:1]
    for l in range(DEPTH):
        h = rms_norm(x, norm_mix[l])
        x = x + hybrid_mixer(h, w_in[l], w_out[l], attn_sinks[l], lower_bounds[l], hgrn_out_norm[l],
                             mlstm_conv[l], mlstm_i_bias[l], mlstm_f_bias[l])
        h = rms_norm(x, norm_ffn[l])
        x = x + peer_ffn(h, peer_query[l], peer_sub_keys[l], peer_u[l], peer_v[l])
    return rms_norm(x, norm_final)
```

```cpp
#include <hip/hip_runtime.h>
#include <hip/hip_cooperative_groups.h>
#include <math.h>
#include <stdio.h>
#include <stdint.h>
namespace nv {
constexpr int D = 2048, NB = 4, S = 4096, T = NB * S, IN_DIM = 5384;
constexpr int C_QA = 0, C_KA = 1024, C_VA = 1152, C_QH = 1280, C_FH = 1792, C_IH = 2304, C_GH = 2816,
              C_QM = 3328, C_KM = 3840, C_VM = 4352, C_OM = 4864, C_IM = 5376, C_FM = 5380;
constexpr float EPS = 1e-6f;

__device__ __forceinline__ float wave_sum(float v) {
#pragma unroll
    for (int o = 1; o < 64; o <<= 1) v += __shfl_xor(v, o);
    return v;
}
__device__ __forceinline__ float wave_max(float v) {
#pragma unroll
    for (int o = 1; o < 64; o <<= 1) v = fmaxf(v, __shfl_xor(v, o));
    return v;
}
__device__ __forceinline__ float sigmoidf_(float x) { return 1.f / (1.f + expf(-x)); }
__device__ __forceinline__ float siluf_(float x) { return x / (1.f + expf(-x)); }

__global__ __launch_bounds__(256) void rmsnorm_kernel(const float* __restrict__ x, const float* __restrict__ g, float* __restrict__ out) {
    const int row = blockIdx.x * 4 + (threadIdx.x >> 6), lane = threadIdx.x & 63;
    const float4* xr = (const float4*)(x + (size_t)row * D);
    float4 v[8]; float ss = 0.f;
#pragma unroll
    for (int j = 0; j < 8; ++j) { v[j] = xr[lane + 64 * j]; ss += v[j].x * v[j].x + v[j].y * v[j].y + v[j].z * v[j].z + v[j].w * v[j].w; }
    ss = wave_sum(ss);
    const float r = rsqrtf(ss * (1.f / D) + EPS);
    float4* o = (float4*)(out + (size_t)row * D);
    const float4* g4 = (const float4*)g;
#pragma unroll
    for (int j = 0; j < 8; ++j) { float4 gg = g4[lane + 64 * j]; float4 w; w.x = v[j].x * r * gg.x; w.y = v[j].y * r * gg.y; w.z = v[j].z * r * gg.z; w.w = v[j].w * r * gg.w; o[lane + 64 * j] = w; }
}

template <bool RES>
__global__ __launch_bounds__(256) void gemm_f32(const float* __restrict__ A, const float* __restrict__ Bm, const float* __restrict__ R,
                                                float* __restrict__ C, int M, int N, int K) {
    __shared__ float As[16][68];
    __shared__ float Bs[16][68];
    const int tid = threadIdx.x, tx = tid & 15, ty = tid >> 4;
    const int m0 = blockIdx.y * 64, n0 = blockIdx.x * 64;
    float acc[4][4];
#pragma unroll
    for (int i = 0; i < 4; ++i)
#pragma unroll
        for (int j = 0; j < 4; ++j) acc[i][j] = 0.f;
    const int am = tid >> 2, ak = (tid & 3) * 4;
    const int bk = tid >> 4, bn = (tid & 15) * 4;
    for (int k0 = 0; k0 < K; k0 += 16) {
        float4 a = *(const float4*)(A + (size_t)(m0 + am) * K + k0 + ak);
        float4 b = make_float4(0.f, 0.f, 0.f, 0.f);
        if (n0 + bn < N) b = *(const float4*)(Bm + (size_t)(k0 + bk) * N + n0 + bn);
        __syncthreads();
        As[ak + 0][am] = a.x; As[ak + 1][am] = a.y; As[ak + 2][am] = a.z; As[ak + 3][am] = a.w;
        Bs[bk][bn + 0] = b.x; Bs[bk][bn + 1] = b.y; Bs[bk][bn + 2] = b.z; Bs[bk][bn + 3] = b.w;
        __syncthreads();
#pragma unroll
        for (int kk = 0; kk < 16; ++kk) {
            float av[4], bv[4];
#pragma unroll
            for (int i = 0; i < 4; ++i) av[i] = As[kk][ty * 4 + i];
#pragma unroll
            for (int j = 0; j < 4; ++j) bv[j] = Bs[kk][tx * 4 + j];
#pragma unroll
            for (int i = 0; i < 4; ++i)
#pragma unroll
                for (int j = 0; j < 4; ++j) acc[i][j] = fmaf(av[i], bv[j], acc[i][j]);
        }
    }
    if (n0 + tx * 4 < N) {
#pragma unroll
        for (int i = 0; i < 4; ++i) {
            const size_t off = (size_t)(m0 + ty * 4 + i) * N + n0 + tx * 4;
            float4 o = make_float4(acc[i][0], acc[i][1], acc[i][2], acc[i][3]);
            if (RES) { float4 r = *(const float4*)(R + off); o.x += r.x; o.y += r.y; o.z += r.z; o.w += r.w; }
            *(float4*)(C + off) = o;
        }
    }
}

__global__ __launch_bounds__(256) void rope_kernel(float* __restrict__ P) {
    const int gid = blockIdx.x * 256 + threadIdx.x;
    if (gid >= T * 18 * 32) return;
    const int i = gid & 31, hd = (gid >> 5) % 18, t = gid / (18 * 32);
    const int pos = t % S;
    const float inv = powf(10000.f, -(float)i / 32.f);
    const float ang = (float)pos * inv;
    const float c = cosf(ang), s = sinf(ang);
    float* p = P + (size_t)t * IN_DIM + hd * 64;
    const float x1 = p[i], x2 = p[i + 32];
    p[i] = x1 * c - x2 * s;
    p[i + 32] = x2 * c + x1 * s;
}

__global__ __launch_bounds__(64) void attn_kernel(const float* __restrict__ P, const float* __restrict__ sinks, float* __restrict__ Y) {
    __shared__ float qs[64];
    __shared__ float ps[128];
    const int t = blockIdx.x, hq = blockIdx.y, lane = threadIdx.x;
    const int pos = t % S, kvh = hq >> 3;
    qs[lane] = P[(size_t)t * IN_DIM + C_QA + hq * 64 + lane];
    __syncthreads();
    float lg[2];
#pragma unroll
    for (int r = 0; r < 2; ++r) {
        const int j = lane + 64 * r;
        float a = -1e30f;
        if (pos - j >= 0) {
            const float* kr = P + (size_t)(t - j) * IN_DIM + C_KA + kvh * 64;
            float acc = 0.f;
            for (int d = 0; d < 64; ++d) acc = fmaf(qs[d], kr[d], acc);
            a = acc * 0.125f;
        }
        lg[r] = a;
    }
    const float sink = sinks[hq];
    float m = wave_max(fmaxf(fmaxf(lg[0], lg[1]), sink));
    const float p0 = (pos - lane >= 0) ? expf(lg[0] - m) : 0.f;
    const float p1 = (pos - lane - 64 >= 0) ? expf(lg[1] - m) : 0.f;
    const float den = wave_sum(p0 + p1) + expf(sink - m);
    ps[lane] = p0; ps[lane + 64] = p1;
    __syncthreads();
    const int nk = min(128, pos + 1);
    float o = 0.f;
    for (int j = 0; j < nk; ++j) o = fmaf(ps[j], P[(size_t)(t - j) * IN_DIM + C_VA + kvh * 64 + lane], o);
    Y[(size_t)t * D + hq * 64 + lane] = o / den;
}

__global__ __launch_bounds__(256) void hgrn_kernel(const float* __restrict__ P, const float* __restrict__ lb_logits, int layer, float* __restrict__ OH) {
    __shared__ float qs[128], fs[128], ks[128], vs[32], red[8][32];
    const int tid = threadIdx.x, vloc = tid & 31, kg = tid >> 5;
    const int vq = blockIdx.x & 3, h = (blockIdx.x >> 2) & 3, b = blockIdx.x >> 4;
    float lb = 0.f;
    if (tid < 128) {
        const int c = h * 128 + tid;
        if (layer == 1) { const float l0 = lb_logits[c], l1 = lb_logits[512 + c]; const float mm = fmaxf(l0, l1); const float e0 = expf(l0 - mm), e1 = expf(l1 - mm); lb = e1 / (e0 + e1); }
    }
    float st[16];
#pragma unroll
    for (int i = 0; i < 16; ++i) st[i] = 0.f;
    const size_t base = (size_t)b * S;
    for (int s = 0; s < S; ++s) {
        const float* pr = P + (base + s) * IN_DIM;
        if (tid < 128) {
            const float qv = pr[C_QH + h * 128 + tid], fz = pr[C_FH + h * 128 + tid];
            const float sg = sigmoidf_(fz);
            qs[tid] = siluf_(qv);
            fs[tid] = lb + (1.f - lb) * sg;
            ks[tid] = (1.f - lb) * sigmoidf_(-fz);
        } else if (tid < 160) {
            vs[tid - 128] = pr[C_IH + h * 128 + vq * 32 + (tid - 128)];
        }
        __syncthreads();
        const float vv = vs[vloc];
        float part = 0.f;
#pragma unroll
        for (int i = 0; i < 16; ++i) {
            const int k = kg * 16 + i;
            st[i] = fmaf(fs[k], st[i], ks[k] * vv);
            part = fmaf(qs[k], st[i], part);
        }
        red[kg][vloc] = part;
        __syncthreads();
        if (tid < 32) {
            float o = 0.f;
#pragma unroll
            for (int g = 0; g < 8; ++g) o += red[g][tid];
            OH[(base + s) * 512 + h * 128 + vq * 32 + tid] = o;
        }
    }
}

__global__ __launch_bounds__(256) void hgrn_out_kernel(const float* __restrict__ OH, const float* __restrict__ P, const float* __restrict__ gain, float* __restrict__ Y) {
    const int w = blockIdx.x * 4 + (threadIdx.x >> 6), lane = threadIdx.x & 63;
    const int t = w >> 2, h = w & 3;
    const float a = OH[(size_t)t * 512 + h * 128 + lane], c = OH[(size_t)t * 512 + h * 128 + 64 + lane];
    const float ss = wave_sum(a * a + c * c);
    const float r = rsqrtf(ss * (1.f / 128.f) + EPS);
    const float g0 = P[(size_t)t * IN_DIM + C_GH + h * 128 + lane], g1 = P[(size_t)t * IN_DIM + C_GH + h * 128 + 64 + lane];
    Y[(size_t)t * D + 1024 + h * 128 + lane] = a * r * gain[h * 128 + lane] * siluf_(g0);
    Y[(size_t)t * D + 1024 + h * 128 + 64 + lane] = c * r * gain[h * 128 + 64 + lane] * siluf_(g1);
}

__global__ __launch_bounds__(256) void mlstm_kernel(const float* __restrict__ P, const float* __restrict__ conv_w, const float* __restrict__ i_bias,
                                                    const float* __restrict__ f_bias, float* __restrict__ Y) {
    __shared__ float qs[128], ks[128], vs[32], red[8][32], dred[8], sc[2];
    const int tid = threadIdx.x, vloc = tid & 31, kg = tid >> 5;
    const int vq = blockIdx.x & 3, h = (blockIdx.x >> 2) & 3, b = blockIdx.x >> 4;
    float cs[16], ns[16];
#pragma unroll
    for (int i = 0; i < 16; ++i) { cs[i] = 0.f; ns[i] = 0.f; }
    float m = 0.f;
    float xq0 = 0.f, xq1 = 0.f, xq2 = 0.f, xk0 = 0.f, xk1 = 0.f, xk2 = 0.f;
    float wq[4] = {0.f, 0.f, 0.f, 0.f}, wk[4] = {0.f, 0.f, 0.f, 0.f};
    if (tid < 128) {
#pragma unroll
        for (int j = 0; j < 4; ++j) { wq[j] = conv_w[j * 1024 + h * 128 + tid]; wk[j] = conv_w[j * 1024 + 512 + h * 128 + tid]; }
    }
    const float ib = i_bias[h], fb = f_bias[h];
    const size_t base = (size_t)b * S;
    for (int s = 0; s < S; ++s) {
        const float* pr = P + (base + s) * IN_DIM;
        if (tid < 128) {
            const float xq3 = pr[C_QM + h * 128 + tid], xk3 = pr[C_KM + h * 128 + tid];
            const float cq = wq[0] * xq0 + wq[1] * xq1 + wq[2] * xq2 + wq[3] * xq3;
            const float ck = wk[0] * xk0 + wk[1] * xk1 + wk[2] * xk2 + wk[3] * xk3;
            xq0 = xq1; xq1 = xq2; xq2 = xq3; xk0 = xk1; xk1 = xk2; xk2 = xk3;
            qs[tid] = siluf_(cq);
            ks[tid] = siluf_(ck) * 0.08838834764831845f;
        } else if (tid < 160) {
            vs[tid - 128] = pr[C_VM + h * 128 + vq * 32 + (tid - 128)];
        } else if (tid == 160) {
            sc[0] = pr[C_IM + h] + ib;
            const float z = pr[C_FM + h] + fb;
            sc[1] = fminf(z, 0.f) - log1pf(expf(-fabsf(z)));
        }
        __syncthreads();
        const float ip = sc[0], lf = sc[1];
        const float mn = fmaxf(lf + m, ip);
        const float fd = expf(lf + m - mn), iw = expf(ip - mn);
        m = mn;
        const float vv = vs[vloc];
        float part = 0.f, dpart = 0.f;
#pragma unroll
        for (int i = 0; i < 16; ++i) {
            const int k = kg * 16 + i;
            const float kk = ks[k] * iw;
            cs[i] = fmaf(fd, cs[i], kk * vv);
            ns[i] = fmaf(fd, ns[i], kk);
            part = fmaf(qs[k], cs[i], part);
            dpart = fmaf(qs[k], ns[i], dpart);
        }
        red[kg][vloc] = part;
        if (vloc == 0) dred[kg] = dpart;
        __syncthreads();
        if (tid < 32) {
            float o = 0.f, dn = 0.f;
#pragma unroll
            for (int g = 0; g < 8; ++g) { o += red[g][tid]; dn += dred[g]; }
            const float hv = o / fmaxf(fabsf(dn), expf(-mn));
            const float om = pr[C_OM + h * 128 + vq * 32 + tid];
            Y[(base + s) * D + 1536 + h * 128 + vq * 32 + tid] = sigmoidf_(om) * hv;
        }
    }
}

__global__ __launch_bounds__(128) void peer_route_kernel(const float* __restrict__ Q, const float* __restrict__ subk, int* __restrict__ IDX, float* __restrict__ GATE) {
    __shared__ float qh[256], s1[128], s2[128], v1[16], v2[16], cand[256], tops[16];
    __shared__ int i1[16], i2[16], topi[16];
    const int t = blockIdx.x, h = blockIdx.y, n = threadIdx.x;
    qh[n] = Q[(size_t)t * D + h * 256 + n];
    qh[n + 128] = Q[(size_t)t * D + h * 256 + 128 + n];
    __syncthreads();
    {
        const float* k0 = subk + ((size_t)(0 * 8 + h) * 128 + n) * 128;
        const float* k1 = subk + ((size_t)(1 * 8 + h) * 128 + n) * 128;
        float a = 0.f, c = 0.f;
        for (int d = 0; d < 128; ++d) { a = fmaf(qh[d], k0[d], a); c = fmaf(qh[128 + d], k1[d], c); }
        s1[n] = a; s2[n] = c;
    }
    __syncthreads();
    {
        const float a = s1[n], c = s2[n];
        int r1 = 0, r2 = 0;
        for (int j = 0; j < 128; ++j) {
            const float x = s1[j], y = s2[j];
            r1 += (x > a || (x == a && j < n)) ? 1 : 0;
            r2 += (y > c || (y == c && j < n)) ? 1 : 0;
        }
        if (r1 < 16) { v1[r1] = a; i1[r1] = n; }
        if (r2 < 16) { v2[r2] = c; i2[r2] = n; }
    }
    __syncthreads();
    cand[n] = v1[n >> 4] + v2[n & 15];
    cand[n + 128] = v1[(n + 128) >> 4] + v2[(n + 128) & 15];
    __syncthreads();
#pragma unroll
    for (int r = 0; r < 2; ++r) {
        const int c = n + 128 * r;
        const float a = cand[c];
        int rk = 0;
        for (int j = 0; j < 256; ++j) { const float x = cand[j]; rk += (x > a || (x == a && j < c)) ? 1 : 0; }
        if (rk < 16) { tops[rk] = a; topi[rk] = i1[c >> 4] * 128 + i2[c & 15]; }
    }
    __syncthreads();
    if (n < 16) {
        const float mx = tops[0];
        float den = 0.f;
        for (int j = 0; j < 16; ++j) den += expf(tops[j] - mx);
        GATE[(size_t)t * 128 + h * 16 + n] = expf(tops[n] - mx) / den;
        IDX[(size_t)t * 128 + h * 16 + n] = topi[n];
    }
}

__global__ __launch_bounds__(256) void peer_expert_kernel(const float* __restrict__ H, const float* __restrict__ X1, const int* __restrict__ IDX, const float* __restrict__ GATE,
                                                          const float* __restrict__ U, const float* __restrict__ V, float* __restrict__ X2) {
    __shared__ float red[4][8];
    __shared__ int sidx[128];
    __shared__ float sg[128];
    const int t = blockIdx.x, tid = threadIdx.x, lane = tid & 63, wv = tid >> 6;
    if (tid < 128) { sidx[tid] = IDX[(size_t)t * 128 + tid]; sg[tid] = GATE[(size_t)t * 128 + tid]; }
    float hx[8], out[8];
#pragma unroll
    for (int i = 0; i < 8; ++i) { hx[i] = H[(size_t)t * D + tid + 256 * i]; out[i] = 0.f; }
    __syncthreads();
    for (int e0 = 0; e0 < 128; e0 += 8) {
        float part[8];
#pragma unroll
        for (int e = 0; e < 8; ++e) {
            const float* ur = U + (size_t)sidx[e0 + e] * D;
            float a = 0.f;
#pragma unroll
            for (int i = 0; i < 8; ++i) a = fmaf(hx[i], ur[tid + 256 * i], a);
            part[e] = wave_sum(a);
        }
        __syncthreads();
        if (lane == 0) {
#pragma unroll
            for (int e = 0; e < 8; ++e) red[wv][e] = part[e];
        }
        __syncthreads();
#pragma unroll
        for (int e = 0; e < 8; ++e) {
            const float pre = red[0][e] + red[1][e] + red[2][e] + red[3][e];
            const float act = 0.5f * pre * (1.f + erff(pre * 0.70710678118654752f)) * sg[e0 + e];
            const float* vr = V + (size_t)sidx[e0 + e] * D;
#pragma unroll
            for (int i = 0; i < 8; ++i) out[i] = fmaf(act, vr[tid + 256 * i], out[i]);
        }
    }
#pragma unroll
    for (int i = 0; i < 8; ++i) X2[(size_t)t * D + tid + 256 * i] = X1[(size_t)t * D + tid + 256 * i] + out[i];
}
}
namespace nv2 {
using namespace nv;
typedef unsigned short bf_t;
constexpr int NPB = 5632;
__device__ __forceinline__ float b2f(bf_t h) { return __uint_as_float((unsigned)h << 16); }
__device__ __forceinline__ bf_t f2b(float x) { unsigned u = __float_as_uint(x); u += 0x7fffu + ((u >> 16) & 1u); return (bf_t)(u >> 16); }
__global__ __launch_bounds__(256) void rope_kernel(bf_t* __restrict__ P) {
    const int gid = blockIdx.x * 256 + threadIdx.x;
    if (gid >= T * 18 * 32) return;
    const int i = gid & 31, hd = (gid >> 5) % 18, t = gid / (18 * 32);
    const int pos = t % S;
    const float inv = powf(10000.f, -(float)i / 32.f);
    const float ang = (float)pos * inv;
    const float c = cosf(ang), s = sinf(ang);
    bf_t* p = P + (size_t)t * NPB + hd * 64;
    const float x1 = b2f(p[i]), x2 = b2f(p[i + 32]);
    p[i] = f2b(x1 * c - x2 * s);
    p[i + 32] = f2b(x2 * c + x1 * s);
}

__global__ __launch_bounds__(64) void attn_kernel(const bf_t* __restrict__ P, const float* __restrict__ sinks, bf_t* __restrict__ Y) {
    __shared__ float qs[64];
    __shared__ float ps[128];
    const int t = blockIdx.x, hq = blockIdx.y, lane = threadIdx.x;
    const int pos = t % S, kvh = hq >> 3;
    qs[lane] = b2f(P[(size_t)t * NPB + C_QA + hq * 64 + lane]);
    __syncthreads();
    float lg[2];
#pragma unroll
    for (int r = 0; r < 2; ++r) {
        const int j = lane + 64 * r;
        float a = -1e30f;
        if (pos - j >= 0) {
            const bf_t* kr = P + (size_t)(t - j) * NPB + C_KA + kvh * 64;
            float acc = 0.f;
            for (int d = 0; d < 64; ++d) acc = fmaf(qs[d], b2f(kr[d]), acc);
            a = acc * 0.125f;
        }
        lg[r] = a;
    }
    const float sink = sinks[hq];
    float m = wave_max(fmaxf(fmaxf(lg[0], lg[1]), sink));
    const float p0 = (pos - lane >= 0) ? expf(lg[0] - m) : 0.f;
    const float p1 = (pos - lane - 64 >= 0) ? expf(lg[1] - m) : 0.f;
    const float den = wave_sum(p0 + p1) + expf(sink - m);
    ps[lane] = p0; ps[lane + 64] = p1;
    __syncthreads();
    const int nk = min(128, pos + 1);
    float o = 0.f;
    for (int j = 0; j < nk; ++j) o = fmaf(ps[j], b2f(P[(size_t)(t - j) * NPB + C_VA + kvh * 64 + lane]), o);
    Y[(size_t)t * D + hq * 64 + lane] = f2b(o / den);
}

__global__ __launch_bounds__(256) void hgrn_kernel(const bf_t* __restrict__ P, const float* __restrict__ lb_logits, int layer, float* __restrict__ OH) {
    __shared__ float qs[128], fs[128], ks[128], vs[32], red[8][32];
    const int tid = threadIdx.x, vloc = tid & 31, kg = tid >> 5;
    const int vq = blockIdx.x & 3, h = (blockIdx.x >> 2) & 3, b = blockIdx.x >> 4;
    float lb = 0.f;
    if (tid < 128) {
        const int c = h * 128 + tid;
        if (layer == 1) { const float l0 = lb_logits[c], l1 = lb_logits[512 + c]; const float mm = fmaxf(l0, l1); const float e0 = expf(l0 - mm), e1 = expf(l1 - mm); lb = e1 / (e0 + e1); }
    }
    float st[16];
#pragma unroll
    for (int i = 0; i < 16; ++i) st[i] = 0.f;
    const size_t base = (size_t)b * S;
    for (int s = 0; s < S; ++s) {
        const bf_t* pr = P + (base + s) * NPB;
        if (tid < 128) {
            const float qv = b2f(pr[C_QH + h * 128 + tid]), fz = b2f(pr[C_FH + h * 128 + tid]);
            const float sg = sigmoidf_(fz);
            qs[tid] = siluf_(qv);
            fs[tid] = lb + (1.f - lb) * sg;
            ks[tid] = (1.f - lb) * sigmoidf_(-fz);
        } else if (tid < 160) {
            vs[tid - 128] = b2f(pr[C_IH + h * 128 + vq * 32 + (tid - 128)]);
        }
        __syncthreads();
        const float vv = vs[vloc];
        float part = 0.f;
#pragma unroll
        for (int i = 0; i < 16; ++i) {
            const int k = kg * 16 + i;
            st[i] = fmaf(fs[k], st[i], ks[k] * vv);
            part = fmaf(qs[k], st[i], part);
        }
        red[kg][vloc] = part;
        __syncthreads();
        if (tid < 32) {
            float o = 0.f;
#pragma unroll
            for (int g = 0; g < 8; ++g) o += red[g][tid];
            OH[(base + s) * 512 + h * 128 + vq * 32 + tid] = o;
        }
    }
}

__global__ __launch_bounds__(256) void hgrn_out_kernel(const float* __restrict__ OH, const bf_t* __restrict__ P, const float* __restrict__ gain, bf_t* __restrict__ Y) {
    const int w = blockIdx.x * 4 + (threadIdx.x >> 6), lane = threadIdx.x & 63;
    const int t = w >> 2, h = w & 3;
    const float a = OH[(size_t)t * 512 + h * 128 + lane], c = OH[(size_t)t * 512 + h * 128 + 64 + lane];
    const float ss = wave_sum(a * a + c * c);
    const float r = rsqrtf(ss * (1.f / 128.f) + EPS);
    const float g0 = b2f(P[(size_t)t * NPB + C_GH + h * 128 + lane]), g1 = b2f(P[(size_t)t * NPB + C_GH + h * 128 + 64 + lane]);
    Y[(size_t)t * D + 1024 + h * 128 + lane] = f2b(a * r * gain[h * 128 + lane] * siluf_(g0));
    Y[(size_t)t * D + 1024 + h * 128 + 64 + lane] = f2b(c * r * gain[h * 128 + 64 + lane] * siluf_(g1));
}

__global__ __launch_bounds__(256) void mlstm_kernel(const bf_t* __restrict__ P, const float* __restrict__ conv_w, const float* __restrict__ i_bias,
                                                    const float* __restrict__ f_bias, bf_t* __restrict__ Y) {
    __shared__ float qs[128], ks[128], vs[32], red[8][32], dred[8], sc[2];
    const int tid = threadIdx.x, vloc = tid & 31, kg = tid >> 5;
    const int vq = blockIdx.x & 3, h = (blockIdx.x >> 2) & 3, b = blockIdx.x >> 4;
    float cs[16], ns[16];
#pragma unroll
    for (int i = 0; i < 16; ++i) { cs[i] = 0.f; ns[i] = 0.f; }
    float m = 0.f;
    float xq0 = 0.f, xq1 = 0.f, xq2 = 0.f, xk0 = 0.f, xk1 = 0.f, xk2 = 0.f;
    float wq[4] = {0.f, 0.f, 0.f, 0.f}, wk[4] = {0.f, 0.f, 0.f, 0.f};
    if (tid < 128) {
#pragma unroll
        for (int j = 0; j < 4; ++j) { wq[j] = conv_w[j * 1024 + h * 128 + tid]; wk[j] = conv_w[j * 1024 + 512 + h * 128 + tid]; }
    }
    const float ib = i_bias[h], fb = f_bias[h];
    const size_t base = (size_t)b * S;
    for (int s = 0; s < S; ++s) {
        const bf_t* pr = P + (base + s) * NPB;
        if (tid < 128) {
            const float xq3 = b2f(pr[C_QM + h * 128 + tid]), xk3 = b2f(pr[C_KM + h * 128 + tid]);
            const float cq = wq[0] * xq0 + wq[1] * xq1 + wq[2] * xq2 + wq[3] * xq3;
            const float ck = wk[0] * xk0 + wk[1] * xk1 + wk[2] * xk2 + wk[3] * xk3;
            xq0 = xq1; xq1 = xq2; xq2 = xq3; xk0 = xk1; xk1 = xk2; xk2 = xk3;
            qs[tid] = siluf_(cq);
            ks[tid] = siluf_(ck) * 0.08838834764831845f;
        } else if (tid < 160) {
            vs[tid - 128] = b2f(pr[C_VM + h * 128 + vq * 32 + (tid - 128)]);
        } else if (tid == 160) {
            sc[0] = b2f(pr[C_IM + h]) + ib;
            const float z = b2f(pr[C_FM + h]) + fb;
            sc[1] = fminf(z, 0.f) - log1pf(expf(-fabsf(z)));
        }
        __syncthreads();
        const float ip = sc[0], lf = sc[1];
        const float mn = fmaxf(lf + m, ip);
        const float fd = expf(lf + m - mn), iw = expf(ip - mn);
        m = mn;
        const float vv = vs[vloc];
        float part = 0.f, dpart = 0.f;
#pragma unroll
        for (int i = 0; i < 16; ++i) {
            const int k = kg * 16 + i;
            const float kk = ks[k] * iw;
            cs[i] = fmaf(fd, cs[i], kk * vv);
            ns[i] = fmaf(fd, ns[i], kk);
            part = fmaf(qs[k], cs[i], part);
            dpart = fmaf(qs[k], ns[i], dpart);
        }
        red[kg][vloc] = part;
        if (vloc == 0) dred[kg] = dpart;
        __syncthreads();
        if (tid < 32) {
            float o = 0.f, dn = 0.f;
#pragma unroll
            for (int g = 0; g < 8; ++g) { o += red[g][tid]; dn += dred[g]; }
            const float hv = o / fmaxf(fabsf(dn), expf(-mn));
            const float om = b2f(pr[C_OM + h * 128 + vq * 32 + tid]);
            Y[(base + s) * D + 1536 + h * 128 + vq * 32 + tid] = f2b(sigmoidf_(om) * hv);
        }
    }
}

}
namespace pg8 {
#define PG8_LAS __attribute__((address_space(3)))
typedef unsigned short bf16_t;
typedef short bf16x8 __attribute__((ext_vector_type(8)));
typedef float f32x4 __attribute__((ext_vector_type(4)));
typedef unsigned u32x4 __attribute__((ext_vector_type(4)));
constexpr int BM = 256, BK = 64, HALF = 128, HTB = HALF * BK * 2  , STAGE_BYTES = 8 * HTB, NXCD = 8, WGM = 8;

__host__ __device__ __forceinline__ int lds_byte(int r, int c) { const int st = (r >> 4) * 2 + (c >> 5), rr = r & 15, cc = c & 31, ob = rr * 64 + cc * 2; return st * 1024 + (ob ^ (((ob >> 9) & 1) << 5)); }
__host__ __device__ __forceinline__ void stage_rc(int b, int& R, int& C) { const int st = b / 1024, sb = b % 1024, swz = sb ^ (((sb >> 9) & 1) << 5); R = (st >> 1) * 16 + swz / 64; C = (st & 1) * 32 + (swz % 64) / 2; }
__host__ __device__ __forceinline__ int perm32(int rho) { const int n = rho >> 4, i = rho & 15; return 8 * (i >> 2) + 4 * n + (i & 3); }

struct Unit { int pm, pn; };
struct Gemm { const bf16_t* A; const bf16_t* Bt; int M, N, K; };

struct StaticOrder {
    int nM, nN, nwg, G, c;
    __host__ __device__ void init(int M, int N, int G_, int c_) { nM = M / BM; nN = N / BM; nwg = nM * nN; G = G_; c = c_; }
    __host__ __device__ bool next(int i, Unit& u) const {
        const long L = (long)i * G + c; if (L >= nwg) return false;
        int wgid = (int)L; { const int q = nwg / NXCD, r = nwg % NXCD, xcd = wgid % NXCD, off = wgid / NXCD; wgid = (xcd < r ? xcd * (q + 1) : r * (q + 1) + (xcd - r) * q) + off; }
        const int nig = WGM * nN, gid = wgid / nig, fm = gid * WGM, gsz = (nM - fm) < WGM ? (nM - fm) : WGM;
        u.pm = fm + ((wgid % nig) % gsz); u.pn = (wgid % nig) / gsz; return true;
    }
    __device__ __forceinline__ void a_ready(const Unit&) const {}
    __device__ __forceinline__ void done(const Unit&) const {}
};

template <class Epi, class Sched, bool ALIGN_EPI = false, bool SP2 = false>
__device__ __forceinline__ void gemm_phase(PG8_LAS unsigned char* lds, const Gemm g, const Sched& S, const Epi& E) {
    const int tid = threadIdx.x, wid = __builtin_amdgcn_readfirstlane(tid >> 6), lane = tid & 63, wr = wid >> 2, wc = wid & 3, fr = lane & 15, fq = lane >> 4;
    const int K = g.K, nt = K / BK;
    unsigned voffA[2], voffB[2];
#pragma unroll
    for (int i = 0; i < 2; ++i) { int R, C; stage_rc(tid * 16 + i * 8192, R, C); const int Rb = Epi::PERM ? ((R & ~31) + perm32(R & 31)) : R;
        voffA[i] = (unsigned)(R * K + C) * 2u; voffB[i] = (unsigned)(Rb * K + C) * 2u; }
    const size_t kstep = (size_t)(BK * 2);
    const size_t hstep = (size_t)HALF * K * 2;
    const size_t tstep = 2 * hstep;
    const unsigned ldsw = (unsigned)wid * 1024u;
    const int aoff = lds_byte(wr * 64 + fr, fq * 8), boff = lds_byte(wc * 32 + fr, fq * 8);
#define PG8_SA(b, h) (((b) * 2 + (h)) * HTB)
#define PG8_SB(b, h) ((4 + (b) * 2 + (h)) * HTB)
#define PG8_STAGE(bufoff, gbase, voff) do { _Pragma("unroll") for (int _i = 0; _i < 2; ++_i) \
        __builtin_amdgcn_global_load_lds((const unsigned*)((const char*)(gbase) + (voff)[_i]), (PG8_LAS unsigned*)(lds + (bufoff) + ldsw + _i * 8192), 16, 0, 0); } while (0)
#define PG8_LDA(dst, b, h) do { _Pragma("unroll") for (int m = 0; m < 4; ++m) _Pragma("unroll") for (int k = 0; k < 2; ++k) dst[m][k] = *(const PG8_LAS bf16x8*)(lds + PG8_SA(b, h) + aoff + m * 2048 + k * 1024); } while (0)
#define PG8_LDB(dst, b, h) do { _Pragma("unroll") for (int n = 0; n < 2; ++n) _Pragma("unroll") for (int k = 0; k < 2; ++k) dst[n][k] = *(const PG8_LAS bf16x8*)(lds + PG8_SB(b, h) + boff + n * 2048 + k * 1024); } while (0)
#define PG8_MMA(ai, bj, At, Bt) do { __builtin_amdgcn_s_setprio(1); _Pragma("unroll") for (int m = 0; m < 4; ++m) _Pragma("unroll") for (int n = 0; n < 2; ++n) _Pragma("unroll") for (int k = 0; k < 2; ++k) \
        acc[ai][bj][m][n] = __builtin_amdgcn_mfma_f32_16x16x32_bf16(Bt[n][k], At[m][k], acc[ai][bj][m][n], 0, 0, 0); __builtin_amdgcn_s_setprio(0); } while (0)
#define PG8_WAIT_V(n) asm volatile("s_waitcnt vmcnt(" #n ")" ::: "memory")
#define PG8_WAIT_L(n) asm volatile("s_waitcnt lgkmcnt(" #n ")" ::: "memory")
#define PG8_BAR __builtin_amdgcn_s_barrier()
#define PG8_SCHED __builtin_amdgcn_sched_barrier(0)
    Unit cur, nxt; int ui = 0;
    if (!S.next(0, cur)) return;
    f32x4 acc[2][2][4][2];
#pragma unroll
    for (int a = 0; a < 2; ++a)
#pragma unroll
        for (int b = 0; b < 2; ++b)
#pragma unroll
            for (int m = 0; m < 4; ++m)
#pragma unroll
                for (int n = 0; n < 2; ++n) acc[a][b][m][n] = (f32x4){0.f, 0.f, 0.f, 0.f};
    bf16x8 At[4][2], B0[2][2], B1[2][2];
    const char* cA = (const char*)g.A + (size_t)cur.pm * tstep; const char* cB = (const char*)g.Bt + (size_t)cur.pn * tstep;
    S.a_ready(cur);
    if constexpr (SP2) {
        PG8_STAGE(PG8_SB(0, 0), cB, voffB); PG8_STAGE(PG8_SB(0, 1), cB + hstep, voffB); PG8_STAGE(PG8_SA(0, 0), cA, voffA); PG8_STAGE(PG8_SA(0, 1), cA + hstep, voffA);
        if (wr == 1) PG8_BAR;
        PG8_WAIT_V(2); PG8_BAR;
        PG8_STAGE(PG8_SB(1, 0), cB + kstep, voffB); PG8_STAGE(PG8_SA(1, 0), cA + kstep, voffA); PG8_STAGE(PG8_SB(1, 1), cB + hstep + kstep, voffB);
        PG8_WAIT_V(6); PG8_BAR;
    } else {
        PG8_STAGE(PG8_SB(0, 0), cB, voffB); PG8_STAGE(PG8_SA(0, 0), cA, voffA); PG8_STAGE(PG8_SB(0, 1), cB + hstep, voffB); PG8_STAGE(PG8_SA(0, 1), cA + hstep, voffA);
        if (wr == 1) PG8_BAR;
        PG8_WAIT_V(4); PG8_BAR;
        PG8_STAGE(PG8_SB(1, 0), cB + kstep, voffB); PG8_STAGE(PG8_SA(1, 0), cA + kstep, voffA); PG8_STAGE(PG8_SB(1, 1), cB + hstep + kstep, voffB);
        PG8_WAIT_V(6); PG8_BAR;
    }
    for (;;) {
        const bool has_next = S.next(ui + 1, nxt);
        const char* nA = has_next ? (const char*)g.A + (size_t)nxt.pm * tstep : cA; const char* nB = has_next ? (const char*)g.Bt + (size_t)nxt.pn * tstep : cB;
        for (int t = 0; t < nt; t += 2) {
            const bool last = (t == nt - 2);
            const char* a1 = cA + (size_t)(t + 1) * kstep;
            const char* a2 = last ? nA : cA + (size_t)(t + 2) * kstep; const char* b2 = last ? nB : cB + (size_t)(t + 2) * kstep;
            const char* a3 = a2 + kstep; const char* b3 = b2 + kstep;
            if (last && has_next) S.a_ready(nxt);
            if constexpr (SP2) {
            PG8_LDB(B0, 0, 0); PG8_LDB(B1, 0, 1); PG8_SCHED; PG8_LDA(At, 0, 0); PG8_STAGE(PG8_SA(1, 1), a1 + hstep, voffA);
            PG8_WAIT_V(8); PG8_WAIT_L(0); PG8_BAR; PG8_MMA(0, 0, At, B0); PG8_MMA(0, 1, At, B1); PG8_BAR; PG8_SCHED;
            PG8_LDA(At, 0, 1); PG8_STAGE(PG8_SB(0, 0), b2, voffB); PG8_STAGE(PG8_SB(0, 1), b2 + hstep, voffB); PG8_STAGE(PG8_SA(0, 0), a2, voffA);
            PG8_WAIT_V(8); PG8_WAIT_L(0); PG8_BAR; PG8_MMA(1, 0, At, B0); PG8_MMA(1, 1, At, B1); PG8_BAR; PG8_SCHED;
            PG8_LDB(B0, 1, 0); PG8_LDB(B1, 1, 1); PG8_SCHED; PG8_LDA(At, 1, 0); PG8_STAGE(PG8_SA(0, 1), a2 + hstep, voffA);
            PG8_WAIT_V(8); PG8_WAIT_L(0); PG8_BAR; PG8_MMA(0, 0, At, B0); PG8_MMA(0, 1, At, B1); PG8_BAR; PG8_SCHED;
            PG8_LDA(At, 1, 1); PG8_STAGE(PG8_SB(1, 0), b3, voffB); PG8_STAGE(PG8_SB(1, 1), b3 + hstep, voffB); PG8_STAGE(PG8_SA(1, 0), a3, voffA);
            PG8_WAIT_V(8); PG8_WAIT_L(0); PG8_BAR; PG8_MMA(1, 0, At, B0); PG8_MMA(1, 1, At, B1); PG8_BAR; PG8_SCHED;
            } else {
            PG8_LDB(B0, 0, 0); PG8_SCHED; PG8_LDA(At, 0, 0); PG8_STAGE(PG8_SA(1, 1), a1 + hstep, voffA);
            PG8_WAIT_L(8); PG8_BAR; PG8_WAIT_L(0); PG8_MMA(0, 0, At, B0); PG8_BAR; PG8_SCHED;
            PG8_LDB(B1, 0, 1); PG8_STAGE(PG8_SB(0, 0), b2, voffB);
            PG8_BAR; PG8_WAIT_L(0); PG8_MMA(0, 1, At, B1); PG8_BAR;
            PG8_LDA(At, 0, 1); PG8_STAGE(PG8_SA(0, 0), a2, voffA);
            PG8_BAR; PG8_WAIT_L(0); PG8_MMA(1, 0, At, B0); PG8_BAR; PG8_SCHED;
            PG8_STAGE(PG8_SB(0, 1), b2 + hstep, voffB);
            PG8_WAIT_V(6); PG8_BAR; PG8_MMA(1, 1, At, B1); PG8_BAR;
            PG8_LDB(B0, 1, 0); PG8_SCHED; PG8_LDA(At, 1, 0); PG8_STAGE(PG8_SA(0, 1), a2 + hstep, voffA);
            PG8_WAIT_L(8); PG8_BAR; PG8_WAIT_L(0); PG8_MMA(0, 0, At, B0); PG8_BAR; PG8_SCHED;
            PG8_LDB(B1, 1, 1); PG8_STAGE(PG8_SB(1, 0), b3, voffB);
            PG8_BAR; PG8_WAIT_L(0); PG8_MMA(0, 1, At, B1); PG8_BAR;
            PG8_LDA(At, 1, 1); PG8_STAGE(PG8_SA(1, 0), a3, voffA);
            PG8_BAR; PG8_WAIT_L(0); PG8_MMA(1, 0, At, B0); PG8_BAR; PG8_SCHED;
            PG8_STAGE(PG8_SB(1, 1), b3 + hstep, voffB);
            PG8_WAIT_V(6); PG8_BAR; PG8_MMA(1, 1, At, B1); PG8_BAR;
            }
        }
        if constexpr (ALIGN_EPI) { if (wr == 0) PG8_BAR; }
        if constexpr (!Epi::AFTER_DRAIN) { E(acc, cur, wr, wc, fr, fq); S.done(cur); }
        if (!has_next) break;
#pragma unroll
        for (int a = 0; a < 2; ++a)
#pragma unroll
            for (int b = 0; b < 2; ++b)
#pragma unroll
                for (int m = 0; m < 4; ++m)
#pragma unroll
                    for (int n = 0; n < 2; ++n) acc[a][b][m][n] = (f32x4){0.f, 0.f, 0.f, 0.f};
        cur = nxt; cA = nA; cB = nB; ++ui;
        if constexpr (ALIGN_EPI) { if (wr == 1) PG8_BAR; }
    }
    PG8_WAIT_V(0);
    if constexpr (!ALIGN_EPI) { if (wr == 0) PG8_BAR; }
    PG8_BAR;
    if constexpr (Epi::AFTER_DRAIN) { E.fused(acc, cur, wr, wc, fr, fq, lds, wid, lane); S.done(cur); }
#undef PG8_SA
#undef PG8_SB
#undef PG8_STAGE
#undef PG8_LDA
#undef PG8_LDB
#undef PG8_MMA
#undef PG8_WAIT_V
#undef PG8_WAIT_L
#undef PG8_BAR
#undef PG8_SCHED
}
}
namespace mk {
#define LAS __attribute__((address_space(3)))
typedef unsigned short bf16_t;
typedef float f32x4 __attribute__((ext_vector_type(4)));
typedef float f32x2 __attribute__((ext_vector_type(2)));
typedef unsigned u32x4 __attribute__((ext_vector_type(4)));
typedef unsigned u32x2 __attribute__((ext_vector_type(2)));
typedef __bf16 bf16x2_t __attribute__((ext_vector_type(2)));
typedef short bf16x8 __attribute__((ext_vector_type(8)));
typedef short s16x4 __attribute__((ext_vector_type(4)));
constexpr int D = 2048, NB = 4, S = 4096, T = NB * S, IN_LD = 5384, NP = 5632, NE = 16384;
constexpr int NTHR = 512, NWAVES = 8;
constexpr int LDS_BYTES = 160 * 1024;
constexpr int LDS_SPARE = 128 * 1024;
constexpr float EPS = 1e-6f;
constexpr int C_QA = 0, C_KA = 1024, C_VA = 1152, C_QH = 1280, C_FH = 1792, C_IH = 2304, C_GH = 2816, C_QM = 3328, C_KM = 3840, C_VM = 4352, C_OM = 4864, C_IM = 5376, C_FM = 5380;

constexpr size_t WS_CTL = 0;
constexpr size_t WS_WINT = 65536;
constexpr size_t WS_WOUTT = WS_WINT + 2 * (size_t)NP * D * 2;
constexpr size_t WS_WQT = WS_WOUTT + 2 * (size_t)D * D * 2;
constexpr size_t WS_SUBK = WS_WQT + 2 * (size_t)D * D * 2;
constexpr size_t WS_U8 = WS_SUBK + 2 * 2 * 8 * 128 * 128 * 2;
constexpr size_t WS_V8 = WS_U8 + 2 * (size_t)NE * D;
constexpr size_t WS_USC = WS_V8 + 2 * (size_t)NE * D;
constexpr size_t WS_VSC = WS_USC + 2 * (size_t)NE * 4;
constexpr size_t WS_ROPE = WS_VSC + 2 * (size_t)NE * 4;
constexpr size_t WS_SS = WS_ROPE + (size_t)S * 32 * 8;
constexpr size_t WS_SSP = WS_SS + (size_t)T * 4;
constexpr size_t WS_XB = WS_SSP + (size_t)T * 32 * 4;
constexpr size_t WS_P = WS_XB + (size_t)T * D * 2;
constexpr size_t WS_YB = WS_P + (size_t)T * NP * 2;
constexpr size_t WS_Q = WS_YB + (size_t)T * D * 2;
constexpr size_t WS_IDX = WS_Q + (size_t)T * D * 2;
constexpr size_t WS_GATE = WS_IDX + (size_t)T * 128 * 4;
constexpr size_t WS_X1 = WS_GATE + (size_t)T * 128 * 4;
constexpr size_t WS_X2 = WS_X1 + (size_t)T * D * 4;
constexpr size_t WS_END = WS_X2 + (size_t)T * D * 4;
static_assert(WS_END <= ((size_t)1 << 30), "workspace");
struct Params { const float* in[16]; float* out; unsigned char* ws; int ph_lo, ph_hi, layer, pad; };

__device__ __forceinline__ unsigned pk2(float lo, float hi) { f32x2 v = {lo, hi}; bf16x2_t b = __builtin_convertvector(v, bf16x2_t); return __builtin_bit_cast(unsigned, b); }
__device__ __forceinline__ float bf2f(unsigned short h) { return __uint_as_float((unsigned)h << 16); }
__device__ __forceinline__ float bflo(unsigned w) { return __uint_as_float(w << 16); }
__device__ __forceinline__ float bfhi(unsigned w) { return __uint_as_float(w & 0xffff0000u); }
__device__ __forceinline__ float wsum(float v) {
#pragma unroll
    for (int o = 1; o < 64; o <<= 1) v += __shfl_xor(v, o);
    return v;
}
__device__ __forceinline__ float wmax(float v) {
#pragma unroll
    for (int o = 1; o < 64; o <<= 1) v = fmaxf(v, __shfl_xor(v, o));
    return v;
}

__device__ __forceinline__ void transpose_item(const float* __restrict__ W, int ldw, int nvalid, const float* __restrict__ gain, bf16_t* __restrict__ WT, int K, int k0, int n0, LAS float* scr, int lane) {
    const int n = n0 + (lane & 31);
#pragma unroll 8
    for (int i = 0; i < 32; ++i) {
        const int kk = 2 * i + (lane >> 5);
        float v = 0.f;
        if (n < nvalid) v = W[(size_t)(k0 + kk) * ldw + n];
        if (gain) v *= gain[k0 + kk];
        scr[kk * 33 + (lane & 31)] = v;
    }
    __builtin_amdgcn_s_waitcnt(0xc07f);
    asm volatile("" ::: "memory");
    const int c = lane & 7;
#pragma unroll
    for (int j = 0; j < 4; ++j) {
        const int nn = (lane >> 3) + 8 * j;
        const LAS float* s = scr + (8 * c) * 33 + nn;
        u32x4 o; o.x = pk2(s[0 * 33], s[1 * 33]); o.y = pk2(s[2 * 33], s[3 * 33]); o.z = pk2(s[4 * 33], s[5 * 33]); o.w = pk2(s[6 * 33], s[7 * 33]);
        *(u32x4*)(WT + (size_t)(n0 + nn) * K + k0 + 8 * c) = o;
    }
    __builtin_amdgcn_s_waitcnt(0xc07f);
    asm volatile("" ::: "memory");
}
__device__ __forceinline__ void xprep_row(const float* __restrict__ xrow, bf16_t* __restrict__ orow, float* __restrict__ ss, int lane) {
    const f32x4* xr = (const f32x4*)xrow + lane;
    f32x4 v[8]; float s = 0.f;
#pragma unroll
    for (int j = 0; j < 8; ++j) { v[j] = xr[64 * j]; s += (v[j].x * v[j].x + v[j].y * v[j].y) + (v[j].z * v[j].z + v[j].w * v[j].w); }
    s = wsum(s);
    u32x2* o = (u32x2*)orow + lane;
#pragma unroll
    for (int j = 0; j < 8; ++j) { u32x2 w; w.x = pk2(v[j].x, v[j].y); w.y = pk2(v[j].z, v[j].w); o[64 * j] = w; }
    if (lane == 0) *ss = s;
}
__device__ __forceinline__ void fp8_row(const float* __restrict__ src, const float* __restrict__ gain, unsigned char* __restrict__ dst, float* __restrict__ sc, int lane) {
    f32x4 v[2][4]; float am = 0.f;
#pragma unroll
    for (int j = 0; j < 2; ++j)
#pragma unroll
        for (int q = 0; q < 4; ++q) {
            const int e = j * 1024 + lane * 16 + q * 4;
            f32x4 a = *(const f32x4*)(src + e);
            if (gain) a = a * *(const f32x4*)(gain + e);
            v[j][q] = a;
            am = fmaxf(am, fmaxf(fmaxf(fabsf(a.x), fabsf(a.y)), fmaxf(fabsf(a.z), fabsf(a.w))));
        }
    am = wmax(am);
    const float qs = am > 0.f ? 256.f / am : 1.f;
#pragma unroll
    for (int j = 0; j < 2; ++j) {
        u32x4 w;
#pragma unroll
        for (int q = 0; q < 4; ++q) {
            const f32x4 a = v[j][q] * qs;
            int pkd = __builtin_amdgcn_cvt_pk_fp8_f32(a.x, a.y, 0, false);
            pkd = __builtin_amdgcn_cvt_pk_fp8_f32(a.z, a.w, pkd, true);
            w[q] = (unsigned)pkd;
        }
        *(u32x4*)(dst + j * 1024 + lane * 16) = w;
    }
    if (lane == 0) *sc = am > 0.f ? am * (1.f / 256.f) : 1.f;
}

__device__ __forceinline__ void p0_prologue(const Params& p, LAS unsigned char* lds) {
    const int tid = threadIdx.x, lane = tid & 63, wave = tid >> 6;
    const int G = gridDim.x, gw = blockIdx.x * NWAVES + wave, ngw = G * NWAVES;
    const size_t gt = (size_t)blockIdx.x * NTHR + tid, ngt = (size_t)G * NTHR;
    unsigned char* ws = p.ws;
    const float* x = p.in[0]; const float* norm_mix = p.in[1]; const float* w_in = p.in[2]; const float* w_out = p.in[3];
    const float* norm_ffn = p.in[10]; const float* peer_query = p.in[11]; const float* sub_keys = p.in[12]; const float* peer_u = p.in[13]; const float* peer_v = p.in[14];
    {
        LAS float* scr = (LAS float*)(lds + wave * 8448);
        constexpr int I_IN = 32 * (NP / 32), I_SQ = 32 * (D / 32), PER_L = I_IN + 2 * I_SQ;
        for (int it = gw; it < 2 * PER_L; it += ngw) {
            const int l = it / PER_L; int r = it % PER_L;
            if (r < I_IN) { transpose_item(w_in + (size_t)l * D * IN_LD, IN_LD, IN_LD, norm_mix + l * D, (bf16_t*)(ws + WS_WINT) + (size_t)l * NP * D, D, (r / (NP / 32)) * 64, (r % (NP / 32)) * 32, scr, lane); continue; }
            r -= I_IN;
            if (r < I_SQ) { transpose_item(w_out + (size_t)l * D * D, D, D, nullptr, (bf16_t*)(ws + WS_WOUTT) + (size_t)l * D * D, D, (r / (D / 32)) * 64, (r % (D / 32)) * 32, scr, lane); continue; }
            r -= I_SQ;
            transpose_item(peer_query + (size_t)l * D * D, D, D, norm_ffn + l * D, (bf16_t*)(ws + WS_WQT) + (size_t)l * D * D, D, (r / (D / 32)) * 64, (r % (D / 32)) * 32, scr, lane);
        }
    }
    for (size_t i = gt; i < 2 * 2 * 8 * 128 * 128 / 4; i += ngt) {
        const f32x4 v = ((const f32x4*)sub_keys)[i];
        u32x2 w; w.x = pk2(v.x, v.y); w.y = pk2(v.z, v.w);
        ((u32x2*)(ws + WS_SUBK))[i] = w;
    }
    for (int r = gw; r < 4 * NE; r += ngw) {
        const int tb = r / (2 * NE), rr = r % (2 * NE), l = rr / NE;
        if (tb == 0) fp8_row(peer_u + (size_t)rr * D, norm_ffn + l * D, ws + WS_U8 + (size_t)rr * D, (float*)(ws + WS_USC) + rr, lane);
        else fp8_row(peer_v + (size_t)rr * D, nullptr, ws + WS_V8 + (size_t)rr * D, (float*)(ws + WS_VSC) + rr, lane);
    }
    for (size_t i = gt; i < (size_t)S * 32; i += ngt) {
        const int fi = (int)(i & 31), pos = (int)(i >> 5);
        const float inv = powf(10000.f, -(float)fi / 32.f);
        const float ang = (float)pos * inv;
        f32x2 cs; cs.x = cosf(ang); cs.y = sinf(ang);
        ((f32x2*)(ws + WS_ROPE))[i] = cs;
    }
    for (int t = gw; t < T; t += ngw) xprep_row(x + (size_t)t * D, (bf16_t*)(ws + WS_XB) + (size_t)t * D, (float*)(ws + WS_SS) + t, lane);
}

template <int NSS>
struct EpiScaleBf16 {
    static constexpr bool PERM = true, AFTER_DRAIN = false;
    bf16_t* O; int ldc; const float* ss;
    __device__ __forceinline__ void operator()(const pg8::f32x4 (&acc)[2][2][4][2], const pg8::Unit& u, int wr, int wc, int fr, int fq) const {
        const int row0 = u.pm * 256 + wr * 64 + fr, col0 = u.pn * 256 + wc * 32 + 8 * fq;
#pragma unroll
        for (int ai = 0; ai < 2; ++ai)
#pragma unroll
            for (int m = 0; m < 4; ++m) {
                const int row = row0 + ai * 128 + m * 16;
                float s;
                if (NSS == 1) s = ss[row];
                else {
                    const f32x4* sp = (const f32x4*)(ss + (size_t)row * 32);
                    f32x4 a = sp[0];
#pragma unroll
                    for (int i = 1; i < 8; ++i) a = a + sp[i];
                    s = (a.x + a.y) + (a.z + a.w);
                }
                const float r = rsqrtf(s * (1.f / D) + EPS);
                bf16_t* rowp = O + (size_t)row * ldc + col0;
#pragma unroll
                for (int bj = 0; bj < 2; ++bj) {
                    const pg8::f32x4 v0 = acc[ai][bj][m][0] * r, v1 = acc[ai][bj][m][1] * r;
                    u32x4 w; w.x = pk2(v0[0], v0[1]); w.y = pk2(v0[2], v0[3]); w.z = pk2(v1[0], v1[1]); w.w = pk2(v1[2], v1[3]);
                    *(u32x4*)(rowp + bj * 128) = w;
                }
            }
    }
};

struct EpiX1 {
    static constexpr bool PERM = false, AFTER_DRAIN = false;
    const float* xin; float* X1; bf16_t* X1B; float* ssp;
    __device__ __forceinline__ void operator()(const pg8::f32x4 (&acc)[2][2][4][2], const pg8::Unit& u, int wr, int wc, int fr, int fq) const {
        const int col0 = u.pn * 256 + wc * 32 + 4 * fq;
#pragma unroll
        for (int ai = 0; ai < 2; ++ai)
#pragma unroll
            for (int m = 0; m < 4; ++m) {
                const int row = u.pm * 256 + ai * 128 + wr * 64 + m * 16 + fr;
                float q = 0.f;
#pragma unroll
                for (int bj = 0; bj < 2; ++bj)
#pragma unroll
                    for (int n = 0; n < 2; ++n) {
                        const size_t off = (size_t)row * D + col0 + bj * 128 + n * 16;
                        const pg8::f32x4 o = *(const pg8::f32x4*)(xin + off) + acc[ai][bj][m][n];
                        *(pg8::f32x4*)(X1 + off) = o;
                        u32x2 w; w.x = pk2(o[0], o[1]); w.y = pk2(o[2], o[3]);
                        *(u32x2*)(X1B + off) = w;
                        q += (o[0] * o[0] + o[1] * o[1]) + (o[2] * o[2] + o[3] * o[3]);
                    }
                q += __shfl_xor(q, 16); q += __shfl_xor(q, 32);
                if (fq == 0) ssp[(size_t)row * 32 + u.pn * 4 + wc] = q;
            }
    }
};

#define TOPK_INSERT(L, x) do { _Pragma("unroll") for (int _i = 15; _i >= 1; --_i) L[_i] = __builtin_amdgcn_fmed3f(L[_i - 1], L[_i], (x)); L[0] = fmaxf(L[0], (x)); } while (0)
__device__ __forceinline__ void route_unit(const bf16_t* __restrict__ Q, const bf16_t* __restrict__ subk_l, int pm, int h, int* __restrict__ IDX, float* __restrict__ GATE,
                                           LAS float* scr  , int wave, int lane) {
    const int fr = lane & 15, fq = lane >> 4;
    float L1[16], L2[16];
#pragma unroll 1
    for (int nt = 0; nt < 2; ++nt) {
        const int tok = pm * 256 + wave * 32 + nt * 16 + fr;
#pragma unroll
        for (int half = 0; half < 2; ++half) {
            float L[16];
#pragma unroll
            for (int i = 0; i < 16; ++i) L[i] = -3.0e38f;
            bf16x8 bq[4];
            const bf16_t* qp = Q + (size_t)tok * D + h * 256 + half * 128 + 8 * fq;
#pragma unroll
            for (int ks = 0; ks < 4; ++ks) bq[ks] = *(const bf16x8*)(qp + ks * 32);
            const bf16_t* kb = subk_l + ((size_t)(half * 8 + h) * 128) * 128;
#pragma unroll 2
            for (int mt = 0; mt < 8; ++mt) {
                pg8::f32x4 acc = {0.f, 0.f, 0.f, 0.f};
                const bf16_t* kp = kb + (size_t)(mt * 16 + fr) * 128 + 8 * fq;
#pragma unroll
                for (int ks = 0; ks < 4; ++ks) {
                    const bf16x8 ak = *(const bf16x8*)(kp + ks * 32);
                    acc = __builtin_amdgcn_mfma_f32_16x16x32_bf16(ak, bq[ks], acc, 0, 0, 0);
                }
#pragma unroll
                for (int r = 0; r < 4; ++r) {
                    const unsigned key = (unsigned)(mt * 16 + 4 * fq + r);
                    const float xv = __uint_as_float((__float_as_uint(acc[r]) & 0xffffff80u) | key);
                    TOPK_INSERT(L, xv);
                }
            }
#pragma unroll
            for (int sh = 16; sh <= 32; sh <<= 1) {
                float o[16];
#pragma unroll
                for (int i = 0; i < 16; ++i) o[i] = __shfl_xor(L[i], sh);
#pragma unroll
                for (int i = 0; i < 16; ++i) TOPK_INSERT(L, o[i]);
            }
#pragma unroll
            for (int i = 0; i < 16; ++i) { if (half == 0) L1[i] = L[i]; else L2[i] = L[i]; }
        }
        float C[16];
#pragma unroll
        for (int i = 0; i < 16; ++i) C[i] = -3.0e38f;
#pragma unroll
        for (int a = 0; a < 16; ++a)
#pragma unroll
            for (int b = 0; b < 16; ++b)
                if ((a + 1) * (b + 1) <= 16) {
                    const float sm = L1[a] + L2[b];
                    const float xv = __uint_as_float((__float_as_uint(sm) & 0xffffff00u) | (unsigned)(a * 16 + b));
                    TOPK_INSERT(C, xv);
                }
        LAS float* my = scr + lane * 33;
#pragma unroll
        for (int i = 0; i < 16; ++i) { my[i] = L1[i]; my[16 + i] = L2[i]; }
        __builtin_amdgcn_s_waitcnt(0xc07f);
        asm volatile("" ::: "memory");
        const float mx = __uint_as_float(__float_as_uint(C[0]) & 0xffffff00u);
        float e[16], den = 0.f;
#pragma unroll
        for (int i = 0; i < 16; ++i) { e[i] = __expf(__uint_as_float(__float_as_uint(C[i]) & 0xffffff00u) - mx); den += e[i]; }
        const float rden = 1.f / den;
#pragma unroll
        for (int i = 0; i < 16; ++i) {
            if ((i >> 2) == fq) {
                const unsigned ab = __float_as_uint(C[i]) & 0xffu;
                const unsigned i1 = __float_as_uint(my[ab >> 4]) & 0x7fu, i2 = __float_as_uint(my[16 + (ab & 15)]) & 0x7fu;
                IDX[(size_t)tok * 128 + h * 16 + i] = (int)(i1 * 128 + i2);
                GATE[(size_t)tok * 128 + h * 16 + i] = e[i] * rden;
            }
        }
        __builtin_amdgcn_s_waitcnt(0xc07f);
        asm volatile("" ::: "memory");
    }
}

__device__ __forceinline__ float gelu_erf(float x) { return 0.5f * x * (1.f + erff(x * 0.70710678118654752f)); }
template <bool FINAL>
__device__ __forceinline__ void expert_token(int t, const bf16_t* __restrict__ X1B, const float* __restrict__ X1, const float* __restrict__ ssp, const int* __restrict__ IDX, const float* __restrict__ GATE,
                                             const unsigned char* __restrict__ U8, const float* __restrict__ USC, const unsigned char* __restrict__ V8, const float* __restrict__ VSC,
                                             float* __restrict__ X2, bf16_t* __restrict__ XB, float* __restrict__ SS, const float* __restrict__ norm_final, float* __restrict__ OUT, int lane) {
    float xf[2][16];
#pragma unroll
    for (int j = 0; j < 2; ++j) {
        const u32x4* xp = (const u32x4*)(X1B + (size_t)t * D + j * 1024 + lane * 16);
        const u32x4 a = xp[0], b = xp[1];
#pragma unroll
        for (int q = 0; q < 4; ++q) { xf[j][2 * q] = bflo(a[q]); xf[j][2 * q + 1] = bfhi(a[q]); xf[j][8 + 2 * q] = bflo(b[q]); xf[j][8 + 2 * q + 1] = bfhi(b[q]); }
    }
    float sp = (lane < 32) ? ssp[(size_t)t * 32 + lane] : 0.f;
    sp = wsum(sp);
    const float rs1 = rsqrtf(sp * (1.f / D) + EPS);
    const int id0 = IDX[(size_t)t * 128 + lane], id1 = IDX[(size_t)t * 128 + 64 + lane];
    const float g0 = GATE[(size_t)t * 128 + lane], g1 = GATE[(size_t)t * 128 + 64 + lane];
    const float us0 = USC[id0], us1 = USC[id1], vs0 = VSC[id0], vs1 = VSC[id1];
    float acc[2][16];
#pragma unroll
    for (int j = 0; j < 2; ++j)
#pragma unroll
        for (int i = 0; i < 16; ++i) acc[j][i] = 0.f;
    float act0 = 0.f, act1 = 0.f;
#pragma unroll 1
    for (int e0 = 0; e0 < 128; e0 += 4) {
        u32x4 w[4][2];
#pragma unroll
        for (int e = 0; e < 4; ++e) {
            const int ee = e0 + e;
            const int id = __builtin_amdgcn_readlane(ee < 64 ? id0 : id1, ee & 63);
            const unsigned char* up = U8 + (size_t)id * D + lane * 16;
            w[e][0] = *(const u32x4*)up; w[e][1] = *(const u32x4*)(up + 1024);
        }
        float d[4];
#pragma unroll
        for (int e = 0; e < 4; ++e) {
            float s = 0.f;
#pragma unroll
            for (int j = 0; j < 2; ++j)
#pragma unroll
                for (int q = 0; q < 4; ++q) {
                    const f32x2 lo = __builtin_amdgcn_cvt_pk_f32_fp8((int)w[e][j][q], false), hi = __builtin_amdgcn_cvt_pk_f32_fp8((int)w[e][j][q], true);
                    s = fmaf(lo.x, xf[j][4 * q], s); s = fmaf(lo.y, xf[j][4 * q + 1], s); s = fmaf(hi.x, xf[j][4 * q + 2], s); s = fmaf(hi.y, xf[j][4 * q + 3], s);
                }
            d[e] = wsum(s);
        }
#pragma unroll
        for (int e = 0; e < 4; ++e) {
            const int ee = e0 + e;
            if (ee < 64) { if (lane == ee) act0 = d[e]; } else { if (lane == ee - 64) act1 = d[e]; }
        }
    }
    act0 = gelu_erf(act0 * us0 * rs1) * g0 * vs0;
    act1 = gelu_erf(act1 * us1 * rs1) * g1 * vs1;
#pragma unroll 1
    for (int e0 = 0; e0 < 128; e0 += 4) {
        u32x4 w[4][2];
        float a[4];
#pragma unroll
        for (int e = 0; e < 4; ++e) {
            const int ee = e0 + e;
            const int id = __builtin_amdgcn_readlane(ee < 64 ? id0 : id1, ee & 63);
            a[e] = __int_as_float(__builtin_amdgcn_readlane(__float_as_int(ee < 64 ? act0 : act1), ee & 63));
            const unsigned char* vp = V8 + (size_t)id * D + lane * 16;
            w[e][0] = *(const u32x4*)vp; w[e][1] = *(const u32x4*)(vp + 1024);
        }
#pragma unroll
        for (int e = 0; e < 4; ++e)
#pragma unroll
            for (int j = 0; j < 2; ++j)
#pragma unroll
                for (int q = 0; q < 4; ++q) {
                    const f32x2 lo = __builtin_amdgcn_cvt_pk_f32_fp8((int)w[e][j][q], false), hi = __builtin_amdgcn_cvt_pk_f32_fp8((int)w[e][j][q], true);
                    acc[j][4 * q] = fmaf(a[e], lo.x, acc[j][4 * q]); acc[j][4 * q + 1] = fmaf(a[e], lo.y, acc[j][4 * q + 1]);
                    acc[j][4 * q + 2] = fmaf(a[e], hi.x, acc[j][4 * q + 2]); acc[j][4 * q + 3] = fmaf(a[e], hi.y, acc[j][4 * q + 3]);
                }
    }
    float q2 = 0.f;
#pragma unroll
    for (int j = 0; j < 2; ++j)
#pragma unroll
        for (int q = 0; q < 4; ++q) {
            const f32x4 r = *(const f32x4*)(X1 + (size_t)t * D + j * 1024 + lane * 16 + q * 4);
            acc[j][4 * q] += r.x; acc[j][4 * q + 1] += r.y; acc[j][4 * q + 2] += r.z; acc[j][4 * q + 3] += r.w;
            q2 += (acc[j][4 * q] * acc[j][4 * q] + acc[j][4 * q + 1] * acc[j][4 * q + 1]) + (acc[j][4 * q + 2] * acc[j][4 * q + 2] + acc[j][4 * q + 3] * acc[j][4 * q + 3]);
        }
    q2 = wsum(q2);
    if (FINAL) {
        const float rf = rsqrtf(q2 * (1.f / D) + EPS);
#pragma unroll
        for (int j = 0; j < 2; ++j)
#pragma unroll
            for (int q = 0; q < 4; ++q) {
                const int e = j * 1024 + lane * 16 + q * 4;
                const f32x4 g = *(const f32x4*)(norm_final + e);
                f32x4 o; o.x = acc[j][4 * q] * rf * g.x; o.y = acc[j][4 * q + 1] * rf * g.y; o.z = acc[j][4 * q + 2] * rf * g.z; o.w = acc[j][4 * q + 3] * rf * g.w;
                *(f32x4*)(OUT + (size_t)t * D + e) = o;
            }
    } else {
#pragma unroll
        for (int j = 0; j < 2; ++j) {
#pragma unroll
            for (int q = 0; q < 4; ++q) {
                f32x4 o; o.x = acc[j][4 * q]; o.y = acc[j][4 * q + 1]; o.z = acc[j][4 * q + 2]; o.w = acc[j][4 * q + 3];
                *(f32x4*)(X2 + (size_t)t * D + j * 1024 + lane * 16 + q * 4) = o;
            }
            u32x4 b0, b1;
#pragma unroll
            for (int q = 0; q < 4; ++q) { b0[q] = pk2(acc[j][2 * q], acc[j][2 * q + 1]); b1[q] = pk2(acc[j][8 + 2 * q], acc[j][8 + 2 * q + 1]); }
            u32x4* xo = (u32x4*)(XB + (size_t)t * D + j * 1024 + lane * 16);
            xo[0] = b0; xo[1] = b1;
        }
        if (lane == 0) SS[t] = q2;
    }
}

__global__ void __launch_bounds__(NTHR, 2) mega(Params p) {
    extern __shared__ __attribute__((aligned(16))) unsigned char lds_raw[];
    LAS unsigned char* lds = (LAS unsigned char*)lds_raw;
    unsigned char* ws = p.ws;
    const int G = gridDim.x;
    const int tid = threadIdx.x, lane = tid & 63, wave = __builtin_amdgcn_readfirstlane(tid >> 6);
    const int lo = p.ph_lo, hi = p.ph_hi;
    const int l = p.layer;
#define IN(k) (lo <= (k) && (k) < hi)
    if (IN(0)) p0_prologue(p, lds);
    if (IN(1)) {
        pg8::Gemm g{(const bf16_t*)(ws + WS_XB), (const bf16_t*)(ws + WS_WINT) + (size_t)l * NP * D, T, NP, D};
        pg8::StaticOrder So; So.init(T, NP, G, (int)blockIdx.x);
        EpiScaleBf16<1> E{(bf16_t*)(ws + WS_P), NP, (const float*)(ws + WS_SS)};
        pg8::gemm_phase<EpiScaleBf16<1>, pg8::StaticOrder, true, true>(lds, g, So, E);
    }
    if (IN(4)) {
        pg8::Gemm g{(const bf16_t*)(ws + WS_YB), (const bf16_t*)(ws + WS_WOUTT) + (size_t)l * D * D, T, D, D};
        pg8::StaticOrder So; So.init(T, D, G, (int)blockIdx.x);
        EpiX1 E{l == 0 ? p.in[0] : (const float*)(ws + WS_X2), (float*)(ws + WS_X1), (bf16_t*)(ws + WS_XB), (float*)(ws + WS_SSP)};
        pg8::gemm_phase<EpiX1, pg8::StaticOrder, true, true>(lds, g, So, E);
    }
    if (IN(5)) {
        pg8::Gemm g{(const bf16_t*)(ws + WS_XB), (const bf16_t*)(ws + WS_WQT) + (size_t)l * D * D, T, D, D};
        pg8::StaticOrder So; So.init(T, D, G, (int)blockIdx.x);
        EpiScaleBf16<32> E{(bf16_t*)(ws + WS_Q), D, (const float*)(ws + WS_SSP)};
        pg8::gemm_phase<EpiScaleBf16<32>, pg8::StaticOrder, true, true>(lds, g, So, E);
        pg8::Unit u;
        for (int i = 0; So.next(i, u); ++i)
            route_unit((const bf16_t*)(ws + WS_Q), (const bf16_t*)(ws + WS_SUBK) + (size_t)l * 2 * 8 * 128 * 128, u.pm, u.pn, (int*)(ws + WS_IDX), (float*)(ws + WS_GATE),
                       (LAS float*)(lds + wave * 8448), wave, lane);
    }
    if (IN(6)) {
        const int gw = blockIdx.x * NWAVES + wave, ngw = G * NWAVES;
        for (int t = gw; t < T; t += ngw) {
            if (l == 0)
                expert_token<false>(t, (const bf16_t*)(ws + WS_XB), (const float*)(ws + WS_X1), (const float*)(ws + WS_SSP), (const int*)(ws + WS_IDX), (const float*)(ws + WS_GATE),
                                    ws + WS_U8, (const float*)(ws + WS_USC), ws + WS_V8, (const float*)(ws + WS_VSC),
                                    (float*)(ws + WS_X2), (bf16_t*)(ws + WS_XB), (float*)(ws + WS_SS), nullptr, nullptr, lane);
            else
                expert_token<true>(t, (const bf16_t*)(ws + WS_XB), (const float*)(ws + WS_X1), (const float*)(ws + WS_SSP), (const int*)(ws + WS_IDX), (const float*)(ws + WS_GATE),
                                   ws + WS_U8 + (size_t)NE * D, (const float*)(ws + WS_USC) + NE, ws + WS_V8 + (size_t)NE * D, (const float*)(ws + WS_VSC) + NE,
                                   nullptr, nullptr, nullptr, p.in[15], p.out, lane);
        }
    }
#undef IN
}
__global__ __launch_bounds__(256) void shim_xprep_kernel(const float* __restrict__ X, bf16_t* __restrict__ XB, float* __restrict__ SS) {
    const int t = blockIdx.x * 4 + (threadIdx.x >> 6), lane = threadIdx.x & 63;
    xprep_row(X + (size_t)t * D, XB + (size_t)t * D, SS + t, lane);
}
}

extern "C" void kernel_launch(void* const* d_in, const int* in_sizes, int n_in, void* d_out, int out_size, void* d_ws, size_t ws_size, hipStream_t stream) {
    using namespace mk;
    static int grid = 0;
    if (grid == 0) {
        int dev = 0, cus = 0;
        (void)hipGetDevice(&dev); (void)hipDeviceGetAttribute(&cus, hipDeviceAttributeMultiprocessorCount, dev);
        if (hipFuncSetAttribute((const void*)mega, hipFuncAttributeMaxDynamicSharedMemorySize, LDS_BYTES) != hipSuccess) { fprintf(stderr, "kernel_launch: hipFuncSetAttribute failed\n"); grid = -1; return; }
        if (ws_size < WS_END) { fprintf(stderr, "kernel_launch: workspace too small: need %zu have %zu\n", (size_t)WS_END, ws_size); grid = -1; return; }
        grid = cus;
    }
    if (grid < 0) return;
    const float* sinks = (const float*)d_in[4];
    const float* lb_logits = (const float*)d_in[5];
    const float* hgrn_gain = (const float*)d_in[6];
    const float* conv_w = (const float*)d_in[7];
    const float* i_bias = (const float*)d_in[8];
    const float* f_bias = (const float*)d_in[9];
    unsigned char* ws = (unsigned char*)d_ws;
    nv2::bf_t* PB = (nv2::bf_t*)(ws + WS_P);
    nv2::bf_t* YB = (nv2::bf_t*)(ws + WS_YB);
    float* OH = (float*)(ws + WS_X1);

    Params p{};
    for (int i = 0; i < 16; ++i) p.in[i] = (const float*)d_in[i];
    p.out = (float*)d_out; p.ws = ws;
#define MEGA(lo_, hi_, l_) do { p.ph_lo = (lo_); p.ph_hi = (hi_); p.layer = (l_); hipLaunchKernelGGL(mega, dim3(grid), dim3(NTHR), LDS_BYTES, stream, p); } while (0)
    MEGA(0, 1, 0);
    for (int l = 0; l < 2; ++l) {
        MEGA(1, 2, l);
        nv2::rope_kernel<<<(T * 18 * 32 + 255) / 256, 256, 0, stream>>>(PB);
        nv2::attn_kernel<<<dim3(T, 16), 64, 0, stream>>>(PB, sinks + l * 16, YB);
        nv2::hgrn_kernel<<<64, 256, 0, stream>>>(PB, lb_logits, l, OH);
        nv2::hgrn_out_kernel<<<T, 256, 0, stream>>>(OH, PB, hgrn_gain + l * 512, YB);
        nv2::mlstm_kernel<<<64, 256, 0, stream>>>(PB, conv_w + (size_t)l * 4 * 1024, i_bias + l * 4, f_bias + l * 4, YB);
        MEGA(4, 5, l);
        MEGA(5, 6, l);
        MEGA(6, 7, l);
    }
#undef MEGA
}
```

```cpp
#include <hip/hip_runtime.h>
#include <hip/hip_cooperative_groups.h>
#include <math.h>
#include <stdio.h>
#include <stdint.h>
namespace pg8 {
#define PG8_LAS __attribute__((address_space(3)))
typedef unsigned short bf16_t;
typedef short bf16x8 __attribute__((ext_vector_type(8)));
typedef float f32x4 __attribute__((ext_vector_type(4)));
typedef unsigned u32x4 __attribute__((ext_vector_type(4)));
constexpr int BM = 256, BK = 64, HALF = 128, HTB = HALF * BK * 2  , STAGE_BYTES = 8 * HTB, NXCD = 8, WGM = 8;

__host__ __device__ __forceinline__ int lds_byte(int r, int c) { const int st = (r >> 4) * 2 + (c >> 5), rr = r & 15, cc = c & 31, ob = rr * 64 + cc * 2; return st * 1024 + (ob ^ (((ob >> 9) & 1) << 5)); }
__host__ __device__ __forceinline__ void stage_rc(int b, int& R, int& C) { const int st = b / 1024, sb = b % 1024, swz = sb ^ (((sb >> 9) & 1) << 5); R = (st >> 1) * 16 + swz / 64; C = (st & 1) * 32 + (swz % 64) / 2; }
__host__ __device__ __forceinline__ int perm32(int rho) { const int n = rho >> 4, i = rho & 15; return 8 * (i >> 2) + 4 * n + (i & 3); }

struct Unit { int pm, pn; };
struct Gemm { const bf16_t* A; const bf16_t* Bt; int M, N, K; };

struct StaticOrder {
    int nM, nN, nwg, G, c;
    __host__ __device__ void init(int M, int N, int G_, int c_) { nM = M / BM; nN = N / BM; nwg = nM * nN; G = G_; c = c_; }
    __host__ __device__ bool next(int i, Unit& u) const {
        const long L = (long)i * G + c; if (L >= nwg) return false;
        int wgid = (int)L; { const int q = nwg / NXCD, r = nwg % NXCD, xcd = wgid % NXCD, off = wgid / NXCD; wgid = (xcd < r ? xcd * (q + 1) : r * (q + 1) + (xcd - r) * q) + off; }
        const int nig = WGM * nN, gid = wgid / nig, fm = gid * WGM, gsz = (nM - fm) < WGM ? (nM - fm) : WGM;
        u.pm = fm + ((wgid % nig) % gsz); u.pn = (wgid % nig) / gsz; return true;
    }
    __device__ __forceinline__ void a_ready(const Unit&) const {}
    __device__ __forceinline__ void done(const Unit&) const {}
};

template <class Epi, class Sched, bool ALIGN_EPI = false, bool SP2 = false>
__device__ __forceinline__ void gemm_phase(PG8_LAS unsigned char* lds, const Gemm g, const Sched& S, const Epi& E) {
    const int tid = threadIdx.x, wid = __builtin_amdgcn_readfirstlane(tid >> 6), lane = tid & 63, wr = wid >> 2, wc = wid & 3, fr = lane & 15, fq = lane >> 4;
    const int K = g.K, nt = K / BK;
    unsigned voffA[2], voffB[2];
#pragma unroll
    for (int i = 0; i < 2; ++i) { int R, C; stage_rc(tid * 16 + i * 8192, R, C); const int Rb = Epi::PERM ? ((R & ~31) + perm32(R & 31)) : R;
        voffA[i] = (unsigned)(R * K + C) * 2u; voffB[i] = (unsigned)(Rb * K + C) * 2u; }
    const size_t kstep = (size_t)(BK * 2);
    const size_t hstep = (size_t)HALF * K * 2;
    const size_t tstep = 2 * hstep;
    const unsigned ldsw = (unsigned)wid * 1024u;
    const int aoff = lds_byte(wr * 64 + fr, fq * 8), boff = lds_byte(wc * 32 + fr, fq * 8);
#define PG8_SA(b, h) (((b) * 2 + (h)) * HTB)
#define PG8_SB(b, h) ((4 + (b) * 2 + (h)) * HTB)
#define PG8_STAGE(bufoff, gbase, voff) do { _Pragma("unroll") for (int _i = 0; _i < 2; ++_i) \
        __builtin_amdgcn_global_load_lds((const unsigned*)((const char*)(gbase) + (voff)[_i]), (PG8_LAS unsigned*)(lds + (bufoff) + ldsw + _i * 8192), 16, 0, 0); } while (0)
#define PG8_LDA(dst, b, h) do { _Pragma("unroll") for (int m = 0; m < 4; ++m) _Pragma("unroll") for (int k = 0; k < 2; ++k) dst[m][k] = *(const PG8_LAS bf16x8*)(lds + PG8_SA(b, h) + aoff + m * 2048 + k * 1024); } while (0)
#define PG8_LDB(dst, b, h) do { _Pragma("unroll") for (int n = 0; n < 2; ++n) _Pragma("unroll") for (int k = 0; k < 2; ++k) dst[n][k] = *(const PG8_LAS bf16x8*)(lds + PG8_SB(b, h) + boff + n * 2048 + k * 1024); } while (0)
#define PG8_MMA(ai, bj, At, Bt) do { __builtin_amdgcn_s_setprio(1); _Pragma("unroll") for (int m = 0; m < 4; ++m) _Pragma("unroll") for (int n = 0; n < 2; ++n) _Pragma("unroll") for (int k = 0; k < 2; ++k) \
        acc[ai][bj][m][n] = __builtin_amdgcn_mfma_f32_16x16x32_bf16(Bt[n][k], At[m][k], acc[ai][bj][m][n], 0, 0, 0); __builtin_amdgcn_s_setprio(0); } while (0)
#define PG8_WAIT_V(n) asm volatile("s_waitcnt vmcnt(" #n ")" ::: "memory")
#define PG8_WAIT_L(n) asm volatile("s_waitcnt lgkmcnt(" #n ")" ::: "memory")
#define PG8_BAR __builtin_amdgcn_s_barrier()
#define PG8_SCHED __builtin_amdgcn_sched_barrier(0)
    Unit cur, nxt; int ui = 0;
    if (!S.next(0, cur)) return;
    f32x4 acc[2][2][4][2];
#pragma unroll
    for (int a = 0; a < 2; ++a)
#pragma unroll
        for (int b = 0; b < 2; ++b)
#pragma unroll
            for (int m = 0; m < 4; ++m)
#pragma unroll
                for (int n = 0; n < 2; ++n) acc[a][b][m][n] = (f32x4){0.f, 0.f, 0.f, 0.f};
    bf16x8 At[4][2], B0[2][2], B1[2][2];
    const char* cA = (const char*)g.A + (size_t)cur.pm * tstep; const char* cB = (const char*)g.Bt + (size_t)cur.pn * tstep;
    S.a_ready(cur);
    if constexpr (SP2) {
        PG8_STAGE(PG8_SB(0, 0), cB, voffB); PG8_STAGE(PG8_SB(0, 1), cB + hstep, voffB); PG8_STAGE(PG8_SA(0, 0), cA, voffA); PG8_STAGE(PG8_SA(0, 1), cA + hstep, voffA);
        if (wr == 1) PG8_BAR;
        PG8_WAIT_V(2); PG8_BAR;
        PG8_STAGE(PG8_SB(1, 0), cB + kstep, voffB); PG8_STAGE(PG8_SA(1, 0), cA + kstep, voffA); PG8_STAGE(PG8_SB(1, 1), cB + hstep + kstep, voffB);
        PG8_WAIT_V(6); PG8_BAR;
    } else {
        PG8_STAGE(PG8_SB(0, 0), cB, voffB); PG8_STAGE(PG8_SA(0, 0), cA, voffA); PG8_STAGE(PG8_SB(0, 1), cB + hstep, voffB); PG8_STAGE(PG8_SA(0, 1), cA + hstep, voffA);
        if (wr == 1) PG8_BAR;
        PG8_WAIT_V(4); PG8_BAR;
        PG8_STAGE(PG8_SB(1, 0), cB + kstep, voffB); PG8_STAGE(PG8_SA(1, 0), cA + kstep, voffA); PG8_STAGE(PG8_SB(1, 1), cB + hstep + kstep, voffB);
        PG8_WAIT_V(6); PG8_BAR;
    }
    for (;;) {
        const bool has_next = S.next(ui + 1, nxt);
        const char* nA = has_next ? (const char*)g.A + (size_t)nxt.pm * tstep : cA; const char* nB = has_next ? (const char*)g.Bt + (size_t)nxt.pn * tstep : cB;
        for (int t = 0; t < nt; t += 2) {
            const bool last = (t == nt - 2);
            const char* a1 = cA + (size_t)(t + 1) * kstep;
            const char* a2 = last ? nA : cA + (size_t)(t + 2) * kstep; const char* b2 = last ? nB : cB + (size_t)(t + 2) * kstep;
            const char* a3 = a2 + kstep; const char* b3 = b2 + kstep;
            if (last && has_next) S.a_ready(nxt);
            if constexpr (SP2) {
            PG8_LDB(B0, 0, 0); PG8_LDB(B1, 0, 1); PG8_SCHED; PG8_LDA(At, 0, 0); PG8_STAGE(PG8_SA(1, 1), a1 + hstep, voffA);
            PG8_WAIT_V(8); PG8_WAIT_L(0); PG8_BAR; PG8_MMA(0, 0, At, B0); PG8_MMA(0, 1, At, B1); PG8_BAR; PG8_SCHED;
            PG8_LDA(At, 0, 1); PG8_STAGE(PG8_SB(0, 0), b2, voffB); PG8_STAGE(PG8_SB(0, 1), b2 + hstep, voffB); PG8_STAGE(PG8_SA(0, 0), a2, voffA);
            PG8_WAIT_V(8); PG8_WAIT_L(0); PG8_BAR; PG8_MMA(1, 0, At, B0); PG8_MMA(1, 1, At, B1); PG8_BAR; PG8_SCHED;
            PG8_LDB(B0, 1, 0); PG8_LDB(B1, 1, 1); PG8_SCHED; PG8_LDA(At, 1, 0); PG8_STAGE(PG8_SA(0, 1), a2 + hstep, voffA);
            PG8_WAIT_V(8); PG8_WAIT_L(0); PG8_BAR; PG8_MMA(0, 0, At, B0); PG8_MMA(0, 1, At, B1); PG8_BAR; PG8_SCHED;
            PG8_LDA(At, 1, 1); PG8_STAGE(PG8_SB(1, 0), b3, voffB); PG8_STAGE(PG8_SB(1, 1), b3 + hstep, voffB); PG8_STAGE(PG8_SA(1, 0), a3, voffA);
            PG8_WAIT_V(8); PG8_WAIT_L(0); PG8_BAR; PG8_MMA(1, 0, At, B0); PG8_MMA(1, 1, At, B1); PG8_BAR; PG8_SCHED;
            } else {
            PG8_LDB(B0, 0, 0); PG8_SCHED; PG8_LDA(At, 0, 0); PG8_STAGE(PG8_SA(1, 1), a1 + hstep, voffA);
            PG8_WAIT_L(8); PG8_BAR; PG8_WAIT_L(0); PG8_MMA(0, 0, At, B0); PG8_BAR; PG8_SCHED;
            PG8_LDB(B1, 0, 1); PG8_STAGE(PG8_SB(0, 0), b2, voffB);
            PG8_BAR; PG8_WAIT_L(0); PG8_MMA(0, 1, At, B1); PG8_BAR;
            PG8_LDA(At, 0, 1); PG8_STAGE(PG8_SA(0, 0), a2, voffA);
            PG8_BAR; PG8_WAIT_L(0); PG8_MMA(1, 0, At, B0); PG8_BAR; PG8_SCHED;
            PG8_STAGE(PG8_SB(0, 1), b2 + hstep, voffB);
            PG8_WAIT_V(6); PG8_BAR; PG8_MMA(1, 1, At, B1); PG8_BAR;
            PG8_LDB(B0, 1, 0); PG8_SCHED; PG8_LDA(At, 1, 0); PG8_STAGE(PG8_SA(0, 1), a2 + hstep, voffA);
            PG8_WAIT_L(8); PG8_BAR; PG8_WAIT_L(0); PG8_MMA(0, 0, At, B0); PG8_BAR; PG8_SCHED;
            PG8_LDB(B1, 1, 1); PG8_STAGE(PG8_SB(1, 0), b3, voffB);
            PG8_BAR; PG8_WAIT_L(0); PG8_MMA(0, 1, At, B1); PG8_BAR;
            PG8_LDA(At, 1, 1); PG8_STAGE(PG8_SA(1, 0), a3, voffA);
            PG8_BAR; PG8_WAIT_L(0); PG8_MMA(1, 0, At, B0); PG8_BAR; PG8_SCHED;
            PG8_STAGE(PG8_SB(1, 1), b3 + hstep, voffB);
            PG8_WAIT_V(6); PG8_BAR; PG8_MMA(1, 1, At, B1); PG8_BAR;
            }
        }
        if constexpr (ALIGN_EPI) { if (wr == 0) PG8_BAR; }
        if constexpr (!Epi::AFTER_DRAIN) { E(acc, cur, wr, wc, fr, fq); S.done(cur); }
        if (!has_next) break;
#pragma unroll
        for (int a = 0; a < 2; ++a)
#pragma unroll
            for (int b = 0; b < 2; ++b)
#pragma unroll
                for (int m = 0; m < 4; ++m)
#pragma unroll
                    for (int n = 0; n < 2; ++n) acc[a][b][m][n] = (f32x4){0.f, 0.f, 0.f, 0.f};
        cur = nxt; cA = nA; cB = nB; ++ui;
        if constexpr (ALIGN_EPI) { if (wr == 1) PG8_BAR; }
    }
    PG8_WAIT_V(0);
    if constexpr (!ALIGN_EPI) { if (wr == 0) PG8_BAR; }
    PG8_BAR;
    if constexpr (Epi::AFTER_DRAIN) { E.fused(acc, cur, wr, wc, fr, fq, lds, wid, lane); S.done(cur); }
#undef PG8_SA
#undef PG8_SB
#undef PG8_STAGE
#undef PG8_LDA
#undef PG8_LDB
#undef PG8_MMA
#undef PG8_WAIT_V
#undef PG8_WAIT_L
#undef PG8_BAR
#undef PG8_SCHED
}
}
namespace mk {
#define LAS __attribute__((address_space(3)))
typedef unsigned short bf16_t;
typedef float f32x4 __attribute__((ext_vector_type(4)));
typedef float f32x2 __attribute__((ext_vector_type(2)));
typedef unsigned u32x4 __attribute__((ext_vector_type(4)));
typedef unsigned u32x2 __attribute__((ext_vector_type(2)));
typedef __bf16 bf16x2_t __attribute__((ext_vector_type(2)));
typedef short bf16x8 __attribute__((ext_vector_type(8)));
typedef short s16x4 __attribute__((ext_vector_type(4)));
constexpr int D = 2048, NB = 4, S = 4096, T = NB * S, IN_LD = 5384, NP = 5632, NE = 16384;
constexpr int NTHR = 512, NWAVES = 8;
constexpr int LDS_BYTES = 160 * 1024;
constexpr int LDS_SPARE = 128 * 1024;
constexpr float EPS = 1e-6f;
constexpr int C_QA = 0, C_KA = 1024, C_VA = 1152, C_QH = 1280, C_FH = 1792, C_IH = 2304, C_GH = 2816, C_QM = 3328, C_KM = 3840, C_VM = 4352, C_OM = 4864, C_IM = 5376, C_FM = 5380;

constexpr size_t WS_CTL = 0;
constexpr size_t WS_WINT = 65536;
constexpr size_t WS_WOUTT = WS_WINT + 2 * (size_t)NP * D * 2;
constexpr size_t WS_WQT = WS_WOUTT + 2 * (size_t)D * D * 2;
constexpr size_t WS_SUBK = WS_WQT + 2 * (size_t)D * D * 2;
constexpr size_t WS_U8 = WS_SUBK + 2 * 2 * 8 * 128 * 128 * 2;
constexpr size_t WS_V8 = WS_U8 + 2 * (size_t)NE * D;
constexpr size_t WS_USC = WS_V8 + 2 * (size_t)NE * D;
constexpr size_t WS_VSC = WS_USC + 2 * (size_t)NE * 4;
constexpr size_t WS_ROPE = WS_VSC + 2 * (size_t)NE * 4;
constexpr size_t WS_SS = WS_ROPE + (size_t)S * 32 * 8;
constexpr size_t WS_SSP = WS_SS + (size_t)T * 4;
constexpr size_t WS_XB = WS_SSP + (size_t)T * 32 * 4;
constexpr size_t WS_P = WS_XB + (size_t)T * D * 2;
constexpr size_t WS_YB = WS_P + (size_t)T * NP * 2;
constexpr size_t WS_Q = WS_YB + (size_t)T * D * 2;
constexpr size_t WS_IDX = WS_Q + (size_t)T * D * 2;
constexpr size_t WS_GATE = WS_IDX + (size_t)T * 128 * 4;
constexpr size_t WS_X1 = WS_GATE + (size_t)T * 128 * 4;
constexpr size_t WS_X2 = WS_X1 + (size_t)T * D * 4;
constexpr size_t WS_STH = WS_X2 + (size_t)T * D * 4;
constexpr size_t WS_STM = WS_STH + (size_t)128 * 16640 * 4;
constexpr size_t WS_END = WS_STM + (size_t)128 * 16640 * 4;
static_assert(WS_END <= ((size_t)1 << 30), "workspace");
struct Params { const float* in[16]; float* out; unsigned char* ws; int ph_lo, ph_hi, layer, layer_hi, pad, pad2; };

__device__ __forceinline__ unsigned pk2(float lo, float hi) { f32x2 v = {lo, hi}; bf16x2_t b = __builtin_convertvector(v, bf16x2_t); return __builtin_bit_cast(unsigned, b); }
__device__ __forceinline__ float bf2f(unsigned short h) { return __uint_as_float((unsigned)h << 16); }
__device__ __forceinline__ float bflo(unsigned w) { return __uint_as_float(w << 16); }
__device__ __forceinline__ float bfhi(unsigned w) { return __uint_as_float(w & 0xffff0000u); }
__device__ __forceinline__ float wsum(float v) {
#pragma unroll
    for (int o = 1; o < 64; o <<= 1) v += __shfl_xor(v, o);
    return v;
}
__device__ __forceinline__ float wmax(float v) {
#pragma unroll
    for (int o = 1; o < 64; o <<= 1) v = fmaxf(v, __shfl_xor(v, o));
    return v;
}

__device__ __forceinline__ void transpose_item(const float* __restrict__ W, int ldw, int nvalid, const float* __restrict__ gain, bf16_t* __restrict__ WT, int K, int k0, int n0, LAS float* scr, int lane) {
    const int n = n0 + (lane & 31);
#pragma unroll 8
    for (int i = 0; i < 32; ++i) {
        const int kk = 2 * i + (lane >> 5);
        float v = 0.f;
        if (n < nvalid) v = W[(size_t)(k0 + kk) * ldw + n];
        if (gain) v *= gain[k0 + kk];
        scr[kk * 33 + (lane & 31)] = v;
    }
    __builtin_amdgcn_s_waitcnt(0xc07f);
    asm volatile("" ::: "memory");
    const int c = lane & 7;
#pragma unroll
    for (int j = 0; j < 4; ++j) {
        const int nn = (lane >> 3) + 8 * j;
        const LAS float* s = scr + (8 * c) * 33 + nn;
        u32x4 o; o.x = pk2(s[0 * 33], s[1 * 33]); o.y = pk2(s[2 * 33], s[3 * 33]); o.z = pk2(s[4 * 33], s[5 * 33]); o.w = pk2(s[6 * 33], s[7 * 33]);
        *(u32x4*)(WT + (size_t)(n0 + nn) * K + k0 + 8 * c) = o;
    }
    __builtin_amdgcn_s_waitcnt(0xc07f);
    asm volatile("" ::: "memory");
}
__device__ __forceinline__ void xprep_row(const float* __restrict__ xrow, bf16_t* __restrict__ orow, float* __restrict__ ss, int lane) {
    const f32x4* xr = (const f32x4*)xrow + lane;
    f32x4 v[8]; float s = 0.f;
#pragma unroll
    for (int j = 0; j < 8; ++j) { v[j] = xr[64 * j]; s += (v[j].x * v[j].x + v[j].y * v[j].y) + (v[j].z * v[j].z + v[j].w * v[j].w); }
    s = wsum(s);
    u32x2* o = (u32x2*)orow + lane;
#pragma unroll
    for (int j = 0; j < 8; ++j) { u32x2 w; w.x = pk2(v[j].x, v[j].y); w.y = pk2(v[j].z, v[j].w); o[64 * j] = w; }
    if (lane == 0) *ss = s;
}
__device__ __forceinline__ void fp8_row(const float* __restrict__ src, const float* __restrict__ gain, unsigned char* __restrict__ dst, float* __restrict__ sc, int lane) {
    f32x4 v[2][4]; float am = 0.f;
#pragma unroll
    for (int j = 0; j < 2; ++j)
#pragma unroll
        for (int q = 0; q < 4; ++q) {
            const int e = j * 1024 + lane * 16 + q * 4;
            f32x4 a = *(const f32x4*)(src + e);
            if (gain) a = a * *(const f32x4*)(gain + e);
            v[j][q] = a;
            am = fmaxf(am, fmaxf(fmaxf(fabsf(a.x), fabsf(a.y)), fmaxf(fabsf(a.z), fabsf(a.w))));
        }
    am = wmax(am);
    const float qs = am > 0.f ? 256.f / am : 1.f;
#pragma unroll
    for (int j = 0; j < 2; ++j) {
        u32x4 w;
#pragma unroll
        for (int q = 0; q < 4; ++q) {
            const f32x4 a = v[j][q] * qs;
            int pkd = __builtin_amdgcn_cvt_pk_fp8_f32(a.x, a.y, 0, false);
            pkd = __builtin_amdgcn_cvt_pk_fp8_f32(a.z, a.w, pkd, true);
            w[q] = (unsigned)pkd;
        }
        *(u32x4*)(dst + j * 1024 + lane * 16) = w;
    }
    if (lane == 0) *sc = am > 0.f ? am * (1.f / 256.f) : 1.f;
}

__device__ __forceinline__ void p0_prologue(const Params& p, LAS unsigned char* lds) {
    const int tid = threadIdx.x, lane = tid & 63, wave = tid >> 6;
    const int G = gridDim.x, gw = blockIdx.x * NWAVES + wave, ngw = G * NWAVES;
    const size_t gt = (size_t)blockIdx.x * NTHR + tid, ngt = (size_t)G * NTHR;
    unsigned char* ws = p.ws;
    const float* x = p.in[0]; const float* norm_mix = p.in[1]; const float* w_in = p.in[2]; const float* w_out = p.in[3];
    const float* norm_ffn = p.in[10]; const float* peer_query = p.in[11]; const float* sub_keys = p.in[12]; const float* peer_u = p.in[13]; const float* peer_v = p.in[14];
    {
        LAS float* scr = (LAS float*)(lds + wave * 8448);
        constexpr int I_IN = 32 * (NP / 32), I_SQ = 32 * (D / 32), PER_L = I_IN + 2 * I_SQ;
        for (int it = gw; it < 2 * PER_L; it += ngw) {
            const int l = it / PER_L; int r = it % PER_L;
            if (r < I_IN) { transpose_item(w_in + (size_t)l * D * IN_LD, IN_LD, IN_LD, norm_mix + l * D, (bf16_t*)(ws + WS_WINT) + (size_t)l * NP * D, D, (r / (NP / 32)) * 64, (r % (NP / 32)) * 32, scr, lane); continue; }
            r -= I_IN;
            if (r < I_SQ) { transpose_item(w_out + (size_t)l * D * D, D, D, nullptr, (bf16_t*)(ws + WS_WOUTT) + (size_t)l * D * D, D, (r / (D / 32)) * 64, (r % (D / 32)) * 32, scr, lane); continue; }
            r -= I_SQ;
            transpose_item(peer_query + (size_t)l * D * D, D, D, norm_ffn + l * D, (bf16_t*)(ws + WS_WQT) + (size_t)l * D * D, D, (r / (D / 32)) * 64, (r % (D / 32)) * 32, scr, lane);
        }
    }
    for (size_t i = gt; i < 2 * 2 * 8 * 128 * 128 / 4; i += ngt) {
        const f32x4 v = ((const f32x4*)sub_keys)[i];
        u32x2 w; w.x = pk2(v.x, v.y); w.y = pk2(v.z, v.w);
        ((u32x2*)(ws + WS_SUBK))[i] = w;
    }
    for (int r = gw; r < 4 * NE; r += ngw) {
        const int tb = r / (2 * NE), rr = r % (2 * NE), l = rr / NE;
        if (tb == 0) fp8_row(peer_u + (size_t)rr * D, norm_ffn + l * D, ws + WS_U8 + (size_t)rr * D, (float*)(ws + WS_USC) + rr, lane);
        else fp8_row(peer_v + (size_t)rr * D, nullptr, ws + WS_V8 + (size_t)rr * D, (float*)(ws + WS_VSC) + rr, lane);
    }
    for (size_t i = gt; i < (size_t)S * 32; i += ngt) {
        const int fi = (int)(i & 31), pos = (int)(i >> 5);
        const float inv = powf(10000.f, -(float)fi / 32.f);
        const float ang = (float)pos * inv;
        f32x2 cs; cs.x = cosf(ang); cs.y = sinf(ang);
        ((f32x2*)(ws + WS_ROPE))[i] = cs;
    }
    for (int t = gw; t < T; t += ngw) xprep_row(x + (size_t)t * D, (bf16_t*)(ws + WS_XB) + (size_t)t * D, (float*)(ws + WS_SS) + t, lane);
}

template <int NSS>
struct EpiScaleBf16 {
    static constexpr bool PERM = true, AFTER_DRAIN = false;
    bf16_t* O; int ldc; const float* ss;
    __device__ __forceinline__ void operator()(const pg8::f32x4 (&acc)[2][2][4][2], const pg8::Unit& u, int wr, int wc, int fr, int fq) const {
        const int row0 = u.pm * 256 + wr * 64 + fr, col0 = u.pn * 256 + wc * 32 + 8 * fq;
#pragma unroll
        for (int ai = 0; ai < 2; ++ai)
#pragma unroll
            for (int m = 0; m < 4; ++m) {
                const int row = row0 + ai * 128 + m * 16;
                float s;
                if (NSS == 1) s = ss[row];
                else {
                    const f32x4* sp = (const f32x4*)(ss + (size_t)row * 32);
                    f32x4 a = sp[0];
#pragma unroll
                    for (int i = 1; i < 8; ++i) a = a + sp[i];
                    s = (a.x + a.y) + (a.z + a.w);
                }
                const float r = rsqrtf(s * (1.f / D) + EPS);
                bf16_t* rowp = O + (size_t)row * ldc + col0;
#pragma unroll
                for (int bj = 0; bj < 2; ++bj) {
                    const pg8::f32x4 v0 = acc[ai][bj][m][0] * r, v1 = acc[ai][bj][m][1] * r;
                    u32x4 w; w.x = pk2(v0[0], v0[1]); w.y = pk2(v0[2], v0[3]); w.z = pk2(v1[0], v1[1]); w.w = pk2(v1[2], v1[3]);
                    *(u32x4*)(rowp + bj * 128) = w;
                }
            }
    }
};

struct EpiX1 {
    static constexpr bool PERM = false, AFTER_DRAIN = false;
    const float* xin; float* X1; bf16_t* X1B; float* ssp;
    __device__ __forceinline__ void operator()(const pg8::f32x4 (&acc)[2][2][4][2], const pg8::Unit& u, int wr, int wc, int fr, int fq) const {
        const int col0 = u.pn * 256 + wc * 32 + 4 * fq;
#pragma unroll
        for (int ai = 0; ai < 2; ++ai)
#pragma unroll
            for (int m = 0; m < 4; ++m) {
                const int row = u.pm * 256 + ai * 128 + wr * 64 + m * 16 + fr;
                float q = 0.f;
#pragma unroll
                for (int bj = 0; bj < 2; ++bj)
#pragma unroll
                    for (int n = 0; n < 2; ++n) {
                        const size_t off = (size_t)row * D + col0 + bj * 128 + n * 16;
                        const pg8::f32x4 o = *(const pg8::f32x4*)(xin + off) + acc[ai][bj][m][n];
                        *(pg8::f32x4*)(X1 + off) = o;
                        u32x2 w; w.x = pk2(o[0], o[1]); w.y = pk2(o[2], o[3]);
                        *(u32x2*)(X1B + off) = w;
                        q += (o[0] * o[0] + o[1] * o[1]) + (o[2] * o[2] + o[3] * o[3]);
                    }
                q += __shfl_xor(q, 16); q += __shfl_xor(q, 32);
                if (fq == 0) ssp[(size_t)row * 32 + u.pn * 4 + wc] = q;
            }
    }
};

#define TOPK_INSERT(L, x) do { _Pragma("unroll") for (int _i = 15; _i >= 1; --_i) L[_i] = __builtin_amdgcn_fmed3f(L[_i - 1], L[_i], (x)); L[0] = fmaxf(L[0], (x)); } while (0)
__device__ __forceinline__ void route_unit(const bf16_t* __restrict__ Q, const bf16_t* __restrict__ subk_l, int pm, int h, int* __restrict__ IDX, float* __restrict__ GATE,
                                           LAS float* scr  , int wave, int lane) {
    const int fr = lane & 15, fq = lane >> 4;
    float L1[16], L2[16];
#pragma unroll 1
    for (int nt = 0; nt < 2; ++nt) {
        const int tok = pm * 256 + wave * 32 + nt * 16 + fr;
#pragma unroll
        for (int half = 0; half < 2; ++half) {
            float L[16];
#pragma unroll
            for (int i = 0; i < 16; ++i) L[i] = -3.0e38f;
            bf16x8 bq[4];
            const bf16_t* qp = Q + (size_t)tok * D + h * 256 + half * 128 + 8 * fq;
#pragma unroll
            for (int ks = 0; ks < 4; ++ks) bq[ks] = *(const bf16x8*)(qp + ks * 32);
            const bf16_t* kb = subk_l + ((size_t)(half * 8 + h) * 128) * 128;
#pragma unroll 2
            for (int mt = 0; mt < 8; ++mt) {
                pg8::f32x4 acc = {0.f, 0.f, 0.f, 0.f};
                const bf16_t* kp = kb + (size_t)(mt * 16 + fr) * 128 + 8 * fq;
#pragma unroll
                for (int ks = 0; ks < 4; ++ks) {
                    const bf16x8 ak = *(const bf16x8*)(kp + ks * 32);
                    acc = __builtin_amdgcn_mfma_f32_16x16x32_bf16(ak, bq[ks], acc, 0, 0, 0);
                }
#pragma unroll
                for (int r = 0; r < 4; ++r) {
                    const unsigned key = (unsigned)(mt * 16 + 4 * fq + r);
                    const float xv = __uint_as_float((__float_as_uint(acc[r]) & 0xffffff80u) | key);
                    TOPK_INSERT(L, xv);
                }
            }
#pragma unroll
            for (int sh = 16; sh <= 32; sh <<= 1) {
                float o[16];
#pragma unroll
                for (int i = 0; i < 16; ++i) o[i] = __shfl_xor(L[i], sh);
#pragma unroll
                for (int i = 0; i < 16; ++i) TOPK_INSERT(L, o[i]);
            }
#pragma unroll
            for (int i = 0; i < 16; ++i) { if (half == 0) L1[i] = L[i]; else L2[i] = L[i]; }
        }
        float C[16];
#pragma unroll
        for (int i = 0; i < 16; ++i) C[i] = -3.0e38f;
#pragma unroll
        for (int a = 0; a < 16; ++a)
#pragma unroll
            for (int b = 0; b < 16; ++b)
                if ((a + 1) * (b + 1) <= 16) {
                    const float sm = L1[a] + L2[b];
                    const float xv = __uint_as_float((__float_as_uint(sm) & 0xffffff00u) | (unsigned)(a * 16 + b));
                    TOPK_INSERT(C, xv);
                }
        LAS float* my = scr + lane * 33;
#pragma unroll
        for (int i = 0; i < 16; ++i) { my[i] = L1[i]; my[16 + i] = L2[i]; }
        __builtin_amdgcn_s_waitcnt(0xc07f);
        asm volatile("" ::: "memory");
        const float mx = __uint_as_float(__float_as_uint(C[0]) & 0xffffff00u);
        float e[16], den = 0.f;
#pragma unroll
        for (int i = 0; i < 16; ++i) { e[i] = __expf(__uint_as_float(__float_as_uint(C[i]) & 0xffffff00u) - mx); den += e[i]; }
        const float rden = 1.f / den;
#pragma unroll
        for (int i = 0; i < 16; ++i) {
            if ((i >> 2) == fq) {
                const unsigned ab = __float_as_uint(C[i]) & 0xffu;
                const unsigned i1 = __float_as_uint(my[ab >> 4]) & 0x7fu, i2 = __float_as_uint(my[16 + (ab & 15)]) & 0x7fu;
                IDX[(size_t)tok * 128 + h * 16 + i] = (int)(i1 * 128 + i2);
                GATE[(size_t)tok * 128 + h * 16 + i] = e[i] * rden;
            }
        }
        __builtin_amdgcn_s_waitcnt(0xc07f);
        asm volatile("" ::: "memory");
    }
}

__device__ __forceinline__ float gelu_erf(float x) { return 0.5f * x * (1.f + erff(x * 0.70710678118654752f)); }
template <bool FINAL>
__device__ __forceinline__ void expert_token(int t, const bf16_t* __restrict__ X1B, const float* __restrict__ X1, const float* __restrict__ ssp, const int* __restrict__ IDX, const float* __restrict__ GATE,
                                             const unsigned char* __restrict__ U8, const float* __restrict__ USC, const unsigned char* __restrict__ V8, const float* __restrict__ VSC,
                                             float* __restrict__ X2, bf16_t* __restrict__ XB, float* __restrict__ SS, const float* __restrict__ norm_final, float* __restrict__ OUT, int lane) {
    float xf[2][16];
#pragma unroll
    for (int j = 0; j < 2; ++j) {
        const u32x4* xp = (const u32x4*)(X1B + (size_t)t * D + j * 1024 + lane * 16);
        const u32x4 a = xp[0], b = xp[1];
#pragma unroll
        for (int q = 0; q < 4; ++q) { xf[j][2 * q] = bflo(a[q]); xf[j][2 * q + 1] = bfhi(a[q]); xf[j][8 + 2 * q] = bflo(b[q]); xf[j][8 + 2 * q + 1] = bfhi(b[q]); }
    }
    float sp = (lane < 32) ? ssp[(size_t)t * 32 + lane] : 0.f;
    sp = wsum(sp);
    const float rs1 = rsqrtf(sp * (1.f / D) + EPS);
    const int id0 = IDX[(size_t)t * 128 + lane], id1 = IDX[(size_t)t * 128 + 64 + lane];
    const float g0 = GATE[(size_t)t * 128 + lane], g1 = GATE[(size_t)t * 128 + 64 + lane];
    const float us0 = USC[id0], us1 = USC[id1], vs0 = VSC[id0], vs1 = VSC[id1];
    float acc[2][16];
#pragma unroll
    for (int j = 0; j < 2; ++j)
#pragma unroll
        for (int i = 0; i < 16; ++i) acc[j][i] = 0.f;
    float act0 = 0.f, act1 = 0.f;
#pragma unroll 1
    for (int e0 = 0; e0 < 128; e0 += 4) {
        u32x4 w[4][2];
#pragma unroll
        for (int e = 0; e < 4; ++e) {
            const int ee = e0 + e;
            const int id = __builtin_amdgcn_readlane(ee < 64 ? id0 : id1, ee & 63);
            const unsigned char* up = U8 + (size_t)id * D + lane * 16;
            w[e][0] = *(const u32x4*)up; w[e][1] = *(const u32x4*)(up + 1024);
        }
        float d[4];
#pragma unroll
        for (int e = 0; e < 4; ++e) {
            float s = 0.f;
#pragma unroll
            for (int j = 0; j < 2; ++j)
#pragma unroll
                for (int q = 0; q < 4; ++q) {
                    const f32x2 lo = __builtin_amdgcn_cvt_pk_f32_fp8((int)w[e][j][q], false), hi = __builtin_amdgcn_cvt_pk_f32_fp8((int)w[e][j][q], true);
                    s = fmaf(lo.x, xf[j][4 * q], s); s = fmaf(lo.y, xf[j][4 * q + 1], s); s = fmaf(hi.x, xf[j][4 * q + 2], s); s = fmaf(hi.y, xf[j][4 * q + 3], s);
                }
            d[e] = wsum(s);
        }
#pragma unroll
        for (int e = 0; e < 4; ++e) {
            const int ee = e0 + e;
            if (ee < 64) { if (lane == ee) act0 = d[e]; } else { if (lane == ee - 64) act1 = d[e]; }
        }
    }
    act0 = gelu_erf(act0 * us0 * rs1) * g0 * vs0;
    act1 = gelu_erf(act1 * us1 * rs1) * g1 * vs1;
#pragma unroll 1
    for (int e0 = 0; e0 < 128; e0 += 4) {
        u32x4 w[4][2];
        float a[4];
#pragma unroll
        for (int e = 0; e < 4; ++e) {
            const int ee = e0 + e;
            const int id = __builtin_amdgcn_readlane(ee < 64 ? id0 : id1, ee & 63);
            a[e] = __int_as_float(__builtin_amdgcn_readlane(__float_as_int(ee < 64 ? act0 : act1), ee & 63));
            const unsigned char* vp = V8 + (size_t)id * D + lane * 16;
            w[e][0] = *(const u32x4*)vp; w[e][1] = *(const u32x4*)(vp + 1024);
        }
#pragma unroll
        for (int e = 0; e < 4; ++e)
#pragma unroll
            for (int j = 0; j < 2; ++j)
#pragma unroll
                for (int q = 0; q < 4; ++q) {
                    const f32x2 lo = __builtin_amdgcn_cvt_pk_f32_fp8((int)w[e][j][q], false), hi = __builtin_amdgcn_cvt_pk_f32_fp8((int)w[e][j][q], true);
                    acc[j][4 * q] = fmaf(a[e], lo.x, acc[j][4 * q]); acc[j][4 * q + 1] = fmaf(a[e], lo.y, acc[j][4 * q + 1]);
                    acc[j][4 * q + 2] = fmaf(a[e], hi.x, acc[j][4 * q + 2]); acc[j][4 * q + 3] = fmaf(a[e], hi.y, acc[j][4 * q + 3]);
                }
    }
    float q2 = 0.f;
#pragma unroll
    for (int j = 0; j < 2; ++j)
#pragma unroll
        for (int q = 0; q < 4; ++q) {
            const f32x4 r = *(const f32x4*)(X1 + (size_t)t * D + j * 1024 + lane * 16 + q * 4);
            acc[j][4 * q] += r.x; acc[j][4 * q + 1] += r.y; acc[j][4 * q + 2] += r.z; acc[j][4 * q + 3] += r.w;
            q2 += (acc[j][4 * q] * acc[j][4 * q] + acc[j][4 * q + 1] * acc[j][4 * q + 1]) + (acc[j][4 * q + 2] * acc[j][4 * q + 2] + acc[j][4 * q + 3] * acc[j][4 * q + 3]);
        }
    q2 = wsum(q2);
    if (FINAL) {
        const float rf = rsqrtf(q2 * (1.f / D) + EPS);
#pragma unroll
        for (int j = 0; j < 2; ++j)
#pragma unroll
            for (int q = 0; q < 4; ++q) {
                const int e = j * 1024 + lane * 16 + q * 4;
                const f32x4 g = *(const f32x4*)(norm_final + e);
                f32x4 o; o.x = acc[j][4 * q] * rf * g.x; o.y = acc[j][4 * q + 1] * rf * g.y; o.z = acc[j][4 * q + 2] * rf * g.z; o.w = acc[j][4 * q + 3] * rf * g.w;
                *(f32x4*)(OUT + (size_t)t * D + e) = o;
            }
    } else {
#pragma unroll
        for (int j = 0; j < 2; ++j) {
#pragma unroll
            for (int q = 0; q < 4; ++q) {
                f32x4 o; o.x = acc[j][4 * q]; o.y = acc[j][4 * q + 1]; o.z = acc[j][4 * q + 2]; o.w = acc[j][4 * q + 3];
                *(f32x4*)(X2 + (size_t)t * D + j * 1024 + lane * 16 + q * 4) = o;
            }
            u32x4 b0, b1;
#pragma unroll
            for (int q = 0; q < 4; ++q) { b0[q] = pk2(acc[j][2 * q], acc[j][2 * q + 1]); b1[q] = pk2(acc[j][8 + 2 * q], acc[j][8 + 2 * q + 1]); }
            u32x4* xo = (u32x4*)(XB + (size_t)t * D + j * 1024 + lane * 16);
            xo[0] = b0; xo[1] = b1;
        }
        if (lane == 0) SS[t] = q2;
    }
}
}

namespace mk {
constexpr int KS_LD = 72, VS_LD = 80;
constexpr int ATT_KS_OFF = 0, ATT_VS_OFF = 256 * KS_LD * 2;
constexpr int ATT_LDS = ATT_VS_OFF + 256 * VS_LD * 2;

__device__ __forceinline__ bf16x8 tr_pair(const LAS bf16_t* p0, const LAS bf16_t* p1) {
    const s16x4 a = __builtin_amdgcn_ds_read_tr16_b64_v4i16((LAS s16x4*)p0);
    const s16x4 b = __builtin_amdgcn_ds_read_tr16_b64_v4i16((LAS s16x4*)p1);
    bf16x8 r; r[0] = a[0]; r[1] = a[1]; r[2] = a[2]; r[3] = a[3]; r[4] = b[0]; r[5] = b[1]; r[6] = b[2]; r[7] = b[3];
    return r;
}

__device__ __forceinline__ void attn_unit(const bf16_t* __restrict__ P, const f32x2* __restrict__ rope, const float* __restrict__ sinks_l, bf16_t* __restrict__ Y,
                                          int unit, LAS unsigned char* lds, int tid, int lane, int wave) {
    const int b = unit >> 6, n = (unit >> 1) & 31, kvh = unit & 1;
    const int tok0 = b * S + n * 128;
    LAS bf16_t* KS = (LAS bf16_t*)(lds + ATT_KS_OFF);
    LAS bf16_t* VS = (LAS bf16_t*)(lds + ATT_VS_OFF);
    {
        const int key = tid >> 1, part = tid & 1;
        const int kpos = n * 128 - 128 + key;
        u32x4 k1a = {0, 0, 0, 0}, k1b = k1a, k2a = k1a, k2b = k1a, v0 = k1a, v1 = k1a, v2 = k1a, v3 = k1a;
        if (kpos >= 0) {
            const bf16_t* kr = P + (size_t)(tok0 - 128 + key) * NP + C_KA + kvh * 64 + part * 16;
            const u32x4 x1a = *(const u32x4*)kr, x1b = *(const u32x4*)(kr + 8), x2a = *(const u32x4*)(kr + 32), x2b = *(const u32x4*)(kr + 40);
            const f32x2* cs = rope + (size_t)kpos * 32 + part * 16;
#pragma unroll
            for (int q = 0; q < 4; ++q) {
                {
                    const f32x2 c0 = cs[2 * q], c1 = cs[2 * q + 1];
                    const float a0 = bflo(x1a[q]), a1 = bfhi(x1a[q]), b0 = bflo(x2a[q]), b1 = bfhi(x2a[q]);
                    k1a[q] = pk2(a0 * c0.x - b0 * c0.y, a1 * c1.x - b1 * c1.y);
                    k2a[q] = pk2(b0 * c0.x + a0 * c0.y, b1 * c1.x + a1 * c1.y);
                }
                {
                    const f32x2 c0 = cs[8 + 2 * q], c1 = cs[8 + 2 * q + 1];
                    const float a0 = bflo(x1b[q]), a1 = bfhi(x1b[q]), b0 = bflo(x2b[q]), b1 = bfhi(x2b[q]);
                    k1b[q] = pk2(a0 * c0.x - b0 * c0.y, a1 * c1.x - b1 * c1.y);
                    k2b[q] = pk2(b0 * c0.x + a0 * c0.y, b1 * c1.x + a1 * c1.y);
                }
            }
            const bf16_t* vr = P + (size_t)(tok0 - 128 + key) * NP + C_VA + kvh * 64 + part * 32;
            v0 = *(const u32x4*)vr; v1 = *(const u32x4*)(vr + 8); v2 = *(const u32x4*)(vr + 16); v3 = *(const u32x4*)(vr + 24);
        }
        LAS bf16_t* kd = KS + key * KS_LD + part * 16;
        *(LAS u32x4*)kd = k1a; *(LAS u32x4*)(kd + 8) = k1b; *(LAS u32x4*)(kd + 32) = k2a; *(LAS u32x4*)(kd + 40) = k2b;
        LAS bf16_t* vd = VS + key * VS_LD + part * 32;
        *(LAS u32x4*)vd = v0; *(LAS u32x4*)(vd + 8) = v1; *(LAS u32x4*)(vd + 16) = v2; *(LAS u32x4*)(vd + 24) = v3;
    }
    __syncthreads();
    const int hq = kvh * 8 + wave;
    const int fr = lane & 15, fq = lane >> 4;
    constexpr float L2E = 1.4426950408889634f;
    const float sink2 = sinks_l[hq] * L2E;
    const int tq = (lane & 15) >> 2, tp = lane & 3;
#pragma unroll 1
    for (int rb = 0; rb < 8; ++rb) {
        const int q0 = rb * 16;
        const int qtok = tok0 + q0 + fr;
        bf16x8 bq0, bq1;
        {
            const bf16_t* qr = P + (size_t)qtok * NP + C_QA + hq * 64 + 8 * fq;
            const u32x4 x1 = *(const u32x4*)qr, x2 = *(const u32x4*)(qr + 32);
            const f32x2* cs = rope + (size_t)(n * 128 + q0 + fr) * 32 + 8 * fq;
            u32x4 o1, o2;
            constexpr float SC = 0.125f * L2E;
#pragma unroll
            for (int q = 0; q < 4; ++q) {
                const f32x2 c0 = cs[2 * q], c1 = cs[2 * q + 1];
                const float a0 = bflo(x1[q]), a1 = bfhi(x1[q]), b0 = bflo(x2[q]), b1 = bfhi(x2[q]);
                o1[q] = pk2((a0 * c0.x - b0 * c0.y) * SC, (a1 * c1.x - b1 * c1.y) * SC);
                o2[q] = pk2((b0 * c0.x + a0 * c0.y) * SC, (b1 * c1.x + a1 * c1.y) * SC);
            }
            bq0 = __builtin_bit_cast(bf16x8, o1); bq1 = __builtin_bit_cast(bf16x8, o2);
        }
        const int wsk = (q0 >> 5) << 5;
        pg8::f32x4 sc[10];
#pragma unroll
        for (int kt = 0; kt < 10; ++kt) {
            const LAS bf16_t* kp = KS + (wsk + kt * 16 + fr) * KS_LD + 8 * fq;
            const bf16x8 a0 = *(const LAS bf16x8*)kp, a1 = *(const LAS bf16x8*)(kp + 32);
            pg8::f32x4 acc = {0.f, 0.f, 0.f, 0.f};
            acc = __builtin_amdgcn_mfma_f32_16x16x32_bf16(a0, bq0, acc, 0, 0, 0);
            acc = __builtin_amdgcn_mfma_f32_16x16x32_bf16(a1, bq1, acc, 0, 0, 0);
            sc[kt] = acc;
        }
        const int qb = q0 + fr;
        const int kmin = (n == 0) ? 128 : 0;
        float mx = sink2;
#pragma unroll
        for (int kt = 0; kt < 10; ++kt)
#pragma unroll
            for (int r = 0; r < 4; ++r) {
                const int kb = wsk + kt * 16 + 4 * fq + r;
                const bool ok = (kb >= qb + 1) && (kb <= qb + 128) && (kb >= kmin);
                sc[kt][r] = ok ? sc[kt][r] : -1e30f;
                mx = fmaxf(mx, sc[kt][r]);
            }
        mx = fmaxf(mx, __shfl_xor(mx, 16)); mx = fmaxf(mx, __shfl_xor(mx, 32));
        float sum = 0.f;
#pragma unroll
        for (int kt = 0; kt < 10; ++kt)
#pragma unroll
            for (int r = 0; r < 4; ++r) { const float pv = __builtin_amdgcn_exp2f(sc[kt][r] - mx); sc[kt][r] = pv; sum += pv; }
        sum += __shfl_xor(sum, 16); sum += __shfl_xor(sum, 32);
        const float rden = 1.f / (sum + __builtin_amdgcn_exp2f(sink2 - mx));
        pg8::f32x4 oacc[4];
#pragma unroll
        for (int mt = 0; mt < 4; ++mt) oacc[mt] = (pg8::f32x4){0.f, 0.f, 0.f, 0.f};
#pragma unroll
        for (int kk = 0; kk < 5; ++kk) {
            u32x4 pb; pb[0] = pk2(sc[2 * kk][0], sc[2 * kk][1]); pb[1] = pk2(sc[2 * kk][2], sc[2 * kk][3]);
            pb[2] = pk2(sc[2 * kk + 1][0], sc[2 * kk + 1][1]); pb[3] = pk2(sc[2 * kk + 1][2], sc[2 * kk + 1][3]);
            const bf16x8 bp = __builtin_bit_cast(bf16x8, pb);
            const LAS bf16_t* v0 = VS + (wsk + (2 * kk) * 16 + 4 * fq + tq) * VS_LD + 4 * tp;
            const LAS bf16_t* v1 = v0 + 16 * VS_LD;
#pragma unroll
            for (int mt = 0; mt < 4; ++mt) {
                const bf16x8 av = tr_pair(v0 + mt * 16, v1 + mt * 16);
                oacc[mt] = __builtin_amdgcn_mfma_f32_16x16x32_bf16(av, bp, oacc[mt], 0, 0, 0);
            }
        }
        bf16_t* yr = Y + (size_t)qtok * D + hq * 64 + 4 * fq;
#pragma unroll
        for (int mt = 0; mt < 4; ++mt) {
            u32x2 w; w.x = pk2(oacc[mt][0] * rden, oacc[mt][1] * rden); w.y = pk2(oacc[mt][2] * rden, oacc[mt][3] * rden);
            *(u32x2*)(yr + mt * 16) = w;
        }
    }
}
}

namespace mk {
constexpr int RL = 144;
constexpr int PSL = 72;
constexpr int OBL = 132;
constexpr int R_QT = 0, R_KT = 64 * RL * 2, R_KD = 2 * 64 * RL * 2, R_V = 3 * 64 * RL * 2, R_SB = 4 * 64 * RL * 2;
constexpr int R_PS = R_SB + 128 * RL * 2;
constexpr int R_VEC = R_PS + 64 * PSL * 2;
constexpr int R_OB = R_KT;
constexpr int REC_LDS = R_VEC + 8192;
static_assert(64 * OBL * 4 <= 2 * 64 * RL * 2, "OB overlay");
constexpr int ST_STRIDE = 16384 + 256;

__device__ __forceinline__ bf16x8 ld_row_split(const LAS bf16_t* p) {
    const s16x4 a = *(const LAS s16x4*)p, b = *(const LAS s16x4*)(p + 16);
    bf16x8 r; r[0] = a[0]; r[1] = a[1]; r[2] = a[2]; r[3] = a[3]; r[4] = b[0]; r[5] = b[1]; r[6] = b[2]; r[7] = b[3];
    return r;
}
__device__ __forceinline__ float clamp80(float x) { return fminf(fmaxf(x, -80.f), 80.f); }
__device__ __forceinline__ float sigm(float x) { return 1.f / (1.f + __expf(-x)); }
__device__ __forceinline__ void st_bf16(LAS bf16_t* p, float v) { *p = (bf16_t)(pk2(v, 0.f) & 0xffffu); }

__device__ __forceinline__ void state_update(pg8::f32x4 (&acc)[8], const LAS bf16_t* KDm, const LAS bf16_t* Vm, int wave, int fq, int tq, int tp) {
    bf16x8 ka[2];
#pragma unroll
    for (int ks = 0; ks < 2; ++ks) { const LAS bf16_t* p = KDm + (ks * 32 + 4 * fq + tq) * RL + 16 * wave + 4 * tp; ka[ks] = tr_pair(p, p + 16 * RL); }
#pragma unroll
    for (int j = 0; j < 8; ++j)
#pragma unroll
        for (int ks = 0; ks < 2; ++ks) {
            const LAS bf16_t* p = Vm + (ks * 32 + 4 * fq + tq) * RL + 16 * j + 4 * tp;
            const bf16x8 vb = tr_pair(p, p + 16 * RL);
            acc[j] = __builtin_amdgcn_mfma_f32_16x16x32_bf16(ka[ks], vb, acc[j], 0, 0, 0);
        }
}
__device__ __forceinline__ void state_to_lds(const pg8::f32x4 (&acc)[8], const float (&rsc)[4], LAS bf16_t* SBm, int wave, int fr, int fq) {
#pragma unroll
    for (int j = 0; j < 8; ++j)
#pragma unroll
        for (int r = 0; r < 4; ++r) st_bf16(SBm + (16 * wave + 4 * fq + r) * RL + 16 * j + fr, acc[j][r] * rsc[r]);
}
__device__ __forceinline__ void score_tile(pg8::f32x4& acc, const LAS bf16_t* Am, const LAS bf16_t* Bm, int ti, int tj, int fr, int fq) {
    acc = (pg8::f32x4){0.f, 0.f, 0.f, 0.f};
#pragma unroll
    for (int ks = 0; ks < 4; ++ks) {
        const bf16x8 a = *(const LAS bf16x8*)(Am + (16 * ti + fr) * RL + ks * 32 + 8 * fq);
        const bf16x8 b = *(const LAS bf16x8*)(Bm + (16 * tj + fr) * RL + ks * 32 + 8 * fq);
        acc = __builtin_amdgcn_mfma_f32_16x16x32_bf16(a, b, acc, 0, 0, 0);
    }
}
__device__ __forceinline__ void copy_tile(const bf16_t* __restrict__ src, LAS bf16_t* dst, int tid) {
    const int row = tid >> 3, seg = tid & 7;
    const bf16_t* s = src + (size_t)row * NP + seg * 16;
    const u32x4 a = *(const u32x4*)s, b = *(const u32x4*)(s + 8);
    LAS bf16_t* d = dst + row * RL + seg * 16;
    *(LAS u32x4*)d = a; *(LAS u32x4*)(d + 8) = b;
}
__device__ __forceinline__ void state_store(const pg8::f32x4 (&acc)[8], float* __restrict__ dst, int wave, int lane) {
#pragma unroll
    for (int j = 0; j < 8; ++j)
#pragma unroll
        for (int r = 0; r < 4; ++r) dst[((wave * 8 + j) * 4 + r) * 64 + lane] = acc[j][r];
}

template <int PASS>
__device__ __forceinline__ void hgrn_unit(const bf16_t* __restrict__ P, const float* __restrict__ lb_logits, int layer, const float* __restrict__ gain_l,
                                          float* __restrict__ STB, bf16_t* __restrict__ Y, int unit, LAS unsigned char* lds, int tid, int lane, int wave) {
    const int chain = unit >> 3, g = unit & 7, b = chain >> 2, h = chain & 3;
    const int t0 = b * S + g * 512;
    const int fr = lane & 15, fq = lane >> 4, tq = (lane & 15) >> 2, tp = lane & 3;
    const int kp = tid & 63, rg = wave, c0 = 2 * kp;
    LAS bf16_t* QT = (LAS bf16_t*)(lds + R_QT); LAS bf16_t* KT = (LAS bf16_t*)(lds + R_KT); LAS bf16_t* KD = (LAS bf16_t*)(lds + R_KD);
    LAS bf16_t* VV = (LAS bf16_t*)(lds + R_V); LAS bf16_t* SB = (LAS bf16_t*)(lds + R_SB); LAS bf16_t* PS = (LAS bf16_t*)(lds + R_PS);
    LAS float* TOT = (LAS float*)(lds + R_VEC);
    LAS float* EREF = TOT + 1024; LAS float* ELAST = EREF + 128;
    LAS float* OB = (LAS float*)(lds + R_OB);
    float lb0 = 0.f, lb1 = 0.f;
    if (layer == 1) {
        const float a0 = lb_logits[h * 128 + c0], a1 = lb_logits[512 + h * 128 + c0], d0 = lb_logits[h * 128 + c0 + 1], d1 = lb_logits[512 + h * 128 + c0 + 1];
        const float m0 = fmaxf(a0, a1), m1 = fmaxf(d0, d1);
        lb0 = __expf(a1 - m0) / (__expf(a0 - m0) + __expf(a1 - m0));
        lb1 = __expf(d1 - m1) / (__expf(d0 - m1) + __expf(d1 - m1));
    }
    pg8::f32x4 acc[8];
#pragma unroll
    for (int j = 0; j < 8; ++j) acc[j] = (pg8::f32x4){0.f, 0.f, 0.f, 0.f};
    if (PASS == 2) {
        for (int jg = 0; jg < g; ++jg) {
            const float* sb = STB + (size_t)(chain * 8 + jg) * ST_STRIDE;
            float dk[4];
#pragma unroll
            for (int r = 0; r < 4; ++r) dk[r] = __expf(sb[16384 + 16 * wave + 4 * fq + r]);
#pragma unroll
            for (int j = 0; j < 8; ++j)
#pragma unroll
                for (int r = 0; r < 4; ++r) acc[j][r] = acc[j][r] * dk[r] + sb[((wave * 8 + j) * 4 + r) * 64 + lane];
        }
    }
    float gl0 = 0.f, gl1 = 0.f;
#pragma unroll 1
    for (int c = 0; c < 8; ++c) {
        const int tr0 = t0 + c * 64;
        float lf0[8], lf1[8], kk0[8], kk1[8], qv0[8], qv1[8];
#pragma unroll
        for (int i = 0; i < 8; ++i) {
            const bf16_t* pr = P + (size_t)(tr0 + rg * 8 + i) * NP + h * 128 + c0;
            const unsigned fw = *(const unsigned*)(pr + C_FH);
            const float z0 = bflo(fw), z1 = bfhi(fw);
            const float s0 = sigm(z0), s1 = sigm(z1);
            lf0[i] = __logf(fmaxf(lb0 + (1.f - lb0) * s0, 1e-30f)); lf1[i] = __logf(fmaxf(lb1 + (1.f - lb1) * s1, 1e-30f));
            kk0[i] = (1.f - lb0) * (1.f - s0); kk1[i] = (1.f - lb1) * (1.f - s1);
            if (PASS == 2) { const unsigned qw = *(const unsigned*)(pr + C_QH); const float q0 = bflo(qw), q1 = bfhi(qw); qv0[i] = q0 * sigm(q0); qv1[i] = q1 * sigm(q1); }
        }
#pragma unroll
        for (int i = 1; i < 8; ++i) { lf0[i] += lf0[i - 1]; lf1[i] += lf1[i - 1]; }
        TOT[rg * 128 + c0] = lf0[7]; TOT[rg * 128 + c0 + 1] = lf1[7];
        copy_tile(P + (size_t)tr0 * NP + C_IH + h * 128, VV, tid);
        __syncthreads();
        {
            float pre0 = 0.f, pre1 = 0.f, ref0 = 0.f, ref1 = 0.f, la0 = 0.f, la1 = 0.f;
#pragma unroll
            for (int r = 0; r < 8; ++r) {
                const float a0 = TOT[r * 128 + c0], a1 = TOT[r * 128 + c0 + 1];
                if (r < rg) { pre0 += a0; pre1 += a1; }
                if (r < 4) { ref0 += a0; ref1 += a1; }
                la0 += a0; la1 += a1;
            }
#pragma unroll
            for (int i = 0; i < 8; ++i) {
                const int row = rg * 8 + i;
                const float cu0 = pre0 + lf0[i], cu1 = pre1 + lf1[i];
                if (PASS == 2) {
                    *(LAS unsigned*)(QT + row * RL + c0) = pk2(qv0[i] * __expf(clamp80(cu0 - ref0)), qv1[i] * __expf(clamp80(cu1 - ref1)));
                    *(LAS unsigned*)(KT + row * RL + c0) = pk2(kk0[i] * __expf(clamp80(ref0 - cu0)), kk1[i] * __expf(clamp80(ref1 - cu1)));
                }
                *(LAS unsigned*)(KD + row * RL + c0) = pk2(kk0[i] * __expf(la0 - cu0), kk1[i] * __expf(la1 - cu1));
            }
            if (rg == 0) { EREF[c0] = __expf(ref0); EREF[c0 + 1] = __expf(ref1); ELAST[c0] = __expf(la0); ELAST[c0 + 1] = __expf(la1); }
            gl0 += la0; gl1 += la1;
        }
        __syncthreads();
        pg8::f32x4 o[4];
        if (PASS == 2) {
            { float rs[4];
#pragma unroll
              for (int r = 0; r < 4; ++r) rs[r] = EREF[16 * wave + 4 * fq + r];
              state_to_lds(acc, rs, SB, wave, fr, fq); }
            { const int ti = wave >> 1;
#pragma unroll
              for (int tjj = 0; tjj < 2; ++tjj) {
                  const int tj = 2 * (wave & 1) + tjj;
                  pg8::f32x4 sa = {0.f, 0.f, 0.f, 0.f};
                  if (tj <= ti) score_tile(sa, QT, KT, ti, tj, fr, fq);
#pragma unroll
                  for (int r = 0; r < 4; ++r) {
                      const int t = 16 * ti + 4 * fq + r, s = 16 * tj + fr;
                      st_bf16(PS + t * PSL + s, (s <= t) ? sa[r] : 0.f);
                  }
              } }
            __syncthreads();
            bf16x8 sbf[4], vbf[2];
#pragma unroll
            for (int ks = 0; ks < 4; ++ks) { const LAS bf16_t* p = SB + (ks * 32 + 4 * fq + tq) * RL + 16 * wave + 4 * tp; sbf[ks] = tr_pair(p, p + 16 * RL); }
#pragma unroll
            for (int ks = 0; ks < 2; ++ks) { const LAS bf16_t* p = VV + (ks * 32 + 4 * fq + tq) * RL + 16 * wave + 4 * tp; vbf[ks] = tr_pair(p, p + 16 * RL); }
#pragma unroll
            for (int ti = 0; ti < 4; ++ti) {
                o[ti] = (pg8::f32x4){0.f, 0.f, 0.f, 0.f};
#pragma unroll
                for (int ks = 0; ks < 4; ++ks) o[ti] = __builtin_amdgcn_mfma_f32_16x16x32_bf16(ld_row_split(QT + (16 * ti + fr) * RL + ks * 32 + 4 * fq), sbf[ks], o[ti], 0, 0, 0);
#pragma unroll
                for (int ks = 0; ks < 2; ++ks) o[ti] = __builtin_amdgcn_mfma_f32_16x16x32_bf16(ld_row_split(PS + (16 * ti + fr) * PSL + ks * 32 + 4 * fq), vbf[ks], o[ti], 0, 0, 0);
            }
        }
        {
#pragma unroll
            for (int r = 0; r < 4; ++r) { const float el = ELAST[16 * wave + 4 * fq + r];
#pragma unroll
                for (int j = 0; j < 8; ++j) acc[j][r] *= el; }
            state_update(acc, KD, VV, wave, fq, tq, tp);
        }
        __syncthreads();
        if (PASS == 2) {
#pragma unroll
            for (int ti = 0; ti < 4; ++ti)
#pragma unroll
                for (int r = 0; r < 4; ++r) OB[(16 * ti + 4 * fq + r) * OBL + 16 * wave + fr] = o[ti][r];
            __syncthreads();
            const int t = tid >> 3, seg = tid & 7;
            float ov[16]; float ss = 0.f;
#pragma unroll
            for (int q = 0; q < 4; ++q) { const f32x4 a = *(const LAS f32x4*)(OB + t * OBL + seg * 16 + 4 * q); ov[4 * q] = a.x; ov[4 * q + 1] = a.y; ov[4 * q + 2] = a.z; ov[4 * q + 3] = a.w;
                ss += (a.x * a.x + a.y * a.y) + (a.z * a.z + a.w * a.w); }
            ss += __shfl_xor(ss, 1); ss += __shfl_xor(ss, 2); ss += __shfl_xor(ss, 4);
            const float rn = rsqrtf(ss * (1.f / 128.f) + EPS);
            const bf16_t* gp = P + (size_t)(tr0 + t) * NP + C_GH + h * 128 + seg * 16;
            const u32x4 g0 = *(const u32x4*)gp, g1 = *(const u32x4*)(gp + 8);
            const float* gn = gain_l + h * 128 + seg * 16;
            u32x4 y0, y1;
#pragma unroll
            for (int q = 0; q < 4; ++q) {
                const float ga = bflo(g0[q]), gb = bfhi(g0[q]), gc = bflo(g1[q]), gd = bfhi(g1[q]);
                y0[q] = pk2(ov[2 * q] * rn * gn[2 * q] * (ga * sigm(ga)), ov[2 * q + 1] * rn * gn[2 * q + 1] * (gb * sigm(gb)));
                y1[q] = pk2(ov[8 + 2 * q] * rn * gn[8 + 2 * q] * (gc * sigm(gc)), ov[8 + 2 * q + 1] * rn * gn[8 + 2 * q + 1] * (gd * sigm(gd)));
            }
            bf16_t* yp = Y + (size_t)(tr0 + t) * D + 1024 + h * 128 + seg * 16;
            *(u32x4*)yp = y0; *(u32x4*)(yp + 8) = y1;
        }
    }
    if (PASS == 1) {
        float* sb = STB + (size_t)(chain * 8 + g) * ST_STRIDE;
        state_store(acc, sb, wave, lane);
        if (rg == 0) { sb[16384 + c0] = gl0; sb[16384 + c0 + 1] = gl1; }
    }
}

template <int PASS>
__device__ __forceinline__ void mlstm_unit(const bf16_t* __restrict__ P, const float* __restrict__ conv_l, const float* __restrict__ ib_l, const float* __restrict__ fb_l,
                                           float* __restrict__ STB, bf16_t* __restrict__ Y, int unit, LAS unsigned char* lds, int tid, int lane, int wave) {
    const int chain = unit >> 3, g = unit & 7, b = chain >> 2, h = chain & 3;
    const int t0 = b * S + g * 512;
    const int fr = lane & 15, fq = lane >> 4, tq = (lane & 15) >> 2, tp = lane & 3;
    const int kp = tid & 63, rg = wave, c0 = 2 * kp;
    LAS bf16_t* QM = (LAS bf16_t*)(lds + R_QT); LAS bf16_t* KM = (LAS bf16_t*)(lds + R_KT); LAS bf16_t* KW = (LAS bf16_t*)(lds + R_KD);
    LAS bf16_t* VV = (LAS bf16_t*)(lds + R_V); LAS bf16_t* CB = (LAS bf16_t*)(lds + R_SB); LAS bf16_t* PS = (LAS bf16_t*)(lds + R_PS);
    LAS float* VEC = (LAS float*)(lds + R_VEC);
    LAS float* AV = VEC;
    LAS float* MV = VEC + 64;
    LAS float* CUM = VEC + 128;
    LAS float* SCAL = VEC + 192;
    LAS float* NV = VEC + 256;
    LAS float* DENP = VEC + 384;
    LAS float* DINT = VEC + 640;
    LAS float* OB = (LAS float*)(lds + R_OB);
    float wq0[4], wq1[4], wk0[4], wk1[4];
#pragma unroll
    for (int j = 0; j < 4; ++j) {
        wq0[j] = conv_l[j * 1024 + h * 128 + c0]; wq1[j] = conv_l[j * 1024 + h * 128 + c0 + 1];
        wk0[j] = conv_l[j * 1024 + 512 + h * 128 + c0]; wk1[j] = conv_l[j * 1024 + 512 + h * 128 + c0 + 1];
    }
    const float ib = ib_l[h], fb = fb_l[h];
    pg8::f32x4 acc[8];
#pragma unroll
    for (int j = 0; j < 8; ++j) acc[j] = (pg8::f32x4){0.f, 0.f, 0.f, 0.f};
    float mprev = (PASS == 1) ? -1e30f : 0.f;
    float nreg = 0.f;
    float fsum = 0.f;
    if (PASS == 2) {
        for (int jg = 0; jg < g; ++jg) {
            const float* sb = STB + (size_t)(chain * 8 + jg) * ST_STRIDE;
            const float mE = sb[16384 + 128], F = sb[16384 + 129];
            const float mn = fmaxf(F + mprev, mE);
            const float s1 = __expf(F + mprev - mn), s2 = __expf(mE - mn);
#pragma unroll
            for (int j = 0; j < 8; ++j)
#pragma unroll
                for (int r = 0; r < 4; ++r) acc[j][r] = acc[j][r] * s1 + s2 * sb[((wave * 8 + j) * 4 + r) * 64 + lane];
            if (tid < 128) nreg = nreg * s1 + s2 * sb[16384 + tid];
            mprev = mn;
        }
    }
    if (tid < 128) NV[tid] = nreg;
#pragma unroll 1
    for (int c = 0; c < 8; ++c) {
        const int tr0 = t0 + c * 64;
        if (wave == 0) {
            const bf16_t* pr = P + (size_t)(tr0 + lane) * NP;
            const float ip = bf2f(pr[C_IM + h]) + ib;
            const float z = bf2f(pr[C_FM + h]) + fb;
            const float lf = fminf(z, 0.f) - __logf(1.f + __expf(-fabsf(z)));
            float cu = lf;
#pragma unroll
            for (int o = 1; o < 64; o <<= 1) { const float t = __shfl_up(cu, o); if (lane >= o) cu += t; }
            const float a = ip - cu;
            float pm = a;
#pragma unroll
            for (int o = 1; o < 64; o <<= 1) { const float t = __shfl_up(pm, o); if (lane >= o) pm = fmaxf(pm, t); }
            const float M = fmaxf(pm, mprev);
            AV[lane] = a; MV[lane] = M; CUM[lane] = cu;
            if (lane == 63) { SCAL[1] = M; SCAL[2] = cu; }
            if (lane == 0) SCAL[0] = mprev;
        }
        copy_tile(P + (size_t)tr0 * NP + C_VM + h * 128, VV, tid);
        float xq0[11], xq1[11], xk0[11], xk1[11];
#pragma unroll
        for (int i = 0; i < 11; ++i) {
            const int row = rg * 8 + i - 3;
            const int pos = g * 512 + c * 64 + row;
            unsigned wq = 0u, wk = 0u;
            if (pos >= 0) { const bf16_t* pr = P + (size_t)(tr0 + row) * NP + h * 128 + c0; if (PASS == 2) wq = *(const unsigned*)(pr + C_QM); wk = *(const unsigned*)(pr + C_KM); }
            xq0[i] = bflo(wq); xq1[i] = bfhi(wq); xk0[i] = bflo(wk); xk1[i] = bfhi(wk);
        }
        __syncthreads();
        const float M63 = SCAL[1], last = SCAL[2];
        {
#pragma unroll
            for (int i = 0; i < 8; ++i) {
                const int row = rg * 8 + i;
                float k0v = 0.f, k1v = 0.f, q0v = 0.f, q1v = 0.f;
#pragma unroll
                for (int j = 0; j < 4; ++j) { k0v += wk0[j] * xk0[i + j]; k1v += wk1[j] * xk1[i + j]; if (PASS == 2) { q0v += wq0[j] * xq0[i + j]; q1v += wq1[j] * xq1[i + j]; } }
                k0v = k0v * sigm(k0v) * 0.08838834764831845f; k1v = k1v * sigm(k1v) * 0.08838834764831845f;
                const float wsr = __expf(AV[row] - M63);
                *(LAS unsigned*)(KW + row * RL + c0) = pk2(k0v * wsr, k1v * wsr);
                if (PASS == 2) {
                    *(LAS unsigned*)(KM + row * RL + c0) = pk2(k0v, k1v);
                    *(LAS unsigned*)(QM + row * RL + c0) = pk2(q0v * sigm(q0v), q1v * sigm(q1v));
                }
            }
        }
        const float decay = __expf(mprev - M63);
        pg8::f32x4 o1[4], o2[4];
        if (PASS == 2) {
            const float one[4] = {1.f, 1.f, 1.f, 1.f};
            state_to_lds(acc, one, CB, wave, fr, fq);
        }
        __syncthreads();
        if (PASS == 2) {
            { const int ti = wave >> 1;
              float dp[4] = {0.f, 0.f, 0.f, 0.f};
#pragma unroll
              for (int tjj = 0; tjj < 2; ++tjj) {
                  const int tj = 2 * (wave & 1) + tjj;
                  pg8::f32x4 sa = {0.f, 0.f, 0.f, 0.f};
                  if (tj <= ti) score_tile(sa, QM, KM, ti, tj, fr, fq);
                  const int s = 16 * tj + fr;
                  const float as = AV[s];
#pragma unroll
                  for (int r = 0; r < 4; ++r) {
                      const int t = 16 * ti + 4 * fq + r;
                      const float w = (s <= t) ? sa[r] * __expf(as - MV[t]) : 0.f;
                      st_bf16(PS + t * PSL + s, w);
                      dp[r] += w;
                  }
              }
#pragma unroll
              for (int r = 0; r < 4; ++r) {
                  float v = dp[r];
                  v += __shfl_xor(v, 1); v += __shfl_xor(v, 2); v += __shfl_xor(v, 4); v += __shfl_xor(v, 8);
                  if (fr == 0) DENP[(16 * ti + 4 * fq + r) * 4 + 2 * (wave & 1)] = v;
              } }
            { const int t = tid >> 3, seg = tid & 7;
              float dsum = 0.f;
#pragma unroll
              for (int q = 0; q < 16; ++q) dsum += bf2f(QM[t * RL + seg * 16 + q]) * NV[seg * 16 + q];
              dsum += __shfl_xor(dsum, 1); dsum += __shfl_xor(dsum, 2); dsum += __shfl_xor(dsum, 4);
              if (seg == 0) DINT[t] = dsum; }
            __syncthreads();
            bf16x8 cbf[4], vbf[2];
#pragma unroll
            for (int ks = 0; ks < 4; ++ks) { const LAS bf16_t* p = CB + (ks * 32 + 4 * fq + tq) * RL + 16 * wave + 4 * tp; cbf[ks] = tr_pair(p, p + 16 * RL); }
#pragma unroll
            for (int ks = 0; ks < 2; ++ks) { const LAS bf16_t* p = VV + (ks * 32 + 4 * fq + tq) * RL + 16 * wave + 4 * tp; vbf[ks] = tr_pair(p, p + 16 * RL); }
#pragma unroll
            for (int ti = 0; ti < 4; ++ti) {
                o1[ti] = (pg8::f32x4){0.f, 0.f, 0.f, 0.f}; o2[ti] = (pg8::f32x4){0.f, 0.f, 0.f, 0.f};
#pragma unroll
                for (int ks = 0; ks < 4; ++ks) o2[ti] = __builtin_amdgcn_mfma_f32_16x16x32_bf16(ld_row_split(QM + (16 * ti + fr) * RL + ks * 32 + 4 * fq), cbf[ks], o2[ti], 0, 0, 0);
#pragma unroll
                for (int ks = 0; ks < 2; ++ks) o1[ti] = __builtin_amdgcn_mfma_f32_16x16x32_bf16(ld_row_split(PS + (16 * ti + fr) * PSL + ks * 32 + 4 * fq), vbf[ks], o1[ti], 0, 0, 0);
            }
        }
        {
#pragma unroll
            for (int j = 0; j < 8; ++j) acc[j] = acc[j] * decay;
            state_update(acc, KW, VV, wave, fq, tq, tp);
            if (tid < 128) {
                float sumk = 0.f;
#pragma unroll 8
                for (int s = 0; s < 64; ++s) sumk += bf2f(KW[s * RL + tid]);
                nreg = nreg * decay + sumk;
            }
        }
        fsum += last;
        const float mnew = last + M63;
        __syncthreads();
        if (tid < 128) NV[tid] = nreg;
        if (PASS == 2) {
#pragma unroll
            for (int ti = 0; ti < 4; ++ti)
#pragma unroll
                for (int r = 0; r < 4; ++r) {
                    const int t = 16 * ti + 4 * fq + r;
                    OB[t * OBL + 16 * wave + fr] = o1[ti][r] + __expf(mprev - MV[t]) * o2[ti][r];
                }
            __syncthreads();
            const int t = tid >> 3, seg = tid & 7;
            const float wi = __expf(mprev - MV[t]);
            const float den = DENP[t * 4] + DENP[t * 4 + 2] + wi * DINT[t];
            const float hd = 1.f / fmaxf(fabsf(den), __expf(-(CUM[t] + MV[t])));
            const bf16_t* gp = P + (size_t)(tr0 + t) * NP + C_OM + h * 128 + seg * 16;
            const u32x4 g0 = *(const u32x4*)gp, g1 = *(const u32x4*)(gp + 8);
            const unsigned gw[8] = {g0[0], g0[1], g0[2], g0[3], g1[0], g1[1], g1[2], g1[3]};
            unsigned yw[8];
#pragma unroll
            for (int q = 0; q < 4; ++q) {
                const f32x4 a = *(const LAS f32x4*)(OB + t * OBL + seg * 16 + 4 * q);
                yw[2 * q] = pk2(a.x * hd * sigm(bflo(gw[2 * q])), a.y * hd * sigm(bfhi(gw[2 * q])));
                yw[2 * q + 1] = pk2(a.z * hd * sigm(bflo(gw[2 * q + 1])), a.w * hd * sigm(bfhi(gw[2 * q + 1])));
            }
            u32x4 y0, y1;
            y0[0] = yw[0]; y0[1] = yw[1]; y0[2] = yw[2]; y0[3] = yw[3]; y1[0] = yw[4]; y1[1] = yw[5]; y1[2] = yw[6]; y1[3] = yw[7];
            bf16_t* yp = Y + (size_t)(tr0 + t) * D + 1536 + h * 128 + seg * 16;
            *(u32x4*)yp = y0; *(u32x4*)(yp + 8) = y1;
        }
        mprev = mnew;
        __syncthreads();
    }
    if (PASS == 1) {
        float* sb = STB + (size_t)(chain * 8 + g) * ST_STRIDE;
        state_store(acc, sb, wave, lane);
        if (tid < 128) sb[16384 + tid] = nreg;
        if (tid == 0) { sb[16384 + 128] = mprev; sb[16384 + 129] = fsum; }
    }
}
}

namespace mk {
#define IN(k) (lo <= (k) && (k) < hi)
#define GSYNC() do { if (coop) cooperative_groups::this_grid().sync(); } while (0)
template <int l>
__device__ __forceinline__ void layer_body(const Params& p, LAS unsigned char* lds, unsigned char* ws, int G, int tid, int lane, int wave, int lo, int hi, bool coop) {

    if (IN(1)) {
        pg8::Gemm g{(const bf16_t*)(ws + WS_XB), (const bf16_t*)(ws + WS_WINT) + (size_t)l * NP * D, T, NP, D};
        pg8::StaticOrder So; So.init(T, NP, G, (int)blockIdx.x);
        EpiScaleBf16<1> E{(bf16_t*)(ws + WS_P), NP, (const float*)(ws + WS_SS)};
        pg8::gemm_phase<EpiScaleBf16<1>, pg8::StaticOrder, true, true>(lds, g, So, E);
        GSYNC();
    }
    if (IN(2)) {
        for (int u = blockIdx.x; u < 256; u += G) {
            if (u < 128) hgrn_unit<1>((const bf16_t*)(ws + WS_P), p.in[5], l, nullptr, (float*)(ws + WS_STH), nullptr, u, lds, tid, lane, wave);
            else mlstm_unit<1>((const bf16_t*)(ws + WS_P), p.in[7] + (size_t)l * 4 * 1024, p.in[8] + l * 4, p.in[9] + l * 4, (float*)(ws + WS_STM), nullptr, u - 128, lds, tid, lane, wave);
            __syncthreads();
        }
        GSYNC();
    }
    if (IN(3)) {
        for (int u = blockIdx.x; u < 256; u += G) {
            if (u < 128) hgrn_unit<2>((const bf16_t*)(ws + WS_P), p.in[5], l, p.in[6] + l * 512, (float*)(ws + WS_STH), (bf16_t*)(ws + WS_YB), u, lds, tid, lane, wave);
            else mlstm_unit<2>((const bf16_t*)(ws + WS_P), p.in[7] + (size_t)l * 4 * 1024, p.in[8] + l * 4, p.in[9] + l * 4, (float*)(ws + WS_STM), (bf16_t*)(ws + WS_YB), u - 128, lds, tid, lane, wave);
            __syncthreads();
        }
        for (int u = blockIdx.x; u < 256; u += G) {
            attn_unit((const bf16_t*)(ws + WS_P), (const f32x2*)(ws + WS_ROPE), p.in[4] + l * 16, (bf16_t*)(ws + WS_YB), u, lds, tid, lane, wave);
            __syncthreads();
        }
        GSYNC();
    }
    if (IN(4)) {
        pg8::Gemm g{(const bf16_t*)(ws + WS_YB), (const bf16_t*)(ws + WS_WOUTT) + (size_t)l * D * D, T, D, D};
        pg8::StaticOrder So; So.init(T, D, G, (int)blockIdx.x);
        EpiX1 E{l == 0 ? p.in[0] : (const float*)(ws + WS_X2), (float*)(ws + WS_X1), (bf16_t*)(ws + WS_XB), (float*)(ws + WS_SSP)};
        pg8::gemm_phase<EpiX1, pg8::StaticOrder, true, true>(lds, g, So, E);
        GSYNC();
    }
    if (IN(5)) {
        pg8::Gemm g{(const bf16_t*)(ws + WS_XB), (const bf16_t*)(ws + WS_WQT) + (size_t)l * D * D, T, D, D};
        pg8::StaticOrder So; So.init(T, D, G, (int)blockIdx.x);
        EpiScaleBf16<32> E{(bf16_t*)(ws + WS_Q), D, (const float*)(ws + WS_SSP)};
        pg8::gemm_phase<EpiScaleBf16<32>, pg8::StaticOrder, true, true>(lds, g, So, E);
        pg8::Unit u;
        for (int i = 0; So.next(i, u); ++i)
            route_unit((const bf16_t*)(ws + WS_Q), (const bf16_t*)(ws + WS_SUBK) + (size_t)l * 2 * 8 * 128 * 128, u.pm, u.pn, (int*)(ws + WS_IDX), (float*)(ws + WS_GATE),
                       (LAS float*)(lds + wave * 8448), wave, lane);
        GSYNC();
    }
    if (IN(6)) {
        const int gw = blockIdx.x * NWAVES + wave, ngw = G * NWAVES;
        for (int t = gw; t < T; t += ngw) {
            if (l == 0)
                expert_token<false>(t, (const bf16_t*)(ws + WS_XB), (const float*)(ws + WS_X1), (const float*)(ws + WS_SSP), (const int*)(ws + WS_IDX), (const float*)(ws + WS_GATE),
                                    ws + WS_U8, (const float*)(ws + WS_USC), ws + WS_V8, (const float*)(ws + WS_VSC),
                                    (float*)(ws + WS_X2), (bf16_t*)(ws + WS_XB), (float*)(ws + WS_SS), nullptr, nullptr, lane);
            else
                expert_token<true>(t, (const bf16_t*)(ws + WS_XB), (const float*)(ws + WS_X1), (const float*)(ws + WS_SSP), (const int*)(ws + WS_IDX), (const float*)(ws + WS_GATE),
                                   ws + WS_U8 + (size_t)NE * D, (const float*)(ws + WS_USC) + NE, ws + WS_V8 + (size_t)NE * D, (const float*)(ws + WS_VSC) + NE,
                                   nullptr, nullptr, nullptr, p.in[15], p.out, lane);
        }
    }
}
__global__ void __launch_bounds__(NTHR, 2) mega(Params p) {
    extern __shared__ __attribute__((aligned(16))) unsigned char lds_raw[];
    LAS unsigned char* lds = (LAS unsigned char*)lds_raw;
    unsigned char* ws = p.ws;
    const int G = gridDim.x;
    const int tid = threadIdx.x, lane = tid & 63, wave = __builtin_amdgcn_readfirstlane(tid >> 6);
    const int lo = p.ph_lo, hi = p.ph_hi;
    const bool coop = p.pad != 0;
    if (IN(0)) { p0_prologue(p, lds); GSYNC(); }
    if (p.layer <= 0 && 0 < p.layer_hi) { layer_body<0>(p, lds, ws, G, tid, lane, wave, lo, hi, coop); if (1 < p.layer_hi) GSYNC(); }
    if (p.layer <= 1 && 1 < p.layer_hi) layer_body<1>(p, lds, ws, G, tid, lane, wave, lo, hi, coop);

#undef IN
#undef GSYNC
}
__global__ __launch_bounds__(256) void shim_xprep_kernel(const float* __restrict__ X, bf16_t* __restrict__ XB, float* __restrict__ SS) {
    const int t = blockIdx.x * 4 + (threadIdx.x >> 6), lane = threadIdx.x & 63;
    xprep_row(X + (size_t)t * D, XB + (size_t)t * D, SS + t, lane);
}
}

extern "C" void kernel_launch(void* const* d_in, const int* in_sizes, int n_in, void* d_out, int out_size, void* d_ws, size_t ws_size, hipStream_t stream) {
    using namespace mk;
    static int grid = 0;
    if (grid == 0) {
        int dev = 0, cus = 0, per_cu = 0;
        (void)hipGetDevice(&dev); (void)hipDeviceGetAttribute(&cus, hipDeviceAttributeMultiprocessorCount, dev);
        if (hipFuncSetAttribute((const void*)mega, hipFuncAttributeMaxDynamicSharedMemorySize, LDS_BYTES) != hipSuccess) { fprintf(stderr, "kernel_launch: hipFuncSetAttribute failed\n"); grid = -1; return; }
        if (ws_size < WS_END) { fprintf(stderr, "kernel_launch: workspace too small: need %zu have %zu\n", (size_t)WS_END, ws_size); grid = -1; return; }
        if (hipOccupancyMaxActiveBlocksPerMultiprocessor(&per_cu, (const void*)mega, NTHR, LDS_BYTES) != hipSuccess || per_cu < 1) { fprintf(stderr, "kernel_launch: occupancy query says %d blocks per CU\n", per_cu); grid = -1; return; }
        grid = cus;
    }
    if (grid < 0) return;
    Params p{};
    for (int i = 0; i < 16; ++i) p.in[i] = (const float*)d_in[i];
    p.out = (float*)d_out; p.ws = (unsigned char*)d_ws;
    p.ph_lo = 0; p.ph_hi = 7; p.layer = 0; p.layer_hi = 2; p.pad = 1; p.pad2 = 0;
    void* args[] = {&p};
    hipError_t e = hipLaunchCooperativeKernel((const void*)mega, dim3(grid), dim3(NTHR), args, LDS_BYTES, stream);
    if (e != hipSuccess) fprintf(stderr, "kernel_launch: cooperative launch failed: %s (grid %d)\n", hipGetErrorString(e), grid);
}
```

```cpp
#include <hip/hip_runtime.h>
#include <hip/hip_cooperative_groups.h>
#include <math.h>
#include <stdio.h>
#include <stdint.h>
namespace pg8 {
#define PG8_LAS __attribute__((address_space(3)))
typedef unsigned short bf16_t;
typedef short bf16x8 __attribute__((ext_vector_type(8)));
typedef float f32x4 __attribute__((ext_vector_type(4)));
typedef unsigned u32x4 __attribute__((ext_vector_type(4)));
constexpr int BM = 256, BK = 64, HALF = 128, HTB = HALF * BK * 2  , STAGE_BYTES = 8 * HTB, NXCD = 8, WGM = 8;

__host__ __device__ __forceinline__ int lds_byte(int r, int c) { const int st = (r >> 4) * 2 + (c >> 5), rr = r & 15, cc = c & 31, ob = rr * 64 + cc * 2; return st * 1024 + (ob ^ (((ob >> 9) & 1) << 5)); }
__host__ __device__ __forceinline__ void stage_rc(int b, int& R, int& C) { const int st = b / 1024, sb = b % 1024, swz = sb ^ (((sb >> 9) & 1) << 5); R = (st >> 1) * 16 + swz / 64; C = (st & 1) * 32 + (swz % 64) / 2; }
__host__ __device__ __forceinline__ int perm32(int rho) { const int n = rho >> 4, i = rho & 15; return 8 * (i >> 2) + 4 * n + (i & 3); }

struct Unit { int pm, pn; };
struct Gemm { const bf16_t* A; const bf16_t* Bt; int M, N, K; };

struct StaticOrder {
    int nM, nN, nwg, G, c;
    __host__ __device__ void init(int M, int N, int G_, int c_) { nM = M / BM; nN = N / BM; nwg = nM * nN; G = G_; c = c_; }
    __host__ __device__ bool next(int i, Unit& u) const {
        const long L = (long)i * G + c; if (L >= nwg) return false;
        int wgid = (int)L; { const int q = nwg / NXCD, r = nwg % NXCD, xcd = wgid % NXCD, off = wgid / NXCD; wgid = (xcd < r ? xcd * (q + 1) : r * (q + 1) + (xcd - r) * q) + off; }
        const int nig = WGM * nN, gid = wgid / nig, fm = gid * WGM, gsz = (nM - fm) < WGM ? (nM - fm) : WGM;
        u.pm = fm + ((wgid % nig) % gsz); u.pn = (wgid % nig) / gsz; return true;
    }
    __device__ __forceinline__ void a_ready(const Unit&) const {}
    __device__ __forceinline__ void done(const Unit&) const {}
};

template <class Epi, class Sched, bool ALIGN_EPI = false, bool SP2 = false>
__device__ __forceinline__ void gemm_phase(PG8_LAS unsigned char* lds, const Gemm g, const Sched& S, const Epi& E) {
    const int tid = threadIdx.x, wid = __builtin_amdgcn_readfirstlane(tid >> 6), lane = tid & 63, wr = wid >> 2, wc = wid & 3, fr = lane & 15, fq = lane >> 4;
    const int K = g.K, nt = K / BK;
    unsigned voffA[2], voffB[2];
#pragma unroll
    for (int i = 0; i < 2; ++i) { int R, C; stage_rc(tid * 16 + i * 8192, R, C); const int Rb = Epi::PERM ? ((R & ~31) + perm32(R & 31)) : R;
        voffA[i] = (unsigned)(R * K + C) * 2u; voffB[i] = (unsigned)(Rb * K + C) * 2u; }
    const size_t kstep = (size_t)(BK * 2);
    const size_t hstep = (size_t)HALF * K * 2;
    const size_t tstep = 2 * hstep;
    const unsigned ldsw = (unsigned)wid * 1024u;
    const int aoff = lds_byte(wr * 64 + fr, fq * 8), boff = lds_byte(wc * 32 + fr, fq * 8);
#define PG8_SA(b, h) (((b) * 2 + (h)) * HTB)
#define PG8_SB(b, h) ((4 + (b) * 2 + (h)) * HTB)
#define PG8_STAGE(bufoff, gbase, voff) do { _Pragma("unroll") for (int _i = 0; _i < 2; ++_i) \
        __builtin_amdgcn_global_load_lds((const unsigned*)((const char*)(gbase) + (voff)[_i]), (PG8_LAS unsigned*)(lds + (bufoff) + ldsw + _i * 8192), 16, 0, 0); } while (0)
#define PG8_LDA(dst, b, h) do { _Pragma("unroll") for (int m = 0; m < 4; ++m) _Pragma("unroll") for (int k = 0; k < 2; ++k) dst[m][k] = *(const PG8_LAS bf16x8*)(lds + PG8_SA(b, h) + aoff + m * 2048 + k * 1024); } while (0)
#define PG8_LDB(dst, b, h) do { _Pragma("unroll") for (int n = 0; n < 2; ++n) _Pragma("unroll") for (int k = 0; k < 2; ++k) dst[n][k] = *(const PG8_LAS bf16x8*)(lds + PG8_SB(b, h) + boff + n * 2048 + k * 1024); } while (0)
#define PG8_MMA(ai, bj, At, Bt) do { __builtin_amdgcn_s_setprio(1); _Pragma("unroll") for (int m = 0; m < 4; ++m) _Pragma("unroll") for (int n = 0; n < 2; ++n) _Pragma("unroll") for (int k = 0; k < 2; ++k) \
        acc[ai][bj][m][n] = __builtin_amdgcn_mfma_f32_16x16x32_bf16(Bt[n][k], At[m][k], acc[ai][bj][m][n], 0, 0, 0); __builtin_amdgcn_s_setprio(0); } while (0)
#define PG8_WAIT_V(n) asm volatile("s_waitcnt vmcnt(" #n ")" ::: "memory")
#define PG8_WAIT_L(n) asm volatile("s_waitcnt lgkmcnt(" #n ")" ::: "memory")
#define PG8_BAR __builtin_amdgcn_s_barrier()
#define PG8_SCHED __builtin_amdgcn_sched_barrier(0)
    Unit cur, nxt; int ui = 0;
    if (!S.next(0, cur)) return;
    f32x4 acc[2][2][4][2];
#pragma unroll
    for (int a = 0; a < 2; ++a)
#pragma unroll
        for (int b = 0; b < 2; ++b)
#pragma unroll
            for (int m = 0; m < 4; ++m)
#pragma unroll
                for (int n = 0; n < 2; ++n) acc[a][b][m][n] = (f32x4){0.f, 0.f, 0.f, 0.f};
    bf16x8 At[4][2], B0[2][2], B1[2][2];
    const char* cA = (const char*)g.A + (size_t)cur.pm * tstep; const char* cB = (const char*)g.Bt + (size_t)cur.pn * tstep;
    S.a_ready(cur);
    if constexpr (SP2) {
        PG8_STAGE(PG8_SB(0, 0), cB, voffB); PG8_STAGE(PG8_SB(0, 1), cB + hstep, voffB); PG8_STAGE(PG8_SA(0, 0), cA, voffA); PG8_STAGE(PG8_SA(0, 1), cA + hstep, voffA);
        if (wr == 1) PG8_BAR;
        PG8_WAIT_V(2); PG8_BAR;
        PG8_STAGE(PG8_SB(1, 0), cB + kstep, voffB); PG8_STAGE(PG8_SA(1, 0), cA + kstep, voffA); PG8_STAGE(PG8_SB(1, 1), cB + hstep + kstep, voffB);
        PG8_WAIT_V(6); PG8_BAR;
    } else {
        PG8_STAGE(PG8_SB(0, 0), cB, voffB); PG8_STAGE(PG8_SA(0, 0), cA, voffA); PG8_STAGE(PG8_SB(0, 1), cB + hstep, voffB); PG8_STAGE(PG8_SA(0, 1), cA + hstep, voffA);
        if (wr == 1) PG8_BAR;
        PG8_WAIT_V(4); PG8_BAR;
        PG8_STAGE(PG8_SB(1, 0), cB + kstep, voffB); PG8_STAGE(PG8_SA(1, 0), cA + kstep, voffA); PG8_STAGE(PG8_SB(1, 1), cB + hstep + kstep, voffB);
        PG8_WAIT_V(6); PG8_BAR;
    }
    for (;;) {
        const bool has_next = S.next(ui + 1, nxt);
        const char* nA = has_next ? (const char*)g.A + (size_t)nxt.pm * tstep : cA; const char* nB = has_next ? (const char*)g.Bt + (size_t)nxt.pn * tstep : cB;
        for (int t = 0; t < nt; t += 2) {
            const bool last = (t == nt - 2);
            const char* a1 = cA + (size_t)(t + 1) * kstep;
            const char* a2 = last ? nA : cA + (size_t)(t + 2) * kstep; const char* b2 = last ? nB : cB + (size_t)(t + 2) * kstep;
            const char* a3 = a2 + kstep; const char* b3 = b2 + kstep;
            if (last && has_next) S.a_ready(nxt);
            if constexpr (SP2) {
            PG8_LDB(B0, 0, 0); PG8_LDB(B1, 0, 1); PG8_SCHED; PG8_LDA(At, 0, 0); PG8_STAGE(PG8_SA(1, 1), a1 + hstep, voffA);
            PG8_WAIT_V(8); PG8_WAIT_L(0); PG8_BAR; PG8_MMA(0, 0, At, B0); PG8_MMA(0, 1, At, B1); PG8_BAR; PG8_SCHED;
            PG8_LDA(At, 0, 1); PG8_STAGE(PG8_SB(0, 0), b2, voffB); PG8_STAGE(PG8_SB(0, 1), b2 + hstep, voffB); PG8_STAGE(PG8_SA(0, 0), a2, voffA);
            PG8_WAIT_V(8); PG8_WAIT_L(0); PG8_BAR; PG8_MMA(1, 0, At, B0); PG8_MMA(1, 1, At, B1); PG8_BAR; PG8_SCHED;
            PG8_LDB(B0, 1, 0); PG8_LDB(B1, 1, 1); PG8_SCHED; PG8_LDA(At, 1, 0); PG8_STAGE(PG8_SA(0, 1), a2 + hstep, voffA);
            PG8_WAIT_V(8); PG8_WAIT_L(0); PG8_BAR; PG8_MMA(0, 0, At, B0); PG8_MMA(0, 1, At, B1); PG8_BAR; PG8_SCHED;
            PG8_LDA(At, 1, 1); PG8_STAGE(PG8_SB(1, 0), b3, voffB); PG8_STAGE(PG8_SB(1, 1), b3 + hstep, voffB); PG8_STAGE(PG8_SA(1, 0), a3, voffA);
            PG8_WAIT_V(8); PG8_WAIT_L(0); PG8_BAR; PG8_MMA(1, 0, At, B0); PG8_MMA(1, 1, At, B1); PG8_BAR; PG8_SCHED;
            } else {
            PG8_LDB(B0, 0, 0); PG8_SCHED; PG8_LDA(At, 0, 0); PG8_STAGE(PG8_SA(1, 1), a1 + hstep, voffA);
            PG8_WAIT_L(8); PG8_BAR; PG8_WAIT_L(0); PG8_MMA(0, 0, At, B0); PG8_BAR; PG8_SCHED;
            PG8_LDB(B1, 0, 1); PG8_STAGE(PG8_SB(0, 0), b2, voffB);
            PG8_BAR; PG8_WAIT_L(0); PG8_MMA(0, 1, At, B1); PG8_BAR;
            PG8_LDA(At, 0, 1); PG8_STAGE(PG8_SA(0, 0), a2, voffA);
            PG8_BAR; PG8_WAIT_L(0); PG8_MMA(1, 0, At, B0); PG8_BAR; PG8_SCHED;
            PG8_STAGE(PG8_SB(0, 1), b2 + hstep, voffB);
            PG8_WAIT_V(6); PG8_BAR; PG8_MMA(1, 1, At, B1); PG8_BAR;
            PG8_LDB(B0, 1, 0); PG8_SCHED; PG8_LDA(At, 1, 0); PG8_STAGE(PG8_SA(0, 1), a2 + hstep, voffA);
            PG8_WAIT_L(8); PG8_BAR; PG8_WAIT_L(0); PG8_MMA(0, 0, At, B0); PG8_BAR; PG8_SCHED;
            PG8_LDB(B1, 1, 1); PG8_STAGE(PG8_SB(1, 0), b3, voffB);
            PG8_BAR; PG8_WAIT_L(0); PG8_MMA(0, 1, At, B1); PG8_BAR;
            PG8_LDA(At, 1, 1); PG8_STAGE(PG8_SA(1, 0), a3, voffA);
            PG8_BAR; PG8_WAIT_L(0); PG8_MMA(1, 0, At, B0); PG8_BAR; PG8_SCHED;
            PG8_STAGE(PG8_SB(1, 1), b3 + hstep, voffB);
            PG8_WAIT_V(6); PG8_BAR; PG8_MMA(1, 1, At, B1); PG8_BAR;
            }
        }
        if constexpr (ALIGN_EPI) { if (wr == 0) PG8_BAR; }
        if constexpr (!Epi::AFTER_DRAIN) { E(acc, cur, wr, wc, fr, fq); S.done(cur); }
        if (!has_next) break;
#pragma unroll
        for (int a = 0; a < 2; ++a)
#pragma unroll
            for (int b = 0; b < 2; ++b)
#pragma unroll
                for (int m = 0; m < 4; ++m)
#pragma unroll
                    for (int n = 0; n < 2; ++n) acc[a][b][m][n] = (f32x4){0.f, 0.f, 0.f, 0.f};
        cur = nxt; cA = nA; cB = nB; ++ui;
        if constexpr (ALIGN_EPI) { if (wr == 1) PG8_BAR; }
    }
    PG8_WAIT_V(0);
    if constexpr (!ALIGN_EPI) { if (wr == 0) PG8_BAR; }
    PG8_BAR;
    if constexpr (Epi::AFTER_DRAIN) { E.fused(acc, cur, wr, wc, fr, fq, lds, wid, lane); S.done(cur); }
#undef PG8_SA
#undef PG8_SB
#undef PG8_STAGE
#undef PG8_LDA
#undef PG8_LDB
#undef PG8_MMA
#undef PG8_WAIT_V
#undef PG8_WAIT_L
#undef PG8_BAR
#undef PG8_SCHED
}
}
namespace mk {
#define LAS __attribute__((address_space(3)))
typedef unsigned short bf16_t;
typedef float f32x4 __attribute__((ext_vector_type(4)));
typedef float f32x2 __attribute__((ext_vector_type(2)));
typedef unsigned u32x4 __attribute__((ext_vector_type(4)));
typedef unsigned u32x2 __attribute__((ext_vector_type(2)));
typedef __bf16 bf16x2_t __attribute__((ext_vector_type(2)));
typedef short bf16x8 __attribute__((ext_vector_type(8)));
typedef short s16x4 __attribute__((ext_vector_type(4)));
constexpr int D = 2048, NB = 4, S = 4096, T = NB * S, IN_LD = 5384, NP = 5632, NE = 16384;
constexpr int NTHR = 512, NWAVES = 8;
constexpr int LDS_BYTES = 160 * 1024;
constexpr int LDS_SPARE = 128 * 1024;
constexpr float EPS = 1e-6f;
#ifndef REPS
#define REPS 1,1,1,1,1,1,1
#endif
constexpr int REPV[7] = {REPS};
constexpr int REP0 = REPV[0], REP1 = REPV[1], REP2 = REPV[2], REP3 = REPV[3], REP4 = REPV[4], REP5 = REPV[5], REP6 = REPV[6];
constexpr int C_QA = 0, C_KA = 1024, C_VA = 1152, C_QH = 1280, C_FH = 1792, C_IH = 2304, C_GH = 2816, C_QM = 3328, C_KM = 3840, C_VM = 4352, C_OM = 4864, C_IM = 5376, C_FM = 5380;

constexpr size_t WS_CTL = 0;
constexpr size_t WS_WINT = 65536;
constexpr size_t WS_WOUTT = WS_WINT + 2 * (size_t)NP * D * 2;
constexpr size_t WS_WQT = WS_WOUTT + 2 * (size_t)D * D * 2;
constexpr size_t WS_SUBK = WS_WQT + 2 * (size_t)D * D * 2;
constexpr size_t WS_U8 = WS_SUBK + 2 * 2 * 8 * 128 * 128 * 2;
constexpr size_t WS_V8 = WS_U8 + 2 * (size_t)NE * D;
constexpr size_t WS_USC = WS_V8 + 2 * (size_t)NE * D;
constexpr size_t WS_VSC = WS_USC + 2 * (size_t)NE * 4;
constexpr size_t WS_ROPE = WS_VSC + 2 * (size_t)NE * 4;
constexpr size_t WS_SS = WS_ROPE + (size_t)S * 32 * 8;
constexpr size_t WS_SSP = WS_SS + (size_t)T * 16 * 4;
constexpr size_t WS_XB = WS_SSP + (size_t)T * 32 * 4;
constexpr size_t WS_P = WS_XB + (size_t)T * D * 2;
constexpr size_t WS_YB = WS_P + (size_t)T * NP * 2;
constexpr size_t WS_Q = WS_YB + (size_t)T * D * 2;
constexpr size_t WS_IDX = WS_Q + (size_t)T * D * 2;
constexpr size_t WS_GATE = WS_IDX + (size_t)T * 128 * 4;
constexpr size_t WS_X1 = WS_GATE + (size_t)T * 128 * 4;
constexpr size_t WS_X2 = WS_X1 + (size_t)T * D * 4;
constexpr size_t WS_IDXU = WS_X2 + (size_t)T * D * 4;
constexpr size_t WS_STH = WS_IDXU + (size_t)T * 128 * 4;
constexpr size_t WS_STM = WS_STH + (size_t)128 * 16640 * 4;
constexpr size_t WS_END = WS_STM + (size_t)128 * 16640 * 4;
constexpr size_t WS_PART = WS_P;
constexpr size_t WS_ACT = WS_Q;
static_assert((size_t)16 * T * 128 * 4 <= (size_t)T * NP * 2, "PART overlay");
static_assert(WS_END <= ((size_t)1 << 30), "workspace");
struct Params { const float* in[16]; float* out; unsigned char* ws; int ph_lo, ph_hi, layer, layer_hi, pad, pad2; };

__device__ __forceinline__ unsigned pk2(float lo, float hi) { f32x2 v = {lo, hi}; bf16x2_t b = __builtin_convertvector(v, bf16x2_t); return __builtin_bit_cast(unsigned, b); }
__device__ __forceinline__ float bf2f(unsigned short h) { return __uint_as_float((unsigned)h << 16); }
__device__ __forceinline__ float bflo(unsigned w) { return __uint_as_float(w << 16); }
__device__ __forceinline__ float bfhi(unsigned w) { return __uint_as_float(w & 0xffff0000u); }
__device__ __forceinline__ float wsum(float v) {
#pragma unroll
    for (int o = 1; o < 64; o <<= 1) v += __shfl_xor(v, o);
    return v;
}
__device__ __forceinline__ float wmax(float v) {
#pragma unroll
    for (int o = 1; o < 64; o <<= 1) v = fmaxf(v, __shfl_xor(v, o));
    return v;
}

__device__ __forceinline__ void transpose_item(const float* __restrict__ W, int ldw, int nvalid, const float* __restrict__ gain, bf16_t* __restrict__ WT, int K, int k0, int n0, LAS float* scr, int lane) {
    const int n = n0 + (lane & 31);
#pragma unroll 8
    for (int i = 0; i < 32; ++i) {
        const int kk = 2 * i + (lane >> 5);
        float v = 0.f;
        if (n < nvalid) v = W[(size_t)(k0 + kk) * ldw + n];
        if (gain) v *= gain[k0 + kk];
        scr[kk * 33 + (lane & 31)] = v;
    }
    __builtin_amdgcn_s_waitcnt(0xc07f);
    asm volatile("" ::: "memory");
    const int c = lane & 7;
#pragma unroll
    for (int j = 0; j < 4; ++j) {
        const int nn = (lane >> 3) + 8 * j;
        const LAS float* s = scr + (8 * c) * 33 + nn;
        u32x4 o; o.x = pk2(s[0 * 33], s[1 * 33]); o.y = pk2(s[2 * 33], s[3 * 33]); o.z = pk2(s[4 * 33], s[5 * 33]); o.w = pk2(s[6 * 33], s[7 * 33]);
        *(u32x4*)(WT + (size_t)(n0 + nn) * K + k0 + 8 * c) = o;
    }
    __builtin_amdgcn_s_waitcnt(0xc07f);
    asm volatile("" ::: "memory");
}
__device__ __forceinline__ void xprep_row(const float* __restrict__ xrow, bf16_t* __restrict__ orow, float* __restrict__ ss, int lane) {
    const f32x4* xr = (const f32x4*)xrow + lane;
    f32x4 v[8]; float s = 0.f;
#pragma unroll
    for (int j = 0; j < 8; ++j) { v[j] = xr[64 * j]; s += (v[j].x * v[j].x + v[j].y * v[j].y) + (v[j].z * v[j].z + v[j].w * v[j].w); }
    s = wsum(s);
    u32x2* o = (u32x2*)orow + lane;
#pragma unroll
    for (int j = 0; j < 8; ++j) { u32x2 w; w.x = pk2(v[j].x, v[j].y); w.y = pk2(v[j].z, v[j].w); o[64 * j] = w; }
    if (lane < 16) ss[lane] = (lane == 0) ? s : 0.f;
}
__device__ __forceinline__ void fp8_row(const float* __restrict__ src, const float* __restrict__ gain, unsigned char* __restrict__ dst, float* __restrict__ sc, int lane) {
    f32x4 v[2][4]; float am = 0.f;
#pragma unroll
    for (int j = 0; j < 2; ++j)
#pragma unroll
        for (int q = 0; q < 4; ++q) {
            const int e = j * 1024 + lane * 16 + q * 4;
            f32x4 a = *(const f32x4*)(src + e);
            if (gain) a = a * *(const f32x4*)(gain + e);
            v[j][q] = a;
            am = fmaxf(am, fmaxf(fmaxf(fabsf(a.x), fabsf(a.y)), fmaxf(fabsf(a.z), fabsf(a.w))));
        }
    am = wmax(am);
    const float qs = am > 0.f ? 256.f / am : 1.f;
#pragma unroll
    for (int j = 0; j < 2; ++j) {
        u32x4 w;
#pragma unroll
        for (int q = 0; q < 4; ++q) {
            const f32x4 a = v[j][q] * qs;
            int pkd = __builtin_amdgcn_cvt_pk_fp8_f32(a.x, a.y, 0, false);
            pkd = __builtin_amdgcn_cvt_pk_fp8_f32(a.z, a.w, pkd, true);
            w[q] = (unsigned)pkd;
        }
        *(u32x4*)(dst + ((size_t)(j * 8 + (lane >> 3)) * NE) * 128 + (lane & 7) * 16) = w;
    }
    if (lane == 0) *sc = am > 0.f ? am * (1.f / 256.f) : 1.f;
}

__device__ __forceinline__ void p0_prologue(const Params& p, LAS unsigned char* lds) {
    const int tid = threadIdx.x, lane = tid & 63, wave = tid >> 6;
    const int G = gridDim.x, gw = blockIdx.x * NWAVES + wave, ngw = G * NWAVES;
    const size_t gt = (size_t)blockIdx.x * NTHR + tid, ngt = (size_t)G * NTHR;
    unsigned char* ws = p.ws;
    const float* x = p.in[0]; const float* norm_mix = p.in[1]; const float* w_in = p.in[2]; const float* w_out = p.in[3];
    const float* norm_ffn = p.in[10]; const float* peer_query = p.in[11]; const float* sub_keys = p.in[12]; const float* peer_u = p.in[13]; const float* peer_v = p.in[14];
    {
        LAS float* scr = (LAS float*)(lds + wave * 8448);
        constexpr int I_IN = 32 * (NP / 32), I_SQ = 32 * (D / 32), PER_L = I_IN + 2 * I_SQ;
        for (int it = gw; it < 2 * PER_L; it += ngw) {
            const int l = it / PER_L; int r = it % PER_L;
            if (r < I_IN) { transpose_item(w_in + (size_t)l * D * IN_LD, IN_LD, IN_LD, norm_mix + l * D, (bf16_t*)(ws + WS_WINT) + (size_t)l * NP * D, D, (r / (NP / 32)) * 64, (r % (NP / 32)) * 32, scr, lane); continue; }
            r -= I_IN;
            if (r < I_SQ) { transpose_item(w_out + (size_t)l * D * D, D, D, nullptr, (bf16_t*)(ws + WS_WOUTT) + (size_t)l * D * D, D, (r / (D / 32)) * 64, (r % (D / 32)) * 32, scr, lane); continue; }
            r -= I_SQ;
            transpose_item(peer_query + (size_t)l * D * D, D, D, norm_ffn + l * D, (bf16_t*)(ws + WS_WQT) + (size_t)l * D * D, D, (r / (D / 32)) * 64, (r % (D / 32)) * 32, scr, lane);
        }
    }
    for (size_t i = gt; i < 2 * 2 * 8 * 128 * 128 / 4; i += ngt) {
        const f32x4 v = ((const f32x4*)sub_keys)[i];
        u32x2 w; w.x = pk2(v.x, v.y); w.y = pk2(v.z, v.w);
        ((u32x2*)(ws + WS_SUBK))[i] = w;
    }
    for (int r = gw; r < 4 * NE; r += ngw) {
        const int tb = r / (2 * NE), rr = r % (2 * NE), l = rr / NE;
        if (tb == 0) fp8_row(peer_u + (size_t)rr * D, norm_ffn + l * D, ws + WS_U8 + (size_t)l * NE * D + (size_t)(rr - l * NE) * 128, (float*)(ws + WS_USC) + rr, lane);
        else fp8_row(peer_v + (size_t)rr * D, nullptr, ws + WS_V8 + (size_t)l * NE * D + (size_t)(rr - l * NE) * 128, (float*)(ws + WS_VSC) + rr, lane);
    }
    for (size_t i = gt; i < (size_t)S * 32; i += ngt) {
        const int fi = (int)(i & 31), pos = (int)(i >> 5);
        const float inv = powf(10000.f, -(float)fi / 32.f);
        const float ang = (float)pos * inv;
        f32x2 cs; cs.x = cosf(ang); cs.y = sinf(ang);
        ((f32x2*)(ws + WS_ROPE))[i] = cs;
    }
    for (int t = gw; t < T; t += ngw) xprep_row(x + (size_t)t * D, (bf16_t*)(ws + WS_XB) + (size_t)t * D, (float*)(ws + WS_SS) + (size_t)t * 16, lane);
}

template <int NSS>
struct EpiScaleBf16 {
    static constexpr bool PERM = true, AFTER_DRAIN = false;
    bf16_t* O; int ldc; const float* ss;
    __device__ __forceinline__ void operator()(const pg8::f32x4 (&acc)[2][2][4][2], const pg8::Unit& u, int wr, int wc, int fr, int fq) const {
        const int row0 = u.pm * 256 + wr * 64 + fr, col0 = u.pn * 256 + wc * 32 + 8 * fq;
#pragma unroll
        for (int ai = 0; ai < 2; ++ai)
#pragma unroll
            for (int m = 0; m < 4; ++m) {
                const int row = row0 + ai * 128 + m * 16;
                float s;
                {
                    const f32x4* sp = (const f32x4*)(ss + (size_t)row * NSS);
                    f32x4 a = sp[0];
#pragma unroll
                    for (int i = 1; i < NSS / 4; ++i) a = a + sp[i];
                    s = (a.x + a.y) + (a.z + a.w);
                }
                const float r = rsqrtf(s * (1.f / D) + EPS);
                bf16_t* rowp = O + (size_t)row * ldc + col0;
#pragma unroll
                for (int bj = 0; bj < 2; ++bj) {
                    const pg8::f32x4 v0 = acc[ai][bj][m][0] * r, v1 = acc[ai][bj][m][1] * r;
                    u32x4 w; w.x = pk2(v0[0], v0[1]); w.y = pk2(v0[2], v0[3]); w.z = pk2(v1[0], v1[1]); w.w = pk2(v1[2], v1[3]);
                    *(u32x4*)(rowp + bj * 128) = w;
                }
            }
    }
};

struct EpiX1 {
    static constexpr bool PERM = false, AFTER_DRAIN = false;
    const float* xin32;
    bf16_t* X1B; float* ssp;
    __device__ __forceinline__ void operator()(const pg8::f32x4 (&acc)[2][2][4][2], const pg8::Unit& u, int wr, int wc, int fr, int fq) const {
        const int col0 = u.pn * 256 + wc * 32 + 4 * fq;
#pragma unroll
        for (int ai = 0; ai < 2; ++ai)
#pragma unroll
            for (int m = 0; m < 4; ++m) {
                const int row = u.pm * 256 + ai * 128 + wr * 64 + m * 16 + fr;
                float q = 0.f;
#pragma unroll
                for (int bj = 0; bj < 2; ++bj)
#pragma unroll
                    for (int n = 0; n < 2; ++n) {
                        const size_t off = (size_t)row * D + col0 + bj * 128 + n * 16;
                        pg8::f32x4 r;
                        if (xin32) r = *(const pg8::f32x4*)(xin32 + off);
                        else { const u32x2 rb = *(const u32x2*)(X1B + off); r = (pg8::f32x4){bflo(rb.x), bfhi(rb.x), bflo(rb.y), bfhi(rb.y)}; }
                        const pg8::f32x4 o = r + acc[ai][bj][m][n];
                        u32x2 w; w.x = pk2(o[0], o[1]); w.y = pk2(o[2], o[3]);
                        *(u32x2*)(X1B + off) = w;
                        const float o0 = bflo(w.x), o1 = bfhi(w.x), o2 = bflo(w.y), o3 = bfhi(w.y);
                        q += (o0 * o0 + o1 * o1) + (o2 * o2 + o3 * o3);
                    }
                q += __shfl_xor(q, 16); q += __shfl_xor(q, 32);
                if (fq == 0) ssp[(size_t)row * 32 + u.pn * 4 + wc] = q;
            }
    }
};

#define TOPK_INSERT(L, x) do { _Pragma("unroll") for (int _i = 15; _i >= 1; --_i) L[_i] = __builtin_amdgcn_fmed3f(L[_i - 1], L[_i], (x)); L[0] = fmaxf(L[0], (x)); } while (0)
__device__ __forceinline__ void route_unit(const bf16_t* __restrict__ Q, const bf16_t* __restrict__ subk_l, int pm, int h, int* __restrict__ IDX, int* __restrict__ IDXU, float* __restrict__ GATE,
                                           LAS float* scr  , int wave, int lane) {
    const int fr = lane & 15, fq = lane >> 4;
    float L1[16], L2[16];
#pragma unroll 1
    for (int nt = 0; nt < 2; ++nt) {
        const int tok = pm * 256 + wave * 32 + nt * 16 + fr;
#pragma unroll
        for (int half = 0; half < 2; ++half) {
            float L[16];
#pragma unroll
            for (int i = 0; i < 16; ++i) L[i] = -3.0e38f;
            bf16x8 bq[4];
            const bf16_t* qp = Q + (size_t)tok * D + h * 256 + half * 128 + 8 * fq;
#pragma unroll
            for (int ks = 0; ks < 4; ++ks) bq[ks] = *(const bf16x8*)(qp + ks * 32);
            const bf16_t* kb = subk_l + ((size_t)(half * 8 + h) * 128) * 128;
#pragma unroll 2
            for (int mt = 0; mt < 8; ++mt) {
                pg8::f32x4 acc = {0.f, 0.f, 0.f, 0.f};
                const bf16_t* kp = kb + (size_t)(mt * 16 + fr) * 128 + 8 * fq;
#pragma unroll
                for (int ks = 0; ks < 4; ++ks) {
                    const bf16x8 ak = *(const bf16x8*)(kp + ks * 32);
                    acc = __builtin_amdgcn_mfma_f32_16x16x32_bf16(ak, bq[ks], acc, 0, 0, 0);
                }
#pragma unroll
                for (int r = 0; r < 4; ++r) {
                    const unsigned key = (unsigned)(mt * 16 + 4 * fq + r);
                    const float xv = __uint_as_float((__float_as_uint(acc[r]) & 0xffffff80u) | key);
                    TOPK_INSERT(L, xv);
                }
            }
#pragma unroll
            for (int sh = 16; sh <= 32; sh <<= 1) {
                float o[16];
#pragma unroll
                for (int i = 0; i < 16; ++i) o[i] = __shfl_xor(L[i], sh);
#pragma unroll
                for (int i = 0; i < 16; ++i) TOPK_INSERT(L, o[i]);
            }
#pragma unroll
            for (int i = 0; i < 16; ++i) { if (half == 0) L1[i] = L[i]; else L2[i] = L[i]; }
        }
        float C[16];
#pragma unroll
        for (int i = 0; i < 16; ++i) C[i] = -3.0e38f;
#pragma unroll
        for (int a = 0; a < 16; ++a)
#pragma unroll
            for (int b = 0; b < 16; ++b)
                if ((a + 1) * (b + 1) <= 16) {
                    const float sm = L1[a] + L2[b];
                    const float xv = __uint_as_float((__float_as_uint(sm) & 0xffffff00u) | (unsigned)(a * 16 + b));
                    TOPK_INSERT(C, xv);
                }
        LAS float* my = scr + lane * 33;
#pragma unroll
        for (int i = 0; i < 16; ++i) { my[i] = L1[i]; my[16 + i] = L2[i]; }
        __builtin_amdgcn_s_waitcnt(0xc07f);
        asm volatile("" ::: "memory");
        const float mx = __uint_as_float(__float_as_uint(C[0]) & 0xffffff00u);
        float e[16], den = 0.f;
#pragma unroll
        for (int i = 0; i < 16; ++i) { e[i] = __expf(__uint_as_float(__float_as_uint(C[i]) & 0xffffff00u) - mx); den += e[i]; }
        const float rden = 1.f / den;
#pragma unroll
        for (int i = 0; i < 16; ++i) {
            if ((i >> 2) == fq) {
                const unsigned ab = __float_as_uint(C[i]) & 0xffu;
                const unsigned i1 = __float_as_uint(my[ab >> 4]) & 0x7fu, i2 = __float_as_uint(my[16 + (ab & 15)]) & 0x7fu;
                const int pp = h * 16 + i, pos = (pp & 7) * 16 + (pp >> 3);
                IDX[(size_t)tok * 128 + pos] = (int)(i1 * 128 + i2);
                GATE[(size_t)tok * 128 + pos] = e[i] * rden;
                IDXU[(size_t)tok * 128 + (pp & 15) * 8 + (pp >> 4)] = (int)(i1 * 128 + i2);
            }
        }
        __builtin_amdgcn_s_waitcnt(0xc07f);
        asm volatile("" ::: "memory");
    }
}

__device__ __forceinline__ float gelu_erf(float x) { return 0.5f * x * (1.f + erff(x * 0.70710678118654752f)); }
template <bool FINAL>
__device__ __forceinline__ void expert_token(int t, const bf16_t* __restrict__ X1B, const float* __restrict__ X1, const float* __restrict__ ssp, const int* __restrict__ IDX, const float* __restrict__ GATE,
                                             const unsigned char* __restrict__ U8, const float* __restrict__ USC, const unsigned char* __restrict__ V8, const float* __restrict__ VSC,
                                             float* __restrict__ X2, bf16_t* __restrict__ XB, float* __restrict__ SS, const float* __restrict__ norm_final, float* __restrict__ OUT, int lane) {
    float xf[2][16];
#pragma unroll
    for (int j = 0; j < 2; ++j) {
        const u32x4* xp = (const u32x4*)(X1B + (size_t)t * D + j * 1024 + lane * 16);
        const u32x4 a = xp[0], b = xp[1];
#pragma unroll
        for (int q = 0; q < 4; ++q) { xf[j][2 * q] = bflo(a[q]); xf[j][2 * q + 1] = bfhi(a[q]); xf[j][8 + 2 * q] = bflo(b[q]); xf[j][8 + 2 * q + 1] = bfhi(b[q]); }
    }
    float sp = (lane < 32) ? ssp[(size_t)t * 32 + lane] : 0.f;
    sp = wsum(sp);
    const float rs1 = rsqrtf(sp * (1.f / D) + EPS);
    const int id0 = IDX[(size_t)t * 128 + lane], id1 = IDX[(size_t)t * 128 + 64 + lane];
    const float g0 = GATE[(size_t)t * 128 + lane], g1 = GATE[(size_t)t * 128 + 64 + lane];
    const float us0 = USC[id0], us1 = USC[id1], vs0 = VSC[id0], vs1 = VSC[id1];
    float acc[2][16];
#pragma unroll
    for (int j = 0; j < 2; ++j)
#pragma unroll
        for (int i = 0; i < 16; ++i) acc[j][i] = 0.f;
    float act0 = 0.f, act1 = 0.f;
#pragma unroll 1
    for (int e0 = 0; e0 < 128; e0 += 4) {
        u32x4 w[4][2];
#pragma unroll
        for (int e = 0; e < 4; ++e) {
            const int ee = e0 + e;
            const int id = __builtin_amdgcn_readlane(ee < 64 ? id0 : id1, ee & 63);
            const unsigned char* up = U8 + (size_t)id * D + lane * 16;
            w[e][0] = *(const u32x4*)up; w[e][1] = *(const u32x4*)(up + 1024);
        }
        float d[4];
#pragma unroll
        for (int e = 0; e < 4; ++e) {
            float s = 0.f;
#pragma unroll
            for (int j = 0; j < 2; ++j)
#pragma unroll
                for (int q = 0; q < 4; ++q) {
                    const f32x2 lo = __builtin_amdgcn_cvt_pk_f32_fp8((int)w[e][j][q], false), hi = __builtin_amdgcn_cvt_pk_f32_fp8((int)w[e][j][q], true);
                    s = fmaf(lo.x, xf[j][4 * q], s); s = fmaf(lo.y, xf[j][4 * q + 1], s); s = fmaf(hi.x, xf[j][4 * q + 2], s); s = fmaf(hi.y, xf[j][4 * q + 3], s);
                }
            d[e] = wsum(s);
        }
#pragma unroll
        for (int e = 0; e < 4; ++e) {
            const int ee = e0 + e;
            if (ee < 64) { if (lane == ee) act0 = d[e]; } else { if (lane == ee - 64) act1 = d[e]; }
        }
    }
    act0 = gelu_erf(act0 * us0 * rs1) * g0 * vs0;
    act1 = gelu_erf(act1 * us1 * rs1) * g1 * vs1;
#pragma unroll 1
    for (int e0 = 0; e0 < 128; e0 += 4) {
        u32x4 w[4][2];
        float a[4];
#pragma unroll
        for (int e = 0; e < 4; ++e) {
            const int ee = e0 + e;
            const int id = __builtin_amdgcn_readlane(ee < 64 ? id0 : id1, ee & 63);
            a[e] = __int_as_float(__builtin_amdgcn_readlane(__float_as_int(ee < 64 ? act0 : act1), ee & 63));
            const unsigned char* vp = V8 + (size_t)id * D + lane * 16;
            w[e][0] = *(const u32x4*)vp; w[e][1] = *(const u32x4*)(vp + 1024);
        }
#pragma unroll
        for (int e = 0; e < 4; ++e)
#pragma unroll
            for (int j = 0; j < 2; ++j)
#pragma unroll
                for (int q = 0; q < 4; ++q) {
                    const f32x2 lo = __builtin_amdgcn_cvt_pk_f32_fp8((int)w[e][j][q], false), hi = __builtin_amdgcn_cvt_pk_f32_fp8((int)w[e][j][q], true);
                    acc[j][4 * q] = fmaf(a[e], lo.x, acc[j][4 * q]); acc[j][4 * q + 1] = fmaf(a[e], lo.y, acc[j][4 * q + 1]);
                    acc[j][4 * q + 2] = fmaf(a[e], hi.x, acc[j][4 * q + 2]); acc[j][4 * q + 3] = fmaf(a[e], hi.y, acc[j][4 * q + 3]);
                }
    }
    float q2 = 0.f;
#pragma unroll
    for (int j = 0; j < 2; ++j)
#pragma unroll
        for (int q = 0; q < 4; ++q) {
            const f32x4 r = *(const f32x4*)(X1 + (size_t)t * D + j * 1024 + lane * 16 + q * 4);
            acc[j][4 * q] += r.x; acc[j][4 * q + 1] += r.y; acc[j][4 * q + 2] += r.z; acc[j][4 * q + 3] += r.w;
            q2 += (acc[j][4 * q] * acc[j][4 * q] + acc[j][4 * q + 1] * acc[j][4 * q + 1]) + (acc[j][4 * q + 2] * acc[j][4 * q + 2] + acc[j][4 * q + 3] * acc[j][4 * q + 3]);
        }
    q2 = wsum(q2);
    if (FINAL) {
        const float rf = rsqrtf(q2 * (1.f / D) + EPS);
#pragma unroll
        for (int j = 0; j < 2; ++j)
#pragma unroll
            for (int q = 0; q < 4; ++q) {
                const int e = j * 1024 + lane * 16 + q * 4;
                const f32x4 g = *(const f32x4*)(norm_final + e);
                f32x4 o; o.x = acc[j][4 * q] * rf * g.x; o.y = acc[j][4 * q + 1] * rf * g.y; o.z = acc[j][4 * q + 2] * rf * g.z; o.w = acc[j][4 * q + 3] * rf * g.w;
                *(f32x4*)(OUT + (size_t)t * D + e) = o;
            }
    } else {
#pragma unroll
        for (int j = 0; j < 2; ++j) {
#pragma unroll
            for (int q = 0; q < 4; ++q) {
                f32x4 o; o.x = acc[j][4 * q]; o.y = acc[j][4 * q + 1]; o.z = acc[j][4 * q + 2]; o.w = acc[j][4 * q + 3];
                *(f32x4*)(X2 + (size_t)t * D + j * 1024 + lane * 16 + q * 4) = o;
            }
            u32x4 b0, b1;
#pragma unroll
            for (int q = 0; q < 4; ++q) { b0[q] = pk2(acc[j][2 * q], acc[j][2 * q + 1]); b1[q] = pk2(acc[j][8 + 2 * q], acc[j][8 + 2 * q + 1]); }
            u32x4* xo = (u32x4*)(XB + (size_t)t * D + j * 1024 + lane * 16);
            xo[0] = b0; xo[1] = b1;
        }
        if (lane == 0) SS[t] = q2;
    }
}
}

namespace mk {
constexpr int KS_LD = 72, VS_LD = 80;
constexpr int ATT_KS_OFF = 0, ATT_VS_OFF = 256 * KS_LD * 2;
constexpr int ATT_LDS = ATT_VS_OFF + 256 * VS_LD * 2;

__device__ __forceinline__ bf16x8 tr_pair(const LAS bf16_t* p0, const LAS bf16_t* p1) {
    const s16x4 a = __builtin_amdgcn_ds_read_tr16_b64_v4i16((LAS s16x4*)p0);
    const s16x4 b = __builtin_amdgcn_ds_read_tr16_b64_v4i16((LAS s16x4*)p1);
    bf16x8 r; r[0] = a[0]; r[1] = a[1]; r[2] = a[2]; r[3] = a[3]; r[4] = b[0]; r[5] = b[1]; r[6] = b[2]; r[7] = b[3];
    return r;
}

__device__ __forceinline__ void attn_unit(const bf16_t* __restrict__ P, const f32x2* __restrict__ rope, const float* __restrict__ sinks_l, bf16_t* __restrict__ Y,
                                          int unit, LAS unsigned char* lds, int tid, int lane, int wave) {
    const int b = unit >> 6, n = (unit >> 1) & 31, kvh = unit & 1;
    const int tok0 = b * S + n * 128;
    LAS bf16_t* KS = (LAS bf16_t*)(lds + ATT_KS_OFF);
    LAS bf16_t* VS = (LAS bf16_t*)(lds + ATT_VS_OFF);
    {
        const int key = tid >> 1, part = tid & 1;
        const int kpos = n * 128 - 128 + key;
        u32x4 k1a = {0, 0, 0, 0}, k1b = k1a, k2a = k1a, k2b = k1a, v0 = k1a, v1 = k1a, v2 = k1a, v3 = k1a;
        if (kpos >= 0) {
            const bf16_t* kr = P + (size_t)(tok0 - 128 + key) * NP + C_KA + kvh * 64 + part * 16;
            const u32x4 x1a = *(const u32x4*)kr, x1b = *(const u32x4*)(kr + 8), x2a = *(const u32x4*)(kr + 32), x2b = *(const u32x4*)(kr + 40);
            const f32x2* cs = rope + (size_t)kpos * 32 + part * 16;
#pragma unroll
            for (int q = 0; q < 4; ++q) {
                {
                    const f32x2 c0 = cs[2 * q], c1 = cs[2 * q + 1];
                    const float a0 = bflo(x1a[q]), a1 = bfhi(x1a[q]), b0 = bflo(x2a[q]), b1 = bfhi(x2a[q]);
                    k1a[q] = pk2(a0 * c0.x - b0 * c0.y, a1 * c1.x - b1 * c1.y);
                    k2a[q] = pk2(b0 * c0.x + a0 * c0.y, b1 * c1.x + a1 * c1.y);
                }
                {
                    const f32x2 c0 = cs[8 + 2 * q], c1 = cs[8 + 2 * q + 1];
                    const float a0 = bflo(x1b[q]), a1 = bfhi(x1b[q]), b0 = bflo(x2b[q]), b1 = bfhi(x2b[q]);
                    k1b[q] = pk2(a0 * c0.x - b0 * c0.y, a1 * c1.x - b1 * c1.y);
                    k2b[q] = pk2(b0 * c0.x + a0 * c0.y, b1 * c1.x + a1 * c1.y);
                }
            }
            const bf16_t* vr = P + (size_t)(tok0 - 128 + key) * NP + C_VA + kvh * 64 + part * 32;
            v0 = *(const u32x4*)vr; v1 = *(const u32x4*)(vr + 8); v2 = *(const u32x4*)(vr + 16); v3 = *(const u32x4*)(vr + 24);
        }
        LAS bf16_t* kd = KS + key * KS_LD + part * 16;
        *(LAS u32x4*)kd = k1a; *(LAS u32x4*)(kd + 8) = k1b; *(LAS u32x4*)(kd + 32) = k2a; *(LAS u32x4*)(kd + 40) = k2b;
        LAS bf16_t* vd = VS + key * VS_LD + part * 32;
        *(LAS u32x4*)vd = v0; *(LAS u32x4*)(vd + 8) = v1; *(LAS u32x4*)(vd + 16) = v2; *(LAS u32x4*)(vd + 24) = v3;
    }
    __syncthreads();
    const int hq = kvh * 8 + wave;
    const int fr = lane & 15, fq = lane >> 4;
    constexpr float L2E = 1.4426950408889634f;
    const float sink2 = sinks_l[hq] * L2E;
    const int tq = (lane & 15) >> 2, tp = lane & 3;
#pragma unroll 1
    for (int rb = 0; rb < 8; ++rb) {
        const int q0 = rb * 16;
        const int qtok = tok0 + q0 + fr;
        bf16x8 bq0, bq1;
        {
            const bf16_t* qr = P + (size_t)qtok * NP + C_QA + hq * 64 + 8 * fq;
            const u32x4 x1 = *(const u32x4*)qr, x2 = *(const u32x4*)(qr + 32);
            const f32x2* cs = rope + (size_t)(n * 128 + q0 + fr) * 32 + 8 * fq;
            u32x4 o1, o2;
            constexpr float SC = 0.125f * L2E;
#pragma unroll
            for (int q = 0; q < 4; ++q) {
                const f32x2 c0 = cs[2 * q], c1 = cs[2 * q + 1];
                const float a0 = bflo(x1[q]), a1 = bfhi(x1[q]), b0 = bflo(x2[q]), b1 = bfhi(x2[q]);
                o1[q] = pk2((a0 * c0.x - b0 * c0.y) * SC, (a1 * c1.x - b1 * c1.y) * SC);
                o2[q] = pk2((b0 * c0.x + a0 * c0.y) * SC, (b1 * c1.x + a1 * c1.y) * SC);
            }
            bq0 = __builtin_bit_cast(bf16x8, o1); bq1 = __builtin_bit_cast(bf16x8, o2);
        }
        const int wsk = (q0 >> 5) << 5;
        pg8::f32x4 sc[10];
#pragma unroll
        for (int kt = 0; kt < 10; ++kt) {
            const LAS bf16_t* kp = KS + (wsk + kt * 16 + fr) * KS_LD + 8 * fq;
            const bf16x8 a0 = *(const LAS bf16x8*)kp, a1 = *(const LAS bf16x8*)(kp + 32);
            pg8::f32x4 acc = {0.f, 0.f, 0.f, 0.f};
            acc = __builtin_amdgcn_mfma_f32_16x16x32_bf16(a0, bq0, acc, 0, 0, 0);
            acc = __builtin_amdgcn_mfma_f32_16x16x32_bf16(a1, bq1, acc, 0, 0, 0);
            sc[kt] = acc;
        }
        const int qb = q0 + fr;
        const int kmin = (n == 0) ? 128 : 0;
        float mx = sink2;
#pragma unroll
        for (int kt = 0; kt < 10; ++kt)
#pragma unroll
            for (int r = 0; r < 4; ++r) {
                const int kb = wsk + kt * 16 + 4 * fq + r;
                const bool ok = (kb >= qb + 1) && (kb <= qb + 128) && (kb >= kmin);
                sc[kt][r] = ok ? sc[kt][r] : -1e30f;
                mx = fmaxf(mx, sc[kt][r]);
            }
        mx = fmaxf(mx, __shfl_xor(mx, 16)); mx = fmaxf(mx, __shfl_xor(mx, 32));
        float sum = 0.f;
#pragma unroll
        for (int kt = 0; kt < 10; ++kt)
#pragma unroll
            for (int r = 0; r < 4; ++r) { const float pv = __builtin_amdgcn_exp2f(sc[kt][r] - mx); sc[kt][r] = pv; sum += pv; }
        sum += __shfl_xor(sum, 16); sum += __shfl_xor(sum, 32);
        const float rden = 1.f / (sum + __builtin_amdgcn_exp2f(sink2 - mx));
        pg8::f32x4 oacc[4];
#pragma unroll
        for (int mt = 0; mt < 4; ++mt) oacc[mt] = (pg8::f32x4){0.f, 0.f, 0.f, 0.f};
#pragma unroll
        for (int kk = 0; kk < 5; ++kk) {
            u32x4 pb; pb[0] = pk2(sc[2 * kk][0], sc[2 * kk][1]); pb[1] = pk2(sc[2 * kk][2], sc[2 * kk][3]);
            pb[2] = pk2(sc[2 * kk + 1][0], sc[2 * kk + 1][1]); pb[3] = pk2(sc[2 * kk + 1][2], sc[2 * kk + 1][3]);
            const bf16x8 bp = __builtin_bit_cast(bf16x8, pb);
            const LAS bf16_t* v0 = VS + (wsk + (2 * kk) * 16 + 4 * fq + tq) * VS_LD + 4 * tp;
            const LAS bf16_t* v1 = v0 + 16 * VS_LD;
#pragma unroll
            for (int mt = 0; mt < 4; ++mt) {
                const bf16x8 av = tr_pair(v0 + mt * 16, v1 + mt * 16);
                oacc[mt] = __builtin_amdgcn_mfma_f32_16x16x32_bf16(av, bp, oacc[mt], 0, 0, 0);
            }
        }
        bf16_t* yr = Y + (size_t)qtok * D + hq * 64 + 4 * fq;
#pragma unroll
        for (int mt = 0; mt < 4; ++mt) {
            u32x2 w; w.x = pk2(oacc[mt][0] * rden, oacc[mt][1] * rden); w.y = pk2(oacc[mt][2] * rden, oacc[mt][3] * rden);
            *(u32x2*)(yr + mt * 16) = w;
        }
    }
}
}

namespace mk {
constexpr int RL = 144;
constexpr int PSL = 72;
constexpr int OBL = 132;
constexpr int R_QT = 0, R_KT = 64 * RL * 2, R_KD = 2 * 64 * RL * 2, R_V = 3 * 64 * RL * 2, R_SB = 4 * 64 * RL * 2;
constexpr int R_PS = R_SB + 128 * RL * 2;
constexpr int R_VEC = R_PS + 64 * PSL * 2;
constexpr int R_OB = R_KT;
constexpr int REC_LDS = R_VEC + 8192;
static_assert(64 * OBL * 4 <= 2 * 64 * RL * 2, "OB overlay");
constexpr int ST_STRIDE = 16384 + 256;

__device__ __forceinline__ bf16x8 ld_row_split(const LAS bf16_t* p) {
    const s16x4 a = *(const LAS s16x4*)p, b = *(const LAS s16x4*)(p + 16);
    bf16x8 r; r[0] = a[0]; r[1] = a[1]; r[2] = a[2]; r[3] = a[3]; r[4] = b[0]; r[5] = b[1]; r[6] = b[2]; r[7] = b[3];
    return r;
}
__device__ __forceinline__ float clamp80(float x) { return fminf(fmaxf(x, -80.f), 80.f); }
__device__ __forceinline__ float sigm(float x) { return 1.f / (1.f + __expf(-x)); }
__device__ __forceinline__ void st_bf16(LAS bf16_t* p, float v) { *p = (bf16_t)(pk2(v, 0.f) & 0xffffu); }

__device__ __forceinline__ void state_update(pg8::f32x4 (&acc)[8], const LAS bf16_t* KDm, const LAS bf16_t* Vm, int wave, int fq, int tq, int tp) {
    bf16x8 ka[2];
#pragma unroll
    for (int ks = 0; ks < 2; ++ks) { const LAS bf16_t* p = KDm + (ks * 32 + 4 * fq + tq) * RL + 16 * wave + 4 * tp; ka[ks] = tr_pair(p, p + 16 * RL); }
#pragma unroll
    for (int j = 0; j < 8; ++j)
#pragma unroll
        for (int ks = 0; ks < 2; ++ks) {
            const LAS bf16_t* p = Vm + (ks * 32 + 4 * fq + tq) * RL + 16 * j + 4 * tp;
            const bf16x8 vb = tr_pair(p, p + 16 * RL);
            acc[j] = __builtin_amdgcn_mfma_f32_16x16x32_bf16(ka[ks], vb, acc[j], 0, 0, 0);
        }
}
__device__ __forceinline__ void state_to_lds(const pg8::f32x4 (&acc)[8], const float (&rsc)[4], LAS bf16_t* SBm, int wave, int fr, int fq) {
#pragma unroll
    for (int j = 0; j < 8; ++j)
#pragma unroll
        for (int r = 0; r < 4; ++r) st_bf16(SBm + (16 * wave + 4 * fq + r) * RL + 16 * j + fr, acc[j][r] * rsc[r]);
}
__device__ __forceinline__ void score_tile(pg8::f32x4& acc, const LAS bf16_t* Am, const LAS bf16_t* Bm, int ti, int tj, int fr, int fq) {
    acc = (pg8::f32x4){0.f, 0.f, 0.f, 0.f};
#pragma unroll
    for (int ks = 0; ks < 4; ++ks) {
        const bf16x8 a = *(const LAS bf16x8*)(Am + (16 * ti + fr) * RL + ks * 32 + 8 * fq);
        const bf16x8 b = *(const LAS bf16x8*)(Bm + (16 * tj + fr) * RL + ks * 32 + 8 * fq);
        acc = __builtin_amdgcn_mfma_f32_16x16x32_bf16(a, b, acc, 0, 0, 0);
    }
}
__device__ __forceinline__ void copy_tile(const bf16_t* __restrict__ src, LAS bf16_t* dst, int tid) {
    const int row = tid >> 3, seg = tid & 7;
    const bf16_t* s = src + (size_t)row * NP + seg * 16;
    const u32x4 a = *(const u32x4*)s, b = *(const u32x4*)(s + 8);
    LAS bf16_t* d = dst + row * RL + seg * 16;
    *(LAS u32x4*)d = a; *(LAS u32x4*)(d + 8) = b;
}
__device__ __forceinline__ void state_store(const pg8::f32x4 (&acc)[8], float* __restrict__ dst, int wave, int lane) {
#pragma unroll
    for (int j = 0; j < 8; ++j)
#pragma unroll
        for (int r = 0; r < 4; ++r) dst[((wave * 8 + j) * 4 + r) * 64 + lane] = acc[j][r];
}

template <int PASS>
__device__ __forceinline__ void hgrn_unit(const bf16_t* __restrict__ P, const float* __restrict__ lb_logits, int layer, const float* __restrict__ gain_l,
                                          float* __restrict__ STB, bf16_t* __restrict__ Y, int unit, LAS unsigned char* lds, int tid, int lane, int wave) {
    const int chain = unit >> 3, g = unit & 7, b = chain >> 2, h = chain & 3;
    const int t0 = b * S + g * 512;
    const int fr = lane & 15, fq = lane >> 4, tq = (lane & 15) >> 2, tp = lane & 3;
    const int kp = tid & 63, rg = wave, c0 = 2 * kp;
    LAS bf16_t* QT = (LAS bf16_t*)(lds + R_QT); LAS bf16_t* KT = (LAS bf16_t*)(lds + R_KT); LAS bf16_t* KD = (LAS bf16_t*)(lds + R_KD);
    LAS bf16_t* VV = (LAS bf16_t*)(lds + R_V); LAS bf16_t* SB = (LAS bf16_t*)(lds + R_SB); LAS bf16_t* PS = (LAS bf16_t*)(lds + R_PS);
    LAS float* TOT = (LAS float*)(lds + R_VEC);
    LAS float* EREF = TOT + 1024; LAS float* ELAST = EREF + 128;
    LAS float* OB = (LAS float*)(lds + R_OB);
    float lb0 = 0.f, lb1 = 0.f;
    if (layer == 1) {
        const float a0 = lb_logits[h * 128 + c0], a1 = lb_logits[512 + h * 128 + c0], d0 = lb_logits[h * 128 + c0 + 1], d1 = lb_logits[512 + h * 128 + c0 + 1];
        const float m0 = fmaxf(a0, a1), m1 = fmaxf(d0, d1);
        lb0 = __expf(a1 - m0) / (__expf(a0 - m0) + __expf(a1 - m0));
        lb1 = __expf(d1 - m1) / (__expf(d0 - m1) + __expf(d1 - m1));
    }
    pg8::f32x4 acc[8];
#pragma unroll
    for (int j = 0; j < 8; ++j) acc[j] = (pg8::f32x4){0.f, 0.f, 0.f, 0.f};
    if (PASS == 2) {
        for (int jg = 0; jg < g; ++jg) {
            const float* sb = STB + (size_t)(chain * 8 + jg) * ST_STRIDE;
            float dk[4];
#pragma unroll
            for (int r = 0; r < 4; ++r) dk[r] = __expf(sb[16384 + 16 * wave + 4 * fq + r]);
#pragma unroll
            for (int j = 0; j < 8; ++j)
#pragma unroll
                for (int r = 0; r < 4; ++r) acc[j][r] = acc[j][r] * dk[r] + sb[((wave * 8 + j) * 4 + r) * 64 + lane];
        }
    }
    float gl0 = 0.f, gl1 = 0.f;
#pragma unroll 1
    for (int c = 0; c < 8; ++c) {
        const int tr0 = t0 + c * 64;
        float lf0[8], lf1[8], kk0[8], kk1[8], qv0[8], qv1[8];
#pragma unroll
        for (int i = 0; i < 8; ++i) {
            const bf16_t* pr = P + (size_t)(tr0 + rg * 8 + i) * NP + h * 128 + c0;
            const unsigned fw = *(const unsigned*)(pr + C_FH);
            const float z0 = bflo(fw), z1 = bfhi(fw);
            const float s0 = sigm(z0), s1 = sigm(z1);
            lf0[i] = __logf(fmaxf(lb0 + (1.f - lb0) * s0, 1e-30f)); lf1[i] = __logf(fmaxf(lb1 + (1.f - lb1) * s1, 1e-30f));
            kk0[i] = (1.f - lb0) * (1.f - s0); kk1[i] = (1.f - lb1) * (1.f - s1);
            if (PASS == 2) { const unsigned qw = *(const unsigned*)(pr + C_QH); const float q0 = bflo(qw), q1 = bfhi(qw); qv0[i] = q0 * sigm(q0); qv1[i] = q1 * sigm(q1); }
        }
#pragma unroll
        for (int i = 1; i < 8; ++i) { lf0[i] += lf0[i - 1]; lf1[i] += lf1[i - 1]; }
        TOT[rg * 128 + c0] = lf0[7]; TOT[rg * 128 + c0 + 1] = lf1[7];
        copy_tile(P + (size_t)tr0 * NP + C_IH + h * 128, VV, tid);
        __syncthreads();
        {
            float pre0 = 0.f, pre1 = 0.f, ref0 = 0.f, ref1 = 0.f, la0 = 0.f, la1 = 0.f;
#pragma unroll
            for (int r = 0; r < 8; ++r) {
                const float a0 = TOT[r * 128 + c0], a1 = TOT[r * 128 + c0 + 1];
                if (r < rg) { pre0 += a0; pre1 += a1; }
                if (r < 4) { ref0 += a0; ref1 += a1; }
                la0 += a0; la1 += a1;
            }
#pragma unroll
            for (int i = 0; i < 8; ++i) {
                const int row = rg * 8 + i;
                const float cu0 = pre0 + lf0[i], cu1 = pre1 + lf1[i];
                if (PASS == 2) {
                    *(LAS unsigned*)(QT + row * RL + c0) = pk2(qv0[i] * __expf(clamp80(cu0 - ref0)), qv1[i] * __expf(clamp80(cu1 - ref1)));
                    *(LAS unsigned*)(KT + row * RL + c0) = pk2(kk0[i] * __expf(clamp80(ref0 - cu0)), kk1[i] * __expf(clamp80(ref1 - cu1)));
                }
                *(LAS unsigned*)(KD + row * RL + c0) = pk2(kk0[i] * __expf(la0 - cu0), kk1[i] * __expf(la1 - cu1));
            }
            if (rg == 0) { EREF[c0] = __expf(ref0); EREF[c0 + 1] = __expf(ref1); ELAST[c0] = __expf(la0); ELAST[c0 + 1] = __expf(la1); }
            gl0 += la0; gl1 += la1;
        }
        __syncthreads();
        pg8::f32x4 o[4];
        if (PASS == 2) {
            { float rs[4];
#pragma unroll
              for (int r = 0; r < 4; ++r) rs[r] = EREF[16 * wave + 4 * fq + r];
              state_to_lds(acc, rs, SB, wave, fr, fq); }
            { const int ti = wave >> 1;
#pragma unroll
              for (int tjj = 0; tjj < 2; ++tjj) {
                  const int tj = 2 * (wave & 1) + tjj;
                  pg8::f32x4 sa = {0.f, 0.f, 0.f, 0.f};
                  if (tj <= ti) score_tile(sa, QT, KT, ti, tj, fr, fq);
#pragma unroll
                  for (int r = 0; r < 4; ++r) {
                      const int t = 16 * ti + 4 * fq + r, s = 16 * tj + fr;
                      st_bf16(PS + t * PSL + s, (s <= t) ? sa[r] : 0.f);
                  }
              } }
            __syncthreads();
            bf16x8 sbf[4], vbf[2];
#pragma unroll
            for (int ks = 0; ks < 4; ++ks) { const LAS bf16_t* p = SB + (ks * 32 + 4 * fq + tq) * RL + 16 * wave + 4 * tp; sbf[ks] = tr_pair(p, p + 16 * RL); }
#pragma unroll
            for (int ks = 0; ks < 2; ++ks) { const LAS bf16_t* p = VV + (ks * 32 + 4 * fq + tq) * RL + 16 * wave + 4 * tp; vbf[ks] = tr_pair(p, p + 16 * RL); }
#pragma unroll
            for (int ti = 0; ti < 4; ++ti) {
                o[ti] = (pg8::f32x4){0.f, 0.f, 0.f, 0.f};
#pragma unroll
                for (int ks = 0; ks < 4; ++ks) o[ti] = __builtin_amdgcn_mfma_f32_16x16x32_bf16(ld_row_split(QT + (16 * ti + fr) * RL + ks * 32 + 4 * fq), sbf[ks], o[ti], 0, 0, 0);
#pragma unroll
                for (int ks = 0; ks < 2; ++ks) o[ti] = __builtin_amdgcn_mfma_f32_16x16x32_bf16(ld_row_split(PS + (16 * ti + fr) * PSL + ks * 32 + 4 * fq), vbf[ks], o[ti], 0, 0, 0);
            }
        }
        {
#pragma unroll
            for (int r = 0; r < 4; ++r) { const float el = ELAST[16 * wave + 4 * fq + r];
#pragma unroll
                for (int j = 0; j < 8; ++j) acc[j][r] *= el; }
            state_update(acc, KD, VV, wave, fq, tq, tp);
        }
        __syncthreads();
        if (PASS == 2) {
#pragma unroll
            for (int ti = 0; ti < 4; ++ti)
#pragma unroll
                for (int r = 0; r < 4; ++r) OB[(16 * ti + 4 * fq + r) * OBL + 16 * wave + fr] = o[ti][r];
            __syncthreads();
            const int t = tid >> 3, seg = tid & 7;
            float ov[16]; float ss = 0.f;
#pragma unroll
            for (int q = 0; q < 4; ++q) { const f32x4 a = *(const LAS f32x4*)(OB + t * OBL + seg * 16 + 4 * q); ov[4 * q] = a.x; ov[4 * q + 1] = a.y; ov[4 * q + 2] = a.z; ov[4 * q + 3] = a.w;
                ss += (a.x * a.x + a.y * a.y) + (a.z * a.z + a.w * a.w); }
            ss += __shfl_xor(ss, 1); ss += __shfl_xor(ss, 2); ss += __shfl_xor(ss, 4);
            const float rn = rsqrtf(ss * (1.f / 128.f) + EPS);
            const bf16_t* gp = P + (size_t)(tr0 + t) * NP + C_GH + h * 128 + seg * 16;
            const u32x4 g0 = *(const u32x4*)gp, g1 = *(const u32x4*)(gp + 8);
            const float* gn = gain_l + h * 128 + seg * 16;
            u32x4 y0, y1;
#pragma unroll
            for (int q = 0; q < 4; ++q) {
                const float ga = bflo(g0[q]), gb = bfhi(g0[q]), gc = bflo(g1[q]), gd = bfhi(g1[q]);
                y0[q] = pk2(ov[2 * q] * rn * gn[2 * q] * (ga * sigm(ga)), ov[2 * q + 1] * rn * gn[2 * q + 1] * (gb * sigm(gb)));
                y1[q] = pk2(ov[8 + 2 * q] * rn * gn[8 + 2 * q] * (gc * sigm(gc)), ov[8 + 2 * q + 1] * rn * gn[8 + 2 * q + 1] * (gd * sigm(gd)));
            }
            bf16_t* yp = Y + (size_t)(tr0 + t) * D + 1024 + h * 128 + seg * 16;
            *(u32x4*)yp = y0; *(u32x4*)(yp + 8) = y1;
        }
    }
    if (PASS == 1) {
        float* sb = STB + (size_t)(chain * 8 + g) * ST_STRIDE;
        state_store(acc, sb, wave, lane);
        if (rg == 0) { sb[16384 + c0] = gl0; sb[16384 + c0 + 1] = gl1; }
    }
}

template <int PASS>
__device__ __forceinline__ void mlstm_unit(const bf16_t* __restrict__ P, const float* __restrict__ conv_l, const float* __restrict__ ib_l, const float* __restrict__ fb_l,
                                           float* __restrict__ STB, bf16_t* __restrict__ Y, int unit, LAS unsigned char* lds, int tid, int lane, int wave) {
    const int chain = unit >> 3, g = unit & 7, b = chain >> 2, h = chain & 3;
    const int t0 = b * S + g * 512;
    const int fr = lane & 15, fq = lane >> 4, tq = (lane & 15) >> 2, tp = lane & 3;
    const int kp = tid & 63, rg = wave, c0 = 2 * kp;
    LAS bf16_t* QM = (LAS bf16_t*)(lds + R_QT); LAS bf16_t* KM = (LAS bf16_t*)(lds + R_KT); LAS bf16_t* KW = (LAS bf16_t*)(lds + R_KD);
    LAS bf16_t* VV = (LAS bf16_t*)(lds + R_V); LAS bf16_t* CB = (LAS bf16_t*)(lds + R_SB); LAS bf16_t* PS = (LAS bf16_t*)(lds + R_PS);
    LAS float* VEC = (LAS float*)(lds + R_VEC);
    LAS float* AV = VEC;
    LAS float* MV = VEC + 64;
    LAS float* CUM = VEC + 128;
    LAS float* SCAL = VEC + 192;
    LAS float* NV = VEC + 256;
    LAS float* DENP = VEC + 384;
    LAS float* DINT = VEC + 640;
    LAS float* OB = (LAS float*)(lds + R_OB);
    float wq0[4], wq1[4], wk0[4], wk1[4];
#pragma unroll
    for (int j = 0; j < 4; ++j) {
        wq0[j] = conv_l[j * 1024 + h * 128 + c0]; wq1[j] = conv_l[j * 1024 + h * 128 + c0 + 1];
        wk0[j] = conv_l[j * 1024 + 512 + h * 128 + c0]; wk1[j] = conv_l[j * 1024 + 512 + h * 128 + c0 + 1];
    }
    const float ib = ib_l[h], fb = fb_l[h];
    pg8::f32x4 acc[8];
#pragma unroll
    for (int j = 0; j < 8; ++j) acc[j] = (pg8::f32x4){0.f, 0.f, 0.f, 0.f};
    float mprev = (PASS == 1) ? -1e30f : 0.f;
    float nreg = 0.f;
    float fsum = 0.f;
    if (PASS == 2) {
        for (int jg = 0; jg < g; ++jg) {
            const float* sb = STB + (size_t)(chain * 8 + jg) * ST_STRIDE;
            const float mE = sb[16384 + 128], F = sb[16384 + 129];
            const float mn = fmaxf(F + mprev, mE);
            const float s1 = __expf(F + mprev - mn), s2 = __expf(mE - mn);
#pragma unroll
            for (int j = 0; j < 8; ++j)
#pragma unroll
                for (int r = 0; r < 4; ++r) acc[j][r] = acc[j][r] * s1 + s2 * sb[((wave * 8 + j) * 4 + r) * 64 + lane];
            if (tid < 128) nreg = nreg * s1 + s2 * sb[16384 + tid];
            mprev = mn;
        }
    }
    if (tid < 128) NV[tid] = nreg;
#pragma unroll 1
    for (int c = 0; c < 8; ++c) {
        const int tr0 = t0 + c * 64;
        if (wave == 0) {
            const bf16_t* pr = P + (size_t)(tr0 + lane) * NP;
            const float ip = bf2f(pr[C_IM + h]) + ib;
            const float z = bf2f(pr[C_FM + h]) + fb;
            const float lf = fminf(z, 0.f) - __logf(1.f + __expf(-fabsf(z)));
            float cu = lf;
#pragma unroll
            for (int o = 1; o < 64; o <<= 1) { const float t = __shfl_up(cu, o); if (lane >= o) cu += t; }
            const float a = ip - cu;
            float pm = a;
#pragma unroll
            for (int o = 1; o < 64; o <<= 1) { const float t = __shfl_up(pm, o); if (lane >= o) pm = fmaxf(pm, t); }
            const float M = fmaxf(pm, mprev);
            AV[lane] = a; MV[lane] = M; CUM[lane] = cu;
            if (lane == 63) { SCAL[1] = M; SCAL[2] = cu; }
            if (lane == 0) SCAL[0] = mprev;
        }
        copy_tile(P + (size_t)tr0 * NP + C_VM + h * 128, VV, tid);
        float xq0[11], xq1[11], xk0[11], xk1[11];
#pragma unroll
        for (int i = 0; i < 11; ++i) {
            const int row = rg * 8 + i - 3;
            const int pos = g * 512 + c * 64 + row;
            unsigned wq = 0u, wk = 0u;
            if (pos >= 0) { const bf16_t* pr = P + (size_t)(tr0 + row) * NP + h * 128 + c0; if (PASS == 2) wq = *(const unsigned*)(pr + C_QM); wk = *(const unsigned*)(pr + C_KM); }
            xq0[i] = bflo(wq); xq1[i] = bfhi(wq); xk0[i] = bflo(wk); xk1[i] = bfhi(wk);
        }
        __syncthreads();
        const float M63 = SCAL[1], last = SCAL[2];
        {
#pragma unroll
            for (int i = 0; i < 8; ++i) {
                const int row = rg * 8 + i;
                float k0v = 0.f, k1v = 0.f, q0v = 0.f, q1v = 0.f;
#pragma unroll
                for (int j = 0; j < 4; ++j) { k0v += wk0[j] * xk0[i + j]; k1v += wk1[j] * xk1[i + j]; if (PASS == 2) { q0v += wq0[j] * xq0[i + j]; q1v += wq1[j] * xq1[i + j]; } }
                k0v = k0v * sigm(k0v) * 0.08838834764831845f; k1v = k1v * sigm(k1v) * 0.08838834764831845f;
                const float wsr = __expf(AV[row] - M63);
                *(LAS unsigned*)(KW + row * RL + c0) = pk2(k0v * wsr, k1v * wsr);
                if (PASS == 2) {
                    *(LAS unsigned*)(KM + row * RL + c0) = pk2(k0v, k1v);
                    *(LAS unsigned*)(QM + row * RL + c0) = pk2(q0v * sigm(q0v), q1v * sigm(q1v));
                }
            }
        }
        const float decay = __expf(mprev - M63);
        pg8::f32x4 o1[4], o2[4];
        if (PASS == 2) {
            const float one[4] = {1.f, 1.f, 1.f, 1.f};
            state_to_lds(acc, one, CB, wave, fr, fq);
        }
        __syncthreads();
        if (PASS == 2) {
            { const int ti = wave >> 1;
              float dp[4] = {0.f, 0.f, 0.f, 0.f};
#pragma unroll
              for (int tjj = 0; tjj < 2; ++tjj) {
                  const int tj = 2 * (wave & 1) + tjj;
                  pg8::f32x4 sa = {0.f, 0.f, 0.f, 0.f};
                  if (tj <= ti) score_tile(sa, QM, KM, ti, tj, fr, fq);
                  const int s = 16 * tj + fr;
                  const float as = AV[s];
#pragma unroll
                  for (int r = 0; r < 4; ++r) {
                      const int t = 16 * ti + 4 * fq + r;
                      const float w = (s <= t) ? sa[r] * __expf(as - MV[t]) : 0.f;
                      st_bf16(PS + t * PSL + s, w);
                      dp[r] += w;
                  }
              }
#pragma unroll
              for (int r = 0; r < 4; ++r) {
                  float v = dp[r];
                  v += __shfl_xor(v, 1); v += __shfl_xor(v, 2); v += __shfl_xor(v, 4); v += __shfl_xor(v, 8);
                  if (fr == 0) DENP[(16 * ti + 4 * fq + r) * 4 + 2 * (wave & 1)] = v;
              } }
            { const int t = tid >> 3, seg = tid & 7;
              float dsum = 0.f;
#pragma unroll
              for (int q = 0; q < 16; ++q) dsum += bf2f(QM[t * RL + seg * 16 + q]) * NV[seg * 16 + q];
              dsum += __shfl_xor(dsum, 1); dsum += __shfl_xor(dsum, 2); dsum += __shfl_xor(dsum, 4);
              if (seg == 0) DINT[t] = dsum; }
            __syncthreads();
            bf16x8 cbf[4], vbf[2];
#pragma unroll
            for (int ks = 0; ks < 4; ++ks) { const LAS bf16_t* p = CB + (ks * 32 + 4 * fq + tq) * RL + 16 * wave + 4 * tp; cbf[ks] = tr_pair(p, p + 16 * RL); }
#pragma unroll
            for (int ks = 0; ks < 2; ++ks) { const LAS bf16_t* p = VV + (ks * 32 + 4 * fq + tq) * RL + 16 * wave + 4 * tp; vbf[ks] = tr_pair(p, p + 16 * RL); }
#pragma unroll
            for (int ti = 0; ti < 4; ++ti) {
                o1[ti] = (pg8::f32x4){0.f, 0.f, 0.f, 0.f}; o2[ti] = (pg8::f32x4){0.f, 0.f, 0.f, 0.f};
#pragma unroll
                for (int ks = 0; ks < 4; ++ks) o2[ti] = __builtin_amdgcn_mfma_f32_16x16x32_bf16(ld_row_split(QM + (16 * ti + fr) * RL + ks * 32 + 4 * fq), cbf[ks], o2[ti], 0, 0, 0);
#pragma unroll
                for (int ks = 0; ks < 2; ++ks) o1[ti] = __builtin_amdgcn_mfma_f32_16x16x32_bf16(ld_row_split(PS + (16 * ti + fr) * PSL + ks * 32 + 4 * fq), vbf[ks], o1[ti], 0, 0, 0);
            }
        }
        {
#pragma unroll
            for (int j = 0; j < 8; ++j) acc[j] = acc[j] * decay;
            state_update(acc, KW, VV, wave, fq, tq, tp);
            if (tid < 128) {
                float sumk = 0.f;
#pragma unroll 8
                for (int s = 0; s < 64; ++s) sumk += bf2f(KW[s * RL + tid]);
                nreg = nreg * decay + sumk;
            }
        }
        fsum += last;
        const float mnew = last + M63;
        __syncthreads();
        if (tid < 128) NV[tid] = nreg;
        if (PASS == 2) {
#pragma unroll
            for (int ti = 0; ti < 4; ++ti)
#pragma unroll
                for (int r = 0; r < 4; ++r) {
                    const int t = 16 * ti + 4 * fq + r;
                    OB[t * OBL + 16 * wave + fr] = o1[ti][r] + __expf(mprev - MV[t]) * o2[ti][r];
                }
            __syncthreads();
            const int t = tid >> 3, seg = tid & 7;
            const float wi = __expf(mprev - MV[t]);
            const float den = DENP[t * 4] + DENP[t * 4 + 2] + wi * DINT[t];
            const float hd = 1.f / fmaxf(fabsf(den), __expf(-(CUM[t] + MV[t])));
            const bf16_t* gp = P + (size_t)(tr0 + t) * NP + C_OM + h * 128 + seg * 16;
            const u32x4 g0 = *(const u32x4*)gp, g1 = *(const u32x4*)(gp + 8);
            const unsigned gw[8] = {g0[0], g0[1], g0[2], g0[3], g1[0], g1[1], g1[2], g1[3]};
            unsigned yw[8];
#pragma unroll
            for (int q = 0; q < 4; ++q) {
                const f32x4 a = *(const LAS f32x4*)(OB + t * OBL + seg * 16 + 4 * q);
                yw[2 * q] = pk2(a.x * hd * sigm(bflo(gw[2 * q])), a.y * hd * sigm(bfhi(gw[2 * q])));
                yw[2 * q + 1] = pk2(a.z * hd * sigm(bflo(gw[2 * q + 1])), a.w * hd * sigm(bfhi(gw[2 * q + 1])));
            }
            u32x4 y0, y1;
            y0[0] = yw[0]; y0[1] = yw[1]; y0[2] = yw[2]; y0[3] = yw[3]; y1[0] = yw[4]; y1[1] = yw[5]; y1[2] = yw[6]; y1[3] = yw[7];
            bf16_t* yp = Y + (size_t)(tr0 + t) * D + 1536 + h * 128 + seg * 16;
            *(u32x4*)yp = y0; *(u32x4*)(yp + 8) = y1;
        }
        mprev = mnew;
        __syncthreads();
    }
    if (PASS == 1) {
        float* sb = STB + (size_t)(chain * 8 + g) * ST_STRIDE;
        state_store(acc, sb, wave, lane);
        if (tid < 128) sb[16384 + tid] = nreg;
        if (tid == 0) { sb[16384 + 128] = mprev; sb[16384 + 129] = fsum; }
    }
}
}

namespace mk {
#define XB_TMO      128
#define XB_XCNT(j)  (256  + 64 * (j))
#define XB_XSUB(j)  (1280 + 64 * (j))
#define XB_XGEN(j)  (2304 + 64 * (j))
#define XB_TOP      3328
#define XB_TOPGEN   3392
#define XCD_BAR_WORDS 3456
#define XB_SPIN_CAP (1u << 18)

__device__ __forceinline__ unsigned xb_ld(unsigned* p)              { return __hip_atomic_load(p, __ATOMIC_RELAXED, __HIP_MEMORY_SCOPE_AGENT); }
__device__ __forceinline__ unsigned xb_add(unsigned* p, unsigned v) { return __hip_atomic_fetch_add(p, v, __ATOMIC_RELAXED, __HIP_MEMORY_SCOPE_AGENT); }
__device__ __forceinline__ unsigned xb_xcc_id() { return (unsigned)__builtin_amdgcn_s_getreg((3 << 11) | 20) & 0xFu; }
#define XB_SPIN(cond, bar) do { unsigned _sp = 0; while (cond) { __builtin_amdgcn_s_sleep(1); \
    if ((++_sp & 255u) == 0u) { if (xb_ld(&(bar)[XB_TMO])) break; if (_sp > XB_SPIN_CAP) { atomicAdd(&(bar)[XB_TMO], 1u); break; } } } } while (0)

struct XcdBarrier {
    unsigned* bar; unsigned x;
    volatile LAS unsigned* st;
};

__device__ __forceinline__ XcdBarrier xcd_barrier_post(unsigned* bar, volatile LAS unsigned* st) {
    XcdBarrier b; b.bar = bar; b.x = xb_xcc_id(); b.st = st;
    if (threadIdx.x == 0) (void)xb_add(&bar[XB_XCNT(b.x)], 1u);
    return b;
}
__device__ __forceinline__ void xcd_barrier_complete(unsigned* bar, unsigned x, unsigned& nloc, unsigned& nx) {
    const unsigned G = gridDim.x * gridDim.y * gridDim.z;
    unsigned sum, cnt, mine, sp = 0u;
    for (;;) {
        sum = 0u; cnt = 0u; mine = 0u;
#pragma unroll
        for (unsigned j = 0; j < 16; ++j) { const unsigned c = xb_ld(&bar[XB_XCNT(j)]); sum += c; cnt += (c > 0u) ? 1u : 0u; mine = (j == x) ? c : mine; }
        if (sum == G) break;
        __builtin_amdgcn_s_sleep(1);
        if ((++sp & 255u) == 0u) { if (xb_ld(&bar[XB_TMO])) break; if (sp > XB_SPIN_CAP) { atomicAdd(&bar[XB_TMO], 1u); break; } }
    }
    nloc = mine > 0u ? mine : 1u; nx = cnt > 0u ? cnt : 1u;
}

__device__ __forceinline__ void xcd_barrier(const XcdBarrier& b) {
    asm volatile("s_waitcnt vmcnt(0)" ::: "memory");
    __syncthreads();
    if (threadIdx.x == 0) {
        unsigned* bar = b.bar;
        __builtin_amdgcn_s_waitcnt(0);
        unsigned nloc = b.st[0], nx = b.st[1];
        if (nloc == 0u) { xcd_barrier_complete(bar, b.x, nloc, nx); b.st[0] = nloc; b.st[1] = nx; }
        const unsigned old = xb_add(&bar[XB_XSUB(b.x)], 1u);
        const unsigned gen = old / nloc;
        if (old + 1u == (gen + 1u) * nloc) {
            __builtin_amdgcn_fence(__ATOMIC_RELEASE, "agent");
            asm volatile("s_waitcnt vmcnt(0)" ::: "memory");
            const unsigned og = xb_add(&bar[XB_TOP], 1u);
            const unsigned tg = og / nx;
            if (og + 1u == (tg + 1u) * nx) xb_add(&bar[XB_TOPGEN], 1u);
            else XB_SPIN(xb_ld(&bar[XB_TOPGEN]) == tg, bar);
            __builtin_amdgcn_fence(__ATOMIC_ACQUIRE, "agent");
            xb_add(&bar[XB_XGEN(b.x)], 1u);
            asm volatile("s_waitcnt vmcnt(0)" ::: "memory");
        } else {
            XB_SPIN(xb_ld(&bar[XB_XGEN(b.x)]) == gen, bar);
            __builtin_amdgcn_fence(__ATOMIC_ACQUIRE, "agent");
            asm volatile("s_waitcnt vmcnt(0)" ::: "memory");
        }
    }
    __syncthreads();
}

}

namespace mk {
constexpr int NSLICE = 16, SLW = 128, TBLK = 128, NTB = T / TBLK;
constexpr int CTL_Q = 3584;

__device__ __forceinline__ f32x2 fma2(f32x2 a, f32x2 b, f32x2 c) { return __builtin_elementwise_fma(a, b, c); }

__device__ __forceinline__ int q_next(unsigned* cnt, LAS int* slot, int tid) {
    __syncthreads();
    if (tid == 0) *slot = (int)__hip_atomic_fetch_add(cnt, 1u, __ATOMIC_RELAXED, __HIP_MEMORY_SCOPE_AGENT);
    __syncthreads();
    const int v = *slot;
    return v < NTB ? v : -1;
}

template <int CTRL> __device__ __forceinline__ float dppf(float x) { return __builtin_bit_cast(float, __builtin_amdgcn_mov_dpp(__builtin_bit_cast(int, x), CTRL, 0xf, 0xf, true)); }
constexpr int DPP_XOR1 = 0xB1, DPP_XOR2 = 0x4E, DPP_HMIR = 0x141, DPP_ROR8 = 0x128;
typedef __amdgpu_buffer_rsrc_t rsrc_t;
__device__ __forceinline__ rsrc_t make_rsrc(const void* p, unsigned bytes) { return __builtin_amdgcn_make_buffer_rsrc((void*)p, 0, bytes, 0x00020000); }

constexpr int PL_IDX = 0, PL_AUX = TBLK * 128 * 4;
#define PEER_ISSUE(W, IDP) do { const LAS u32x4* ip_ = (const LAS u32x4*)(IDP); const u32x4 i0_ = ip_[0], i1_ = ip_[1], i2_ = ip_[2], i3_ = ip_[3]; \
        _Pragma("unroll") for (int k = 0; k < 4; ++k) { \
            W[k]      = __builtin_amdgcn_raw_buffer_load_b128(rs, (int)i0_[k] * SLW + c * 16, soff, 0); \
            W[4 + k]  = __builtin_amdgcn_raw_buffer_load_b128(rs, (int)i1_[k] * SLW + c * 16, soff, 0); \
            W[8 + k]  = __builtin_amdgcn_raw_buffer_load_b128(rs, (int)i2_[k] * SLW + c * 16, soff, 0); \
            W[12 + k] = __builtin_amdgcn_raw_buffer_load_b128(rs, (int)i3_[k] * SLW + c * 16, soff, 0); } } while (0)
constexpr float XS8 = 1.f;
typedef _Float16 h2_t __attribute__((ext_vector_type(2)));
template <int MODE>
__device__ __forceinline__ void u_compute(u32x4 (&w)[16], const LAS unsigned* xs, float* __restrict__ PART, int s, int t, int g, int c) {
    if (MODE == 1) { _Pragma("unroll") for (int k = 0; k < 16; ++k) asm volatile("" :: "v"(w[k])); return; }
    if (MODE == 2) { _Pragma("unroll") for (int k = 0; k < 16; ++k) asm volatile("" : "=v"(w[k])); }
    typedef _Float16 h8_t __attribute__((ext_vector_type(8)));
    const h8_t xlo = *(const LAS h8_t*)xs, xhi = *(const LAS h8_t*)(xs + 4);
    h2_t xv[8];
#pragma unroll
    for (int j = 0; j < 4; ++j) { xv[j] = (h2_t){xlo[2 * j], xlo[2 * j + 1]}; xv[4 + j] = (h2_t){xhi[2 * j], xhi[2 * j + 1]}; }
    float r0 = 0.f, r1 = 0.f;
#pragma unroll
    for (int k = 0; k < 16; ++k) {
        float d0 = 0.f, d1 = 0.f;
#pragma unroll
        for (int q = 0; q < 4; ++q) {
            d0 = __builtin_amdgcn_fdot2(__builtin_amdgcn_cvt_scalef32_pk_f16_fp8((int)w[k][q], 1.0f, false), xv[2 * q], d0, false);
            d1 = __builtin_amdgcn_fdot2(__builtin_amdgcn_cvt_scalef32_pk_f16_fp8((int)w[k][q], 1.0f, true), xv[2 * q + 1], d1, false);
        }
        float d = d0 + d1;
        d += dppf<DPP_XOR1>(d); d += dppf<DPP_XOR2>(d); d += dppf<DPP_HMIR>(d);
        if (k < 8) { if (c == k) r0 = d; } else { if (c == k - 8) r1 = d; }
    }
    if (MODE == 2) { asm volatile("" :: "v"(r0), "v"(r1)); return; }
    float* pp = PART + ((size_t)s * T + t) * 128 + 8 * c + g;
    pp[0] = r0; pp[64] = r1;
}
template <int MODE>
__device__ __forceinline__ void peer_u_block(int s, int tb, const bf16_t* __restrict__ XB, const int* __restrict__ IDX, const unsigned char* __restrict__ U8,
                                             float* __restrict__ PART, LAS unsigned char* lds, int tid, int wave, int lane) {
    const int g = lane >> 3, c = lane & 7;
    const rsrc_t rs = make_rsrc(U8, (unsigned)((size_t)NE * D));
    const int soff = s * NE * SLW;
    constexpr int NTW = TBLK / NWAVES;
    {
        const u32x4* src = (const u32x4*)(IDX + (size_t)tb * TBLK * 128);
#pragma unroll
        for (int j = 0; j < TBLK * 128 * 4 / 16 / NTHR; ++j) *(LAS u32x4*)(lds + PL_IDX + (size_t)(tid + j * NTHR) * 16) = src[tid + j * NTHR];
#pragma unroll
        for (int j = 0; j < TBLK * 16 / NTHR; ++j) { const int e = tid + j * NTHR, tt = e >> 4, ch = e & 15;
            const u32x4 xw = *(const u32x4*)(XB + (size_t)(tb * TBLK + tt) * D + s * SLW + ch * 8);
            u32x4 o;
#pragma unroll
            for (int e2 = 0; e2 < 4; ++e2) { const h2_t hv = {(_Float16)bflo(xw[e2]), (_Float16)bfhi(xw[e2])}; o[e2] = __builtin_bit_cast(unsigned, hv); }
            *(LAS u32x4*)(lds + PL_AUX + tt * 256 + ch * 16) = o; }
    }
    __syncthreads();
    const int tw = wave * NTW, t0 = tb * TBLK + tw;
    const LAS unsigned char* idb = lds + PL_IDX + (size_t)tw * 512 + g * 64;
    const LAS unsigned* xsb = (const LAS unsigned*)(lds + PL_AUX + (size_t)tw * 256) + c * 8;
    u32x4 wa[16], wb[16];
    if (MODE != 2) PEER_ISSUE(wa, idb);
#pragma unroll 1
    for (int i = 0; i < NTW; i += 2) {
        if (MODE != 2) PEER_ISSUE(wb, idb + (i + 1) * 512);
        u_compute<MODE>(wa, xsb + i * 64, PART, s, t0 + i, g, c);
        if (MODE != 2) PEER_ISSUE(wa, idb + min(i + 2, NTW - 1) * 512);
        u_compute<MODE>(wb, xsb + (i + 1) * 64, PART, s, t0 + i + 1, g, c);
    }
}

__device__ __forceinline__ void peer_act_token(int t, const float* __restrict__ PART, const float* __restrict__ ssp, const int* __restrict__ IDX, const float* __restrict__ GATE,
                                               const float* __restrict__ USC, const float* __restrict__ VSC, float* __restrict__ ACT, int lane) {
    const int p0 = 8 * (lane & 15) + (lane >> 4), p1 = 8 * (lane & 15) + 4 + (lane >> 4);
    float s0 = 0.f, s1 = 0.f;
#pragma unroll
    for (int s = 0; s < NSLICE; ++s) { const float* pp = PART + ((size_t)s * T + t) * 128; s0 += pp[p0]; s1 += pp[p1]; }
    float sp = (lane < 32) ? ssp[(size_t)t * 32 + lane] : 0.f;
    sp = wsum(sp);
    const float rs1 = rsqrtf(sp * (1.f / D) + EPS);
    const int id0 = IDX[(size_t)t * 128 + lane], id1 = IDX[(size_t)t * 128 + 64 + lane];
    ACT[(size_t)t * 128 + lane] = gelu_erf(s0 * USC[id0] * (rs1 * (1.f / XS8))) * GATE[(size_t)t * 128 + lane] * VSC[id0];
    ACT[(size_t)t * 128 + 64 + lane] = gelu_erf(s1 * USC[id1] * (rs1 * (1.f / XS8))) * GATE[(size_t)t * 128 + 64 + lane] * VSC[id1];
}

__device__ __forceinline__ void v_compute(const u32x4 (&w)[16], const LAS float* avp, bf16_t* __restrict__ XBio, float* __restrict__ OUT32,
                                          float* __restrict__ SS16, int s, int t, int g, int c, int lane) {
    const size_t off = (size_t)t * D + s * SLW + c * 16 + 2 * g;
    const unsigned rw = *(const unsigned*)(XBio + off);
    const f32x2 res = {bflo(rw), bfhi(rw)};
    const f32x4 a0 = *(const LAS f32x4*)avp, a1 = *(const LAS f32x4*)(avp + 4), a2_ = *(const LAS f32x4*)(avp + 8), a3 = *(const LAS f32x4*)(avp + 12);
    const float avs[16] = {a0[0], a0[1], a0[2], a0[3], a1[0], a1[1], a1[2], a1[3], a2_[0], a2_[1], a2_[2], a2_[3], a3[0], a3[1], a3[2], a3[3]};
    h2_t hacc[8];
#pragma unroll
    for (int q = 0; q < 8; ++q) hacc[q] = (h2_t){(_Float16)0.f, (_Float16)0.f};
#pragma unroll
    for (int k = 0; k < 16; ++k) {
        const _Float16 ah = (_Float16)avs[k];
        const h2_t a2 = {ah, ah};
#pragma unroll
        for (int q = 0; q < 4; ++q) {
            const auto c0 = __builtin_amdgcn_cvt_scalef32_pk_f16_fp8((int)w[k][q], 1.0f, false), c1 = __builtin_amdgcn_cvt_scalef32_pk_f16_fp8((int)w[k][q], 1.0f, true);
            const h2_t w0 = {(_Float16)c0[0], (_Float16)c0[1]}, w1 = {(_Float16)c1[0], (_Float16)c1[1]};
            hacc[2 * q] = __builtin_elementwise_fma(a2, w0, hacc[2 * q]);
            hacc[2 * q + 1] = __builtin_elementwise_fma(a2, w1, hacc[2 * q + 1]);
        }
    }
    f32x2 acc[8];
#pragma unroll
    for (int q = 0; q < 8; ++q) acc[q] = (f32x2){(float)hacc[q][0], (float)hacc[q][1]};
    f32x2 h4[4];
#pragma unroll
    for (int q = 0; q < 4; ++q) {
        const auto sx = __builtin_amdgcn_permlane32_swap(__float_as_uint(acc[q].x), __float_as_uint(acc[4 + q].x), false, false);
        const auto sy = __builtin_amdgcn_permlane32_swap(__float_as_uint(acc[q].y), __float_as_uint(acc[4 + q].y), false, false);
        h4[q] = (f32x2){__uint_as_float(sx[0]) + __uint_as_float(sx[1]), __uint_as_float(sy[0]) + __uint_as_float(sy[1])};
    }
    f32x2 h2[2];
#pragma unroll
    for (int q = 0; q < 2; ++q) {
        const auto sx = __builtin_amdgcn_permlane16_swap(__float_as_uint(h4[q].x), __float_as_uint(h4[2 + q].x), false, false);
        const auto sy = __builtin_amdgcn_permlane16_swap(__float_as_uint(h4[q].y), __float_as_uint(h4[2 + q].y), false, false);
        h2[q] = (f32x2){__uint_as_float(sx[0]) + __uint_as_float(sx[1]), __uint_as_float(sy[0]) + __uint_as_float(sy[1])};
    }
    const bool up = (g & 1) != 0;
    const f32x2 keep = up ? h2[1] : h2[0], send = up ? h2[0] : h2[1];
    f32x2 o = {keep.x + dppf<DPP_ROR8>(send.x) + res.x, keep.y + dppf<DPP_ROR8>(send.y) + res.y};
    if (OUT32) *(f32x2*)(OUT32 + off) = o;
    else { const unsigned ow = pk2(o.x, o.y); *(unsigned*)(XBio + off) = ow; o = (f32x2){bflo(ow), bfhi(ow)}; }
    const float q2 = wsum(o.x * o.x + o.y * o.y);
    if (lane == 0) SS16[(size_t)t * 16 + s] = q2;
}
__device__ __forceinline__ void peer_v_block(int s, int tb, const float* __restrict__ ACT, const int* __restrict__ IDX, const unsigned char* __restrict__ V8,
                                             bf16_t* __restrict__ XBio, float* __restrict__ OUT32, float* __restrict__ SS16,
                                             LAS unsigned char* lds, int tid, int wave, int lane) {
    const int g = lane >> 3, c = lane & 7;
    const rsrc_t rs = make_rsrc(V8, (unsigned)((size_t)NE * D));
    const int soff = s * NE * SLW;
    constexpr int NTW = TBLK / NWAVES;
    {
        const u32x4* src = (const u32x4*)(IDX + (size_t)tb * TBLK * 128);
        const u32x4* srca = (const u32x4*)(ACT + (size_t)tb * TBLK * 128);
#pragma unroll
        for (int j = 0; j < TBLK * 128 * 4 / 16 / NTHR; ++j) {
            *(LAS u32x4*)(lds + PL_IDX + (size_t)(tid + j * NTHR) * 16) = src[tid + j * NTHR];
            *(LAS u32x4*)(lds + PL_AUX + (size_t)(tid + j * NTHR) * 16) = srca[tid + j * NTHR];
        }
    }
    __syncthreads();
    const int tw = wave * NTW, t0 = tb * TBLK + tw;
    const LAS unsigned char* idb = lds + PL_IDX + (size_t)tw * 512 + g * 64;
    const LAS float* avb = (const LAS float*)(lds + PL_AUX + (size_t)tw * 512) + g * 16;
    u32x4 wa[16], wb[16];
    PEER_ISSUE(wa, idb);
#pragma unroll 1
    for (int i = 0; i < NTW; i += 2) {
        PEER_ISSUE(wb, idb + (i + 1) * 512);
        v_compute(wa, avb + i * 128, XBio, OUT32, SS16, s, t0 + i, g, c, lane);
        PEER_ISSUE(wa, idb + min(i + 2, NTW - 1) * 512);
        v_compute(wb, avb + (i + 1) * 128, XBio, OUT32, SS16, s, t0 + i + 1, g, c, lane);
    }
}

__device__ __forceinline__ int slice_of(int xcc, int j) { const int xx = (xcc + (j >> 1)) & 7; return xx + 8 * (j & 1); }

__device__ __forceinline__ void final_norm_row(float* __restrict__ orow, const float* __restrict__ ss16, const float* __restrict__ g, int lane) {
    float sp = (lane < 16) ? ss16[lane] : 0.f;
    sp = wsum(sp);
    const float rf = rsqrtf(sp * (1.f / D) + EPS);
    f32x4* o = (f32x4*)orow + lane;
    const f32x4* g4 = (const f32x4*)g + lane;
#pragma unroll
    for (int j = 0; j < 8; ++j) { f32x4 v = o[64 * j]; const f32x4 gg = g4[64 * j]; v = v * rf * gg; o[64 * j] = v; }
}
}

namespace mk {
#define IN(k) (lo <= (k) && (k) < hi)
#define GSYNC() do { if (coop) xcd_barrier(xb); } while (0)
template <int l>
__device__ __forceinline__ void layer_body(const Params& p, LAS unsigned char* lds, unsigned char* ws, int G, int tid, int lane, int wave, int lo, int hi, bool coop, const XcdBarrier& xb) {

    if (IN(1)) _Pragma("unroll") for (int rep = 0; rep < REP1; ++rep) {
        pg8::Gemm g{(const bf16_t*)(ws + WS_XB), (const bf16_t*)(ws + WS_WINT) + (size_t)l * NP * D, T, NP, D};
        pg8::StaticOrder So; So.init(T, NP, G, (int)blockIdx.x);
        EpiScaleBf16<16> E{(bf16_t*)(ws + WS_P), NP, (const float*)(ws + WS_SS)};
        pg8::gemm_phase<EpiScaleBf16<16>, pg8::StaticOrder, true, true>(lds, g, So, E);
        GSYNC();
    }
    if (IN(2)) _Pragma("unroll") for (int rep = 0; rep < REP2; ++rep) {
        for (int u = blockIdx.x; u < 256; u += G) {
            if (u < 128) hgrn_unit<1>((const bf16_t*)(ws + WS_P), p.in[5], l, nullptr, (float*)(ws + WS_STH), nullptr, u, lds, tid, lane, wave);
            else mlstm_unit<1>((const bf16_t*)(ws + WS_P), p.in[7] + (size_t)l * 4 * 1024, p.in[8] + l * 4, p.in[9] + l * 4, (float*)(ws + WS_STM), nullptr, u - 128, lds, tid, lane, wave);
            __syncthreads();
        }
        GSYNC();
    }
    if (IN(3)) _Pragma("unroll") for (int rep = 0; rep < REP3; ++rep) {
        for (int u = blockIdx.x; u < 256; u += G) {
            if (u < 128) hgrn_unit<2>((const bf16_t*)(ws + WS_P), p.in[5], l, p.in[6] + l * 512, (float*)(ws + WS_STH), (bf16_t*)(ws + WS_YB), u, lds, tid, lane, wave);
            else mlstm_unit<2>((const bf16_t*)(ws + WS_P), p.in[7] + (size_t)l * 4 * 1024, p.in[8] + l * 4, p.in[9] + l * 4, (float*)(ws + WS_STM), (bf16_t*)(ws + WS_YB), u - 128, lds, tid, lane, wave);
            __syncthreads();
        }
        for (int u = blockIdx.x; u < 256; u += G) {
            attn_unit((const bf16_t*)(ws + WS_P), (const f32x2*)(ws + WS_ROPE), p.in[4] + l * 16, (bf16_t*)(ws + WS_YB), u, lds, tid, lane, wave);
            __syncthreads();
        }
        GSYNC();
    }
    if (IN(4)) _Pragma("unroll") for (int rep = 0; rep < REP4; ++rep) {
        pg8::Gemm g{(const bf16_t*)(ws + WS_YB), (const bf16_t*)(ws + WS_WOUTT) + (size_t)l * D * D, T, D, D};
        pg8::StaticOrder So; So.init(T, D, G, (int)blockIdx.x);
        EpiX1 E{l == 0 ? p.in[0] : (const float*)nullptr, (bf16_t*)(ws + WS_XB), (float*)(ws + WS_SSP)};
        pg8::gemm_phase<EpiX1, pg8::StaticOrder, true, true>(lds, g, So, E);
        GSYNC();
    }
    if (IN(5)) _Pragma("unroll") for (int rep = 0; rep < REP5; ++rep) {
        pg8::Gemm g{(const bf16_t*)(ws + WS_XB), (const bf16_t*)(ws + WS_WQT) + (size_t)l * D * D, T, D, D};
        pg8::StaticOrder So; So.init(T, D, G, (int)blockIdx.x);
        EpiScaleBf16<32> E{(bf16_t*)(ws + WS_Q), D, (const float*)(ws + WS_SSP)};
        pg8::gemm_phase<EpiScaleBf16<32>, pg8::StaticOrder, true, true>(lds, g, So, E);
        pg8::Unit u;
        for (int i = 0; So.next(i, u); ++i)
            route_unit((const bf16_t*)(ws + WS_Q), (const bf16_t*)(ws + WS_SUBK) + (size_t)l * 2 * 8 * 128 * 128, u.pm, u.pn, (int*)(ws + WS_IDX), (int*)(ws + WS_IDXU), (float*)(ws + WS_GATE),
                       (LAS float*)(lds + wave * 8448), wave, lane);
        GSYNC();
    }
    if (IN(6)) {
        const int xcc = (int)xb_xcc_id();
        LAS int* slot = (LAS int*)(lds + LDS_BYTES - 32);
        {
            unsigned* qc = (unsigned*)(ws + WS_CTL) + CTL_Q + ((l * 2 + 0) * 2 + 0) * 16;
            for (int j = 0; j < NSLICE; ++j) {
                const int s = slice_of(xcc, j);
                for (;;) {
                    const int tb = q_next(qc + s, slot, tid);
                    if (tb < 0) break;
                    peer_u_block<0>(s, tb, (const bf16_t*)(ws + WS_XB), (const int*)(ws + WS_IDX), ws + WS_U8 + (size_t)l * NE * D, (float*)(ws + WS_PART), lds, tid, wave, lane);
                }
            }
        }
        if (REP6 > 1) {
            GSYNC();
            unsigned* qc = (unsigned*)(ws + WS_CTL) + CTL_Q + ((l * 2 + 0) * 2 + 1) * 16;
            for (int j = 0; j < NSLICE; ++j) {
                const int s = slice_of(xcc, j);
                for (;;) {
                    const int tb = q_next(qc + s, slot, tid);
                    if (tb < 0) break;
                    peer_u_block<(REP6 == 2) ? 1 : 2>(s, tb, (const bf16_t*)(ws + WS_XB), (const int*)(ws + WS_IDX), ws + WS_U8 + (size_t)l * NE * D, (float*)(ws + WS_PART), lds, tid, wave, lane);
                }
            }
        }
        GSYNC();
    }
    if (IN(7)) {
        const int gw = blockIdx.x * NWAVES + wave, ngw = G * NWAVES;
        for (int t = gw; t < T; t += ngw)
            peer_act_token(t, (const float*)(ws + WS_PART), (const float*)(ws + WS_SSP), (const int*)(ws + WS_IDX), (const float*)(ws + WS_GATE),
                           (const float*)(ws + WS_USC) + l * NE, (const float*)(ws + WS_VSC) + l * NE, (float*)(ws + WS_ACT), lane);
        GSYNC();
    }
    if (IN(8)) _Pragma("unroll") for (int rep = 0; rep < REP5 * 0 + 1; ++rep) {
        const int xcc = (int)xb_xcc_id();
        unsigned* qc = (unsigned*)(ws + WS_CTL) + CTL_Q + ((l * 2 + 1) * 2 + rep) * 16;
        LAS int* slot = (LAS int*)(lds + LDS_BYTES - 32);
        for (int j = 0; j < NSLICE; ++j) {
            const int s = slice_of(xcc, j);
            for (;;) {
                const int tb = q_next(qc + s, slot, tid);
                if (tb < 0) break;
                peer_v_block(s, tb, (const float*)(ws + WS_ACT), (const int*)(ws + WS_IDX), ws + WS_V8 + (size_t)l * NE * D, (bf16_t*)(ws + WS_XB),
                             l == 0 ? (float*)nullptr : p.out, (float*)(ws + WS_SS), lds, tid, wave, lane);
            }
        }
    }
    if (l == 1 && IN(9)) {
        GSYNC();
        const int gw = blockIdx.x * NWAVES + wave, ngw = G * NWAVES;
        for (int t = gw; t < T; t += ngw) final_norm_row(p.out + (size_t)t * D, (const float*)(ws + WS_SS) + (size_t)t * 16, p.in[15], lane);
    }
}
__global__ void __launch_bounds__(NTHR, 2) mega(Params p) {
    extern __shared__ __attribute__((aligned(16))) unsigned char lds_raw[];
    LAS unsigned char* lds = (LAS unsigned char*)lds_raw;
    unsigned char* ws = p.ws;
    const int G = gridDim.x;
    const int tid = threadIdx.x, lane = tid & 63, wave = __builtin_amdgcn_readfirstlane(tid >> 6);
    const int lo = p.ph_lo, hi = p.ph_hi;
    const bool coop = p.pad != 0;
    volatile LAS unsigned* xst = (volatile LAS unsigned*)(lds + LDS_BYTES - 16);
    if (tid < 4) xst[tid] = 0u;
    __syncthreads();
    XcdBarrier xb; xb.bar = (unsigned*)(ws + WS_CTL); xb.x = 0; xb.st = xst;
    if (coop) xb = xcd_barrier_post((unsigned*)(ws + WS_CTL), xst);
    if (IN(0)) { for (int rep = 0; rep < REP0; ++rep) { if (rep) { if (coop) xcd_barrier(xb); } p0_prologue(p, lds); } if (coop) cooperative_groups::this_grid().sync(); }
    if (p.layer <= 0 && 0 < p.layer_hi) { layer_body<0>(p, lds, ws, G, tid, lane, wave, lo, hi, coop, xb); if (1 < p.layer_hi) GSYNC(); }
    if (p.layer <= 1 && 1 < p.layer_hi) layer_body<1>(p, lds, ws, G, tid, lane, wave, lo, hi, coop, xb);

#undef IN
#undef GSYNC
}
__global__ __launch_bounds__(256) void shim_xprep_kernel(const float* __restrict__ X, bf16_t* __restrict__ XB, float* __restrict__ SS) {
    const int t = blockIdx.x * 4 + (threadIdx.x >> 6), lane = threadIdx.x & 63;
    xprep_row(X + (size_t)t * D, XB + (size_t)t * D, SS + t, lane);
}
}

extern "C" void kernel_launch(void* const* d_in, const int* in_sizes, int n_in, void* d_out, int out_size, void* d_ws, size_t ws_size, hipStream_t stream) {
    using namespace mk;
    static int grid = 0;
    if (grid == 0) {
        int dev = 0, cus = 0, per_cu = 0;
        (void)hipGetDevice(&dev); (void)hipDeviceGetAttribute(&cus, hipDeviceAttributeMultiprocessorCount, dev);
        if (hipFuncSetAttribute((const void*)mega, hipFuncAttributeMaxDynamicSharedMemorySize, LDS_BYTES) != hipSuccess) { fprintf(stderr, "kernel_launch: hipFuncSetAttribute failed\n"); grid = -1; return; }
        if (ws_size < WS_END) { fprintf(stderr, "kernel_launch: workspace too small: need %zu have %zu\n", (size_t)WS_END, ws_size); grid = -1; return; }
        if (hipOccupancyMaxActiveBlocksPerMultiprocessor(&per_cu, (const void*)mega, NTHR, LDS_BYTES) != hipSuccess || per_cu < 1) { fprintf(stderr, "kernel_launch: occupancy query says %d blocks per CU\n", per_cu); grid = -1; return; }
        grid = cus;
    }
    if (grid < 0) return;
    Params p{};
    for (int i = 0; i < 16; ++i) p.in[i] = (const float*)d_in[i];
    p.out = (float*)d_out; p.ws = (unsigned char*)d_ws;
    p.ph_lo = 0; p.ph_hi = 10; p.layer = 0; p.layer_hi = 2; p.pad = 1; p.pad2 = 0;
    if (hipMemsetAsync(d_ws, 0, 16384, stream) != hipSuccess) { fprintf(stderr, "kernel_launch: memset failed\n"); return; }
    void* args[] = {&p};
    hipError_t e = hipLaunchCooperativeKernel((const void*)mega, dim3(grid), dim3(NTHR), args, LDS_BYTES, stream);
    if (e != hipSuccess) fprintf(stderr, "kernel_launch: cooperative launch failed: %s (grid %d)\n", hipGetErrorString(e), grid);
}
```

```cpp
#include <hip/hip_runtime.h>
#include <hip/hip_cooperative_groups.h>
#include <math.h>
#include <stdio.h>
#include <stdint.h>
namespace pg8 {
#define PG8_LAS __attribute__((address_space(3)))
typedef unsigned short bf16_t;
typedef short bf16x8 __attribute__((ext_vector_type(8)));
typedef float f32x4 __attribute__((ext_vector_type(4)));
typedef unsigned u32x4 __attribute__((ext_vector_type(4)));
constexpr int BM = 256, BK = 64, HALF = 128, HTB = HALF * BK * 2  , STAGE_BYTES = 8 * HTB, NXCD = 8, WGM = 8;

__host__ __device__ __forceinline__ int lds_byte(int r, int c) { const int st = (r >> 4) * 2 + (c >> 5), rr = r & 15, cc = c & 31, ob = rr * 64 + cc * 2; return st * 1024 + (ob ^ (((ob >> 9) & 1) << 5)); }
__host__ __device__ __forceinline__ void stage_rc(int b, int& R, int& C) { const int st = b / 1024, sb = b % 1024, swz = sb ^ (((sb >> 9) & 1) << 5); R = (st >> 1) * 16 + swz / 64; C = (st & 1) * 32 + (swz % 64) / 2; }
__host__ __device__ __forceinline__ int perm32(int rho) { const int n = rho >> 4, i = rho & 15; return 8 * (i >> 2) + 4 * n + (i & 3); }

struct Unit { int pm, pn; };
struct Gemm { const bf16_t* A; const bf16_t* Bt; int M, N, K; };

struct StaticOrder {
    int nM, nN, nwg, G, c;
    __host__ __device__ void init(int M, int N, int G_, int c_) { nM = M / BM; nN = N / BM; nwg = nM * nN; G = G_; c = c_; }
    __host__ __device__ bool next(int i, Unit& u) const {
        const long L = (long)i * G + c; if (L >= nwg) return false;
        int wgid = (int)L; { const int q = nwg / NXCD, r = nwg % NXCD, xcd = wgid % NXCD, off = wgid / NXCD; wgid = (xcd < r ? xcd * (q + 1) : r * (q + 1) + (xcd - r) * q) + off; }
        const int nig = WGM * nN, gid = wgid / nig, fm = gid * WGM, gsz = (nM - fm) < WGM ? (nM - fm) : WGM;
        u.pm = fm + ((wgid % nig) % gsz); u.pn = (wgid % nig) / gsz; return true;
    }
    __device__ __forceinline__ void a_ready(const Unit&) const {}
    __device__ __forceinline__ void done(const Unit&) const {}
};

template <class Epi, class Sched, bool ALIGN_EPI = false, bool SP2 = false>
__device__ __forceinline__ void gemm_phase(PG8_LAS unsigned char* lds, const Gemm g, const Sched& S, const Epi& E) {
    const int tid = threadIdx.x, wid = __builtin_amdgcn_readfirstlane(tid >> 6), lane = tid & 63, wr = wid >> 2, wc = wid & 3, fr = lane & 15, fq = lane >> 4;
    const int K = g.K, nt = K / BK;
    unsigned voffA[2], voffB[2];
#pragma unroll
    for (int i = 0; i < 2; ++i) { int R, C; stage_rc(tid * 16 + i * 8192, R, C); const int Rb = Epi::PERM ? ((R & ~31) + perm32(R & 31)) : R;
        voffA[i] = (unsigned)(R * K + C) * 2u; voffB[i] = (unsigned)(Rb * K + C) * 2u; }
    const size_t kstep = (size_t)(BK * 2);
    const size_t hstep = (size_t)HALF * K * 2;
    const size_t tstep = 2 * hstep;
    const unsigned ldsw = (unsigned)wid * 1024u;
    const int aoff = lds_byte(wr * 64 + fr, fq * 8), boff = lds_byte(wc * 32 + fr, fq * 8);
#define PG8_SA(b, h) (((b) * 2 + (h)) * HTB)
#define PG8_SB(b, h) ((4 + (b) * 2 + (h)) * HTB)
#define PG8_STAGE(bufoff, gbase, voff) do { _Pragma("unroll") for (int _i = 0; _i < 2; ++_i) \
        __builtin_amdgcn_global_load_lds((const unsigned*)((const char*)(gbase) + (voff)[_i]), (PG8_LAS unsigned*)(lds + (bufoff) + ldsw + _i * 8192), 16, 0, 0); } while (0)
#define PG8_LDA(dst, b, h) do { _Pragma("unroll") for (int m = 0; m < 4; ++m) _Pragma("unroll") for (int k = 0; k < 2; ++k) dst[m][k] = *(const PG8_LAS bf16x8*)(lds + PG8_SA(b, h) + aoff + m * 2048 + k * 1024); } while (0)
#define PG8_LDB(dst, b, h) do { _Pragma("unroll") for (int n = 0; n < 2; ++n) _Pragma("unroll") for (int k = 0; k < 2; ++k) dst[n][k] = *(const PG8_LAS bf16x8*)(lds + PG8_SB(b, h) + boff + n * 2048 + k * 1024); } while (0)
#define PG8_MMA(ai, bj, At, Bt) do { __builtin_amdgcn_s_setprio(1); _Pragma("unroll") for (int m = 0; m < 4; ++m) _Pragma("unroll") for (int n = 0; n < 2; ++n) _Pragma("unroll") for (int k = 0; k < 2; ++k) \
        acc[ai][bj][m][n] = __builtin_amdgcn_mfma_f32_16x16x32_bf16(Bt[n][k], At[m][k], acc[ai][bj][m][n], 0, 0, 0); __builtin_amdgcn_s_setprio(0); } while (0)
#define PG8_WAIT_V(n) asm volatile("s_waitcnt vmcnt(" #n ")" ::: "memory")
#define PG8_WAIT_L(n) asm volatile("s_waitcnt lgkmcnt(" #n ")" ::: "memory")
#define PG8_BAR __builtin_amdgcn_s_barrier()
#define PG8_SCHED __builtin_amdgcn_sched_barrier(0)
    Unit cur, nxt; int ui = 0;
    if (!S.next(0, cur)) return;
    f32x4 acc[2][2][4][2];
#pragma unroll
    for (int a = 0; a < 2; ++a)
#pragma unroll
        for (int b = 0; b < 2; ++b)
#pragma unroll
            for (int m = 0; m < 4; ++m)
#pragma unroll
                for (int n = 0; n < 2; ++n) acc[a][b][m][n] = (f32x4){0.f, 0.f, 0.f, 0.f};
    bf16x8 At[4][2], B0[2][2], B1[2][2];
    const char* cA = (const char*)g.A + (size_t)cur.pm * tstep; const char* cB = (const char*)g.Bt + (size_t)cur.pn * tstep;
    S.a_ready(cur);
    if constexpr (SP2) {
        PG8_STAGE(PG8_SB(0, 0), cB, voffB); PG8_STAGE(PG8_SB(0, 1), cB + hstep, voffB); PG8_STAGE(PG8_SA(0, 0), cA, voffA); PG8_STAGE(PG8_SA(0, 1), cA + hstep, voffA);
        if (wr == 1) PG8_BAR;
        PG8_WAIT_V(2); PG8_BAR;
        PG8_STAGE(PG8_SB(1, 0), cB + kstep, voffB); PG8_STAGE(PG8_SA(1, 0), cA + kstep, voffA); PG8_STAGE(PG8_SB(1, 1), cB + hstep + kstep, voffB);
        PG8_WAIT_V(6); PG8_BAR;
    } else {
        PG8_STAGE(PG8_SB(0, 0), cB, voffB); PG8_STAGE(PG8_SA(0, 0), cA, voffA); PG8_STAGE(PG8_SB(0, 1), cB + hstep, voffB); PG8_STAGE(PG8_SA(0, 1), cA + hstep, voffA);
        if (wr == 1) PG8_BAR;
        PG8_WAIT_V(4); PG8_BAR;
        PG8_STAGE(PG8_SB(1, 0), cB + kstep, voffB); PG8_STAGE(PG8_SA(1, 0), cA + kstep, voffA); PG8_STAGE(PG8_SB(1, 1), cB + hstep + kstep, voffB);
        PG8_WAIT_V(6); PG8_BAR;
    }
    for (;;) {
        const bool has_next = S.next(ui + 1, nxt);
        const char* nA = has_next ? (const char*)g.A + (size_t)nxt.pm * tstep : cA; const char* nB = has_next ? (const char*)g.Bt + (size_t)nxt.pn * tstep : cB;
        for (int t = 0; t < nt; t += 2) {
            const bool last = (t == nt - 2);
            const char* a1 = cA + (size_t)(t + 1) * kstep;
            const char* a2 = last ? nA : cA + (size_t)(t + 2) * kstep; const char* b2 = last ? nB : cB + (size_t)(t + 2) * kstep;
            const char* a3 = a2 + kstep; const char* b3 = b2 + kstep;
            if (last && has_next) S.a_ready(nxt);
            if constexpr (SP2) {
            PG8_LDB(B0, 0, 0); PG8_LDB(B1, 0, 1); PG8_SCHED; PG8_LDA(At, 0, 0); PG8_STAGE(PG8_SA(1, 1), a1 + hstep, voffA);
            PG8_WAIT_V(8); PG8_WAIT_L(0); PG8_BAR; PG8_MMA(0, 0, At, B0); PG8_MMA(0, 1, At, B1); PG8_BAR; PG8_SCHED;
            PG8_LDA(At, 0, 1); PG8_STAGE(PG8_SB(0, 0), b2, voffB); PG8_STAGE(PG8_SB(0, 1), b2 + hstep, voffB); PG8_STAGE(PG8_SA(0, 0), a2, voffA);
            PG8_WAIT_V(8); PG8_WAIT_L(0); PG8_BAR; PG8_MMA(1, 0, At, B0); PG8_MMA(1, 1, At, B1); PG8_BAR; PG8_SCHED;
            PG8_LDB(B0, 1, 0); PG8_LDB(B1, 1, 1); PG8_SCHED; PG8_LDA(At, 1, 0); PG8_STAGE(PG8_SA(0, 1), a2 + hstep, voffA);
            PG8_WAIT_V(8); PG8_WAIT_L(0); PG8_BAR; PG8_MMA(0, 0, At, B0); PG8_MMA(0, 1, At, B1); PG8_BAR; PG8_SCHED;
            PG8_LDA(At, 1, 1); PG8_STAGE(PG8_SB(1, 0), b3, voffB); PG8_STAGE(PG8_SB(1, 1), b3 + hstep, voffB); PG8_STAGE(PG8_SA(1, 0), a3, voffA);
            PG8_WAIT_V(8); PG8_WAIT_L(0); PG8_BAR; PG8_MMA(1, 0, At, B0); PG8_MMA(1, 1, At, B1); PG8_BAR; PG8_SCHED;
            } else {
            PG8_LDB(B0, 0, 0); PG8_SCHED; PG8_LDA(At, 0, 0); PG8_STAGE(PG8_SA(1, 1), a1 + hstep, voffA);
            PG8_WAIT_L(8); PG8_BAR; PG8_WAIT_L(0); PG8_MMA(0, 0, At, B0); PG8_BAR; PG8_SCHED;
            PG8_LDB(B1, 0, 1); PG8_STAGE(PG8_SB(0, 0), b2, voffB);
            PG8_BAR; PG8_WAIT_L(0); PG8_MMA(0, 1, At, B1); PG8_BAR;
            PG8_LDA(At, 0, 1); PG8_STAGE(PG8_SA(0, 0), a2, voffA);
            PG8_BAR; PG8_WAIT_L(0); PG8_MMA(1, 0, At, B0); PG8_BAR; PG8_SCHED;
            PG8_STAGE(PG8_SB(0, 1), b2 + hstep, voffB);
            PG8_WAIT_V(6); PG8_BAR; PG8_MMA(1, 1, At, B1); PG8_BAR;
            PG8_LDB(B0, 1, 0); PG8_SCHED; PG8_LDA(At, 1, 0); PG8_STAGE(PG8_SA(0, 1), a2 + hstep, voffA);
            PG8_WAIT_L(8); PG8_BAR; PG8_WAIT_L(0); PG8_MMA(0, 0, At, B0); PG8_BAR; PG8_SCHED;
            PG8_LDB(B1, 1, 1); PG8_STAGE(PG8_SB(1, 0), b3, voffB);
            PG8_BAR; PG8_WAIT_L(0); PG8_MMA(0, 1, At, B1); PG8_BAR;
            PG8_LDA(At, 1, 1); PG8_STAGE(PG8_SA(1, 0), a3, voffA);
            PG8_BAR; PG8_WAIT_L(0); PG8_MMA(1, 0, At, B0); PG8_BAR; PG8_SCHED;
            PG8_STAGE(PG8_SB(1, 1), b3 + hstep, voffB);
            PG8_WAIT_V(6); PG8_BAR; PG8_MMA(1, 1, At, B1); PG8_BAR;
            }
        }
        if constexpr (ALIGN_EPI) { if (wr == 0) PG8_BAR; }
        if constexpr (!Epi::AFTER_DRAIN) { E(acc, cur, wr, wc, fr, fq); S.done(cur); }
        if (!has_next) break;
#pragma unroll
        for (int a = 0; a < 2; ++a)
#pragma unroll
            for (int b = 0; b < 2; ++b)
#pragma unroll
                for (int m = 0; m < 4; ++m)
#pragma unroll
                    for (int n = 0; n < 2; ++n) acc[a][b][m][n] = (f32x4){0.f, 0.f, 0.f, 0.f};
        cur = nxt; cA = nA; cB = nB; ++ui;
        if constexpr (ALIGN_EPI) { if (wr == 1) PG8_BAR; }
    }
    PG8_WAIT_V(0);
    if constexpr (!ALIGN_EPI) { if (wr == 0) PG8_BAR; }
    PG8_BAR;
    if constexpr (Epi::AFTER_DRAIN) { E.fused(acc, cur, wr, wc, fr, fq, lds, wid, lane); S.done(cur); }
#undef PG8_SA
#undef PG8_SB
#undef PG8_STAGE
#undef PG8_LDA
#undef PG8_LDB
#undef PG8_MMA
#undef PG8_WAIT_V
#undef PG8_WAIT_L
#undef PG8_BAR
#undef PG8_SCHED
}
}
namespace mk {
#define LAS __attribute__((address_space(3)))
typedef unsigned short bf16_t;
typedef float f32x4 __attribute__((ext_vector_type(4)));
typedef float f32x2 __attribute__((ext_vector_type(2)));
typedef unsigned u32x4 __attribute__((ext_vector_type(4)));
typedef unsigned u32x2 __attribute__((ext_vector_type(2)));
typedef __bf16 bf16x2_t __attribute__((ext_vector_type(2)));
typedef short bf16x8 __attribute__((ext_vector_type(8)));
typedef short s16x4 __attribute__((ext_vector_type(4)));
constexpr int D = 2048, NB = 4, S = 4096, T = NB * S, IN_LD = 5384, NP = 5632, NE = 16384;
constexpr int NTHR = 512, NWAVES = 8;
constexpr int LDS_BYTES = 160 * 1024;
constexpr int LDS_SPARE = 128 * 1024;
constexpr float EPS = 1e-6f;
#ifndef REPS
#define REPS 1,1,1,1,1,1,1,1
#endif
constexpr int REPV[8] = {REPS};
constexpr int REP7 = REPV[7];
constexpr int REP0 = REPV[0], REP1 = REPV[1], REP2 = REPV[2], REP3 = REPV[3], REP4 = REPV[4], REP5 = REPV[5], REP6 = REPV[6];
constexpr int C_QA = 0, C_KA = 1024, C_VA = 1152, C_QH = 1280, C_FH = 1792, C_IH = 2304, C_GH = 2816, C_QM = 3328, C_KM = 3840, C_VM = 4352, C_OM = 4864, C_IM = 5376, C_FM = 5380;

constexpr size_t WS_CTL = 0;
constexpr size_t WS_WINT = 65536;
constexpr size_t WS_WOUTT = WS_WINT + 2 * (size_t)NP * D * 2;
constexpr size_t WS_WQT = WS_WOUTT + 2 * (size_t)D * D * 2;
constexpr size_t WS_SUBK = WS_WQT + 2 * (size_t)D * D * 2;
constexpr size_t WS_U8 = WS_SUBK + 2 * 2 * 8 * 128 * 128 * 2;
constexpr size_t WS_V8 = WS_U8 + 2 * (size_t)NE * D;
constexpr size_t WS_USC = WS_V8 + 2 * (size_t)NE * D;
constexpr size_t WS_VSC = WS_USC + 2 * (size_t)NE * 4;
constexpr size_t WS_ROPE = WS_VSC + 2 * (size_t)NE * 4;
constexpr size_t WS_SS = WS_ROPE + (size_t)S * 32 * 8;
constexpr size_t WS_SSP = WS_SS + (size_t)T * 16 * 4;
constexpr size_t WS_XB = WS_SSP + (size_t)T * 32 * 4;
constexpr size_t WS_P = WS_XB + (size_t)T * D * 2;
constexpr size_t WS_YB = WS_P + (size_t)T * NP * 2;
constexpr size_t WS_Q = WS_YB + (size_t)T * D * 2;
constexpr size_t WS_IDX = WS_Q + (size_t)T * D * 2;
constexpr size_t WS_GATE = WS_IDX + (size_t)T * 128 * 4;
constexpr size_t WS_X1 = WS_GATE + (size_t)T * 128 * 4;
constexpr size_t WS_X2 = WS_X1 + (size_t)T * D * 4;
constexpr size_t WS_IDXU = WS_X2 + (size_t)T * D * 4;
constexpr size_t WS_STH = WS_IDXU + (size_t)T * 128 * 4;
constexpr size_t WS_STM = WS_STH + (size_t)128 * 16640 * 4;
constexpr size_t WS_END = WS_STM + (size_t)128 * 16640 * 4;
constexpr size_t WS_PART = WS_P;
constexpr size_t WS_ACT = WS_Q;
static_assert((size_t)16 * T * 128 * 4 <= (size_t)T * NP * 2, "PART overlay");
static_assert(WS_END <= ((size_t)1 << 30), "workspace");
struct Params { const float* in[16]; float* out; unsigned char* ws; int ph_lo, ph_hi, layer, layer_hi, pad, pad2; };

__device__ __forceinline__ unsigned pk2(float lo, float hi) { f32x2 v = {lo, hi}; bf16x2_t b = __builtin_convertvector(v, bf16x2_t); return __builtin_bit_cast(unsigned, b); }
__device__ __forceinline__ float bf2f(unsigned short h) { return __uint_as_float((unsigned)h << 16); }
__device__ __forceinline__ float bflo(unsigned w) { return __uint_as_float(w << 16); }
__device__ __forceinline__ float bfhi(unsigned w) { return __uint_as_float(w & 0xffff0000u); }
__device__ __forceinline__ float wsum(float v) {
#pragma unroll
    for (int o = 1; o < 64; o <<= 1) v += __shfl_xor(v, o);
    return v;
}
template <int CTRL> __device__ __forceinline__ float dppf(float x) { return __builtin_bit_cast(float, __builtin_amdgcn_mov_dpp(__builtin_bit_cast(int, x), CTRL, 0xf, 0xf, true)); }
constexpr int DPP_XOR1 = 0xB1, DPP_XOR2 = 0x4E, DPP_HMIR = 0x141, DPP_ROR8 = 0x128;
__device__ __forceinline__ float sum8(float v) { v += dppf<DPP_XOR1>(v); v += dppf<DPP_XOR2>(v); v += dppf<DPP_HMIR>(v); return v; }
__device__ __forceinline__ float sum16(float v) { v = sum8(v); v += dppf<DPP_ROR8>(v); return v; }
__device__ __forceinline__ float wmax(float v) {
#pragma unroll
    for (int o = 1; o < 64; o <<= 1) v = fmaxf(v, __shfl_xor(v, o));
    return v;
}

__device__ __forceinline__ void transpose_item(const float* __restrict__ W, int ldw, int nvalid, const float* __restrict__ gain, bf16_t* __restrict__ WT, int K, int k0, int n0, LAS float* scr, int lane) {
    const int n = n0 + (lane & 31);
#pragma unroll 8
    for (int i = 0; i < 32; ++i) {
        const int kk = 2 * i + (lane >> 5);
        float v = 0.f;
        if (n < nvalid) v = W[(size_t)(k0 + kk) * ldw + n];
        if (gain) v *= gain[k0 + kk];
        scr[kk * 33 + (lane & 31)] = v;
    }
    __builtin_amdgcn_s_waitcnt(0xc07f);
    asm volatile("" ::: "memory");
    const int c = lane & 7;
#pragma unroll
    for (int j = 0; j < 4; ++j) {
        const int nn = (lane >> 3) + 8 * j;
        const LAS float* s = scr + (8 * c) * 33 + nn;
        u32x4 o; o.x = pk2(s[0 * 33], s[1 * 33]); o.y = pk2(s[2 * 33], s[3 * 33]); o.z = pk2(s[4 * 33], s[5 * 33]); o.w = pk2(s[6 * 33], s[7 * 33]);
        *(u32x4*)(WT + (size_t)(n0 + nn) * K + k0 + 8 * c) = o;
    }
    __builtin_amdgcn_s_waitcnt(0xc07f);
    asm volatile("" ::: "memory");
}
__device__ __forceinline__ void xprep_row(const float* __restrict__ xrow, bf16_t* __restrict__ orow, float* __restrict__ ss, int lane) {
    const f32x4* xr = (const f32x4*)xrow + lane;
    f32x4 v[8]; float s = 0.f;
#pragma unroll
    for (int j = 0; j < 8; ++j) { v[j] = xr[64 * j]; s += (v[j].x * v[j].x + v[j].y * v[j].y) + (v[j].z * v[j].z + v[j].w * v[j].w); }
    s = wsum(s);
    u32x2* o = (u32x2*)orow + lane;
#pragma unroll
    for (int j = 0; j < 8; ++j) { u32x2 w; w.x = pk2(v[j].x, v[j].y); w.y = pk2(v[j].z, v[j].w); o[64 * j] = w; }
    if (lane < 16) ss[lane] = (lane == 0) ? s : 0.f;
}
__device__ __forceinline__ void fp8_row(const float* __restrict__ src, const float* __restrict__ gain, unsigned char* __restrict__ dst, float* __restrict__ sc, int lane) {
    f32x4 v[2][4]; float am = 0.f;
#pragma unroll
    for (int j = 0; j < 2; ++j)
#pragma unroll
        for (int q = 0; q < 4; ++q) {
            const int e = j * 1024 + lane * 16 + q * 4;
            f32x4 a = *(const f32x4*)(src + e);
            if (gain) a = a * *(const f32x4*)(gain + e);
            v[j][q] = a;
            am = fmaxf(am, fmaxf(fmaxf(fabsf(a.x), fabsf(a.y)), fmaxf(fabsf(a.z), fabsf(a.w))));
        }
    am = wmax(am);
    const float qs = am > 0.f ? 256.f / am : 1.f;
#pragma unroll
    for (int j = 0; j < 2; ++j) {
        u32x4 w;
#pragma unroll
        for (int q = 0; q < 4; ++q) {
            const f32x4 a = v[j][q] * qs;
            int pkd = __builtin_amdgcn_cvt_pk_fp8_f32(a.x, a.y, 0, false);
            pkd = __builtin_amdgcn_cvt_pk_fp8_f32(a.z, a.w, pkd, true);
            w[q] = (unsigned)pkd;
        }
        *(u32x4*)(dst + ((size_t)(j * 8 + (lane >> 3)) * NE) * 128 + (lane & 7) * 16) = w;
    }
    if (lane == 0) *sc = am > 0.f ? am * (1.f / 256.f) : 1.f;
}

__device__ __forceinline__ void p0_prologue(const Params& p, LAS unsigned char* lds) {
    const int tid = threadIdx.x, lane = tid & 63, wave = tid >> 6;
    const int G = gridDim.x, gw = blockIdx.x * NWAVES + wave, ngw = G * NWAVES;
    const size_t gt = (size_t)blockIdx.x * NTHR + tid, ngt = (size_t)G * NTHR;
    unsigned char* ws = p.ws;
    const float* x = p.in[0]; const float* norm_mix = p.in[1]; const float* w_in = p.in[2]; const float* w_out = p.in[3];
    const float* norm_ffn = p.in[10]; const float* peer_query = p.in[11]; const float* sub_keys = p.in[12]; const float* peer_u = p.in[13]; const float* peer_v = p.in[14];
    {
        LAS float* scr = (LAS float*)(lds + wave * 8448);
        constexpr int I_IN = 32 * (NP / 32), I_SQ = 32 * (D / 32), PER_L = I_IN + 2 * I_SQ;
        for (int it = gw; it < 2 * PER_L; it += ngw) {
            const int l = it / PER_L; int r = it % PER_L;
            if (r < I_IN) { transpose_item(w_in + (size_t)l * D * IN_LD, IN_LD, IN_LD, norm_mix + l * D, (bf16_t*)(ws + WS_WINT) + (size_t)l * NP * D, D, (r / (NP / 32)) * 64, (r % (NP / 32)) * 32, scr, lane); continue; }
            r -= I_IN;
            if (r < I_SQ) { transpose_item(w_out + (size_t)l * D * D, D, D, nullptr, (bf16_t*)(ws + WS_WOUTT) + (size_t)l * D * D, D, (r / (D / 32)) * 64, (r % (D / 32)) * 32, scr, lane); continue; }
            r -= I_SQ;
            transpose_item(peer_query + (size_t)l * D * D, D, D, norm_ffn + l * D, (bf16_t*)(ws + WS_WQT) + (size_t)l * D * D, D, (r / (D / 32)) * 64, (r % (D / 32)) * 32, scr, lane);
        }
    }
    for (size_t i = gt; i < 2 * 2 * 8 * 128 * 128 / 4; i += ngt) {
        const f32x4 v = ((const f32x4*)sub_keys)[i];
        u32x2 w; w.x = pk2(v.x, v.y); w.y = pk2(v.z, v.w);
        ((u32x2*)(ws + WS_SUBK))[i] = w;
    }
    for (int r = gw; r < 4 * NE; r += ngw) {
        const int tb = r / (2 * NE), rr = r % (2 * NE), l = rr / NE;
        if (tb == 0) fp8_row(peer_u + (size_t)rr * D, norm_ffn + l * D, ws + WS_U8 + (size_t)l * NE * D + (size_t)(rr - l * NE) * 128, (float*)(ws + WS_USC) + rr, lane);
        else fp8_row(peer_v + (size_t)rr * D, nullptr, ws + WS_V8 + (size_t)l * NE * D + (size_t)(rr - l * NE) * 128, (float*)(ws + WS_VSC) + rr, lane);
    }
    for (size_t i = gt; i < (size_t)S * 32; i += ngt) {
        const int fi = (int)(i & 31), pos = (int)(i >> 5);
        const float inv = powf(10000.f, -(float)fi / 32.f);
        const float ang = (float)pos * inv;
        f32x2 cs; cs.x = cosf(ang); cs.y = sinf(ang);
        ((f32x2*)(ws + WS_ROPE))[i] = cs;
    }
    for (int t = gw; t < T; t += ngw) xprep_row(x + (size_t)t * D, (bf16_t*)(ws + WS_XB) + (size_t)t * D, (float*)(ws + WS_SS) + (size_t)t * 16, lane);
}

template <int NSS>
struct EpiScaleBf16 {
    static constexpr bool PERM = true, AFTER_DRAIN = false;
    bf16_t* O; int ldc; const float* ss;
    __device__ __forceinline__ void operator()(const pg8::f32x4 (&acc)[2][2][4][2], const pg8::Unit& u, int wr, int wc, int fr, int fq) const {
        const int row0 = u.pm * 256 + wr * 64 + fr, col0 = u.pn * 256 + wc * 32 + 8 * fq;
#pragma unroll
        for (int ai = 0; ai < 2; ++ai)
#pragma unroll
            for (int m = 0; m < 4; ++m) {
                const int row = row0 + ai * 128 + m * 16;
                float s;
                {
                    const f32x4* sp = (const f32x4*)(ss + (size_t)row * NSS);
                    f32x4 a = sp[0];
#pragma unroll
                    for (int i = 1; i < NSS / 4; ++i) a = a + sp[i];
                    s = (a.x + a.y) + (a.z + a.w);
                }
                const float r = rsqrtf(s * (1.f / D) + EPS);
                bf16_t* rowp = O + (size_t)row * ldc + col0;
#pragma unroll
                for (int bj = 0; bj < 2; ++bj) {
                    const pg8::f32x4 v0 = acc[ai][bj][m][0] * r, v1 = acc[ai][bj][m][1] * r;
                    u32x4 w; w.x = pk2(v0[0], v0[1]); w.y = pk2(v0[2], v0[3]); w.z = pk2(v1[0], v1[1]); w.w = pk2(v1[2], v1[3]);
                    *(u32x4*)(rowp + bj * 128) = w;
                }
            }
    }
};

struct EpiX1 {
    static constexpr bool PERM = false, AFTER_DRAIN = false;
    const float* xin32;
    bf16_t* X1B; float* ssp;
    __device__ __forceinline__ void operator()(const pg8::f32x4 (&acc)[2][2][4][2], const pg8::Unit& u, int wr, int wc, int fr, int fq) const {
        const int col0 = u.pn * 256 + wc * 32 + 4 * fq;
#pragma unroll
        for (int ai = 0; ai < 2; ++ai)
#pragma unroll
            for (int m = 0; m < 4; ++m) {
                const int row = u.pm * 256 + ai * 128 + wr * 64 + m * 16 + fr;
                float q = 0.f;
#pragma unroll
                for (int bj = 0; bj < 2; ++bj)
#pragma unroll
                    for (int n = 0; n < 2; ++n) {
                        const size_t off = (size_t)row * D + col0 + bj * 128 + n * 16;
                        pg8::f32x4 r;
                        if (xin32) r = *(const pg8::f32x4*)(xin32 + off);
                        else { const u32x2 rb = *(const u32x2*)(X1B + off); r = (pg8::f32x4){bflo(rb.x), bfhi(rb.x), bflo(rb.y), bfhi(rb.y)}; }
                        const pg8::f32x4 o = r + acc[ai][bj][m][n];
                        u32x2 w; w.x = pk2(o[0], o[1]); w.y = pk2(o[2], o[3]);
                        *(u32x2*)(X1B + off) = w;
                        const float o0 = bflo(w.x), o1 = bfhi(w.x), o2 = bflo(w.y), o3 = bfhi(w.y);
                        q += (o0 * o0 + o1 * o1) + (o2 * o2 + o3 * o3);
                    }
                q += __shfl_xor(q, 16); q += __shfl_xor(q, 32);
                if (fq == 0) ssp[(size_t)row * 32 + u.pn * 4 + wc] = q;
            }
    }
};

#define TOPK_INSERT(L, x) do { _Pragma("unroll") for (int _i = 15; _i >= 1; --_i) L[_i] = __builtin_amdgcn_fmed3f(L[_i - 1], L[_i], (x)); L[0] = fmaxf(L[0], (x)); } while (0)
constexpr int SK_LD = 136;
constexpr int ROUTE_SK_OFF = 8 * 8448;
__device__ __forceinline__ void route_unit(const bf16_t* __restrict__ Q, const bf16_t* __restrict__ subk_l, int pm, int h, int* __restrict__ IDX, int* __restrict__ IDXU, float* __restrict__ GATE,
                                           LAS unsigned char* lds, int tid, int wave, int lane) {
    const int fr = lane & 15, fq = lane >> 4;
    LAS float* scr = (LAS float*)(lds + wave * 8448);
    LAS bf16_t* SK = (LAS bf16_t*)(lds + ROUTE_SK_OFF);
    __syncthreads();
#pragma unroll
    for (int j = 0; j < 8; ++j) {
        const int e = tid + j * NTHR, half = e >> 11, row = (e >> 4) & 127, ch = e & 15;
        *(LAS u32x4*)(SK + (half * 128 + row) * SK_LD + ch * 8) = *(const u32x4*)(subk_l + ((size_t)(half * 8 + h) * 128 + row) * 128 + ch * 8);
    }
    __syncthreads();
    float L1[16], L2[16];
#pragma unroll 1
    for (int nt = 0; nt < 2; ++nt) {
        const int tok = pm * 256 + wave * 32 + nt * 16 + fr;
#pragma unroll
        for (int half = 0; half < 2; ++half) {
            float L[16];
#pragma unroll
            for (int i = 0; i < 16; ++i) L[i] = -3.0e38f;
            bf16x8 bq[4];
            const bf16_t* qp = Q + (size_t)tok * D + h * 256 + half * 128 + 8 * fq;
#pragma unroll
            for (int ks = 0; ks < 4; ++ks) bq[ks] = *(const bf16x8*)(qp + ks * 32);
            const LAS bf16_t* kb = SK + (half * 128) * SK_LD;
#pragma unroll 2
            for (int mt = 0; mt < 8; ++mt) {
                pg8::f32x4 acc = {0.f, 0.f, 0.f, 0.f};
                const LAS bf16_t* kp = kb + (mt * 16 + fr) * SK_LD + 8 * fq;
#pragma unroll
                for (int ks = 0; ks < 4; ++ks) {
                    const bf16x8 ak = *(const LAS bf16x8*)(kp + ks * 32);
                    acc = __builtin_amdgcn_mfma_f32_16x16x32_bf16(ak, bq[ks], acc, 0, 0, 0);
                }
#pragma unroll
                for (int r = 0; r < 4; ++r) {
                    const unsigned key = (unsigned)(mt * 16 + 4 * fq + r);
                    const float xv = __uint_as_float((__float_as_uint(acc[r]) & 0xffffff80u) | key);
                    TOPK_INSERT(L, xv);
                }
            }
#pragma unroll
            for (int sh = 16; sh <= 32; sh <<= 1) {
                float o[16];
#pragma unroll
                for (int i = 0; i < 16; ++i) o[i] = __shfl_xor(L[i], sh);
#pragma unroll
                for (int i = 0; i < 16; ++i) TOPK_INSERT(L, o[i]);
            }
#pragma unroll
            for (int i = 0; i < 16; ++i) { if (half == 0) L1[i] = L[i]; else L2[i] = L[i]; }
        }
        float C[16];
#pragma unroll
        for (int i = 0; i < 16; ++i) C[i] = -3.0e38f;
#pragma unroll
        for (int a = 0; a < 16; ++a)
#pragma unroll
            for (int b = 0; b < 16; ++b)
                if ((a + 1) * (b + 1) <= 16) {
                    const float sm = L1[a] + L2[b];
                    const float xv = __uint_as_float((__float_as_uint(sm) & 0xffffff00u) | (unsigned)(a * 16 + b));
                    TOPK_INSERT(C, xv);
                }
        LAS float* my = scr + lane * 33;
#pragma unroll
        for (int i = 0; i < 16; ++i) { my[i] = L1[i]; my[16 + i] = L2[i]; }
        __builtin_amdgcn_s_waitcnt(0xc07f);
        asm volatile("" ::: "memory");
        const float mx = __uint_as_float(__float_as_uint(C[0]) & 0xffffff00u);
        float e[16], den = 0.f;
#pragma unroll
        for (int i = 0; i < 16; ++i) { e[i] = __expf(__uint_as_float(__float_as_uint(C[i]) & 0xffffff00u) - mx); den += e[i]; }
        const float rden = 1.f / den;
#pragma unroll
        for (int i = 0; i < 16; ++i) {
            if ((i >> 2) == fq) {
                const unsigned ab = __float_as_uint(C[i]) & 0xffu;
                const unsigned i1 = __float_as_uint(my[ab >> 4]) & 0x7fu, i2 = __float_as_uint(my[16 + (ab & 15)]) & 0x7fu;
                const int pp = h * 16 + i, pos = (pp & 7) * 16 + (pp >> 3);
                IDX[(size_t)tok * 128 + pos] = (int)(i1 * 128 + i2);
                GATE[(size_t)tok * 128 + pos] = e[i] * rden;
                IDXU[(size_t)tok * 128 + (pp & 15) * 8 + (pp >> 4)] = (int)(i1 * 128 + i2);
            }
        }
        __builtin_amdgcn_s_waitcnt(0xc07f);
        asm volatile("" ::: "memory");
    }
}

__device__ __forceinline__ float gelu_erf(float x) { return 0.5f * x * (1.f + erff(x * 0.70710678118654752f)); }
template <bool FINAL>
__device__ __forceinline__ void expert_token(int t, const bf16_t* __restrict__ X1B, const float* __restrict__ X1, const float* __restrict__ ssp, const int* __restrict__ IDX, const float* __restrict__ GATE,
                                             const unsigned char* __restrict__ U8, const float* __restrict__ USC, const unsigned char* __restrict__ V8, const float* __restrict__ VSC,
                                             float* __restrict__ X2, bf16_t* __restrict__ XB, float* __restrict__ SS, const float* __restrict__ norm_final, float* __restrict__ OUT, int lane) {
    float xf[2][16];
#pragma unroll
    for (int j = 0; j < 2; ++j) {
        const u32x4* xp = (const u32x4*)(X1B + (size_t)t * D + j * 1024 + lane * 16);
        const u32x4 a = xp[0], b = xp[1];
#pragma unroll
        for (int q = 0; q < 4; ++q) { xf[j][2 * q] = bflo(a[q]); xf[j][2 * q + 1] = bfhi(a[q]); xf[j][8 + 2 * q] = bflo(b[q]); xf[j][8 + 2 * q + 1] = bfhi(b[q]); }
    }
    float sp = (lane < 32) ? ssp[(size_t)t * 32 + lane] : 0.f;
    sp = wsum(sp);
    const float rs1 = rsqrtf(sp * (1.f / D) + EPS);
    const int id0 = IDX[(size_t)t * 128 + lane], id1 = IDX[(size_t)t * 128 + 64 + lane];
    const float g0 = GATE[(size_t)t * 128 + lane], g1 = GATE[(size_t)t * 128 + 64 + lane];
    const float us0 = USC[id0], us1 = USC[id1], vs0 = VSC[id0], vs1 = VSC[id1];
    float acc[2][16];
#pragma unroll
    for (int j = 0; j < 2; ++j)
#pragma unroll
        for (int i = 0; i < 16; ++i) acc[j][i] = 0.f;
    float act0 = 0.f, act1 = 0.f;
#pragma unroll 1
    for (int e0 = 0; e0 < 128; e0 += 4) {
        u32x4 w[4][2];
#pragma unroll
        for (int e = 0; e < 4; ++e) {
            const int ee = e0 + e;
            const int id = __builtin_amdgcn_readlane(ee < 64 ? id0 : id1, ee & 63);
            const unsigned char* up = U8 + (size_t)id * D + lane * 16;
            w[e][0] = *(const u32x4*)up; w[e][1] = *(const u32x4*)(up + 1024);
        }
        float d[4];
#pragma unroll
        for (int e = 0; e < 4; ++e) {
            float s = 0.f;
#pragma unroll
            for (int j = 0; j < 2; ++j)
#pragma unroll
                for (int q = 0; q < 4; ++q) {
                    const f32x2 lo = __builtin_amdgcn_cvt_pk_f32_fp8((int)w[e][j][q], false), hi = __builtin_amdgcn_cvt_pk_f32_fp8((int)w[e][j][q], true);
                    s = fmaf(lo.x, xf[j][4 * q], s); s = fmaf(lo.y, xf[j][4 * q + 1], s); s = fmaf(hi.x, xf[j][4 * q + 2], s); s = fmaf(hi.y, xf[j][4 * q + 3], s);
                }
            d[e] = wsum(s);
        }
#pragma unroll
        for (int e = 0; e < 4; ++e) {
            const int ee = e0 + e;
            if (ee < 64) { if (lane == ee) act0 = d[e]; } else { if (lane == ee - 64) act1 = d[e]; }
        }
    }
    act0 = gelu_erf(act0 * us0 * rs1) * g0 * vs0;
    act1 = gelu_erf(act1 * us1 * rs1) * g1 * vs1;
#pragma unroll 1
    for (int e0 = 0; e0 < 128; e0 += 4) {
        u32x4 w[4][2];
        float a[4];
#pragma unroll
        for (int e = 0; e < 4; ++e) {
            const int ee = e0 + e;
            const int id = __builtin_amdgcn_readlane(ee < 64 ? id0 : id1, ee & 63);
            a[e] = __int_as_float(__builtin_amdgcn_readlane(__float_as_int(ee < 64 ? act0 : act1), ee & 63));
            const unsigned char* vp = V8 + (size_t)id * D + lane * 16;
            w[e][0] = *(const u32x4*)vp; w[e][1] = *(const u32x4*)(vp + 1024);
        }
#pragma unroll
        for (int e = 0; e < 4; ++e)
#pragma unroll
            for (int j = 0; j < 2; ++j)
#pragma unroll
                for (int q = 0; q < 4; ++q) {
                    const f32x2 lo = __builtin_amdgcn_cvt_pk_f32_fp8((int)w[e][j][q], false), hi = __builtin_amdgcn_cvt_pk_f32_fp8((int)w[e][j][q], true);
                    acc[j][4 * q] = fmaf(a[e], lo.x, acc[j][4 * q]); acc[j][4 * q + 1] = fmaf(a[e], lo.y, acc[j][4 * q + 1]);
                    acc[j][4 * q + 2] = fmaf(a[e], hi.x, acc[j][4 * q + 2]); acc[j][4 * q + 3] = fmaf(a[e], hi.y, acc[j][4 * q + 3]);
                }
    }
    float q2 = 0.f;
#pragma unroll
    for (int j = 0; j < 2; ++j)
#pragma unroll
        for (int q = 0; q < 4; ++q) {
            const f32x4 r = *(const f32x4*)(X1 + (size_t)t * D + j * 1024 + lane * 16 + q * 4);
            acc[j][4 * q] += r.x; acc[j][4 * q + 1] += r.y; acc[j][4 * q + 2] += r.z; acc[j][4 * q + 3] += r.w;
            q2 += (acc[j][4 * q] * acc[j][4 * q] + acc[j][4 * q + 1] * acc[j][4 * q + 1]) + (acc[j][4 * q + 2] * acc[j][4 * q + 2] + acc[j][4 * q + 3] * acc[j][4 * q + 3]);
        }
    q2 = wsum(q2);
    if (FINAL) {
        const float rf = rsqrtf(q2 * (1.f / D) + EPS);
#pragma unroll
        for (int j = 0; j < 2; ++j)
#pragma unroll
            for (int q = 0; q < 4; ++q) {
                const int e = j * 1024 + lane * 16 + q * 4;
                const f32x4 g = *(const f32x4*)(norm_final + e);
                f32x4 o; o.x = acc[j][4 * q] * rf * g.x; o.y = acc[j][4 * q + 1] * rf * g.y; o.z = acc[j][4 * q + 2] * rf * g.z; o.w = acc[j][4 * q + 3] * rf * g.w;
                *(f32x4*)(OUT + (size_t)t * D + e) = o;
            }
    } else {
#pragma unroll
        for (int j = 0; j < 2; ++j) {
#pragma unroll
            for (int q = 0; q < 4; ++q) {
                f32x4 o; o.x = acc[j][4 * q]; o.y = acc[j][4 * q + 1]; o.z = acc[j][4 * q + 2]; o.w = acc[j][4 * q + 3];
                *(f32x4*)(X2 + (size_t)t * D + j * 1024 + lane * 16 + q * 4) = o;
            }
            u32x4 b0, b1;
#pragma unroll
            for (int q = 0; q < 4; ++q) { b0[q] = pk2(acc[j][2 * q], acc[j][2 * q + 1]); b1[q] = pk2(acc[j][8 + 2 * q], acc[j][8 + 2 * q + 1]); }
            u32x4* xo = (u32x4*)(XB + (size_t)t * D + j * 1024 + lane * 16);
            xo[0] = b0; xo[1] = b1;
        }
        if (lane == 0) SS[t] = q2;
    }
}
}

namespace mk {
constexpr int KS_LD = 72, VS_LD = 80;
constexpr int ATT_KS_OFF = 0, ATT_VS_OFF = 256 * KS_LD * 2;
constexpr int ATT_LDS = ATT_VS_OFF + 256 * VS_LD * 2;

__device__ __forceinline__ bf16x8 tr_pair(const LAS bf16_t* p0, const LAS bf16_t* p1) {
    const s16x4 a = __builtin_amdgcn_ds_read_tr16_b64_v4i16((LAS s16x4*)p0);
    const s16x4 b = __builtin_amdgcn_ds_read_tr16_b64_v4i16((LAS s16x4*)p1);
    bf16x8 r; r[0] = a[0]; r[1] = a[1]; r[2] = a[2]; r[3] = a[3]; r[4] = b[0]; r[5] = b[1]; r[6] = b[2]; r[7] = b[3];
    return r;
}

__device__ __forceinline__ void attn_unit(const bf16_t* __restrict__ P, const f32x2* __restrict__ rope, const float* __restrict__ sinks_l, bf16_t* __restrict__ Y,
                                          int unit, LAS unsigned char* lds, int tid, int lane, int wave) {
    const int b = unit >> 6, n = (unit >> 1) & 31, kvh = unit & 1;
    const int tok0 = b * S + n * 128;
    LAS bf16_t* KS = (LAS bf16_t*)(lds + ATT_KS_OFF);
    LAS bf16_t* VS = (LAS bf16_t*)(lds + ATT_VS_OFF);
    {
        const int key = tid >> 1, part = tid & 1;
        const int kpos = n * 128 - 128 + key;
        u32x4 k1a = {0, 0, 0, 0}, k1b = k1a, k2a = k1a, k2b = k1a, v0 = k1a, v1 = k1a, v2 = k1a, v3 = k1a;
        if (kpos >= 0) {
            const bf16_t* kr = P + (size_t)(tok0 - 128 + key) * NP + C_KA + kvh * 64 + part * 16;
            const u32x4 x1a = *(const u32x4*)kr, x1b = *(const u32x4*)(kr + 8), x2a = *(const u32x4*)(kr + 32), x2b = *(const u32x4*)(kr + 40);
            const f32x2* cs = rope + (size_t)kpos * 32 + part * 16;
#pragma unroll
            for (int q = 0; q < 4; ++q) {
                {
                    const f32x2 c0 = cs[2 * q], c1 = cs[2 * q + 1];
                    const float a0 = bflo(x1a[q]), a1 = bfhi(x1a[q]), b0 = bflo(x2a[q]), b1 = bfhi(x2a[q]);
                    k1a[q] = pk2(a0 * c0.x - b0 * c0.y, a1 * c1.x - b1 * c1.y);
                    k2a[q] = pk2(b0 * c0.x + a0 * c0.y, b1 * c1.x + a1 * c1.y);
                }
                {
                    const f32x2 c0 = cs[8 + 2 * q], c1 = cs[8 + 2 * q + 1];
                    const float a0 = bflo(x1b[q]), a1 = bfhi(x1b[q]), b0 = bflo(x2b[q]), b1 = bfhi(x2b[q]);
                    k1b[q] = pk2(a0 * c0.x - b0 * c0.y, a1 * c1.x - b1 * c1.y);
                    k2b[q] = pk2(b0 * c0.x + a0 * c0.y, b1 * c1.x + a1 * c1.y);
                }
            }
            const bf16_t* vr = P + (size_t)(tok0 - 128 + key) * NP + C_VA + kvh * 64 + part * 32;
            v0 = *(const u32x4*)vr; v1 = *(const u32x4*)(vr + 8); v2 = *(const u32x4*)(vr + 16); v3 = *(const u32x4*)(vr + 24);
        }
        LAS bf16_t* kd = KS + key * KS_LD + part * 16;
        *(LAS u32x4*)kd = k1a; *(LAS u32x4*)(kd + 8) = k1b; *(LAS u32x4*)(kd + 32) = k2a; *(LAS u32x4*)(kd + 40) = k2b;
        LAS bf16_t* vd = VS + key * VS_LD + part * 32;
        *(LAS u32x4*)vd = v0; *(LAS u32x4*)(vd + 8) = v1; *(LAS u32x4*)(vd + 16) = v2; *(LAS u32x4*)(vd + 24) = v3;
    }
    __syncthreads();
    const int hq = kvh * 8 + wave;
    const int fr = lane & 15, fq = lane >> 4;
    constexpr float L2E = 1.4426950408889634f;
    const float sink2 = sinks_l[hq] * L2E;
    const int tq = (lane & 15) >> 2, tp = lane & 3;
#pragma unroll 1
    for (int rb = 0; rb < 8; ++rb) {
        const int q0 = rb * 16;
        const int qtok = tok0 + q0 + fr;
        bf16x8 bq0, bq1;
        {
            const bf16_t* qr = P + (size_t)qtok * NP + C_QA + hq * 64 + 8 * fq;
            const u32x4 x1 = *(const u32x4*)qr, x2 = *(const u32x4*)(qr + 32);
            const f32x2* cs = rope + (size_t)(n * 128 + q0 + fr) * 32 + 8 * fq;
            u32x4 o1, o2;
            constexpr float SC = 0.125f * L2E;
#pragma unroll
            for (int q = 0; q < 4; ++q) {
                const f32x2 c0 = cs[2 * q], c1 = cs[2 * q + 1];
                const float a0 = bflo(x1[q]), a1 = bfhi(x1[q]), b0 = bflo(x2[q]), b1 = bfhi(x2[q]);
                o1[q] = pk2((a0 * c0.x - b0 * c0.y) * SC, (a1 * c1.x - b1 * c1.y) * SC);
                o2[q] = pk2((b0 * c0.x + a0 * c0.y) * SC, (b1 * c1.x + a1 * c1.y) * SC);
            }
            bq0 = __builtin_bit_cast(bf16x8, o1); bq1 = __builtin_bit_cast(bf16x8, o2);
        }
        const int wsk = (q0 >> 5) << 5;
        pg8::f32x4 sc[10];
#pragma unroll
        for (int kt = 0; kt < 10; ++kt) {
            const LAS bf16_t* kp = KS + (wsk + kt * 16 + fr) * KS_LD + 8 * fq;
            const bf16x8 a0 = *(const LAS bf16x8*)kp, a1 = *(const LAS bf16x8*)(kp + 32);
            pg8::f32x4 acc = {0.f, 0.f, 0.f, 0.f};
            acc = __builtin_amdgcn_mfma_f32_16x16x32_bf16(a0, bq0, acc, 0, 0, 0);
            acc = __builtin_amdgcn_mfma_f32_16x16x32_bf16(a1, bq1, acc, 0, 0, 0);
            sc[kt] = acc;
        }
        const int qb = q0 + fr;
        const int kmin = (n == 0) ? 128 : 0;
        float mx = sink2;
#pragma unroll
        for (int kt = 0; kt < 10; ++kt)
#pragma unroll
            for (int r = 0; r < 4; ++r) {
                const int kb = wsk + kt * 16 + 4 * fq + r;
                const bool ok = (kb >= qb + 1) && (kb <= qb + 128) && (kb >= kmin);
                sc[kt][r] = ok ? sc[kt][r] : -1e30f;
                mx = fmaxf(mx, sc[kt][r]);
            }
        mx = fmaxf(mx, __shfl_xor(mx, 16)); mx = fmaxf(mx, __shfl_xor(mx, 32));
        float sum = 0.f;
#pragma unroll
        for (int kt = 0; kt < 10; ++kt)
#pragma unroll
            for (int r = 0; r < 4; ++r) { const float pv = __builtin_amdgcn_exp2f(sc[kt][r] - mx); sc[kt][r] = pv; sum += pv; }
        sum += __shfl_xor(sum, 16); sum += __shfl_xor(sum, 32);
        const float rden = 1.f / (sum + __builtin_amdgcn_exp2f(sink2 - mx));
        pg8::f32x4 oacc[4];
#pragma unroll
        for (int mt = 0; mt < 4; ++mt) oacc[mt] = (pg8::f32x4){0.f, 0.f, 0.f, 0.f};
#pragma unroll
        for (int kk = 0; kk < 5; ++kk) {
            u32x4 pb; pb[0] = pk2(sc[2 * kk][0], sc[2 * kk][1]); pb[1] = pk2(sc[2 * kk][2], sc[2 * kk][3]);
            pb[2] = pk2(sc[2 * kk + 1][0], sc[2 * kk + 1][1]); pb[3] = pk2(sc[2 * kk + 1][2], sc[2 * kk + 1][3]);
            const bf16x8 bp = __builtin_bit_cast(bf16x8, pb);
            const LAS bf16_t* v0 = VS + (wsk + (2 * kk) * 16 + 4 * fq + tq) * VS_LD + 4 * tp;
            const LAS bf16_t* v1 = v0 + 16 * VS_LD;
#pragma unroll
            for (int mt = 0; mt < 4; ++mt) {
                const bf16x8 av = tr_pair(v0 + mt * 16, v1 + mt * 16);
                oacc[mt] = __builtin_amdgcn_mfma_f32_16x16x32_bf16(av, bp, oacc[mt], 0, 0, 0);
            }
        }
        bf16_t* yr = Y + (size_t)qtok * D + hq * 64 + 4 * fq;
#pragma unroll
        for (int mt = 0; mt < 4; ++mt) {
            u32x2 w; w.x = pk2(oacc[mt][0] * rden, oacc[mt][1] * rden); w.y = pk2(oacc[mt][2] * rden, oacc[mt][3] * rden);
            *(u32x2*)(yr + mt * 16) = w;
        }
    }
}
}

namespace mk {
constexpr int RL = 144;
constexpr int PSL = 72;
constexpr int OBL = 132;
constexpr int R_QT = 0, R_KT = 64 * RL * 2, R_KD = 2 * 64 * RL * 2, R_V = 3 * 64 * RL * 2, R_SB = 4 * 64 * RL * 2;
constexpr int R_PS = R_SB + 128 * RL * 2;
constexpr int R_VEC = R_PS + 64 * PSL * 2;
constexpr int R_OB = R_KT;
constexpr int REC_LDS = R_VEC + 12288;
static_assert(64 * OBL * 4 <= 2 * 64 * RL * 2, "OB overlay");
constexpr int ST_STRIDE = 16384 + 256;

__device__ __forceinline__ bf16x8 ld_row_split(const LAS bf16_t* p) {
    const s16x4 a = *(const LAS s16x4*)p, b = *(const LAS s16x4*)(p + 16);
    bf16x8 r; r[0] = a[0]; r[1] = a[1]; r[2] = a[2]; r[3] = a[3]; r[4] = b[0]; r[5] = b[1]; r[6] = b[2]; r[7] = b[3];
    return r;
}
__device__ __forceinline__ float clamp80(float x) { return fminf(fmaxf(x, -80.f), 80.f); }
__device__ __forceinline__ float sigm(float x) { return 1.f / (1.f + __expf(-x)); }
__device__ __forceinline__ void st_bf16(LAS bf16_t* p, float v) { *p = (bf16_t)(pk2(v, 0.f) & 0xffffu); }

__device__ __forceinline__ void state_update(pg8::f32x4 (&acc)[8], const LAS bf16_t* KDm, const LAS bf16_t* Vm, int wave, int fq, int tq, int tp) {
    bf16x8 ka[2];
#pragma unroll
    for (int ks = 0; ks < 2; ++ks) { const LAS bf16_t* p = KDm + (ks * 32 + 4 * fq + tq) * RL + 16 * wave + 4 * tp; ka[ks] = tr_pair(p, p + 16 * RL); }
#pragma unroll
    for (int j = 0; j < 8; ++j)
#pragma unroll
        for (int ks = 0; ks < 2; ++ks) {
            const LAS bf16_t* p = Vm + (ks * 32 + 4 * fq + tq) * RL + 16 * j + 4 * tp;
            const bf16x8 vb = tr_pair(p, p + 16 * RL);
            acc[j] = __builtin_amdgcn_mfma_f32_16x16x32_bf16(ka[ks], vb, acc[j], 0, 0, 0);
        }
}
__device__ __forceinline__ void state_to_lds(const pg8::f32x4 (&acc)[8], const float (&rsc)[4], LAS bf16_t* SBm, int wave, int fr, int fq) {
#pragma unroll
    for (int j = 0; j < 8; ++j)
#pragma unroll
        for (int r = 0; r < 4; ++r) st_bf16(SBm + (16 * wave + 4 * fq + r) * RL + 16 * j + fr, acc[j][r] * rsc[r]);
}
__device__ __forceinline__ void score_tile(pg8::f32x4& acc, const LAS bf16_t* Am, const LAS bf16_t* Bm, int ti, int tj, int fr, int fq) {
    acc = (pg8::f32x4){0.f, 0.f, 0.f, 0.f};
#pragma unroll
    for (int ks = 0; ks < 4; ++ks) {
        const bf16x8 a = *(const LAS bf16x8*)(Am + (16 * ti + fr) * RL + ks * 32 + 8 * fq);
        const bf16x8 b = *(const LAS bf16x8*)(Bm + (16 * tj + fr) * RL + ks * 32 + 8 * fq);
        acc = __builtin_amdgcn_mfma_f32_16x16x32_bf16(a, b, acc, 0, 0, 0);
    }
}
struct TileRegs { u32x4 a, b; };
__device__ __forceinline__ TileRegs tile_load(const bf16_t* __restrict__ src, int tid) {
    const int row = tid >> 3, seg = tid & 7;
    const bf16_t* s = src + (size_t)row * NP + seg * 16;
    TileRegs t; t.a = *(const u32x4*)s; t.b = *(const u32x4*)(s + 8); return t;
}
__device__ __forceinline__ void tile_store(const TileRegs& t, LAS bf16_t* dst, int tid) {
    const int row = tid >> 3, seg = tid & 7;
    LAS bf16_t* d = dst + row * RL + seg * 16;
    *(LAS u32x4*)d = t.a; *(LAS u32x4*)(d + 8) = t.b;
}
__device__ __forceinline__ void state_store(const pg8::f32x4 (&acc)[8], float* __restrict__ dst, int wave, int lane) {
#pragma unroll
    for (int j = 0; j < 8; ++j)
#pragma unroll
        for (int r = 0; r < 4; ++r) dst[((wave * 8 + j) * 4 + r) * 64 + lane] = acc[j][r];
}

template <int PASS>
__device__ __forceinline__ void hgrn_unit(const bf16_t* __restrict__ P, const float* __restrict__ lb_logits, int layer, const float* __restrict__ gain_l,
                                          float* __restrict__ STB, bf16_t* __restrict__ Y, int unit, LAS unsigned char* lds, int tid, int lane, int wave) {
    const int chain = unit >> 3, g = unit & 7, b = chain >> 2, h = chain & 3;
    const int t0 = b * S + g * 512;
    const int fr = lane & 15, fq = lane >> 4, tq = (lane & 15) >> 2, tp = lane & 3;
    const int kp = tid & 63, rg = wave, c0 = 2 * kp;
    LAS bf16_t* QT = (LAS bf16_t*)(lds + R_QT); LAS bf16_t* KT = (LAS bf16_t*)(lds + R_KT); LAS bf16_t* KD = (LAS bf16_t*)(lds + R_KD);
    LAS bf16_t* VV = (LAS bf16_t*)(lds + R_V); LAS bf16_t* SB = (LAS bf16_t*)(lds + R_SB); LAS bf16_t* PS = (LAS bf16_t*)(lds + R_PS);
    LAS float* TOT = (LAS float*)(lds + R_VEC);
    LAS float* EREF = TOT + 1024; LAS float* ELAST = EREF + 128;
    LAS float* OB = (LAS float*)(lds + R_OB);
    float lb0 = 0.f, lb1 = 0.f;
    if (layer == 1) {
        const float a0 = lb_logits[h * 128 + c0], a1 = lb_logits[512 + h * 128 + c0], d0 = lb_logits[h * 128 + c0 + 1], d1 = lb_logits[512 + h * 128 + c0 + 1];
        const float m0 = fmaxf(a0, a1), m1 = fmaxf(d0, d1);
        lb0 = __expf(a1 - m0) / (__expf(a0 - m0) + __expf(a1 - m0));
        lb1 = __expf(d1 - m1) / (__expf(d0 - m1) + __expf(d1 - m1));
    }
    pg8::f32x4 acc[8];
#pragma unroll
    for (int j = 0; j < 8; ++j) acc[j] = (pg8::f32x4){0.f, 0.f, 0.f, 0.f};
    if (PASS == 2) {
        for (int jg = 0; jg < g; ++jg) {
            const float* sb = STB + (size_t)(chain * 8 + jg) * ST_STRIDE;
            float dk[4];
#pragma unroll
            for (int r = 0; r < 4; ++r) dk[r] = __expf(sb[16384 + 16 * wave + 4 * fq + r]);
#pragma unroll
            for (int j = 0; j < 8; ++j)
#pragma unroll
                for (int r = 0; r < 4; ++r) acc[j][r] = acc[j][r] * dk[r] + sb[((wave * 8 + j) * 4 + r) * 64 + lane];
        }
    }
    float gl0 = 0.f, gl1 = 0.f;
    unsigned fwn[8], qwn[8];
    {
#pragma unroll
        for (int i = 0; i < 8; ++i) { const bf16_t* pr = P + (size_t)(t0 + rg * 8 + i) * NP + h * 128 + c0; fwn[i] = *(const unsigned*)(pr + C_FH); if (PASS == 2) qwn[i] = *(const unsigned*)(pr + C_QH); }
    }
#pragma unroll 1
    for (int c = 0; c < 8; ++c) {
        const int tr0 = t0 + c * 64;
        float lf0[8], lf1[8], kk0[8], kk1[8], qv0[8], qv1[8];
#pragma unroll
        for (int i = 0; i < 8; ++i) {
            const unsigned fw = fwn[i];
            const float z0 = bflo(fw), z1 = bfhi(fw);
            const float s0 = sigm(z0), s1 = sigm(z1);
            lf0[i] = __logf(fmaxf(lb0 + (1.f - lb0) * s0, 1e-30f)); lf1[i] = __logf(fmaxf(lb1 + (1.f - lb1) * s1, 1e-30f));
            kk0[i] = (1.f - lb0) * (1.f - s0); kk1[i] = (1.f - lb1) * (1.f - s1);
            if (PASS == 2) { const unsigned qw = qwn[i]; const float q0 = bflo(qw), q1 = bfhi(qw); qv0[i] = q0 * sigm(q0); qv1[i] = q1 * sigm(q1); }
        }
#pragma unroll
        for (int i = 1; i < 8; ++i) { lf0[i] += lf0[i - 1]; lf1[i] += lf1[i - 1]; }
        TOT[rg * 128 + c0] = lf0[7]; TOT[rg * 128 + c0 + 1] = lf1[7];
        { const TileRegs vt = tile_load(P + (size_t)tr0 * NP + C_IH + h * 128, tid); tile_store(vt, VV, tid); }
        if (c < 7) {
            const int trn = tr0 + 64;
#pragma unroll
            for (int i = 0; i < 8; ++i) { const bf16_t* pr = P + (size_t)(trn + rg * 8 + i) * NP + h * 128 + c0; fwn[i] = *(const unsigned*)(pr + C_FH); if (PASS == 2) qwn[i] = *(const unsigned*)(pr + C_QH); }
        }
        __syncthreads();
        {
            float pre0 = 0.f, pre1 = 0.f, ref0 = 0.f, ref1 = 0.f, la0 = 0.f, la1 = 0.f;
#pragma unroll
            for (int r = 0; r < 8; ++r) {
                const float a0 = TOT[r * 128 + c0], a1 = TOT[r * 128 + c0 + 1];
                if (r < rg) { pre0 += a0; pre1 += a1; }
                if (r < 4) { ref0 += a0; ref1 += a1; }
                la0 += a0; la1 += a1;
            }
#pragma unroll
            for (int i = 0; i < 8; ++i) {
                const int row = rg * 8 + i;
                const float cu0 = pre0 + lf0[i], cu1 = pre1 + lf1[i];
                if (PASS == 2) {
                    *(LAS unsigned*)(QT + row * RL + c0) = pk2(qv0[i] * __expf(clamp80(cu0 - ref0)), qv1[i] * __expf(clamp80(cu1 - ref1)));
                    *(LAS unsigned*)(KT + row * RL + c0) = pk2(kk0[i] * __expf(clamp80(ref0 - cu0)), kk1[i] * __expf(clamp80(ref1 - cu1)));
                }
                *(LAS unsigned*)(KD + row * RL + c0) = pk2(kk0[i] * __expf(la0 - cu0), kk1[i] * __expf(la1 - cu1));
            }
            if (rg == 0) { EREF[c0] = __expf(ref0); EREF[c0 + 1] = __expf(ref1); ELAST[c0] = __expf(la0); ELAST[c0 + 1] = __expf(la1); }
            gl0 += la0; gl1 += la1;
        }
        __syncthreads();
        TileRegs gcur = {};
        if (PASS == 2) gcur = tile_load(P + (size_t)tr0 * NP + C_GH + h * 128, tid);
        pg8::f32x4 o[4];
        if (PASS == 2) {
            { float rs[4];
#pragma unroll
              for (int r = 0; r < 4; ++r) rs[r] = EREF[16 * wave + 4 * fq + r];
              state_to_lds(acc, rs, SB, wave, fr, fq); }
            { const int ti = wave >> 1;
#pragma unroll
              for (int tjj = 0; tjj < 2; ++tjj) {
                  const int tj = 2 * (wave & 1) + tjj;
                  pg8::f32x4 sa = {0.f, 0.f, 0.f, 0.f};
                  if (tj <= ti) score_tile(sa, QT, KT, ti, tj, fr, fq);
#pragma unroll
                  for (int r = 0; r < 4; ++r) {
                      const int t = 16 * ti + 4 * fq + r, s = 16 * tj + fr;
                      st_bf16(PS + t * PSL + s, (s <= t) ? sa[r] : 0.f);
                  }
              } }
            __syncthreads();
            bf16x8 sbf[4], vbf[2];
#pragma unroll
            for (int ks = 0; ks < 4; ++ks) { const LAS bf16_t* p = SB + (ks * 32 + 4 * fq + tq) * RL + 16 * wave + 4 * tp; sbf[ks] = tr_pair(p, p + 16 * RL); }
#pragma unroll
            for (int ks = 0; ks < 2; ++ks) { const LAS bf16_t* p = VV + (ks * 32 + 4 * fq + tq) * RL + 16 * wave + 4 * tp; vbf[ks] = tr_pair(p, p + 16 * RL); }
#pragma unroll
            for (int ti = 0; ti < 4; ++ti) {
                o[ti] = (pg8::f32x4){0.f, 0.f, 0.f, 0.f};
#pragma unroll
                for (int ks = 0; ks < 4; ++ks) o[ti] = __builtin_amdgcn_mfma_f32_16x16x32_bf16(ld_row_split(QT + (16 * ti + fr) * RL + ks * 32 + 4 * fq), sbf[ks], o[ti], 0, 0, 0);
#pragma unroll
                for (int ks = 0; ks < 2; ++ks) o[ti] = __builtin_amdgcn_mfma_f32_16x16x32_bf16(ld_row_split(PS + (16 * ti + fr) * PSL + ks * 32 + 4 * fq), vbf[ks], o[ti], 0, 0, 0);
            }
        }
        {
#pragma unroll
            for (int r = 0; r < 4; ++r) { const float el = ELAST[16 * wave + 4 * fq + r];
#pragma unroll
                for (int j = 0; j < 8; ++j) acc[j][r] *= el; }
            state_update(acc, KD, VV, wave, fq, tq, tp);
        }
        __syncthreads();
        if (PASS == 2) {
#pragma unroll
            for (int ti = 0; ti < 4; ++ti)
#pragma unroll
                for (int r = 0; r < 4; ++r) OB[(16 * ti + 4 * fq + r) * OBL + 16 * wave + fr] = o[ti][r];
            __syncthreads();
            const int t = tid >> 3, seg = tid & 7;
            float ov[16]; float ss = 0.f;
#pragma unroll
            for (int q = 0; q < 4; ++q) { const f32x4 a = *(const LAS f32x4*)(OB + t * OBL + seg * 16 + 4 * q); ov[4 * q] = a.x; ov[4 * q + 1] = a.y; ov[4 * q + 2] = a.z; ov[4 * q + 3] = a.w;
                ss += (a.x * a.x + a.y * a.y) + (a.z * a.z + a.w * a.w); }
            ss = sum8(ss);
            const float rn = rsqrtf(ss * (1.f / 128.f) + EPS);
            const u32x4 g0 = gcur.a, g1 = gcur.b;
            const float* gnp = gain_l + h * 128 + seg * 16;
            u32x4 y0, y1;
#pragma unroll
            for (int q = 0; q < 4; ++q) {
                const float ga = bflo(g0[q]), gb = bfhi(g0[q]), gc = bflo(g1[q]), gd = bfhi(g1[q]);
                y0[q] = pk2(ov[2 * q] * rn * gnp[2 * q] * (ga * sigm(ga)), ov[2 * q + 1] * rn * gnp[2 * q + 1] * (gb * sigm(gb)));
                y1[q] = pk2(ov[8 + 2 * q] * rn * gnp[8 + 2 * q] * (gc * sigm(gc)), ov[8 + 2 * q + 1] * rn * gnp[8 + 2 * q + 1] * (gd * sigm(gd)));
            }
            bf16_t* yp = Y + (size_t)(tr0 + t) * D + 1024 + h * 128 + seg * 16;
            *(u32x4*)yp = y0; *(u32x4*)(yp + 8) = y1;
        }
    }
    if (PASS == 1) {
        float* sb = STB + (size_t)(chain * 8 + g) * ST_STRIDE;
        state_store(acc, sb, wave, lane);
        if (rg == 0) { sb[16384 + c0] = gl0; sb[16384 + c0 + 1] = gl1; }
    }
}

template <int PASS>
__device__ __forceinline__ void mlstm_unit(const bf16_t* __restrict__ P, const float* __restrict__ conv_l, const float* __restrict__ ib_l, const float* __restrict__ fb_l,
                                           float* __restrict__ STB, bf16_t* __restrict__ Y, int unit, LAS unsigned char* lds, int tid, int lane, int wave) {
    const int chain = unit >> 3, g = unit & 7, b = chain >> 2, h = chain & 3;
    const int t0 = b * S + g * 512;
    const int fr = lane & 15, fq = lane >> 4, tq = (lane & 15) >> 2, tp = lane & 3;
    const int kp = tid & 63, rg = wave, c0 = 2 * kp;
    LAS bf16_t* QM = (LAS bf16_t*)(lds + R_QT); LAS bf16_t* KM = (LAS bf16_t*)(lds + R_KT); LAS bf16_t* KW = (LAS bf16_t*)(lds + R_KD);
    LAS bf16_t* VV = (LAS bf16_t*)(lds + R_V); LAS bf16_t* CB = (LAS bf16_t*)(lds + R_SB); LAS bf16_t* PS = (LAS bf16_t*)(lds + R_PS);
    LAS float* VEC = (LAS float*)(lds + R_VEC);
    LAS float* GA = VEC;
    LAS float* GPM = VEC + 512;
    LAS float* GCUM = VEC + 1024;
    LAS float* NV = VEC + 1536;
    LAS float* DENP = VEC + 1664;
    LAS float* DINT = VEC + 1792;
    LAS float* KSUM = VEC + 1856;
    LAS float* OB = (LAS float*)(lds + R_OB);
    float wq0[4], wq1[4], wk0[4], wk1[4];
#pragma unroll
    for (int j = 0; j < 4; ++j) {
        wq0[j] = conv_l[j * 1024 + h * 128 + c0]; wq1[j] = conv_l[j * 1024 + h * 128 + c0 + 1];
        wk0[j] = conv_l[j * 1024 + 512 + h * 128 + c0]; wk1[j] = conv_l[j * 1024 + 512 + h * 128 + c0 + 1];
    }
    {
        const bf16_t* pr = P + (size_t)(t0 + wave * 64 + lane) * NP;
        const float ip = bf2f(pr[C_IM + h]) + ib_l[h];
        const float z = bf2f(pr[C_FM + h]) + fb_l[h];
        const float lf = fminf(z, 0.f) - __logf(1.f + __expf(-fabsf(z)));
        float cu = lf;
#pragma unroll
        for (int o = 1; o < 64; o <<= 1) { const float t = __shfl_up(cu, o); if (lane >= o) cu += t; }
        const float a = ip - cu;
        float pm = a;
#pragma unroll
        for (int o = 1; o < 64; o <<= 1) { const float t = __shfl_up(pm, o); if (lane >= o) pm = fmaxf(pm, t); }
        GA[wave * 64 + lane] = a; GPM[wave * 64 + lane] = pm; GCUM[wave * 64 + lane] = cu;
    }
    pg8::f32x4 acc[8];
#pragma unroll
    for (int j = 0; j < 8; ++j) acc[j] = (pg8::f32x4){0.f, 0.f, 0.f, 0.f};
    float mprev = (PASS == 1) ? -1e30f : 0.f;
    float nreg = 0.f;
    float fsum = 0.f;
    if (PASS == 2) {
        for (int jg = 0; jg < g; ++jg) {
            const float* sb = STB + (size_t)(chain * 8 + jg) * ST_STRIDE;
            const float mE = sb[16384 + 128], F = sb[16384 + 129];
            const float mn = fmaxf(F + mprev, mE);
            const float s1 = __expf(F + mprev - mn), s2 = __expf(mE - mn);
#pragma unroll
            for (int j = 0; j < 8; ++j)
#pragma unroll
                for (int r = 0; r < 4; ++r) acc[j][r] = acc[j][r] * s1 + s2 * sb[((wave * 8 + j) * 4 + r) * 64 + lane];
            if (tid < 128) nreg = nreg * s1 + s2 * sb[16384 + tid];
            mprev = mn;
        }
    }
    if (tid < 128) NV[tid] = nreg;
    unsigned xqn[11], xkn[11];
#define MLSTM_FETCH(TR0, CC) do { _Pragma("unroll") for (int i = 0; i < 11; ++i) { \
            const int row_ = rg * 8 + i - 3; const int pos_ = g * 512 + (CC) * 64 + row_; unsigned wq_ = 0u, wk_ = 0u; \
            if (pos_ >= 0) { const bf16_t* pr_ = P + (size_t)((TR0) + row_) * NP + h * 128 + c0; if (PASS == 2) wq_ = *(const unsigned*)(pr_ + C_QM); wk_ = *(const unsigned*)(pr_ + C_KM); } \
            xqn[i] = wq_; xkn[i] = wk_; } \
        } while (0)
    MLSTM_FETCH(t0, 0);
    __syncthreads();
#pragma unroll 1
    for (int c = 0; c < 8; ++c) {
        const int tr0 = t0 + c * 64;
        const LAS float* AV = GA + c * 64; const LAS float* PM = GPM + c * 64; const LAS float* CUM = GCUM + c * 64;
        const float M63 = fmaxf(PM[63], mprev), last = CUM[63];
        float ks0 = 0.f, ks1 = 0.f;
#pragma unroll
        for (int i = 0; i < 8; ++i) {
            const int row = rg * 8 + i;
            float k0v = 0.f, k1v = 0.f, q0v = 0.f, q1v = 0.f;
#pragma unroll
            for (int j = 0; j < 4; ++j) { k0v += wk0[j] * bflo(xkn[i + j]); k1v += wk1[j] * bfhi(xkn[i + j]); if (PASS == 2) { q0v += wq0[j] * bflo(xqn[i + j]); q1v += wq1[j] * bfhi(xqn[i + j]); } }
            k0v = k0v * sigm(k0v) * 0.08838834764831845f; k1v = k1v * sigm(k1v) * 0.08838834764831845f;
            const float wsr = __expf(AV[row] - M63);
            const unsigned kw = pk2(k0v * wsr, k1v * wsr);
            *(LAS unsigned*)(KW + row * RL + c0) = kw;
            ks0 += bflo(kw); ks1 += bfhi(kw);
            if (PASS == 2) {
                *(LAS unsigned*)(KM + row * RL + c0) = pk2(k0v, k1v);
                *(LAS unsigned*)(QM + row * RL + c0) = pk2(q0v * sigm(q0v), q1v * sigm(q1v));
            }
        }
        KSUM[rg * 128 + c0] = ks0; KSUM[rg * 128 + c0 + 1] = ks1;
        { const TileRegs vt = tile_load(P + (size_t)tr0 * NP + C_VM + h * 128, tid); tile_store(vt, VV, tid); }
        if (c < 7) MLSTM_FETCH(tr0 + 64, c + 1);
        const float decay = __expf(mprev - M63);
        pg8::f32x4 o1[4], o2[4];
        if (PASS == 2) {
            const float one[4] = {1.f, 1.f, 1.f, 1.f};
            state_to_lds(acc, one, CB, wave, fr, fq);
        }
        __syncthreads();
        TileRegs ocur = {};
        if (PASS == 2) ocur = tile_load(P + (size_t)tr0 * NP + C_OM + h * 128, tid);
        if (PASS == 2) {
            { const int ti = wave >> 1;
              float dp[4] = {0.f, 0.f, 0.f, 0.f};
#pragma unroll
              for (int tjj = 0; tjj < 2; ++tjj) {
                  const int tj = 2 * (wave & 1) + tjj;
                  pg8::f32x4 sa = {0.f, 0.f, 0.f, 0.f};
                  if (tj <= ti) score_tile(sa, QM, KM, ti, tj, fr, fq);
                  const int s = 16 * tj + fr;
                  const float as = AV[s];
#pragma unroll
                  for (int r = 0; r < 4; ++r) {
                      const int t = 16 * ti + 4 * fq + r;
                      const float w = (s <= t) ? sa[r] * __expf(as - fmaxf(PM[t], mprev)) : 0.f;
                      st_bf16(PS + t * PSL + s, w);
                      dp[r] += w;
                  }
              }
#pragma unroll
              for (int r = 0; r < 4; ++r) {
                  const float v = sum16(dp[r]);
                  if (fr == 0) DENP[(16 * ti + 4 * fq + r) * 2 + (wave & 1)] = v;
              } }
            { const int t = tid >> 3, seg = tid & 7;
              const bf16x8 qa = *(const LAS bf16x8*)(QM + t * RL + seg * 16), qb = *(const LAS bf16x8*)(QM + t * RL + seg * 16 + 8);
              float dsum = 0.f;
#pragma unroll
              for (int q = 0; q < 8; ++q) dsum += bf2f((unsigned short)qa[q]) * NV[seg * 16 + q] + bf2f((unsigned short)qb[q]) * NV[seg * 16 + 8 + q];
              dsum = sum8(dsum);
              if (seg == 0) DINT[t] = dsum; }
            __syncthreads();
            bf16x8 cbf[4], vbf[2];
#pragma unroll
            for (int ks = 0; ks < 4; ++ks) { const LAS bf16_t* p = CB + (ks * 32 + 4 * fq + tq) * RL + 16 * wave + 4 * tp; cbf[ks] = tr_pair(p, p + 16 * RL); }
#pragma unroll
            for (int ks = 0; ks < 2; ++ks) { const LAS bf16_t* p = VV + (ks * 32 + 4 * fq + tq) * RL + 16 * wave + 4 * tp; vbf[ks] = tr_pair(p, p + 16 * RL); }
#pragma unroll
            for (int ti = 0; ti < 4; ++ti) {
                o1[ti] = (pg8::f32x4){0.f, 0.f, 0.f, 0.f}; o2[ti] = (pg8::f32x4){0.f, 0.f, 0.f, 0.f};
#pragma unroll
                for (int ks = 0; ks < 4; ++ks) o2[ti] = __builtin_amdgcn_mfma_f32_16x16x32_bf16(ld_row_split(QM + (16 * ti + fr) * RL + ks * 32 + 4 * fq), cbf[ks], o2[ti], 0, 0, 0);
#pragma unroll
                for (int ks = 0; ks < 2; ++ks) o1[ti] = __builtin_amdgcn_mfma_f32_16x16x32_bf16(ld_row_split(PS + (16 * ti + fr) * PSL + ks * 32 + 4 * fq), vbf[ks], o1[ti], 0, 0, 0);
            }
        }
        {
#pragma unroll
            for (int j = 0; j < 8; ++j) acc[j] = acc[j] * decay;
            state_update(acc, KW, VV, wave, fq, tq, tp);
            if (tid < 128) {
                float sumk = 0.f;
#pragma unroll
                for (int r8 = 0; r8 < 8; ++r8) sumk += KSUM[r8 * 128 + tid];
                nreg = nreg * decay + sumk;
            }
        }
        fsum += last;
        const float mnew = last + M63;
        __syncthreads();
        if (tid < 128) NV[tid] = nreg;
        if (PASS == 2) {
#pragma unroll
            for (int ti = 0; ti < 4; ++ti)
#pragma unroll
                for (int r = 0; r < 4; ++r) {
                    const int t = 16 * ti + 4 * fq + r;
                    OB[t * OBL + 16 * wave + fr] = o1[ti][r] + __expf(mprev - fmaxf(PM[t], mprev)) * o2[ti][r];
                }
            __syncthreads();
            const int t = tid >> 3, seg = tid & 7;
            const float Mt = fmaxf(PM[t], mprev);
            const float wi = __expf(mprev - Mt);
            const float den = DENP[t * 2] + DENP[t * 2 + 1] + wi * DINT[t];
            const float hd = 1.f / fmaxf(fabsf(den), __expf(-(CUM[t] + Mt)));
            const u32x4 g0 = ocur.a, g1 = ocur.b;
            const unsigned gw[8] = {g0[0], g0[1], g0[2], g0[3], g1[0], g1[1], g1[2], g1[3]};
            unsigned yw[8];
#pragma unroll
            for (int q = 0; q < 4; ++q) {
                const f32x4 a = *(const LAS f32x4*)(OB + t * OBL + seg * 16 + 4 * q);
                yw[2 * q] = pk2(a.x * hd * sigm(bflo(gw[2 * q])), a.y * hd * sigm(bfhi(gw[2 * q])));
                yw[2 * q + 1] = pk2(a.z * hd * sigm(bflo(gw[2 * q + 1])), a.w * hd * sigm(bfhi(gw[2 * q + 1])));
            }
            u32x4 y0, y1;
            y0[0] = yw[0]; y0[1] = yw[1]; y0[2] = yw[2]; y0[3] = yw[3]; y1[0] = yw[4]; y1[1] = yw[5]; y1[2] = yw[6]; y1[3] = yw[7];
            bf16_t* yp = Y + (size_t)(tr0 + t) * D + 1536 + h * 128 + seg * 16;
            *(u32x4*)yp = y0; *(u32x4*)(yp + 8) = y1;
        }
        mprev = mnew;
        __syncthreads();
    }
#undef MLSTM_FETCH
    if (PASS == 1) {
        float* sb = STB + (size_t)(chain * 8 + g) * ST_STRIDE;
        state_store(acc, sb, wave, lane);
        if (tid < 128) sb[16384 + tid] = nreg;
        if (tid == 0) { sb[16384 + 128] = mprev; sb[16384 + 129] = fsum; }
    }
}
}

namespace mk {
#define XB_TMO      128
#define XB_XCNT(j)  (256  + 64 * (j))
#define XB_XSUB(j)  (1280 + 64 * (j))
#define XB_XGEN(j)  (2304 + 64 * (j))
#define XB_TOP      3328
#define XB_TOPGEN   3392
#define XCD_BAR_WORDS 3456
#define XB_SPIN_CAP (1u << 18)

__device__ __forceinline__ unsigned xb_ld(unsigned* p)              { return __hip_atomic_load(p, __ATOMIC_RELAXED, __HIP_MEMORY_SCOPE_AGENT); }
__device__ __forceinline__ unsigned xb_add(unsigned* p, unsigned v) { return __hip_atomic_fetch_add(p, v, __ATOMIC_RELAXED, __HIP_MEMORY_SCOPE_AGENT); }
__device__ __forceinline__ unsigned xb_xcc_id() { return (unsigned)__builtin_amdgcn_s_getreg((3 << 11) | 20) & 0xFu; }
#define XB_SPIN(cond, bar) do { unsigned _sp = 0; while (cond) { __builtin_amdgcn_s_sleep(1); \
    if ((++_sp & 255u) == 0u) { if (xb_ld(&(bar)[XB_TMO])) break; if (_sp > XB_SPIN_CAP) { atomicAdd(&(bar)[XB_TMO], 1u); break; } } } } while (0)

struct XcdBarrier {
    unsigned* bar; unsigned x;
    volatile LAS unsigned* st;
};

__device__ __forceinline__ XcdBarrier xcd_barrier_post(unsigned* bar, volatile LAS unsigned* st) {
    XcdBarrier b; b.bar = bar; b.x = xb_xcc_id(); b.st = st;
    if (threadIdx.x == 0) (void)xb_add(&bar[XB_XCNT(b.x)], 1u);
    return b;
}
__device__ __forceinline__ void xcd_barrier_complete(unsigned* bar, unsigned x, unsigned& nloc, unsigned& nx) {
    const unsigned G = gridDim.x * gridDim.y * gridDim.z;
    unsigned sum, cnt, mine, sp = 0u;
    for (;;) {
        sum = 0u; cnt = 0u; mine = 0u;
#pragma unroll
        for (unsigned j = 0; j < 16; ++j) { const unsigned c = xb_ld(&bar[XB_XCNT(j)]); sum += c; cnt += (c > 0u) ? 1u : 0u; mine = (j == x) ? c : mine; }
        if (sum == G) break;
        __builtin_amdgcn_s_sleep(1);
        if ((++sp & 255u) == 0u) { if (xb_ld(&bar[XB_TMO])) break; if (sp > XB_SPIN_CAP) { atomicAdd(&bar[XB_TMO], 1u); break; } }
    }
    nloc = mine > 0u ? mine : 1u; nx = cnt > 0u ? cnt : 1u;
}

__device__ __forceinline__ void xcd_barrier(const XcdBarrier& b) {
    asm volatile("s_waitcnt vmcnt(0)" ::: "memory");
    __syncthreads();
    if (threadIdx.x == 0) {
        unsigned* bar = b.bar;
        __builtin_amdgcn_s_waitcnt(0);
        unsigned nloc = b.st[0], nx = b.st[1];
        if (nloc == 0u) { xcd_barrier_complete(bar, b.x, nloc, nx); b.st[0] = nloc; b.st[1] = nx; }
        const unsigned old = xb_add(&bar[XB_XSUB(b.x)], 1u);
        const unsigned gen = old / nloc;
        if (old + 1u == (gen + 1u) * nloc) {
            __builtin_amdgcn_fence(__ATOMIC_RELEASE, "agent");
            asm volatile("s_waitcnt vmcnt(0)" ::: "memory");
            const unsigned og = xb_add(&bar[XB_TOP], 1u);
            const unsigned tg = og / nx;
            if (og + 1u == (tg + 1u) * nx) xb_add(&bar[XB_TOPGEN], 1u);
            else XB_SPIN(xb_ld(&bar[XB_TOPGEN]) == tg, bar);
            __builtin_amdgcn_fence(__ATOMIC_ACQUIRE, "agent");
            xb_add(&bar[XB_XGEN(b.x)], 1u);
            asm volatile("s_waitcnt vmcnt(0)" ::: "memory");
        } else {
            XB_SPIN(xb_ld(&bar[XB_XGEN(b.x)]) == gen, bar);
            __builtin_amdgcn_fence(__ATOMIC_ACQUIRE, "agent");
            asm volatile("s_waitcnt vmcnt(0)" ::: "memory");
        }
    }
    __syncthreads();
}

}

namespace mk {
constexpr int NSLICE = 16, SLW = 128, TBLK = 128, NTB = T / TBLK;
constexpr int CTL_Q = 3584;

__device__ __forceinline__ f32x2 fma2(f32x2 a, f32x2 b, f32x2 c) { return __builtin_elementwise_fma(a, b, c); }

__device__ __forceinline__ int q_next(unsigned* cnt, LAS int* slot, int tid) {
    __syncthreads();
    if (tid == 0) *slot = (int)__hip_atomic_fetch_add(cnt, 1u, __ATOMIC_RELAXED, __HIP_MEMORY_SCOPE_AGENT);
    __syncthreads();
    const int v = *slot;
    return v < NTB ? v : -1;
}

typedef __amdgpu_buffer_rsrc_t rsrc_t;
__device__ __forceinline__ rsrc_t make_rsrc(const void* p, unsigned bytes) { return __builtin_amdgcn_make_buffer_rsrc((void*)p, 0, bytes, 0x00020000); }

constexpr int PL_IDX = 0, PL_AUX = TBLK * 128 * 4;
#define PEER_ISSUE(W, IDP) do { const LAS u32x4* ip_ = (const LAS u32x4*)(IDP); const u32x4 i0_ = ip_[0], i1_ = ip_[1], i2_ = ip_[2], i3_ = ip_[3]; \
        _Pragma("unroll") for (int k = 0; k < 4; ++k) { \
            W[k]      = __builtin_amdgcn_raw_buffer_load_b128(rs, (int)i0_[k] * SLW + c * 16, soff, 0); \
            W[4 + k]  = __builtin_amdgcn_raw_buffer_load_b128(rs, (int)i1_[k] * SLW + c * 16, soff, 0); \
            W[8 + k]  = __builtin_amdgcn_raw_buffer_load_b128(rs, (int)i2_[k] * SLW + c * 16, soff, 0); \
            W[12 + k] = __builtin_amdgcn_raw_buffer_load_b128(rs, (int)i3_[k] * SLW + c * 16, soff, 0); } } while (0)
constexpr float XS8 = 1.f;
typedef _Float16 h2_t __attribute__((ext_vector_type(2)));
template <int MODE>
__device__ __forceinline__ void u_compute(u32x4 (&w)[16], const LAS unsigned* xs, float* __restrict__ PART, int s, int t, int g, int c) {
    if (MODE == 1) { _Pragma("unroll") for (int k = 0; k < 16; ++k) asm volatile("" :: "v"(w[k])); return; }
    if (MODE == 2) { _Pragma("unroll") for (int k = 0; k < 16; ++k) asm volatile("" : "=v"(w[k])); }
    typedef _Float16 h8_t __attribute__((ext_vector_type(8)));
    const h8_t xlo = *(const LAS h8_t*)xs, xhi = *(const LAS h8_t*)(xs + 4);
    h2_t xv[8];
#pragma unroll
    for (int j = 0; j < 4; ++j) { xv[j] = (h2_t){xlo[2 * j], xlo[2 * j + 1]}; xv[4 + j] = (h2_t){xhi[2 * j], xhi[2 * j + 1]}; }
    float r0 = 0.f, r1 = 0.f;
#pragma unroll
    for (int k = 0; k < 16; ++k) {
        float d0 = 0.f, d1 = 0.f;
#pragma unroll
        for (int q = 0; q < 4; ++q) {
            d0 = __builtin_amdgcn_fdot2(__builtin_amdgcn_cvt_scalef32_pk_f16_fp8((int)w[k][q], 1.0f, false), xv[2 * q], d0, false);
            d1 = __builtin_amdgcn_fdot2(__builtin_amdgcn_cvt_scalef32_pk_f16_fp8((int)w[k][q], 1.0f, true), xv[2 * q + 1], d1, false);
        }
        float d = d0 + d1;
        d += dppf<DPP_XOR1>(d); d += dppf<DPP_XOR2>(d); d += dppf<DPP_HMIR>(d);
        if (k < 8) { if (c == k) r0 = d; } else { if (c == k - 8) r1 = d; }
    }
    if (MODE == 2) { asm volatile("" :: "v"(r0), "v"(r1)); return; }
    float* pp = PART + ((size_t)s * T + t) * 128 + 8 * c + g;
    pp[0] = r0; pp[64] = r1;
}
struct UStage { u32x4 id[8]; u32x4 x[4]; };
__device__ __forceinline__ void u_stage_load(UStage& r, int s, int tb, const bf16_t* __restrict__ XB, const int* __restrict__ IDX, int tid) {
    const u32x4* src = (const u32x4*)(IDX + (size_t)tb * TBLK * 128);
#pragma unroll
    for (int j = 0; j < 8; ++j) r.id[j] = src[tid + j * NTHR];
#pragma unroll
    for (int j = 0; j < 4; ++j) { const int e = tid + j * NTHR, tt = e >> 4, ch = e & 15; r.x[j] = *(const u32x4*)(XB + (size_t)(tb * TBLK + tt) * D + s * SLW + ch * 8); }
}
__device__ __forceinline__ void u_stage_store(const UStage& r, LAS unsigned char* lds, int tid) {
#pragma unroll
    for (int j = 0; j < 8; ++j) *(LAS u32x4*)(lds + PL_IDX + (size_t)(tid + j * NTHR) * 16) = r.id[j];
#pragma unroll
    for (int j = 0; j < 4; ++j) { const int e = tid + j * NTHR, tt = e >> 4, ch = e & 15;
        u32x4 o;
#pragma unroll
        for (int e2 = 0; e2 < 4; ++e2) { const h2_t hv = {(_Float16)bflo(r.x[j][e2]), (_Float16)bfhi(r.x[j][e2])}; o[e2] = __builtin_bit_cast(unsigned, hv); }
        *(LAS u32x4*)(lds + PL_AUX + tt * 256 + ch * 16) = o; }
}
template <int MODE>
__device__ __forceinline__ void peer_u_run(int s, int tb, const unsigned char* __restrict__ U8, float* __restrict__ PART, LAS unsigned char* lds, int wave, int lane) {
    const int g = lane >> 3, c = lane & 7;
    const rsrc_t rs = make_rsrc(U8, (unsigned)((size_t)NE * D));
    const int soff = s * NE * SLW;
    constexpr int NTW = TBLK / NWAVES;
    const int tw = wave * NTW, t0 = tb * TBLK + tw;
    const LAS unsigned char* idb = lds + PL_IDX + (size_t)tw * 512 + g * 64;
    const LAS unsigned* xsb = (const LAS unsigned*)(lds + PL_AUX + (size_t)tw * 256) + c * 8;
    u32x4 wa[16], wb[16];
    if (MODE != 2) PEER_ISSUE(wa, idb);
#pragma unroll 1
    for (int i = 0; i < NTW; i += 2) {
        if (MODE != 2) PEER_ISSUE(wb, idb + (i + 1) * 512);
        u_compute<MODE>(wa, xsb + i * 64, PART, s, t0 + i, g, c);
        if (MODE != 2) PEER_ISSUE(wa, idb + min(i + 2, NTW - 1) * 512);
        u_compute<MODE>(wb, xsb + (i + 1) * 64, PART, s, t0 + i + 1, g, c);
    }
}
template <int MODE>
__device__ __forceinline__ void peer_u_block(int s, int tb, const bf16_t* __restrict__ XB, const int* __restrict__ IDX, const unsigned char* __restrict__ U8,
                                             float* __restrict__ PART, LAS unsigned char* lds, int tid, int wave, int lane) {
    UStage r; u_stage_load(r, s, tb, XB, IDX, tid); u_stage_store(r, lds, tid);
    __syncthreads();
    peer_u_run<MODE>(s, tb, U8, PART, lds, wave, lane);
}

__device__ __forceinline__ void peer_act_token(int t, const float* __restrict__ PART, const float* __restrict__ ssp, const int* __restrict__ IDX, const float* __restrict__ GATE,
                                               const float* __restrict__ USC, const float* __restrict__ VSC, _Float16* __restrict__ ACT, int lane) {
    const int p0 = 8 * (lane & 15) + (lane >> 4), p1 = 8 * (lane & 15) + 4 + (lane >> 4);
    float s0 = 0.f, s1 = 0.f;
#pragma unroll
    for (int s = 0; s < NSLICE; ++s) { const float* pp = PART + ((size_t)s * T + t) * 128; s0 += pp[p0]; s1 += pp[p1]; }
    float sp = (lane < 32) ? ssp[(size_t)t * 32 + lane] : 0.f;
    sp = wsum(sp);
    const float rs1 = rsqrtf(sp * (1.f / D) + EPS);
    const int id0 = IDX[(size_t)t * 128 + lane], id1 = IDX[(size_t)t * 128 + 64 + lane];
    ACT[(size_t)t * 128 + lane] = (_Float16)(gelu_erf(s0 * USC[id0] * (rs1 * (1.f / XS8))) * GATE[(size_t)t * 128 + lane] * VSC[id0]);
    ACT[(size_t)t * 128 + 64 + lane] = (_Float16)(gelu_erf(s1 * USC[id1] * (rs1 * (1.f / XS8))) * GATE[(size_t)t * 128 + 64 + lane] * VSC[id1]);
}

__device__ __forceinline__ void v_compute(const u32x4 (&w)[16], const LAS _Float16* avp, bf16_t* __restrict__ XBio, float* __restrict__ OUT32,
                                          float* __restrict__ SS16, int s, int t, int g, int c, int lane) {
    const size_t off = (size_t)t * D + s * SLW + c * 16 + 2 * g;
    const unsigned rw = *(const unsigned*)(XBio + off);
    const f32x2 res = {bflo(rw), bfhi(rw)};
    typedef _Float16 h8_t __attribute__((ext_vector_type(8)));
    const h8_t al = *(const LAS h8_t*)avp, ah8 = *(const LAS h8_t*)(avp + 8);
    h2_t hacc[8];
#pragma unroll
    for (int q = 0; q < 8; ++q) hacc[q] = (h2_t){(_Float16)0.f, (_Float16)0.f};
#pragma unroll
    for (int k = 0; k < 16; ++k) {
        const _Float16 ah = (k < 8) ? al[k & 7] : ah8[k & 7];
        const h2_t a2 = {ah, ah};
#pragma unroll
        for (int q = 0; q < 4; ++q) {
            const auto c0 = __builtin_amdgcn_cvt_scalef32_pk_f16_fp8((int)w[k][q], 1.0f, false), c1 = __builtin_amdgcn_cvt_scalef32_pk_f16_fp8((int)w[k][q], 1.0f, true);
            const h2_t w0 = {(_Float16)c0[0], (_Float16)c0[1]}, w1 = {(_Float16)c1[0], (_Float16)c1[1]};
            hacc[2 * q] = __builtin_elementwise_fma(a2, w0, hacc[2 * q]);
            hacc[2 * q + 1] = __builtin_elementwise_fma(a2, w1, hacc[2 * q + 1]);
        }
    }
    f32x2 acc[8];
#pragma unroll
    for (int q = 0; q < 8; ++q) acc[q] = (f32x2){(float)hacc[q][0], (float)hacc[q][1]};
    f32x2 h4[4];
#pragma unroll
    for (int q = 0; q < 4; ++q) {
        const auto sx = __builtin_amdgcn_permlane32_swap(__float_as_uint(acc[q].x), __float_as_uint(acc[4 + q].x), false, false);
        const auto sy = __builtin_amdgcn_permlane32_swap(__float_as_uint(acc[q].y), __float_as_uint(acc[4 + q].y), false, false);
        h4[q] = (f32x2){__uint_as_float(sx[0]) + __uint_as_float(sx[1]), __uint_as_float(sy[0]) + __uint_as_float(sy[1])};
    }
    f32x2 h2[2];
#pragma unroll
    for (int q = 0; q < 2; ++q) {
        const auto sx = __builtin_amdgcn_permlane16_swap(__float_as_uint(h4[q].x), __float_as_uint(h4[2 + q].x), false, false);
        const auto sy = __builtin_amdgcn_permlane16_swap(__float_as_uint(h4[q].y), __float_as_uint(h4[2 + q].y), false, false);
        h2[q] = (f32x2){__uint_as_float(sx[0]) + __uint_as_float(sx[1]), __uint_as_float(sy[0]) + __uint_as_float(sy[1])};
    }
    const bool up = (g & 1) != 0;
    const f32x2 keep = up ? h2[1] : h2[0], send = up ? h2[0] : h2[1];
    f32x2 o = {keep.x + dppf<DPP_ROR8>(send.x) + res.x, keep.y + dppf<DPP_ROR8>(send.y) + res.y};
    if (OUT32) *(f32x2*)(OUT32 + off) = o;
    else { const unsigned ow = pk2(o.x, o.y); *(unsigned*)(XBio + off) = ow; o = (f32x2){bflo(ow), bfhi(ow)}; }
    const float q2 = wsum(o.x * o.x + o.y * o.y);
    if (lane == 0) SS16[(size_t)t * 16 + s] = q2;
}
constexpr int PLV_ACT = TBLK * 128 * 4;
struct VStage { u32x4 id[8]; u32x4 a[4]; };
__device__ __forceinline__ void v_stage_load(VStage& r, int tb, const _Float16* __restrict__ ACT, const int* __restrict__ IDX, int tid) {
    const u32x4* src = (const u32x4*)(IDX + (size_t)tb * TBLK * 128);
    const u32x4* srca = (const u32x4*)(ACT + (size_t)tb * TBLK * 128);
#pragma unroll
    for (int j = 0; j < 8; ++j) r.id[j] = src[tid + j * NTHR];
#pragma unroll
    for (int j = 0; j < 4; ++j) r.a[j] = srca[tid + j * NTHR];
}
__device__ __forceinline__ void v_stage_store(const VStage& r, LAS unsigned char* lds, int tid) {
#pragma unroll
    for (int j = 0; j < 8; ++j) *(LAS u32x4*)(lds + PL_IDX + (size_t)(tid + j * NTHR) * 16) = r.id[j];
#pragma unroll
    for (int j = 0; j < 4; ++j) *(LAS u32x4*)(lds + PLV_ACT + (size_t)(tid + j * NTHR) * 16) = r.a[j];
}
__device__ __forceinline__ void peer_v_run(int s, int tb, const unsigned char* __restrict__ V8, bf16_t* __restrict__ XBio, float* __restrict__ OUT32, float* __restrict__ SS16,
                                           LAS unsigned char* lds, int wave, int lane) {
    const int g = lane >> 3, c = lane & 7;
    const rsrc_t rs = make_rsrc(V8, (unsigned)((size_t)NE * D));
    const int soff = s * NE * SLW;
    constexpr int NTW = TBLK / NWAVES;
    const int tw = wave * NTW, t0 = tb * TBLK + tw;
    const LAS unsigned char* idb = lds + PL_IDX + (size_t)tw * 512 + g * 64;
    const LAS _Float16* avb = (const LAS _Float16*)(lds + PLV_ACT + (size_t)tw * 256) + g * 16;
    u32x4 wa[16], wb[16];
    PEER_ISSUE(wa, idb);
#pragma unroll 1
    for (int i = 0; i < NTW; i += 2) {
        PEER_ISSUE(wb, idb + (i + 1) * 512);
        v_compute(wa, avb + i * 128, XBio, OUT32, SS16, s, t0 + i, g, c, lane);
        PEER_ISSUE(wa, idb + min(i + 2, NTW - 1) * 512);
        v_compute(wb, avb + (i + 1) * 128, XBio, OUT32, SS16, s, t0 + i + 1, g, c, lane);
    }
}
__device__ __forceinline__ void peer_v_block(int s, int tb, const _Float16* __restrict__ ACT, const int* __restrict__ IDX, const unsigned char* __restrict__ V8,
                                             bf16_t* __restrict__ XBio, float* __restrict__ OUT32, float* __restrict__ SS16,
                                             LAS unsigned char* lds, int tid, int wave, int lane) {
    VStage r; v_stage_load(r, tb, ACT, IDX, tid); v_stage_store(r, lds, tid);
    __syncthreads();
    peer_v_run(s, tb, V8, XBio, OUT32, SS16, lds, wave, lane);
}

__device__ __forceinline__ int slice_of(int xcc, int j) { const int xx = (xcc + (j >> 1)) & 7; return xx + 8 * (j & 1); }

__device__ __forceinline__ void final_norm_row(float* __restrict__ orow, const float* __restrict__ ss16, const float* __restrict__ g, int lane) {
    float sp = (lane < 16) ? ss16[lane] : 0.f;
    sp = wsum(sp);
    const float rf = rsqrtf(sp * (1.f / D) + EPS);
    f32x4* o = (f32x4*)orow + lane;
    const f32x4* g4 = (const f32x4*)g + lane;
#pragma unroll
    for (int j = 0; j < 8; ++j) { f32x4 v = o[64 * j]; const f32x4 gg = g4[64 * j]; v = v * rf * gg; o[64 * j] = v; }
}
}

namespace mk {
#define IN(k) (lo <= (k) && (k) < hi)
#define GSYNC() do { if (coop) xcd_barrier(xb); } while (0)
template <int l>
__device__ __forceinline__ void layer_body(const Params& p, LAS unsigned char* lds, unsigned char* ws, int G, int tid, int lane, int wave, int lo, int hi, bool coop, const XcdBarrier& xb) {

    if (IN(1)) _Pragma("unroll") for (int rep = 0; rep < REP1; ++rep) {
        pg8::Gemm g{(const bf16_t*)(ws + WS_XB), (const bf16_t*)(ws + WS_WINT) + (size_t)l * NP * D, T, NP, D};
        pg8::StaticOrder So; So.init(T, NP, G, (int)blockIdx.x);
        EpiScaleBf16<16> E{(bf16_t*)(ws + WS_P), NP, (const float*)(ws + WS_SS)};
        pg8::gemm_phase<EpiScaleBf16<16>, pg8::StaticOrder, true, true>(lds, g, So, E);
        GSYNC();
    }
    if (IN(2)) _Pragma("unroll") for (int rep = 0; rep < REP2; ++rep) {
        for (int u = blockIdx.x; u < 256; u += G) {
            int tq_ = tid; asm volatile("" : "+v"(tq_)); const int tid = tq_, lane = tq_ & 63, wave = __builtin_amdgcn_readfirstlane(tq_ >> 6);
            if (u < 128) hgrn_unit<1>((const bf16_t*)(ws + WS_P), p.in[5], l, nullptr, (float*)(ws + WS_STH), nullptr, u, lds, tid, lane, wave);
            else mlstm_unit<1>((const bf16_t*)(ws + WS_P), p.in[7] + (size_t)l * 4 * 1024, p.in[8] + l * 4, p.in[9] + l * 4, (float*)(ws + WS_STM), nullptr, u - 128, lds, tid, lane, wave);
            __syncthreads();
        }
        GSYNC();
    }
    if (IN(3)) {

        _Pragma("unroll") for (int rr = 0; rr < (REP7 > 1 ? 2 : 1); ++rr)
        for (int u = blockIdx.x; u < 256; u += G) {
            if (rr == 1 && REP7 == 2 && u >= 128) continue;
            if (rr == 1 && REP7 == 3 && u < 128) continue;
            int tq_ = tid; asm volatile("" : "+v"(tq_)); const int tid = tq_, lane = tq_ & 63, wave = __builtin_amdgcn_readfirstlane(tq_ >> 6);
            if (u < 128) hgrn_unit<2>((const bf16_t*)(ws + WS_P), p.in[5], l, p.in[6] + l * 512, (float*)(ws + WS_STH), (bf16_t*)(ws + WS_YB), u, lds, tid, lane, wave);
            else mlstm_unit<2>((const bf16_t*)(ws + WS_P), p.in[7] + (size_t)l * 4 * 1024, p.in[8] + l * 4, p.in[9] + l * 4, (float*)(ws + WS_STM), (bf16_t*)(ws + WS_YB), u - 128, lds, tid, lane, wave);
            __syncthreads();
        }
        _Pragma("unroll") for (int rep = 0; rep < REP3; ++rep)
        for (int u = blockIdx.x; u < 256; u += G) {
            int tq_ = tid; asm volatile("" : "+v"(tq_)); const int tid = tq_, lane = tq_ & 63, wave = __builtin_amdgcn_readfirstlane(tq_ >> 6);
            attn_unit((const bf16_t*)(ws + WS_P), (const f32x2*)(ws + WS_ROPE), p.in[4] + l * 16, (bf16_t*)(ws + WS_YB), u, lds, tid, lane, wave);
            __syncthreads();
        }
        GSYNC();
    }
    if (IN(4)) _Pragma("unroll") for (int rep = 0; rep < REP4; ++rep) {
        pg8::Gemm g{(const bf16_t*)(ws + WS_YB), (const bf16_t*)(ws + WS_WOUTT) + (size_t)l * D * D, T, D, D};
        pg8::StaticOrder So; So.init(T, D, G, (int)blockIdx.x);
        EpiX1 E{l == 0 ? p.in[0] : (const float*)nullptr, (bf16_t*)(ws + WS_XB), (float*)(ws + WS_SSP)};
        pg8::gemm_phase<EpiX1, pg8::StaticOrder, true, true>(lds, g, So, E);
        GSYNC();
    }
    if (IN(5)) _Pragma("unroll") for (int rep = 0; rep < REP5; ++rep) {
        pg8::Gemm g{(const bf16_t*)(ws + WS_XB), (const bf16_t*)(ws + WS_WQT) + (size_t)l * D * D, T, D, D};
        pg8::StaticOrder So; So.init(T, D, G, (int)blockIdx.x);
        EpiScaleBf16<32> E{(bf16_t*)(ws + WS_Q), D, (const float*)(ws + WS_SSP)};
        pg8::gemm_phase<EpiScaleBf16<32>, pg8::StaticOrder, true, true>(lds, g, So, E);
        pg8::Unit u;
        for (int i = 0; So.next(i, u); ++i)
            route_unit((const bf16_t*)(ws + WS_Q), (const bf16_t*)(ws + WS_SUBK) + (size_t)l * 2 * 8 * 128 * 128, u.pm, u.pn, (int*)(ws + WS_IDX), (int*)(ws + WS_IDXU), (float*)(ws + WS_GATE), lds, tid, wave, lane);
        GSYNC();
    }
    if (IN(6)) {

        LAS int* slot = (LAS int*)(lds + LDS_BYTES - 32);
        if (G == 256) {
            const int grp = (int)blockIdx.x & 7, rank = (int)blockIdx.x >> 3;
            UStage st; u_stage_load(st, grp, rank * 4, (const bf16_t*)(ws + WS_XB), (const int*)(ws + WS_IDX), tid);
            for (int j = 0; j < 8; ++j) {
                const int s = grp + 8 * (j >> 2), tb = rank * 4 + (j & 3);
                __syncthreads();
                u_stage_store(st, lds, tid);
                __syncthreads();
                if (j < 7) u_stage_load(st, grp + 8 * ((j + 1) >> 2), rank * 4 + ((j + 1) & 3), (const bf16_t*)(ws + WS_XB), (const int*)(ws + WS_IDX), tid);
                peer_u_run<0>(s, tb, ws + WS_U8 + (size_t)l * NE * D, (float*)(ws + WS_PART), lds, wave, lane);
            }
        } else {
            const int xcc = (int)xb_xcc_id();
            unsigned* qc = (unsigned*)(ws + WS_CTL) + CTL_Q + ((l * 2 + 0) * 2 + 0) * 16;
            for (int j = 0; j < NSLICE; ++j) {
                const int s = slice_of(xcc, j);
                for (;;) {
                    const int tb = q_next(qc + s, slot, tid);
                    if (tb < 0) break;
                    peer_u_block<0>(s, tb, (const bf16_t*)(ws + WS_XB), (const int*)(ws + WS_IDX), ws + WS_U8 + (size_t)l * NE * D, (float*)(ws + WS_PART), lds, tid, wave, lane);
                }
            }
        }
        GSYNC();
    }
    if (IN(7)) {

        const int gw = blockIdx.x * NWAVES + wave, ngw = G * NWAVES;
        for (int t = gw; t < T; t += ngw)
            peer_act_token(t, (const float*)(ws + WS_PART), (const float*)(ws + WS_SSP), (const int*)(ws + WS_IDX), (const float*)(ws + WS_GATE),
                           (const float*)(ws + WS_USC) + l * NE, (const float*)(ws + WS_VSC) + l * NE, (_Float16*)(ws + WS_ACT), lane);
        GSYNC();
    }
    if (IN(8)) {

        LAS int* slot = (LAS int*)(lds + LDS_BYTES - 32);
        if (G == 256) {
            const int grp = (int)blockIdx.x & 7, rank = (int)blockIdx.x >> 3;
            VStage st; v_stage_load(st, rank * 4, (const _Float16*)(ws + WS_ACT), (const int*)(ws + WS_IDX), tid);
            for (int j = 0; j < 8; ++j) {
                const int s = grp + 8 * (j >> 2), tb = rank * 4 + (j & 3);
                __syncthreads();
                v_stage_store(st, lds, tid);
                __syncthreads();
                if (j < 7) v_stage_load(st, rank * 4 + ((j + 1) & 3), (const _Float16*)(ws + WS_ACT), (const int*)(ws + WS_IDX), tid);
                peer_v_run(s, tb, ws + WS_V8 + (size_t)l * NE * D, (bf16_t*)(ws + WS_XB), l == 0 ? (float*)nullptr : p.out, (float*)(ws + WS_SS), lds, wave, lane);
            }
        } else {
            const int xcc = (int)xb_xcc_id();
            unsigned* qc = (unsigned*)(ws + WS_CTL) + CTL_Q + ((l * 2 + 1) * 2 + 0) * 16;
            for (int j = 0; j < NSLICE; ++j) {
                const int s = slice_of(xcc, j);
                for (;;) {
                    const int tb = q_next(qc + s, slot, tid);
                    if (tb < 0) break;
                    peer_v_block(s, tb, (const _Float16*)(ws + WS_ACT), (const int*)(ws + WS_IDX), ws + WS_V8 + (size_t)l * NE * D, (bf16_t*)(ws + WS_XB),
                                 l == 0 ? (float*)nullptr : p.out, (float*)(ws + WS_SS), lds, tid, wave, lane);
                }
            }
        }
    }
    if (l == 1 && IN(9)) {
        GSYNC();
        const int gw = blockIdx.x * NWAVES + wave, ngw = G * NWAVES;
        for (int t = gw; t < T; t += ngw) final_norm_row(p.out + (size_t)t * D, (const float*)(ws + WS_SS) + (size_t)t * 16, p.in[15], lane);
    }
}
__global__ void __launch_bounds__(NTHR, 2) mega(Params p) {
    extern __shared__ __attribute__((aligned(16))) unsigned char lds_raw[];
    LAS unsigned char* lds = (LAS unsigned char*)lds_raw;
    unsigned char* ws = p.ws;
    const int G = gridDim.x;
    const int tid = threadIdx.x, lane = tid & 63, wave = __builtin_amdgcn_readfirstlane(tid >> 6);
    const int lo = p.ph_lo, hi = p.ph_hi;
    const bool coop = p.pad != 0;
    volatile LAS unsigned* xst = (volatile LAS unsigned*)(lds + LDS_BYTES - 16);
    if (tid < 4) xst[tid] = 0u;
    __syncthreads();
    XcdBarrier xb; xb.bar = (unsigned*)(ws + WS_CTL); xb.x = 0; xb.st = xst;
    if (coop) xb = xcd_barrier_post((unsigned*)(ws + WS_CTL), xst);
    if (IN(0)) { for (int rep = 0; rep < REP0; ++rep) { if (rep) { if (coop) xcd_barrier(xb); } p0_prologue(p, lds); } if (coop) cooperative_groups::this_grid().sync(); }
    if (p.layer <= 0 && 0 < p.layer_hi) { layer_body<0>(p, lds, ws, G, tid, lane, wave, lo, hi, coop, xb); if (1 < p.layer_hi) GSYNC(); }
    if (p.layer <= 1 && 1 < p.layer_hi) layer_body<1>(p, lds, ws, G, tid, lane, wave, lo, hi, coop, xb);

#undef IN
#undef GSYNC
}
__global__ __launch_bounds__(256) void shim_xprep_kernel(const float* __restrict__ X, bf16_t* __restrict__ XB, float* __restrict__ SS) {
    const int t = blockIdx.x * 4 + (threadIdx.x >> 6), lane = threadIdx.x & 63;
    xprep_row(X + (size_t)t * D, XB + (size_t)t * D, SS + t, lane);
}
}

extern "C" void kernel_launch(void* const* d_in, const int* in_sizes, int n_in, void* d_out, int out_size, void* d_ws, size_t ws_size, hipStream_t stream) {
    using namespace mk;
    static int grid = 0;
    if (grid == 0) {
        int dev = 0, cus = 0, per_cu = 0;
        (void)hipGetDevice(&dev); (void)hipDeviceGetAttribute(&cus, hipDeviceAttributeMultiprocessorCount, dev);
        if (hipFuncSetAttribute((const void*)mega, hipFuncAttributeMaxDynamicSharedMemorySize, LDS_BYTES) != hipSuccess) { fprintf(stderr, "kernel_launch: hipFuncSetAttribute failed\n"); grid = -1; return; }
        if (ws_size < WS_END) { fprintf(stderr, "kernel_launch: workspace too small: need %zu have %zu\n", (size_t)WS_END, ws_size); grid = -1; return; }
        if (hipOccupancyMaxActiveBlocksPerMultiprocessor(&per_cu, (const void*)mega, NTHR, LDS_BYTES) != hipSuccess || per_cu < 1) { fprintf(stderr, "kernel_launch: occupancy query says %d blocks per CU\n", per_cu); grid = -1; return; }
        grid = cus;
    }
    if (grid < 0) return;
    Params p{};
    for (int i = 0; i < 16; ++i) p.in[i] = (const float*)d_in[i];
    p.out = (float*)d_out; p.ws = (unsigned char*)d_ws;
    p.ph_lo = 0; p.ph_hi = 10; p.layer = 0; p.layer_hi = 2; p.pad = 1; p.pad2 = 0;
    if (hipMemsetAsync(d_ws, 0, 16384, stream) != hipSuccess) { fprintf(stderr, "kernel_launch: memset failed\n"); return; }
    void* args[] = {&p};
    hipError_t e = hipLaunchCooperativeKernel((const void*)mega, dim3(grid), dim3(NTHR), args, LDS_BYTES, stream);
    if (e != hipSuccess) fprintf(stderr, "kernel_launch: cooperative launch failed: %s (grid %d)\n", hipGetErrorString(e), grid);
}
```

```cpp
#include <hip/hip_runtime.h>
#include <hip/hip_cooperative_groups.h>
#include <math.h>
#include <stdio.h>
#include <stdint.h>
namespace pg8 {
#define PG8_LAS __attribute__((address_space(3)))
typedef unsigned short bf16_t;
typedef short bf16x8 __attribute__((ext_vector_type(8)));
typedef float f32x4 __attribute__((ext_vector_type(4)));
typedef unsigned u32x4 __attribute__((ext_vector_type(4)));
constexpr int BM = 256, BK = 64, HALF = 128, HTB = HALF * BK * 2  , STAGE_BYTES = 8 * HTB, NXCD = 8, WGM = 8;

__host__ __device__ __forceinline__ int lds_byte(int r, int c) { const int st = (r >> 4) * 2 + (c >> 5), rr = r & 15, cc = c & 31, ob = rr * 64 + cc * 2; return st * 1024 + (ob ^ (((ob >> 9) & 1) << 5)); }
__host__ __device__ __forceinline__ void stage_rc(int b, int& R, int& C) { const int st = b / 1024, sb = b % 1024, swz = sb ^ (((sb >> 9) & 1) << 5); R = (st >> 1) * 16 + swz / 64; C = (st & 1) * 32 + (swz % 64) / 2; }
__host__ __device__ __forceinline__ int perm32(int rho) { const int n = rho >> 4, i = rho & 15; return 8 * (i >> 2) + 4 * n + (i & 3); }

struct Unit { int pm, pn; };
struct Gemm { const bf16_t* A; const bf16_t* Bt; int M, N, K; };

struct StaticOrder {
    int nM, nN, nwg, G, c;
    __host__ __device__ void init(int M, int N, int G_, int c_) { nM = M / BM; nN = N / BM; nwg = nM * nN; G = G_; c = c_; }
    __host__ __device__ bool next(int i, Unit& u) const {
        const long L = (long)i * G + c; if (L >= nwg) return false;
        int wgid = (int)L; { const int q = nwg / NXCD, r = nwg % NXCD, xcd = wgid % NXCD, off = wgid / NXCD; wgid = (xcd < r ? xcd * (q + 1) : r * (q + 1) + (xcd - r) * q) + off; }
        const int nig = WGM * nN, gid = wgid / nig, fm = gid * WGM, gsz = (nM - fm) < WGM ? (nM - fm) : WGM;
        u.pm = fm + ((wgid % nig) % gsz); u.pn = (wgid % nig) / gsz; return true;
    }
    __device__ __forceinline__ void a_ready(const Unit&) const {}
    __device__ __forceinline__ void done(const Unit&) const {}
};

template <class Epi, class Sched, bool ALIGN_EPI = false, bool SP2 = false>
__device__ __forceinline__ void gemm_phase(PG8_LAS unsigned char* lds, const Gemm g, const Sched& S, const Epi& E) {
    const int tid = threadIdx.x, wid = __builtin_amdgcn_readfirstlane(tid >> 6), lane = tid & 63, wr = wid >> 2, wc = wid & 3, fr = lane & 15, fq = lane >> 4;
    const int K = g.K, nt = K / BK;
    unsigned voffA[2], voffB[2];
#pragma unroll
    for (int i = 0; i < 2; ++i) { int R, C; stage_rc(tid * 16 + i * 8192, R, C); const int Rb = Epi::PERM ? ((R & ~31) + perm32(R & 31)) : R;
        voffA[i] = (unsigned)(R * K + C) * 2u; voffB[i] = (unsigned)(Rb * K + C) * 2u; }
    const size_t kstep = (size_t)(BK * 2);
    const size_t hstep = (size_t)HALF * K * 2;
    const size_t tstep = 2 * hstep;
    const unsigned ldsw = (unsigned)wid * 1024u;
    const int aoff = lds_byte(wr * 64 + fr, fq * 8), boff = lds_byte(wc * 32 + fr, fq * 8);
#define PG8_SA(b, h) (((b) * 2 + (h)) * HTB)
#define PG8_SB(b, h) ((4 + (b) * 2 + (h)) * HTB)
#define PG8_STAGE(bufoff, gbase, voff) do { _Pragma("unroll") for (int _i = 0; _i < 2; ++_i) \
        __builtin_amdgcn_global_load_lds((const unsigned*)((const char*)(gbase) + (voff)[_i]), (PG8_LAS unsigned*)(lds + (bufoff) + ldsw + _i * 8192), 16, 0, 0); } while (0)
#define PG8_LDA(dst, b, h) do { _Pragma("unroll") for (int m = 0; m < 4; ++m) _Pragma("unroll") for (int k = 0; k < 2; ++k) dst[m][k] = *(const PG8_LAS bf16x8*)(lds + PG8_SA(b, h) + aoff + m * 2048 + k * 1024); } while (0)
#define PG8_LDB(dst, b, h) do { _Pragma("unroll") for (int n = 0; n < 2; ++n) _Pragma("unroll") for (int k = 0; k < 2; ++k) dst[n][k] = *(const PG8_LAS bf16x8*)(lds + PG8_SB(b, h) + boff + n * 2048 + k * 1024); } while (0)
#define PG8_MMA(ai, bj, At, Bt) do { __builtin_amdgcn_s_setprio(1); _Pragma("unroll") for (int m = 0; m < 4; ++m) _Pragma("unroll") for (int n = 0; n < 2; ++n) _Pragma("unroll") for (int k = 0; k < 2; ++k) \
        acc[ai][bj][m][n] = __builtin_amdgcn_mfma_f32_16x16x32_bf16(Bt[n][k], At[m][k], acc[ai][bj][m][n], 0, 0, 0); __builtin_amdgcn_s_setprio(0); } while (0)
#define PG8_WAIT_V(n) asm volatile("s_waitcnt vmcnt(" #n ")" ::: "memory")
#define PG8_WAIT_L(n) asm volatile("s_waitcnt lgkmcnt(" #n ")" ::: "memory")
#define PG8_BAR __builtin_amdgcn_s_barrier()
#define PG8_SCHED __builtin_amdgcn_sched_barrier(0)
    Unit cur, nxt; int ui = 0;
    if (!S.next(0, cur)) return;
    f32x4 acc[2][2][4][2];
#pragma unroll
    for (int a = 0; a < 2; ++a)
#pragma unroll
        for (int b = 0; b < 2; ++b)
#pragma unroll
            for (int m = 0; m < 4; ++m)
#pragma unroll
                for (int n = 0; n < 2; ++n) acc[a][b][m][n] = (f32x4){0.f, 0.f, 0.f, 0.f};
    bf16x8 At[4][2], B0[2][2], B1[2][2];
    const char* cA = (const char*)g.A + (size_t)cur.pm * tstep; const char* cB = (const char*)g.Bt + (size_t)cur.pn * tstep;
    S.a_ready(cur);
    if constexpr (SP2) {
        PG8_STAGE(PG8_SB(0, 0), cB, voffB); PG8_STAGE(PG8_SB(0, 1), cB + hstep, voffB); PG8_STAGE(PG8_SA(0, 0), cA, voffA); PG8_STAGE(PG8_SA(0, 1), cA + hstep, voffA);
        if (wr == 1) PG8_BAR;
        PG8_WAIT_V(2); PG8_BAR;
        PG8_STAGE(PG8_SB(1, 0), cB + kstep, voffB); PG8_STAGE(PG8_SA(1, 0), cA + kstep, voffA); PG8_STAGE(PG8_SB(1, 1), cB + hstep + kstep, voffB);
        PG8_WAIT_V(6); PG8_BAR;
    } else {
        PG8_STAGE(PG8_SB(0, 0), cB, voffB); PG8_STAGE(PG8_SA(0, 0), cA, voffA); PG8_STAGE(PG8_SB(0, 1), cB + hstep, voffB); PG8_STAGE(PG8_SA(0, 1), cA + hstep, voffA);
        if (wr == 1) PG8_BAR;
        PG8_WAIT_V(4); PG8_BAR;
        PG8_STAGE(PG8_SB(1, 0), cB + kstep, voffB); PG8_STAGE(PG8_SA(1, 0), cA + kstep, voffA); PG8_STAGE(PG8_SB(1, 1), cB + hstep + kstep, voffB);
        PG8_WAIT_V(6); PG8_BAR;
    }
    for (;;) {
        const bool has_next = S.next(ui + 1, nxt);
        const char* nA = has_next ? (const char*)g.A + (size_t)nxt.pm * tstep : cA; const char* nB = has_next ? (const char*)g.Bt + (size_t)nxt.pn * tstep : cB;
        for (int t = 0; t < nt; t += 2) {
            const bool last = (t == nt - 2);
            const char* a1 = cA + (size_t)(t + 1) * kstep;
            const char* a2 = last ? nA : cA + (size_t)(t + 2) * kstep; const char* b2 = last ? nB : cB + (size_t)(t + 2) * kstep;
            const char* a3 = a2 + kstep; const char* b3 = b2 + kstep;
            if (last && has_next) S.a_ready(nxt);
            if constexpr (SP2) {
            PG8_LDB(B0, 0, 0); PG8_LDB(B1, 0, 1); PG8_SCHED; PG8_LDA(At, 0, 0); PG8_STAGE(PG8_SA(1, 1), a1 + hstep, voffA);
            PG8_WAIT_V(8); PG8_WAIT_L(0); PG8_BAR; PG8_MMA(0, 0, At, B0); PG8_MMA(0, 1, At, B1); PG8_BAR; PG8_SCHED;
            PG8_LDA(At, 0, 1); PG8_STAGE(PG8_SB(0, 0), b2, voffB); PG8_STAGE(PG8_SB(0, 1), b2 + hstep, voffB); PG8_STAGE(PG8_SA(0, 0), a2, voffA);
            PG8_WAIT_V(8); PG8_WAIT_L(0); PG8_BAR; PG8_MMA(1, 0, At, B0); PG8_MMA(1, 1, At, B1); PG8_BAR; PG8_SCHED;
            PG8_LDB(B0, 1, 0); PG8_LDB(B1, 1, 1); PG8_SCHED; PG8_LDA(At, 1, 0); PG8_STAGE(PG8_SA(0, 1), a2 + hstep, voffA);
            PG8_WAIT_V(8); PG8_WAIT_L(0); PG8_BAR; PG8_MMA(0, 0, At, B0); PG8_MMA(0, 1, At, B1); PG8_BAR; PG8_SCHED;
            PG8_LDA(At, 1, 1); PG8_STAGE(PG8_SB(1, 0), b3, voffB); PG8_STAGE(PG8_SB(1, 1), b3 + hstep, voffB); PG8_STAGE(PG8_SA(1, 0), a3, voffA);
            PG8_WAIT_V(8); PG8_WAIT_L(0); PG8_BAR; PG8_MMA(1, 0, At, B0); PG8_MMA(1, 1, At, B1); PG8_BAR; PG8_SCHED;
            } else {
            PG8_LDB(B0, 0, 0); PG8_SCHED; PG8_LDA(At, 0, 0); PG8_STAGE(PG8_SA(1, 1), a1 + hstep, voffA);
            PG8_WAIT_L(8); PG8_BAR; PG8_WAIT_L(0); PG8_MMA(0, 0, At, B0); PG8_BAR; PG8_SCHED;
            PG8_LDB(B1, 0, 1); PG8_STAGE(PG8_SB(0, 0), b2, voffB);
            PG8_BAR; PG8_WAIT_L(0); PG8_MMA(0, 1, At, B1); PG8_BAR;
            PG8_LDA(At, 0, 1); PG8_STAGE(PG8_SA(0, 0), a2, voffA);
            PG8_BAR; PG8_WAIT_L(0); PG8_MMA(1, 0, At, B0); PG8_BAR; PG8_SCHED;
            PG8_STAGE(PG8_SB(0, 1), b2 + hstep, voffB);
            PG8_WAIT_V(6); PG8_BAR; PG8_MMA(1, 1, At, B1); PG8_BAR;
            PG8_LDB(B0, 1, 0); PG8_SCHED; PG8_LDA(At, 1, 0); PG8_STAGE(PG8_SA(0, 1), a2 + hstep, voffA);
            PG8_WAIT_L(8); PG8_BAR; PG8_WAIT_L(0); PG8_MMA(0, 0, At, B0); PG8_BAR; PG8_SCHED;
            PG8_LDB(B1, 1, 1); PG8_STAGE(PG8_SB(1, 0), b3, voffB);
            PG8_BAR; PG8_WAIT_L(0); PG8_MMA(0, 1, At, B1); PG8_BAR;
            PG8_LDA(At, 1, 1); PG8_STAGE(PG8_SA(1, 0), a3, voffA);
            PG8_BAR; PG8_WAIT_L(0); PG8_MMA(1, 0, At, B0); PG8_BAR; PG8_SCHED;
            PG8_STAGE(PG8_SB(1, 1), b3 + hstep, voffB);
            PG8_WAIT_V(6); PG8_BAR; PG8_MMA(1, 1, At, B1); PG8_BAR;
            }
        }
        if constexpr (ALIGN_EPI) { if (wr == 0) PG8_BAR; }
        if constexpr (!Epi::AFTER_DRAIN) { E(acc, cur, wr, wc, fr, fq); S.done(cur); }
        if (!has_next) break;
#pragma unroll
        for (int a = 0; a < 2; ++a)
#pragma unroll
            for (int b = 0; b < 2; ++b)
#pragma unroll
                for (int m = 0; m < 4; ++m)
#pragma unroll
                    for (int n = 0; n < 2; ++n) acc[a][b][m][n] = (f32x4){0.f, 0.f, 0.f, 0.f};
        cur = nxt; cA = nA; cB = nB; ++ui;
        if constexpr (ALIGN_EPI) { if (wr == 1) PG8_BAR; }
    }
    PG8_WAIT_V(0);
    if constexpr (!ALIGN_EPI) { if (wr == 0) PG8_BAR; }
    PG8_BAR;
    if constexpr (Epi::AFTER_DRAIN) { E.fused(acc, cur, wr, wc, fr, fq, lds, wid, lane); S.done(cur); }
#undef PG8_SA
#undef PG8_SB
#undef PG8_STAGE
#undef PG8_LDA
#undef PG8_LDB
#undef PG8_MMA
#undef PG8_WAIT_V
#undef PG8_WAIT_L
#undef PG8_BAR
#undef PG8_SCHED
}
}
namespace mk {
#define LAS __attribute__((address_space(3)))
typedef unsigned short bf16_t;
typedef float f32x4 __attribute__((ext_vector_type(4)));
typedef float f32x2 __attribute__((ext_vector_type(2)));
typedef unsigned u32x4 __attribute__((ext_vector_type(4)));
typedef unsigned u32x2 __attribute__((ext_vector_type(2)));
typedef __bf16 bf16x2_t __attribute__((ext_vector_type(2)));
typedef short bf16x8 __attribute__((ext_vector_type(8)));
typedef short s16x4 __attribute__((ext_vector_type(4)));
constexpr int D = 2048, NB = 4, S = 4096, T = NB * S, IN_LD = 5384, NP = 5632, NE = 16384;
constexpr int NTHR = 512, NWAVES = 8;
constexpr int LDS_BYTES = 160 * 1024;
constexpr int LDS_SPARE = 128 * 1024;
constexpr float EPS = 1e-6f;
#ifndef REPS
#define REPS 1,1,1,1,1,1,1,1
#endif
constexpr int REPV[8] = {REPS};
constexpr int REP7 = REPV[7];
constexpr int REP0 = REPV[0], REP1 = REPV[1], REP2 = REPV[2], REP3 = REPV[3], REP4 = REPV[4], REP5 = REPV[5], REP6 = REPV[6];
constexpr int C_QA = 0, C_KA = 1024, C_VA = 1152, C_QH = 1280, C_FH = 1792, C_IH = 2304, C_GH = 2816, C_QM = 3328, C_KM = 3840, C_VM = 4352, C_OM = 4864, C_IM = 5376, C_FM = 5380;

constexpr size_t WS_CTL = 0;
constexpr size_t WS_WINT = 65536;
constexpr size_t WS_WOUTT = WS_WINT + 2 * (size_t)NP * D * 2;
constexpr size_t WS_WQT = WS_WOUTT + 2 * (size_t)D * D * 2;
constexpr size_t WS_SUBK = WS_WQT + 2 * (size_t)D * D * 2;
constexpr size_t WS_U8 = WS_SUBK + 2 * 2 * 8 * 128 * 128 * 2;
constexpr size_t WS_V8 = WS_U8 + 2 * (size_t)NE * D;
constexpr size_t WS_USC = WS_V8 + 2 * (size_t)NE * D;
constexpr size_t WS_VSC = WS_USC + 2 * (size_t)NE * 4;
constexpr size_t WS_ROPE = WS_VSC + 2 * (size_t)NE * 4;
constexpr size_t WS_SS = WS_ROPE + (size_t)S * 32 * 8;
constexpr size_t WS_SSP = WS_SS + (size_t)T * 16 * 4;
constexpr size_t WS_XB = WS_SSP + (size_t)T * 32 * 4;
constexpr size_t WS_P = WS_XB + (size_t)T * D * 2;
constexpr size_t WS_YB = WS_P + (size_t)T * NP * 2;
constexpr size_t WS_Q = WS_YB + (size_t)T * D * 2;
constexpr size_t WS_IDX = WS_Q + (size_t)T * D * 2;
constexpr size_t WS_GATE = WS_IDX + (size_t)T * 128 * 4;
constexpr size_t WS_X1 = WS_GATE + (size_t)T * 128 * 4;
constexpr size_t WS_X2 = WS_X1 + (size_t)T * D * 4;
constexpr size_t WS_IDXU = WS_X2 + (size_t)T * D * 4;
constexpr size_t WS_STH = WS_IDXU + (size_t)T * 128 * 4;
constexpr size_t WS_STM = WS_STH + (size_t)128 * 16640 * 4;
constexpr size_t WS_END = WS_STM + (size_t)128 * 16640 * 4;
constexpr size_t WS_PART = WS_P;
constexpr size_t WS_ACT = WS_Q;
static_assert((size_t)16 * T * 128 * 4 <= (size_t)T * NP * 2, "PART overlay");
static_assert(WS_END <= ((size_t)1 << 30), "workspace");
struct Params { const float* in[16]; float* out; unsigned char* ws; int ph_lo, ph_hi, layer, layer_hi, pad, pad2; };

__device__ __forceinline__ unsigned pk2(float lo, float hi) { f32x2 v = {lo, hi}; bf16x2_t b = __builtin_convertvector(v, bf16x2_t); return __builtin_bit_cast(unsigned, b); }
__device__ __forceinline__ float bf2f(unsigned short h) { return __uint_as_float((unsigned)h << 16); }
__device__ __forceinline__ float bflo(unsigned w) { return __uint_as_float(w << 16); }
__device__ __forceinline__ float bfhi(unsigned w) { return __uint_as_float(w & 0xffff0000u); }
__device__ __forceinline__ float wsum(float v) {
#pragma unroll
    for (int o = 1; o < 64; o <<= 1) v += __shfl_xor(v, o);
    return v;
}
template <int CTRL> __device__ __forceinline__ float dppf(float x) { return __builtin_bit_cast(float, __builtin_amdgcn_mov_dpp(__builtin_bit_cast(int, x), CTRL, 0xf, 0xf, true)); }
constexpr int DPP_XOR1 = 0xB1, DPP_XOR2 = 0x4E, DPP_HMIR = 0x141, DPP_ROR8 = 0x128;
__device__ __forceinline__ float sum8(float v) { v += dppf<DPP_XOR1>(v); v += dppf<DPP_XOR2>(v); v += dppf<DPP_HMIR>(v); return v; }
__device__ __forceinline__ float sum16(float v) { v = sum8(v); v += dppf<DPP_ROR8>(v); return v; }
__device__ __forceinline__ float wmax(float v) {
#pragma unroll
    for (int o = 1; o < 64; o <<= 1) v = fmaxf(v, __shfl_xor(v, o));
    return v;
}

__device__ __forceinline__ void transpose_item(const float* __restrict__ W, int ldw, int nvalid, const float* __restrict__ gain, bf16_t* __restrict__ WT, int K, int k0, int n0, LAS float* scr, int lane) {
    const int n = n0 + (lane & 31);
    float vv[32];
#pragma unroll
    for (int i = 0; i < 32; ++i) {
        const int kk = 2 * i + (lane >> 5);
        float v = 0.f;
        if (n < nvalid) v = W[(size_t)(k0 + kk) * ldw + n];
        vv[i] = v;
    }
#pragma unroll
    for (int i = 0; i < 32; ++i) {
        const int kk = 2 * i + (lane >> 5);
        float v = vv[i];
        if (gain) v *= gain[k0 + kk];
        scr[kk * 33 + (lane & 31)] = v;
    }
    __builtin_amdgcn_s_waitcnt(0xc07f);
    asm volatile("" ::: "memory");
    const int c = lane & 7;
#pragma unroll
    for (int j = 0; j < 4; ++j) {
        const int nn = (lane >> 3) + 8 * j;
        const LAS float* s = scr + (8 * c) * 33 + nn;
        u32x4 o; o.x = pk2(s[0 * 33], s[1 * 33]); o.y = pk2(s[2 * 33], s[3 * 33]); o.z = pk2(s[4 * 33], s[5 * 33]); o.w = pk2(s[6 * 33], s[7 * 33]);
        *(u32x4*)(WT + (size_t)(n0 + nn) * K + k0 + 8 * c) = o;
    }
    __builtin_amdgcn_s_waitcnt(0xc07f);
    asm volatile("" ::: "memory");
}
__device__ __forceinline__ void xprep_row(const float* __restrict__ xrow, bf16_t* __restrict__ orow, float* __restrict__ ss, int lane) {
    const f32x4* xr = (const f32x4*)xrow + lane;
    f32x4 v[8]; float s = 0.f;
#pragma unroll
    for (int j = 0; j < 8; ++j) { v[j] = xr[64 * j]; s += (v[j].x * v[j].x + v[j].y * v[j].y) + (v[j].z * v[j].z + v[j].w * v[j].w); }
    s = wsum(s);
    u32x2* o = (u32x2*)orow + lane;
#pragma unroll
    for (int j = 0; j < 8; ++j) { u32x2 w; w.x = pk2(v[j].x, v[j].y); w.y = pk2(v[j].z, v[j].w); o[64 * j] = w; }
    if (lane < 16) ss[lane] = (lane == 0) ? s : 0.f;
}
template <int NR>
__device__ __forceinline__ void fp8_rows(const float* __restrict__ src, const float* __restrict__ gain, unsigned char* __restrict__ dst, float* __restrict__ sc, int lane) {
    f32x4 v[NR][8]; float am[NR];
#pragma unroll
    for (int r = 0; r < NR; ++r)
#pragma unroll
        for (int i = 0; i < 8; ++i) v[r][i] = *(const f32x4*)(src + (size_t)r * D + 256 * i + 4 * lane);
#pragma unroll
    for (int r = 0; r < NR; ++r) am[r] = 0.f;
#pragma unroll
    for (int i = 0; i < 8; ++i) {
        f32x4 gg = {1.f, 1.f, 1.f, 1.f};
        if (gain) gg = *(const f32x4*)(gain + 256 * i + 4 * lane);
#pragma unroll
        for (int r = 0; r < NR; ++r) {
            if (gain) v[r][i] = v[r][i] * gg;
            const f32x4 a = v[r][i];
            am[r] = fmaxf(am[r], fmaxf(fmaxf(fabsf(a.x), fabsf(a.y)), fmaxf(fabsf(a.z), fabsf(a.w))));
        }
    }
#pragma unroll
    for (int r = 0; r < NR; ++r) am[r] = wmax(am[r]);
#pragma unroll
    for (int r = 0; r < NR; ++r) {
        const float qs = am[r] > 0.f ? 256.f / am[r] : 1.f;
#pragma unroll
        for (int i = 0; i < 8; ++i) {
            const f32x4 a = v[r][i] * qs;
            int pk = __builtin_amdgcn_cvt_pk_fp8_f32(a.x, a.y, 0, false); pk = __builtin_amdgcn_cvt_pk_fp8_f32(a.z, a.w, pk, true);
            *(unsigned*)(dst + (size_t)r * 128 + ((size_t)(2 * i + (lane >> 5)) * NE) * 128 + (lane & 31) * 4) = (unsigned)pk;
        }
        if (lane == 0) sc[r] = am[r] > 0.f ? am[r] * (1.f / 256.f) : 1.f;
    }
}

__device__ __forceinline__ void p0_prologue(const Params& p, LAS unsigned char* lds, int mask = 0xff) {
    const int tid = threadIdx.x, lane = tid & 63, wave = tid >> 6;
    const int G = gridDim.x, gw = blockIdx.x * NWAVES + wave, ngw = G * NWAVES;
    const size_t gt = (size_t)blockIdx.x * NTHR + tid, ngt = (size_t)G * NTHR;
    unsigned char* ws = p.ws;
    const float* x = p.in[0]; const float* norm_mix = p.in[1]; const float* w_in = p.in[2]; const float* w_out = p.in[3];
    const float* norm_ffn = p.in[10]; const float* peer_query = p.in[11]; const float* sub_keys = p.in[12]; const float* peer_u = p.in[13]; const float* peer_v = p.in[14];
    if (mask & 1) {
        LAS float* scr = (LAS float*)(lds + wave * 8448);
        constexpr int I_IN = 32 * (NP / 32), I_SQ = 32 * (D / 32), PER_L = I_IN + 2 * I_SQ;
        for (int it = gw; it < 2 * PER_L; it += ngw) {
            const int l = it / PER_L; int r = it % PER_L;
            if (r < I_IN) { transpose_item(w_in + (size_t)l * D * IN_LD, IN_LD, IN_LD, norm_mix + l * D, (bf16_t*)(ws + WS_WINT) + (size_t)l * NP * D, D, (r / (NP / 32)) * 64, (r % (NP / 32)) * 32, scr, lane); continue; }
            r -= I_IN;
            if (r < I_SQ) { transpose_item(w_out + (size_t)l * D * D, D, D, nullptr, (bf16_t*)(ws + WS_WOUTT) + (size_t)l * D * D, D, (r / (D / 32)) * 64, (r % (D / 32)) * 32, scr, lane); continue; }
            r -= I_SQ;
            transpose_item(peer_query + (size_t)l * D * D, D, D, norm_ffn + l * D, (bf16_t*)(ws + WS_WQT) + (size_t)l * D * D, D, (r / (D / 32)) * 64, (r % (D / 32)) * 32, scr, lane);
        }
    }
    if (mask & 2) for (size_t i = gt; i < 2 * 2 * 8 * 128 * 128 / 4; i += ngt) {
        const f32x4 v = ((const f32x4*)sub_keys)[i];
        u32x2 w; w.x = pk2(v.x, v.y); w.y = pk2(v.z, v.w);
        ((u32x2*)(ws + WS_SUBK))[i] = w;
    }
    if (mask & 4) for (int r = 4 * gw; r < 4 * NE; r += 4 * ngw) {
        const int tb = r / (2 * NE), rr = r % (2 * NE), l = rr / NE;
        const float* src = (tb == 0 ? peer_u : peer_v) + (size_t)rr * D;
        unsigned char* dst = ws + (tb == 0 ? WS_U8 : WS_V8) + (size_t)l * NE * D + (size_t)(rr - l * NE) * 128;
        float* sc = (float*)(ws + (tb == 0 ? WS_USC : WS_VSC)) + rr;
        fp8_rows<4>(src, tb == 0 ? norm_ffn + l * D : (const float*)nullptr, dst, sc, lane);
    }
    if (mask & 8) for (size_t i = gt; i < (size_t)S * 32; i += ngt) {
        const int fi = (int)(i & 31), pos = (int)(i >> 5);
        const float inv = powf(10000.f, -(float)fi / 32.f);
        const float ang = (float)pos * inv;
        f32x2 cs; cs.x = cosf(ang); cs.y = sinf(ang);
        ((f32x2*)(ws + WS_ROPE))[i] = cs;
    }
    if (mask & 16) for (int t = 2 * gw; t < T; t += 2 * ngw) {
        const f32x4* x0 = (const f32x4*)(x + (size_t)t * D) + lane; const f32x4* x1 = x0 + D / 4;
        f32x4 v0[8], v1[8]; float s0 = 0.f, s1 = 0.f;
#pragma unroll
        for (int j = 0; j < 8; ++j) { v0[j] = x0[64 * j]; v1[j] = x1[64 * j]; }
#pragma unroll
        for (int j = 0; j < 8; ++j) { s0 += (v0[j].x * v0[j].x + v0[j].y * v0[j].y) + (v0[j].z * v0[j].z + v0[j].w * v0[j].w); s1 += (v1[j].x * v1[j].x + v1[j].y * v1[j].y) + (v1[j].z * v1[j].z + v1[j].w * v1[j].w); }
        s0 = wsum(s0); s1 = wsum(s1);
        u32x2* o0 = (u32x2*)((bf16_t*)(ws + WS_XB) + (size_t)t * D) + lane; u32x2* o1 = o0 + D / 4;
#pragma unroll
        for (int j = 0; j < 8; ++j) { u32x2 w; w.x = pk2(v0[j].x, v0[j].y); w.y = pk2(v0[j].z, v0[j].w); o0[64 * j] = w; w.x = pk2(v1[j].x, v1[j].y); w.y = pk2(v1[j].z, v1[j].w); o1[64 * j] = w; }
        float* ss = (float*)(ws + WS_SS) + (size_t)t * 16;
        if (lane < 32) ss[lane] = (lane == 0) ? s0 : (lane == 16) ? s1 : 0.f;
    }
}

template <int NSS>
struct EpiScaleBf16 {
    static constexpr bool PERM = true, AFTER_DRAIN = false;
    bf16_t* O; int ldc; const float* ss;
    __device__ __forceinline__ void operator()(const pg8::f32x4 (&acc)[2][2][4][2], const pg8::Unit& u, int wr, int wc, int fr, int fq) const {
        const int row0 = u.pm * 256 + wr * 64 + fr, col0 = u.pn * 256 + wc * 32 + 8 * fq;
#pragma unroll
        for (int ai = 0; ai < 2; ++ai)
#pragma unroll
            for (int m = 0; m < 4; ++m) {
                const int row = row0 + ai * 128 + m * 16;
                float s;
                {
                    const f32x4* sp = (const f32x4*)(ss + (size_t)row * NSS);
                    f32x4 a = sp[0];
#pragma unroll
                    for (int i = 1; i < NSS / 4; ++i) a = a + sp[i];
                    s = (a.x + a.y) + (a.z + a.w);
                }
                const float r = rsqrtf(s * (1.f / D) + EPS);
                bf16_t* rowp = O + (size_t)row * ldc + col0;
#pragma unroll
                for (int bj = 0; bj < 2; ++bj) {
                    const pg8::f32x4 v0 = acc[ai][bj][m][0] * r, v1 = acc[ai][bj][m][1] * r;
                    u32x4 w; w.x = pk2(v0[0], v0[1]); w.y = pk2(v0[2], v0[3]); w.z = pk2(v1[0], v1[1]); w.w = pk2(v1[2], v1[3]);
                    *(u32x4*)(rowp + bj * 128) = w;
                }
            }
    }
};

struct EpiX1 {
    static constexpr bool PERM = false, AFTER_DRAIN = false;
    const float* xin32;
    bf16_t* X1B; float* ssp;
    __device__ __forceinline__ void operator()(const pg8::f32x4 (&acc)[2][2][4][2], const pg8::Unit& u, int wr, int wc, int fr, int fq) const {
        const int col0 = u.pn * 256 + wc * 32 + 4 * fq;
#pragma unroll
        for (int ai = 0; ai < 2; ++ai)
#pragma unroll
            for (int m = 0; m < 4; ++m) {
                const int row = u.pm * 256 + ai * 128 + wr * 64 + m * 16 + fr;
                float q = 0.f;
#pragma unroll
                for (int bj = 0; bj < 2; ++bj)
#pragma unroll
                    for (int n = 0; n < 2; ++n) {
                        const size_t off = (size_t)row * D + col0 + bj * 128 + n * 16;
                        pg8::f32x4 r;
                        if (xin32) r = *(const pg8::f32x4*)(xin32 + off);
                        else { const u32x2 rb = *(const u32x2*)(X1B + off); r = (pg8::f32x4){bflo(rb.x), bfhi(rb.x), bflo(rb.y), bfhi(rb.y)}; }
                        const pg8::f32x4 o = r + acc[ai][bj][m][n];
                        u32x2 w; w.x = pk2(o[0], o[1]); w.y = pk2(o[2], o[3]);
                        *(u32x2*)(X1B + off) = w;
                        const float o0 = bflo(w.x), o1 = bfhi(w.x), o2 = bflo(w.y), o3 = bfhi(w.y);
                        q += (o0 * o0 + o1 * o1) + (o2 * o2 + o3 * o3);
                    }
                q += __shfl_xor(q, 16); q += __shfl_xor(q, 32);
                if (fq == 0) ssp[(size_t)row * 32 + u.pn * 4 + wc] = q;
            }
    }
};

#define TOPK_INSERT(L, x) do { _Pragma("unroll") for (int _i = 15; _i >= 1; --_i) L[_i] = __builtin_amdgcn_fmed3f(L[_i - 1], L[_i], (x)); L[0] = fmaxf(L[0], (x)); } while (0)
constexpr int SK_LD = 136;
constexpr int ROUTE_SK_OFF = 8 * 8448;
typedef float f32x16 __attribute__((ext_vector_type(16)));
__device__ __forceinline__ float swap32(float x) {
    const auto s = __builtin_amdgcn_permlane32_swap(__float_as_uint(x), __float_as_uint(x), false, false);
    return (__builtin_amdgcn_mbcnt_hi(~0u, __builtin_amdgcn_mbcnt_lo(~0u, 0u)) < 32u) ? __uint_as_float(s[1]) : __uint_as_float(s[0]);
}
__device__ __forceinline__ void route_unit(const bf16_t* __restrict__ Q, const bf16_t* __restrict__ subk_l, int pm, int h, int* __restrict__ IDX, int* __restrict__ IDXU, float* __restrict__ GATE,
                                           LAS unsigned char* lds, int tid, int wave, int lane) {
    const int tk = lane & 31, hi = lane >> 5;
    LAS float* scr = (LAS float*)(lds + wave * 8448);
    LAS bf16_t* SK = (LAS bf16_t*)(lds + ROUTE_SK_OFF);
    __syncthreads();
#pragma unroll
    for (int j = 0; j < 8; ++j) {
        const int e = tid + j * NTHR, half = e >> 11, row = (e >> 4) & 127, ch = e & 15;
        *(LAS u32x4*)(SK + (half * 128 + row) * SK_LD + ch * 8) = *(const u32x4*)(subk_l + ((size_t)(half * 8 + h) * 128 + row) * 128 + ch * 8);
    }
    const int tok = pm * 256 + wave * 32 + tk;
    bf16x8 bq[2][8];
#pragma unroll
    for (int half = 0; half < 2; ++half)
#pragma unroll
        for (int ks = 0; ks < 8; ++ks) bq[half][ks] = *(const bf16x8*)(Q + (size_t)tok * D + h * 256 + half * 128 + ks * 16 + 8 * hi);
    __syncthreads();
    float L1[16], L2[16];
#pragma unroll
    for (int half = 0; half < 2; ++half) {
        float L[16];
#pragma unroll
        for (int i = 0; i < 16; ++i) L[i] = -3.0e38f;
#pragma unroll 1
        for (int mt = 0; mt < 4; ++mt) {
            f32x16 acc;
#pragma unroll
            for (int r = 0; r < 16; ++r) acc[r] = 0.f;
            const LAS bf16_t* kp = SK + (half * 128 + mt * 32 + tk) * SK_LD + 8 * hi;
#pragma unroll
            for (int ks = 0; ks < 8; ++ks) acc = __builtin_amdgcn_mfma_f32_32x32x16_bf16(*(const LAS bf16x8*)(kp + ks * 16), bq[half][ks], acc, 0, 0, 0);
#pragma unroll
            for (int r = 0; r < 16; ++r) {
                const unsigned key = (unsigned)(mt * 32 + (r & 3) + 8 * (r >> 2) + 4 * hi);
                const float xv = __uint_as_float((__float_as_uint(acc[r]) & 0xffffff80u) | key);
                TOPK_INSERT(L, xv);
            }
        }
        { float o[16];
#pragma unroll
          for (int i = 0; i < 16; ++i) o[i] = swap32(L[i]);
#pragma unroll
          for (int i = 0; i < 16; ++i) TOPK_INSERT(L, o[i]); }
#pragma unroll
        for (int i = 0; i < 16; ++i) { if (half == 0) L1[i] = L[i]; else L2[i] = L[i]; }
    }
    float C[16];
#pragma unroll
    for (int i = 0; i < 16; ++i) C[i] = -3.0e38f;
    {
        constexpr int NA[50] = {0,0,0,0,0,0,0,0,0,0,0,0,0,0,0,0, 1,1,1,1,1,1,1,1, 2,2,2,2,2, 3,3,3,3, 4,4,4, 5,5, 6,6, 7,7, 8, 9, 10, 11, 12, 13, 14, 15};
        constexpr int NBb[50] = {0,1,2,3,4,5,6,7,8,9,10,11,12,13,14,15, 0,1,2,3,4,5,6,7, 0,1,2,3,4, 0,1,2,3, 0,1,2, 0,1, 0,1, 0,1, 0, 0, 0, 0, 0, 0, 0, 0};
#pragma unroll
        for (int i = 0; i < 25; ++i) {
            const int a0 = NA[2 * i], b0 = NBb[2 * i], a1 = NA[2 * i + 1], b1 = NBb[2 * i + 1];
            const float s0 = L1[a0] + L2[b0], s1 = L1[a1] + L2[b1];
            const float x0 = __uint_as_float((__float_as_uint(s0) & 0xffffff00u) | (unsigned)(a0 * 16 + b0));
            const float x1 = __uint_as_float((__float_as_uint(s1) & 0xffffff00u) | (unsigned)(a1 * 16 + b1));
            const float xv = hi ? x1 : x0;
            TOPK_INSERT(C, xv);
        }
        float o[16];
#pragma unroll
        for (int i = 0; i < 16; ++i) o[i] = swap32(C[i]);
#pragma unroll
        for (int i = 0; i < 16; ++i) TOPK_INSERT(C, o[i]);
    }
    LAS float* my = scr + lane * 33;
#pragma unroll
    for (int i = 0; i < 16; ++i) { my[i] = L1[i]; my[16 + i] = L2[i]; }
    __builtin_amdgcn_s_waitcnt(0xc07f);
    asm volatile("" ::: "memory");
    const float mx = __uint_as_float(__float_as_uint(C[0]) & 0xffffff00u);
    float e[16], den = 0.f;
#pragma unroll
    for (int i = 0; i < 16; ++i) { e[i] = __expf(__uint_as_float(__float_as_uint(C[i]) & 0xffffff00u) - mx); den += e[i]; }
    const float rden = 1.f / den;
#pragma unroll
    for (int i = 0; i < 16; ++i) {
        if ((i >> 3) == hi) {
            const unsigned ab = __float_as_uint(C[i]) & 0xffu;
            const unsigned i1 = __float_as_uint(my[ab >> 4]) & 0x7fu, i2 = __float_as_uint(my[16 + (ab & 15)]) & 0x7fu;
            const int pp = h * 16 + i, pos = (pp & 7) * 16 + (pp >> 3);
            IDX[(size_t)tok * 128 + pos] = (int)(i1 * 128 + i2);
            GATE[(size_t)tok * 128 + pos] = e[i] * rden;
        }
    }
    __builtin_amdgcn_s_waitcnt(0xc07f);
    asm volatile("" ::: "memory");
}

__device__ __forceinline__ float gelu_erf(float x) { return 0.5f * x * (1.f + erff(x * 0.70710678118654752f)); }
template <bool FINAL>
__device__ __forceinline__ void expert_token(int t, const bf16_t* __restrict__ X1B, const float* __restrict__ X1, const float* __restrict__ ssp, const int* __restrict__ IDX, const float* __restrict__ GATE,
                                             const unsigned char* __restrict__ U8, const float* __restrict__ USC, const unsigned char* __restrict__ V8, const float* __restrict__ VSC,
                                             float* __restrict__ X2, bf16_t* __restrict__ XB, float* __restrict__ SS, const float* __restrict__ norm_final, float* __restrict__ OUT, int lane) {
    float xf[2][16];
#pragma unroll
    for (int j = 0; j < 2; ++j) {
        const u32x4* xp = (const u32x4*)(X1B + (size_t)t * D + j * 1024 + lane * 16);
        const u32x4 a = xp[0], b = xp[1];
#pragma unroll
        for (int q = 0; q < 4; ++q) { xf[j][2 * q] = bflo(a[q]); xf[j][2 * q + 1] = bfhi(a[q]); xf[j][8 + 2 * q] = bflo(b[q]); xf[j][8 + 2 * q + 1] = bfhi(b[q]); }
    }
    float sp = (lane < 32) ? ssp[(size_t)t * 32 + lane] : 0.f;
    sp = wsum(sp);
    const float rs1 = rsqrtf(sp * (1.f / D) + EPS);
    const int id0 = IDX[(size_t)t * 128 + lane], id1 = IDX[(size_t)t * 128 + 64 + lane];
    const float g0 = GATE[(size_t)t * 128 + lane], g1 = GATE[(size_t)t * 128 + 64 + lane];
    const float us0 = USC[id0], us1 = USC[id1], vs0 = VSC[id0], vs1 = VSC[id1];
    float acc[2][16];
#pragma unroll
    for (int j = 0; j < 2; ++j)
#pragma unroll
        for (int i = 0; i < 16; ++i) acc[j][i] = 0.f;
    float act0 = 0.f, act1 = 0.f;
#pragma unroll 1
    for (int e0 = 0; e0 < 128; e0 += 4) {
        u32x4 w[4][2];
#pragma unroll
        for (int e = 0; e < 4; ++e) {
            const int ee = e0 + e;
            const int id = __builtin_amdgcn_readlane(ee < 64 ? id0 : id1, ee & 63);
            const unsigned char* up = U8 + (size_t)id * D + lane * 16;
            w[e][0] = *(const u32x4*)up; w[e][1] = *(const u32x4*)(up + 1024);
        }
        float d[4];
#pragma unroll
        for (int e = 0; e < 4; ++e) {
            float s = 0.f;
#pragma unroll
            for (int j = 0; j < 2; ++j)
#pragma unroll
                for (int q = 0; q < 4; ++q) {
                    const f32x2 lo = __builtin_amdgcn_cvt_pk_f32_fp8((int)w[e][j][q], false), hi = __builtin_amdgcn_cvt_pk_f32_fp8((int)w[e][j][q], true);
                    s = fmaf(lo.x, xf[j][4 * q], s); s = fmaf(lo.y, xf[j][4 * q + 1], s); s = fmaf(hi.x, xf[j][4 * q + 2], s); s = fmaf(hi.y, xf[j][4 * q + 3], s);
                }
            d[e] = wsum(s);
        }
#pragma unroll
        for (int e = 0; e < 4; ++e) {
            const int ee = e0 + e;
            if (ee < 64) { if (lane == ee) act0 = d[e]; } else { if (lane == ee - 64) act1 = d[e]; }
        }
    }
    act0 = gelu_erf(act0 * us0 * rs1) * g0 * vs0;
    act1 = gelu_erf(act1 * us1 * rs1) * g1 * vs1;
#pragma unroll 1
    for (int e0 = 0; e0 < 128; e0 += 4) {
        u32x4 w[4][2];
        float a[4];
#pragma unroll
        for (int e = 0; e < 4; ++e) {
            const int ee = e0 + e;
            const int id = __builtin_amdgcn_readlane(ee < 64 ? id0 : id1, ee & 63);
            a[e] = __int_as_float(__builtin_amdgcn_readlane(__float_as_int(ee < 64 ? act0 : act1), ee & 63));
            const unsigned char* vp = V8 + (size_t)id * D + lane * 16;
            w[e][0] = *(const u32x4*)vp; w[e][1] = *(const u32x4*)(vp + 1024);
        }
#pragma unroll
        for (int e = 0; e < 4; ++e)
#pragma unroll
            for (int j = 0; j < 2; ++j)
#pragma unroll
                for (int q = 0; q < 4; ++q) {
                    const f32x2 lo = __builtin_amdgcn_cvt_pk_f32_fp8((int)w[e][j][q], false), hi = __builtin_amdgcn_cvt_pk_f32_fp8((int)w[e][j][q], true);
                    acc[j][4 * q] = fmaf(a[e], lo.x, acc[j][4 * q]); acc[j][4 * q + 1] = fmaf(a[e], lo.y, acc[j][4 * q + 1]);
                    acc[j][4 * q + 2] = fmaf(a[e], hi.x, acc[j][4 * q + 2]); acc[j][4 * q + 3] = fmaf(a[e], hi.y, acc[j][4 * q + 3]);
                }
    }
    float q2 = 0.f;
#pragma unroll
    for (int j = 0; j < 2; ++j)
#pragma unroll
        for (int q = 0; q < 4; ++q) {
            const f32x4 r = *(const f32x4*)(X1 + (size_t)t * D + j * 1024 + lane * 16 + q * 4);
            acc[j][4 * q] += r.x; acc[j][4 * q + 1] += r.y; acc[j][4 * q + 2] += r.z; acc[j][4 * q + 3] += r.w;
            q2 += (acc[j][4 * q] * acc[j][4 * q] + acc[j][4 * q + 1] * acc[j][4 * q + 1]) + (acc[j][4 * q + 2] * acc[j][4 * q + 2] + acc[j][4 * q + 3] * acc[j][4 * q + 3]);
        }
    q2 = wsum(q2);
    if (FINAL) {
        const float rf = rsqrtf(q2 * (1.f / D) + EPS);
#pragma unroll
        for (int j = 0; j < 2; ++j)
#pragma unroll
            for (int q = 0; q < 4; ++q) {
                const int e = j * 1024 + lane * 16 + q * 4;
                const f32x4 g = *(const f32x4*)(norm_final + e);
                f32x4 o; o.x = acc[j][4 * q] * rf * g.x; o.y = acc[j][4 * q + 1] * rf * g.y; o.z = acc[j][4 * q + 2] * rf * g.z; o.w = acc[j][4 * q + 3] * rf * g.w;
                *(f32x4*)(OUT + (size_t)t * D + e) = o;
            }
    } else {
#pragma unroll
        for (int j = 0; j < 2; ++j) {
#pragma unroll
            for (int q = 0; q < 4; ++q) {
                f32x4 o; o.x = acc[j][4 * q]; o.y = acc[j][4 * q + 1]; o.z = acc[j][4 * q + 2]; o.w = acc[j][4 * q + 3];
                *(f32x4*)(X2 + (size_t)t * D + j * 1024 + lane * 16 + q * 4) = o;
            }
            u32x4 b0, b1;
#pragma unroll
            for (int q = 0; q < 4; ++q) { b0[q] = pk2(acc[j][2 * q], acc[j][2 * q + 1]); b1[q] = pk2(acc[j][8 + 2 * q], acc[j][8 + 2 * q + 1]); }
            u32x4* xo = (u32x4*)(XB + (size_t)t * D + j * 1024 + lane * 16);
            xo[0] = b0; xo[1] = b1;
        }
        if (lane == 0) SS[t] = q2;
    }
}
}

namespace mk {
constexpr int KS_LD = 72, VS_LD = 80;
constexpr int ATT_KS_OFF = 0, ATT_VS_OFF = 256 * KS_LD * 2;
constexpr int ATT_LDS = ATT_VS_OFF + 256 * VS_LD * 2;

__device__ __forceinline__ bf16x8 tr_pair(const LAS bf16_t* p0, const LAS bf16_t* p1) {
    const s16x4 a = __builtin_amdgcn_ds_read_tr16_b64_v4i16((LAS s16x4*)p0);
    const s16x4 b = __builtin_amdgcn_ds_read_tr16_b64_v4i16((LAS s16x4*)p1);
    bf16x8 r; r[0] = a[0]; r[1] = a[1]; r[2] = a[2]; r[3] = a[3]; r[4] = b[0]; r[5] = b[1]; r[6] = b[2]; r[7] = b[3];
    return r;
}

__device__ __forceinline__ void attn_unit(const bf16_t* __restrict__ P, const f32x2* __restrict__ rope, const float* __restrict__ sinks_l, bf16_t* __restrict__ Y,
                                          int unit, LAS unsigned char* lds, int tid, int lane, int wave) {
    const int b = unit >> 6, n = (unit >> 1) & 31, kvh = unit & 1;
    const int tok0 = b * S + n * 128;
    LAS bf16_t* KS = (LAS bf16_t*)(lds + ATT_KS_OFF);
    LAS bf16_t* VS = (LAS bf16_t*)(lds + ATT_VS_OFF);
    {
        const int key = tid >> 1, part = tid & 1;
        const int kpos = n * 128 - 128 + key;
        u32x4 k1a = {0, 0, 0, 0}, k1b = k1a, k2a = k1a, k2b = k1a, v0 = k1a, v1 = k1a, v2 = k1a, v3 = k1a;
        if (kpos >= 0) {
            const bf16_t* kr = P + (size_t)(tok0 - 128 + key) * NP + C_KA + kvh * 64 + part * 16;
            const u32x4 x1a = *(const u32x4*)kr, x1b = *(const u32x4*)(kr + 8), x2a = *(const u32x4*)(kr + 32), x2b = *(const u32x4*)(kr + 40);
            const f32x2* cs = rope + (size_t)kpos * 32 + part * 16;
#pragma unroll
            for (int q = 0; q < 4; ++q) {
                {
                    const f32x2 c0 = cs[2 * q], c1 = cs[2 * q + 1];
                    const float a0 = bflo(x1a[q]), a1 = bfhi(x1a[q]), b0 = bflo(x2a[q]), b1 = bfhi(x2a[q]);
                    k1a[q] = pk2(a0 * c0.x - b0 * c0.y, a1 * c1.x - b1 * c1.y);
                    k2a[q] = pk2(b0 * c0.x + a0 * c0.y, b1 * c1.x + a1 * c1.y);
                }
                {
                    const f32x2 c0 = cs[8 + 2 * q], c1 = cs[8 + 2 * q + 1];
                    const float a0 = bflo(x1b[q]), a1 = bfhi(x1b[q]), b0 = bflo(x2b[q]), b1 = bfhi(x2b[q]);
                    k1b[q] = pk2(a0 * c0.x - b0 * c0.y, a1 * c1.x - b1 * c1.y);
                    k2b[q] = pk2(b0 * c0.x + a0 * c0.y, b1 * c1.x + a1 * c1.y);
                }
            }
            const bf16_t* vr = P + (size_t)(tok0 - 128 + key) * NP + C_VA + kvh * 64 + part * 32;
            v0 = *(const u32x4*)vr; v1 = *(const u32x4*)(vr + 8); v2 = *(const u32x4*)(vr + 16); v3 = *(const u32x4*)(vr + 24);
        }
        LAS bf16_t* kd = KS + key * KS_LD + part * 16;
        *(LAS u32x4*)kd = k1a; *(LAS u32x4*)(kd + 8) = k1b; *(LAS u32x4*)(kd + 32) = k2a; *(LAS u32x4*)(kd + 40) = k2b;
        LAS bf16_t* vd = VS + key * VS_LD + part * 32;
        *(LAS u32x4*)vd = v0; *(LAS u32x4*)(vd + 8) = v1; *(LAS u32x4*)(vd + 16) = v2; *(LAS u32x4*)(vd + 24) = v3;
    }
    __syncthreads();
    const int hq = kvh * 8 + wave;
    const int fr = lane & 15, fq = lane >> 4;
    constexpr float L2E = 1.4426950408889634f;
    const float sink2 = sinks_l[hq] * L2E;
    const int tq = (lane & 15) >> 2, tp = lane & 3;
#pragma unroll 1
    for (int rb = 0; rb < 8; ++rb) {
        const int q0 = rb * 16;
        const int qtok = tok0 + q0 + fr;
        bf16x8 bq0, bq1;
        {
            const bf16_t* qr = P + (size_t)qtok * NP + C_QA + hq * 64 + 8 * fq;
            const u32x4 x1 = *(const u32x4*)qr, x2 = *(const u32x4*)(qr + 32);
            const f32x2* cs = rope + (size_t)(n * 128 + q0 + fr) * 32 + 8 * fq;
            u32x4 o1, o2;
            constexpr float SC = 0.125f * L2E;
#pragma unroll
            for (int q = 0; q < 4; ++q) {
                const f32x2 c0 = cs[2 * q], c1 = cs[2 * q + 1];
                const float a0 = bflo(x1[q]), a1 = bfhi(x1[q]), b0 = bflo(x2[q]), b1 = bfhi(x2[q]);
                o1[q] = pk2((a0 * c0.x - b0 * c0.y) * SC, (a1 * c1.x - b1 * c1.y) * SC);
                o2[q] = pk2((b0 * c0.x + a0 * c0.y) * SC, (b1 * c1.x + a1 * c1.y) * SC);
            }
            bq0 = __builtin_bit_cast(bf16x8, o1); bq1 = __builtin_bit_cast(bf16x8, o2);
        }
        const int wsk = (q0 >> 5) << 5;
        pg8::f32x4 sc[10];
#pragma unroll
        for (int kt = 0; kt < 10; ++kt) {
            const LAS bf16_t* kp = KS + (wsk + kt * 16 + fr) * KS_LD + 8 * fq;
            const bf16x8 a0 = *(const LAS bf16x8*)kp, a1 = *(const LAS bf16x8*)(kp + 32);
            pg8::f32x4 acc = {0.f, 0.f, 0.f, 0.f};
            acc = __builtin_amdgcn_mfma_f32_16x16x32_bf16(a0, bq0, acc, 0, 0, 0);
            acc = __builtin_amdgcn_mfma_f32_16x16x32_bf16(a1, bq1, acc, 0, 0, 0);
            sc[kt] = acc;
        }
        const int qb = q0 + fr;
        const int kmin = (n == 0) ? 128 : 0;
        float mx = sink2;
#pragma unroll
        for (int kt = 0; kt < 10; ++kt)
#pragma unroll
            for (int r = 0; r < 4; ++r) {
                const int kb = wsk + kt * 16 + 4 * fq + r;
                const bool ok = (kb >= qb + 1) && (kb <= qb + 128) && (kb >= kmin);
                sc[kt][r] = ok ? sc[kt][r] : -1e30f;
                mx = fmaxf(mx, sc[kt][r]);
            }
        mx = fmaxf(mx, __shfl_xor(mx, 16)); mx = fmaxf(mx, __shfl_xor(mx, 32));
        float sum = 0.f;
#pragma unroll
        for (int kt = 0; kt < 10; ++kt)
#pragma unroll
            for (int r = 0; r < 4; ++r) { const float pv = __builtin_amdgcn_exp2f(sc[kt][r] - mx); sc[kt][r] = pv; sum += pv; }
        sum += __shfl_xor(sum, 16); sum += __shfl_xor(sum, 32);
        const float rden = 1.f / (sum + __builtin_amdgcn_exp2f(sink2 - mx));
        pg8::f32x4 oacc[4];
#pragma unroll
        for (int mt = 0; mt < 4; ++mt) oacc[mt] = (pg8::f32x4){0.f, 0.f, 0.f, 0.f};
#pragma unroll
        for (int kk = 0; kk < 5; ++kk) {
            u32x4 pb; pb[0] = pk2(sc[2 * kk][0], sc[2 * kk][1]); pb[1] = pk2(sc[2 * kk][2], sc[2 * kk][3]);
            pb[2] = pk2(sc[2 * kk + 1][0], sc[2 * kk + 1][1]); pb[3] = pk2(sc[2 * kk + 1][2], sc[2 * kk + 1][3]);
            const bf16x8 bp = __builtin_bit_cast(bf16x8, pb);
            const LAS bf16_t* v0 = VS + (wsk + (2 * kk) * 16 + 4 * fq + tq) * VS_LD + 4 * tp;
            const LAS bf16_t* v1 = v0 + 16 * VS_LD;
#pragma unroll
            for (int mt = 0; mt < 4; ++mt) {
                const bf16x8 av = tr_pair(v0 + mt * 16, v1 + mt * 16);
                oacc[mt] = __builtin_amdgcn_mfma_f32_16x16x32_bf16(av, bp, oacc[mt], 0, 0, 0);
            }
        }
        bf16_t* yr = Y + (size_t)qtok * D + hq * 64 + 4 * fq;
#pragma unroll
        for (int mt = 0; mt < 4; ++mt) {
            u32x2 w; w.x = pk2(oacc[mt][0] * rden, oacc[mt][1] * rden); w.y = pk2(oacc[mt][2] * rden, oacc[mt][3] * rden);
            *(u32x2*)(yr + mt * 16) = w;
        }
    }
}
}

namespace mk {
constexpr int RL = 144;
constexpr int PSL = 72;
constexpr int OBL = 132;
constexpr int R_QT = 0, R_KT = 64 * RL * 2, R_KD = 2 * 64 * RL * 2, R_V = 3 * 64 * RL * 2, R_SB = 4 * 64 * RL * 2;
constexpr int R_PS = R_SB + 128 * RL * 2;
constexpr int R_VEC = R_PS + 64 * PSL * 2;
constexpr int R_OB = R_KT;
constexpr int REC_LDS = R_VEC + 12288;
static_assert(64 * OBL * 4 <= 2 * 64 * RL * 2, "OB overlay");
constexpr int ST_STRIDE = 16384 + 256;

__device__ __forceinline__ bf16x8 ld_row_split(const LAS bf16_t* p) {
    const s16x4 a = *(const LAS s16x4*)p, b = *(const LAS s16x4*)(p + 16);
    bf16x8 r; r[0] = a[0]; r[1] = a[1]; r[2] = a[2]; r[3] = a[3]; r[4] = b[0]; r[5] = b[1]; r[6] = b[2]; r[7] = b[3];
    return r;
}
__device__ __forceinline__ float clamp80(float x) { return fminf(fmaxf(x, -80.f), 80.f); }
__device__ __forceinline__ float sigm(float x) { return 1.f / (1.f + __expf(-x)); }
__device__ __forceinline__ void st_bf16(LAS bf16_t* p, float v) { *p = (bf16_t)(pk2(v, 0.f) & 0xffffu); }

__device__ __forceinline__ void state_update(pg8::f32x4 (&acc)[8], const LAS bf16_t* KDm, const LAS bf16_t* Vm, int wave, int fq, int tq, int tp) {
    bf16x8 ka[2];
#pragma unroll
    for (int ks = 0; ks < 2; ++ks) { const LAS bf16_t* p = KDm + (ks * 32 + 4 * fq + tq) * RL + 16 * wave + 4 * tp; ka[ks] = tr_pair(p, p + 16 * RL); }
#pragma unroll
    for (int j = 0; j < 8; ++j)
#pragma unroll
        for (int ks = 0; ks < 2; ++ks) {
            const LAS bf16_t* p = Vm + (ks * 32 + 4 * fq + tq) * RL + 16 * j + 4 * tp;
            const bf16x8 vb = tr_pair(p, p + 16 * RL);
            acc[j] = __builtin_amdgcn_mfma_f32_16x16x32_bf16(ka[ks], vb, acc[j], 0, 0, 0);
        }
}
__device__ __forceinline__ void state_to_lds(const pg8::f32x4 (&acc)[8], const float (&rsc)[4], LAS bf16_t* SBm, int wave, int fr, int fq) {
#pragma unroll
    for (int j = 0; j < 8; ++j)
#pragma unroll
        for (int r = 0; r < 4; ++r) st_bf16(SBm + (16 * wave + 4 * fq + r) * RL + 16 * j + fr, acc[j][r] * rsc[r]);
}
__device__ __forceinline__ void score_tile(pg8::f32x4& acc, const LAS bf16_t* Am, const LAS bf16_t* Bm, int ti, int tj, int fr, int fq) {
    acc = (pg8::f32x4){0.f, 0.f, 0.f, 0.f};
#pragma unroll
    for (int ks = 0; ks < 4; ++ks) {
        const bf16x8 a = *(const LAS bf16x8*)(Am + (16 * ti + fr) * RL + ks * 32 + 8 * fq);
        const bf16x8 b = *(const LAS bf16x8*)(Bm + (16 * tj + fr) * RL + ks * 32 + 8 * fq);
        acc = __builtin_amdgcn_mfma_f32_16x16x32_bf16(a, b, acc, 0, 0, 0);
    }
}
struct TileRegs { u32x4 a, b; };
__device__ __forceinline__ TileRegs tile_load(const bf16_t* __restrict__ src, int tid) {
    const int row = tid >> 3, seg = tid & 7;
    const bf16_t* s = src + (size_t)row * NP + seg * 16;
    TileRegs t; t.a = *(const u32x4*)s; t.b = *(const u32x4*)(s + 8); return t;
}
__device__ __forceinline__ void tile_store(const TileRegs& t, LAS bf16_t* dst, int tid) {
    const int row = tid >> 3, seg = tid & 7;
    LAS bf16_t* d = dst + row * RL + seg * 16;
    *(LAS u32x4*)d = t.a; *(LAS u32x4*)(d + 8) = t.b;
}
__device__ __forceinline__ void state_store(const pg8::f32x4 (&acc)[8], float* __restrict__ dst, int wave, int lane) {
#pragma unroll
    for (int j = 0; j < 8; ++j)
#pragma unroll
        for (int r = 0; r < 4; ++r) dst[((wave * 8 + j) * 4 + r) * 64 + lane] = acc[j][r];
}

template <int PASS>
__device__ __forceinline__ void hgrn_unit(const bf16_t* __restrict__ P, const float* __restrict__ lb_logits, int layer, const float* __restrict__ gain_l,
                                          float* __restrict__ STB, bf16_t* __restrict__ Y, int unit, LAS unsigned char* lds, int tid, int lane, int wave) {
    const int chain = unit >> 3, g = unit & 7, b = chain >> 2, h = chain & 3;
    const int t0 = b * S + g * 512;
    const int fr = lane & 15, fq = lane >> 4, tq = (lane & 15) >> 2, tp = lane & 3;
    const int kp = tid & 63, rg = wave, c0 = 2 * kp;
    LAS bf16_t* QT = (LAS bf16_t*)(lds + R_QT); LAS bf16_t* KT = (LAS bf16_t*)(lds + R_KT); LAS bf16_t* KD = (LAS bf16_t*)(lds + R_KD);
    LAS bf16_t* VV = (LAS bf16_t*)(lds + R_V); LAS bf16_t* SB = (LAS bf16_t*)(lds + R_SB); LAS bf16_t* PS = (LAS bf16_t*)(lds + R_PS);
    LAS float* TOT = (LAS float*)(lds + R_VEC);
    LAS float* EREF = TOT + 1024; LAS float* ELAST = EREF + 128;
    LAS float* OB = (LAS float*)(lds + R_OB);
    float lb0 = 0.f, lb1 = 0.f;
    if (layer == 1) {
        const float a0 = lb_logits[h * 128 + c0], a1 = lb_logits[512 + h * 128 + c0], d0 = lb_logits[h * 128 + c0 + 1], d1 = lb_logits[512 + h * 128 + c0 + 1];
        const float m0 = fmaxf(a0, a1), m1 = fmaxf(d0, d1);
        lb0 = __expf(a1 - m0) / (__expf(a0 - m0) + __expf(a1 - m0));
        lb1 = __expf(d1 - m1) / (__expf(d0 - m1) + __expf(d1 - m1));
    }
    pg8::f32x4 acc[8];
#pragma unroll
    for (int j = 0; j < 8; ++j) acc[j] = (pg8::f32x4){0.f, 0.f, 0.f, 0.f};
    if (PASS == 2) {
        for (int jg = 0; jg < g; ++jg) {
            const float* sb = STB + (size_t)(chain * 8 + jg) * ST_STRIDE;
            float dk[4];
#pragma unroll
            for (int r = 0; r < 4; ++r) dk[r] = __expf(sb[16384 + 16 * wave + 4 * fq + r]);
#pragma unroll
            for (int j = 0; j < 8; ++j)
#pragma unroll
                for (int r = 0; r < 4; ++r) acc[j][r] = acc[j][r] * dk[r] + sb[((wave * 8 + j) * 4 + r) * 64 + lane];
        }
    }
    float gl0 = 0.f, gl1 = 0.f;
    unsigned fwn[8], qwn[8];
    {
#pragma unroll
        for (int i = 0; i < 8; ++i) { const bf16_t* pr = P + (size_t)(t0 + rg * 8 + i) * NP + h * 128 + c0; fwn[i] = *(const unsigned*)(pr + C_FH); if (PASS == 2) qwn[i] = *(const unsigned*)(pr + C_QH); }
    }
#pragma unroll 1
    for (int c = 0; c < 8; ++c) {
        const int tr0 = t0 + c * 64;
        float lf0[8], lf1[8], kk0[8], kk1[8], qv0[8], qv1[8];
#pragma unroll
        for (int i = 0; i < 8; ++i) {
            const unsigned fw = fwn[i];
            const float z0 = bflo(fw), z1 = bfhi(fw);
            const float s0 = sigm(z0), s1 = sigm(z1);
            lf0[i] = __logf(fmaxf(lb0 + (1.f - lb0) * s0, 1e-30f)); lf1[i] = __logf(fmaxf(lb1 + (1.f - lb1) * s1, 1e-30f));
            kk0[i] = (1.f - lb0) * (1.f - s0); kk1[i] = (1.f - lb1) * (1.f - s1);
            if (PASS == 2) { const unsigned qw = qwn[i]; const float q0 = bflo(qw), q1 = bfhi(qw); qv0[i] = q0 * sigm(q0); qv1[i] = q1 * sigm(q1); }
        }
#pragma unroll
        for (int i = 1; i < 8; ++i) { lf0[i] += lf0[i - 1]; lf1[i] += lf1[i - 1]; }
        TOT[rg * 128 + c0] = lf0[7]; TOT[rg * 128 + c0 + 1] = lf1[7];
        { const TileRegs vt = tile_load(P + (size_t)tr0 * NP + C_IH + h * 128, tid); tile_store(vt, VV, tid); }
        if (c < 7) {
            const int trn = tr0 + 64;
#pragma unroll
            for (int i = 0; i < 8; ++i) { const bf16_t* pr = P + (size_t)(trn + rg * 8 + i) * NP + h * 128 + c0; fwn[i] = *(const unsigned*)(pr + C_FH); if (PASS == 2) qwn[i] = *(const unsigned*)(pr + C_QH); }
        }
        __syncthreads();
        {
            float pre0 = 0.f, pre1 = 0.f, ref0 = 0.f, ref1 = 0.f, la0 = 0.f, la1 = 0.f;
#pragma unroll
            for (int r = 0; r < 8; ++r) {
                const float a0 = TOT[r * 128 + c0], a1 = TOT[r * 128 + c0 + 1];
                if (r < rg) { pre0 += a0; pre1 += a1; }
                if (r < 4) { ref0 += a0; ref1 += a1; }
                la0 += a0; la1 += a1;
            }
#pragma unroll
            for (int i = 0; i < 8; ++i) {
                const int row = rg * 8 + i;
                const float cu0 = pre0 + lf0[i], cu1 = pre1 + lf1[i];
                if (PASS == 2) {
                    *(LAS unsigned*)(QT + row * RL + c0) = pk2(qv0[i] * __expf(clamp80(cu0 - ref0)), qv1[i] * __expf(clamp80(cu1 - ref1)));
                    *(LAS unsigned*)(KT + row * RL + c0) = pk2(kk0[i] * __expf(clamp80(ref0 - cu0)), kk1[i] * __expf(clamp80(ref1 - cu1)));
                }
                *(LAS unsigned*)(KD + row * RL + c0) = pk2(kk0[i] * __expf(la0 - cu0), kk1[i] * __expf(la1 - cu1));
            }
            if (rg == 0) { EREF[c0] = __expf(ref0); EREF[c0 + 1] = __expf(ref1); ELAST[c0] = __expf(la0); ELAST[c0 + 1] = __expf(la1); }
            gl0 += la0; gl1 += la1;
        }
        __syncthreads();
        TileRegs gcur = {};
        if (PASS == 2) gcur = tile_load(P + (size_t)tr0 * NP + C_GH + h * 128, tid);
        pg8::f32x4 o[4];
        if (PASS == 2) {
            { float rs[4];
#pragma unroll
              for (int r = 0; r < 4; ++r) rs[r] = EREF[16 * wave + 4 * fq + r];
              state_to_lds(acc, rs, SB, wave, fr, fq); }
            { const int ti = wave >> 1;
#pragma unroll
              for (int tjj = 0; tjj < 2; ++tjj) {
                  const int tj = 2 * (wave & 1) + tjj;
                  pg8::f32x4 sa = {0.f, 0.f, 0.f, 0.f};
                  if (tj <= ti) score_tile(sa, QT, KT, ti, tj, fr, fq);
#pragma unroll
                  for (int r = 0; r < 4; ++r) {
                      const int t = 16 * ti + 4 * fq + r, s = 16 * tj + fr;
                      st_bf16(PS + t * PSL + s, (s <= t) ? sa[r] : 0.f);
                  }
              } }
            __syncthreads();
            bf16x8 sbf[4], vbf[2];
#pragma unroll
            for (int ks = 0; ks < 4; ++ks) { const LAS bf16_t* p = SB + (ks * 32 + 4 * fq + tq) * RL + 16 * wave + 4 * tp; sbf[ks] = tr_pair(p, p + 16 * RL); }
#pragma unroll
            for (int ks = 0; ks < 2; ++ks) { const LAS bf16_t* p = VV + (ks * 32 + 4 * fq + tq) * RL + 16 * wave + 4 * tp; vbf[ks] = tr_pair(p, p + 16 * RL); }
#pragma unroll
            for (int ti = 0; ti < 4; ++ti) {
                o[ti] = (pg8::f32x4){0.f, 0.f, 0.f, 0.f};
#pragma unroll
                for (int ks = 0; ks < 4; ++ks) o[ti] = __builtin_amdgcn_mfma_f32_16x16x32_bf16(ld_row_split(QT + (16 * ti + fr) * RL + ks * 32 + 4 * fq), sbf[ks], o[ti], 0, 0, 0);
#pragma unroll
                for (int ks = 0; ks < 2; ++ks) o[ti] = __builtin_amdgcn_mfma_f32_16x16x32_bf16(ld_row_split(PS + (16 * ti + fr) * PSL + ks * 32 + 4 * fq), vbf[ks], o[ti], 0, 0, 0);
            }
        }
        {
#pragma unroll
            for (int r = 0; r < 4; ++r) { const float el = ELAST[16 * wave + 4 * fq + r];
#pragma unroll
                for (int j = 0; j < 8; ++j) acc[j][r] *= el; }
            state_update(acc, KD, VV, wave, fq, tq, tp);
        }
        __syncthreads();
        if (PASS == 2) {
#pragma unroll
            for (int ti = 0; ti < 4; ++ti)
#pragma unroll
                for (int r = 0; r < 4; ++r) OB[(16 * ti + 4 * fq + r) * OBL + 16 * wave + fr] = o[ti][r];
            __syncthreads();
            const int t = tid >> 3, seg = tid & 7;
            float ov[16]; float ss = 0.f;
#pragma unroll
            for (int q = 0; q < 4; ++q) { const f32x4 a = *(const LAS f32x4*)(OB + t * OBL + seg * 16 + 4 * q); ov[4 * q] = a.x; ov[4 * q + 1] = a.y; ov[4 * q + 2] = a.z; ov[4 * q + 3] = a.w;
                ss += (a.x * a.x + a.y * a.y) + (a.z * a.z + a.w * a.w); }
            ss = sum8(ss);
            const float rn = rsqrtf(ss * (1.f / 128.f) + EPS);
            const u32x4 g0 = gcur.a, g1 = gcur.b;
            const float* gnp = gain_l + h * 128 + seg * 16;
            u32x4 y0, y1;
#pragma unroll
            for (int q = 0; q < 4; ++q) {
                const float ga = bflo(g0[q]), gb = bfhi(g0[q]), gc = bflo(g1[q]), gd = bfhi(g1[q]);
                y0[q] = pk2(ov[2 * q] * rn * gnp[2 * q] * (ga * sigm(ga)), ov[2 * q + 1] * rn * gnp[2 * q + 1] * (gb * sigm(gb)));
                y1[q] = pk2(ov[8 + 2 * q] * rn * gnp[8 + 2 * q] * (gc * sigm(gc)), ov[8 + 2 * q + 1] * rn * gnp[8 + 2 * q + 1] * (gd * sigm(gd)));
            }
            bf16_t* yp = Y + (size_t)(tr0 + t) * D + 1024 + h * 128 + seg * 16;
            *(u32x4*)yp = y0; *(u32x4*)(yp + 8) = y1;
        }
    }
    if (PASS == 1) {
        float* sb = STB + (size_t)(chain * 8 + g) * ST_STRIDE;
        state_store(acc, sb, wave, lane);
        if (rg == 0) { sb[16384 + c0] = gl0; sb[16384 + c0 + 1] = gl1; }
    }
}

template <int PASS>
__device__ __forceinline__ void mlstm_unit(const bf16_t* __restrict__ P, const float* __restrict__ conv_l, const float* __restrict__ ib_l, const float* __restrict__ fb_l,
                                           float* __restrict__ STB, bf16_t* __restrict__ Y, int unit, LAS unsigned char* lds, int tid, int lane, int wave) {
    const int chain = unit >> 3, g = unit & 7, b = chain >> 2, h = chain & 3;
    const int t0 = b * S + g * 512;
    const int fr = lane & 15, fq = lane >> 4, tq = (lane & 15) >> 2, tp = lane & 3;
    const int kp = tid & 63, rg = wave, c0 = 2 * kp;
    LAS bf16_t* QM = (LAS bf16_t*)(lds + R_QT); LAS bf16_t* KM = (LAS bf16_t*)(lds + R_KT); LAS bf16_t* KW = (LAS bf16_t*)(lds + R_KD);
    LAS bf16_t* VV = (LAS bf16_t*)(lds + R_V); LAS bf16_t* CB = (LAS bf16_t*)(lds + R_SB); LAS bf16_t* PS = (LAS bf16_t*)(lds + R_PS);
    LAS float* VEC = (LAS float*)(lds + R_VEC);
    LAS float* GA = VEC;
    LAS float* GPM = VEC + 512;
    LAS float* GCUM = VEC + 1024;
    LAS float* NV = VEC + 1536;
    LAS float* DENP = VEC + 1664;
    LAS float* DINT = VEC + 1792;
    LAS float* KSUM = VEC + 1856;
    LAS float* OB = (LAS float*)(lds + R_OB);
    float wq0[4], wq1[4], wk0[4], wk1[4];
#pragma unroll
    for (int j = 0; j < 4; ++j) {
        wq0[j] = conv_l[j * 1024 + h * 128 + c0]; wq1[j] = conv_l[j * 1024 + h * 128 + c0 + 1];
        wk0[j] = conv_l[j * 1024 + 512 + h * 128 + c0]; wk1[j] = conv_l[j * 1024 + 512 + h * 128 + c0 + 1];
    }
    {
        const bf16_t* pr = P + (size_t)(t0 + wave * 64 + lane) * NP;
        const float ip = bf2f(pr[C_IM + h]) + ib_l[h];
        const float z = bf2f(pr[C_FM + h]) + fb_l[h];
        const float lf = fminf(z, 0.f) - __logf(1.f + __expf(-fabsf(z)));
        float cu = lf;
#pragma unroll
        for (int o = 1; o < 64; o <<= 1) { const float t = __shfl_up(cu, o); if (lane >= o) cu += t; }
        const float a = ip - cu;
        float pm = a;
#pragma unroll
        for (int o = 1; o < 64; o <<= 1) { const float t = __shfl_up(pm, o); if (lane >= o) pm = fmaxf(pm, t); }
        GA[wave * 64 + lane] = a; GPM[wave * 64 + lane] = pm; GCUM[wave * 64 + lane] = cu;
    }
    pg8::f32x4 acc[8];
#pragma unroll
    for (int j = 0; j < 8; ++j) acc[j] = (pg8::f32x4){0.f, 0.f, 0.f, 0.f};
    float mprev = (PASS == 1) ? -1e30f : 0.f;
    float nreg = 0.f;
    float fsum = 0.f;
    if (PASS == 2) {
        for (int jg = 0; jg < g; ++jg) {
            const float* sb = STB + (size_t)(chain * 8 + jg) * ST_STRIDE;
            const float mE = sb[16384 + 128], F = sb[16384 + 129];
            const float mn = fmaxf(F + mprev, mE);
            const float s1 = __expf(F + mprev - mn), s2 = __expf(mE - mn);
#pragma unroll
            for (int j = 0; j < 8; ++j)
#pragma unroll
                for (int r = 0; r < 4; ++r) acc[j][r] = acc[j][r] * s1 + s2 * sb[((wave * 8 + j) * 4 + r) * 64 + lane];
            if (tid < 128) nreg = nreg * s1 + s2 * sb[16384 + tid];
            mprev = mn;
        }
    }
    if (tid < 128) NV[tid] = nreg;
    unsigned xqn[11], xkn[11];
#define MLSTM_FETCH(TR0, CC) do { _Pragma("unroll") for (int i = 0; i < 11; ++i) { \
            const int row_ = rg * 8 + i - 3; const int pos_ = g * 512 + (CC) * 64 + row_; unsigned wq_ = 0u, wk_ = 0u; \
            if (pos_ >= 0) { const bf16_t* pr_ = P + (size_t)((TR0) + row_) * NP + h * 128 + c0; if (PASS == 2) wq_ = *(const unsigned*)(pr_ + C_QM); wk_ = *(const unsigned*)(pr_ + C_KM); } \
            xqn[i] = wq_; xkn[i] = wk_; } \
        } while (0)
    MLSTM_FETCH(t0, 0);
    __syncthreads();
#pragma unroll 1
    for (int c = 0; c < 8; ++c) {
        const int tr0 = t0 + c * 64;
        const LAS float* AV = GA + c * 64; const LAS float* PM = GPM + c * 64; const LAS float* CUM = GCUM + c * 64;
        const float M63 = fmaxf(PM[63], mprev), last = CUM[63];
        float ks0 = 0.f, ks1 = 0.f;
#pragma unroll
        for (int i = 0; i < 8; ++i) {
            const int row = rg * 8 + i;
            float k0v = 0.f, k1v = 0.f, q0v = 0.f, q1v = 0.f;
#pragma unroll
            for (int j = 0; j < 4; ++j) { k0v += wk0[j] * bflo(xkn[i + j]); k1v += wk1[j] * bfhi(xkn[i + j]); if (PASS == 2) { q0v += wq0[j] * bflo(xqn[i + j]); q1v += wq1[j] * bfhi(xqn[i + j]); } }
            k0v = k0v * sigm(k0v) * 0.08838834764831845f; k1v = k1v * sigm(k1v) * 0.08838834764831845f;
            const float wsr = __expf(AV[row] - M63);
            const unsigned kw = pk2(k0v * wsr, k1v * wsr);
            *(LAS unsigned*)(KW + row * RL + c0) = kw;
            ks0 += bflo(kw); ks1 += bfhi(kw);
            if (PASS == 2) {
                *(LAS unsigned*)(KM + row * RL + c0) = pk2(k0v, k1v);
                *(LAS unsigned*)(QM + row * RL + c0) = pk2(q0v * sigm(q0v), q1v * sigm(q1v));
            }
        }
        KSUM[rg * 128 + c0] = ks0; KSUM[rg * 128 + c0 + 1] = ks1;
        { const TileRegs vt = tile_load(P + (size_t)tr0 * NP + C_VM + h * 128, tid); tile_store(vt, VV, tid); }
        if (c < 7) MLSTM_FETCH(tr0 + 64, c + 1);
        const float decay = __expf(mprev - M63);
        pg8::f32x4 o1[4], o2[4];
        if (PASS == 2) {
            const float one[4] = {1.f, 1.f, 1.f, 1.f};
            state_to_lds(acc, one, CB, wave, fr, fq);
        }
        __syncthreads();
        TileRegs ocur = {};
        if (PASS == 2) ocur = tile_load(P + (size_t)tr0 * NP + C_OM + h * 128, tid);
        if (PASS == 2) {
            { const int ti = wave >> 1;
              float dp[4] = {0.f, 0.f, 0.f, 0.f};
#pragma unroll
              for (int tjj = 0; tjj < 2; ++tjj) {
                  const int tj = 2 * (wave & 1) + tjj;
                  pg8::f32x4 sa = {0.f, 0.f, 0.f, 0.f};
                  if (tj <= ti) score_tile(sa, QM, KM, ti, tj, fr, fq);
                  const int s = 16 * tj + fr;
                  const float as = AV[s];
#pragma unroll
                  for (int r = 0; r < 4; ++r) {
                      const int t = 16 * ti + 4 * fq + r;
                      const float w = (s <= t) ? sa[r] * __expf(as - fmaxf(PM[t], mprev)) : 0.f;
                      st_bf16(PS + t * PSL + s, w);
                      dp[r] += w;
                  }
              }
#pragma unroll
              for (int r = 0; r < 4; ++r) {
                  const float v = sum16(dp[r]);
                  if (fr == 0) DENP[(16 * ti + 4 * fq + r) * 2 + (wave & 1)] = v;
              } }
            { const int t = tid >> 3, seg = tid & 7;
              const bf16x8 qa = *(const LAS bf16x8*)(QM + t * RL + seg * 16), qb = *(const LAS bf16x8*)(QM + t * RL + seg * 16 + 8);
              float dsum = 0.f;
#pragma unroll
              for (int q = 0; q < 8; ++q) dsum += bf2f((unsigned short)qa[q]) * NV[seg * 16 + q] + bf2f((unsigned short)qb[q]) * NV[seg * 16 + 8 + q];
              dsum = sum8(dsum);
              if (seg == 0) DINT[t] = dsum; }
            __syncthreads();
            bf16x8 cbf[4], vbf[2];
#pragma unroll
            for (int ks = 0; ks < 4; ++ks) { const LAS bf16_t* p = CB + (ks * 32 + 4 * fq + tq) * RL + 16 * wave + 4 * tp; cbf[ks] = tr_pair(p, p + 16 * RL); }
#pragma unroll
            for (int ks = 0; ks < 2; ++ks) { const LAS bf16_t* p = VV + (ks * 32 + 4 * fq + tq) * RL + 16 * wave + 4 * tp; vbf[ks] = tr_pair(p, p + 16 * RL); }
#pragma unroll
            for (int ti = 0; ti < 4; ++ti) {
                o1[ti] = (pg8::f32x4){0.f, 0.f, 0.f, 0.f}; o2[ti] = (pg8::f32x4){0.f, 0.f, 0.f, 0.f};
#pragma unroll
                for (int ks = 0; ks < 4; ++ks) o2[ti] = __builtin_amdgcn_mfma_f32_16x16x32_bf16(ld_row_split(QM + (16 * ti + fr) * RL + ks * 32 + 4 * fq), cbf[ks], o2[ti], 0, 0, 0);
#pragma unroll
                for (int ks = 0; ks < 2; ++ks) o1[ti] = __builtin_amdgcn_mfma_f32_16x16x32_bf16(ld_row_split(PS + (16 * ti + fr) * PSL + ks * 32 + 4 * fq), vbf[ks], o1[ti], 0, 0, 0);
            }
        }
        {
#pragma unroll
            for (int j = 0; j < 8; ++j) acc[j] = acc[j] * decay;
            state_update(acc, KW, VV, wave, fq, tq, tp);
            if (tid < 128) {
                float sumk = 0.f;
#pragma unroll
                for (int r8 = 0; r8 < 8; ++r8) sumk += KSUM[r8 * 128 + tid];
                nreg = nreg * decay + sumk;
            }
        }
        fsum += last;
        const float mnew = last + M63;
        __syncthreads();
        if (tid < 128) NV[tid] = nreg;
        if (PASS == 2) {
#pragma unroll
            for (int ti = 0; ti < 4; ++ti)
#pragma unroll
                for (int r = 0; r < 4; ++r) {
                    const int t = 16 * ti + 4 * fq + r;
                    OB[t * OBL + 16 * wave + fr] = o1[ti][r] + __expf(mprev - fmaxf(PM[t], mprev)) * o2[ti][r];
                }
            __syncthreads();
            const int t = tid >> 3, seg = tid & 7;
            const float Mt = fmaxf(PM[t], mprev);
            const float wi = __expf(mprev - Mt);
            const float den = DENP[t * 2] + DENP[t * 2 + 1] + wi * DINT[t];
            const float hd = 1.f / fmaxf(fabsf(den), __expf(-(CUM[t] + Mt)));
            const u32x4 g0 = ocur.a, g1 = ocur.b;
            const unsigned gw[8] = {g0[0], g0[1], g0[2], g0[3], g1[0], g1[1], g1[2], g1[3]};
            unsigned yw[8];
#pragma unroll
            for (int q = 0; q < 4; ++q) {
                const f32x4 a = *(const LAS f32x4*)(OB + t * OBL + seg * 16 + 4 * q);
                yw[2 * q] = pk2(a.x * hd * sigm(bflo(gw[2 * q])), a.y * hd * sigm(bfhi(gw[2 * q])));
                yw[2 * q + 1] = pk2(a.z * hd * sigm(bflo(gw[2 * q + 1])), a.w * hd * sigm(bfhi(gw[2 * q + 1])));
            }
            u32x4 y0, y1;
            y0[0] = yw[0]; y0[1] = yw[1]; y0[2] = yw[2]; y0[3] = yw[3]; y1[0] = yw[4]; y1[1] = yw[5]; y1[2] = yw[6]; y1[3] = yw[7];
            bf16_t* yp = Y + (size_t)(tr0 + t) * D + 1536 + h * 128 + seg * 16;
            *(u32x4*)yp = y0; *(u32x4*)(yp + 8) = y1;
        }
        mprev = mnew;
        __syncthreads();
    }
#undef MLSTM_FETCH
    if (PASS == 1) {
        float* sb = STB + (size_t)(chain * 8 + g) * ST_STRIDE;
        state_store(acc, sb, wave, lane);
        if (tid < 128) sb[16384 + tid] = nreg;
        if (tid == 0) { sb[16384 + 128] = mprev; sb[16384 + 129] = fsum; }
    }
}
}

namespace mk {
#define XB_TMO      128
#define XB_XCNT(j)  (256  + 64 * (j))
#define XB_XSUB(j)  (1280 + 64 * (j))
#define XB_XGEN(j)  (2304 + 64 * (j))
#define XB_TOP      3328
#define XB_TOPGEN   3392
#define XCD_BAR_WORDS 3456
#define XB_SPIN_CAP (1u << 18)

__device__ __forceinline__ unsigned xb_ld(unsigned* p)              { return __hip_atomic_load(p, __ATOMIC_RELAXED, __HIP_MEMORY_SCOPE_AGENT); }
__device__ __forceinline__ unsigned xb_add(unsigned* p, unsigned v) { return __hip_atomic_fetch_add(p, v, __ATOMIC_RELAXED, __HIP_MEMORY_SCOPE_AGENT); }
__device__ __forceinline__ unsigned xb_xcc_id() { return (unsigned)__builtin_amdgcn_s_getreg((3 << 11) | 20) & 0xFu; }
#define XB_SPIN(cond, bar) do { unsigned _sp = 0; while (cond) { __builtin_amdgcn_s_sleep(1); \
    if ((++_sp & 255u) == 0u) { if (xb_ld(&(bar)[XB_TMO])) break; if (_sp > XB_SPIN_CAP) { atomicAdd(&(bar)[XB_TMO], 1u); break; } } } } while (0)

struct XcdBarrier {
    unsigned* bar; unsigned x;
    volatile LAS unsigned* st;
};

__device__ __forceinline__ XcdBarrier xcd_barrier_post(unsigned* bar, volatile LAS unsigned* st) {
    XcdBarrier b; b.bar = bar; b.x = xb_xcc_id(); b.st = st;
    if (threadIdx.x == 0) (void)xb_add(&bar[XB_XCNT(b.x)], 1u);
    return b;
}
__device__ __forceinline__ void xcd_barrier_complete(unsigned* bar, unsigned x, unsigned& nloc, unsigned& nx) {
    const unsigned G = gridDim.x * gridDim.y * gridDim.z;
    unsigned sum, cnt, mine, sp = 0u;
    for (;;) {
        sum = 0u; cnt = 0u; mine = 0u;
#pragma unroll
        for (unsigned j = 0; j < 16; ++j) { const unsigned c = xb_ld(&bar[XB_XCNT(j)]); sum += c; cnt += (c > 0u) ? 1u : 0u; mine = (j == x) ? c : mine; }
        if (sum == G) break;
        __builtin_amdgcn_s_sleep(1);
        if ((++sp & 255u) == 0u) { if (xb_ld(&bar[XB_TMO])) break; if (sp > XB_SPIN_CAP) { atomicAdd(&bar[XB_TMO], 1u); break; } }
    }
    nloc = mine > 0u ? mine : 1u; nx = cnt > 0u ? cnt : 1u;
}

__device__ __forceinline__ void xcd_barrier(const XcdBarrier& b) {
    asm volatile("s_waitcnt vmcnt(0)" ::: "memory");
    __syncthreads();
    if (threadIdx.x == 0) {
        unsigned* bar = b.bar;
        __builtin_amdgcn_s_waitcnt(0);
        unsigned nloc = b.st[0], nx = b.st[1];
        if (nloc == 0u) { xcd_barrier_complete(bar, b.x, nloc, nx); b.st[0] = nloc; b.st[1] = nx; }
        const unsigned old = xb_add(&bar[XB_XSUB(b.x)], 1u);
        const unsigned gen = old / nloc;
        if (old + 1u == (gen + 1u) * nloc) {
            __builtin_amdgcn_fence(__ATOMIC_RELEASE, "agent");
            asm volatile("s_waitcnt vmcnt(0)" ::: "memory");
            const unsigned og = xb_add(&bar[XB_TOP], 1u);
            const unsigned tg = og / nx;
            if (og + 1u == (tg + 1u) * nx) xb_add(&bar[XB_TOPGEN], 1u);
            else XB_SPIN(xb_ld(&bar[XB_TOPGEN]) == tg, bar);
            __builtin_amdgcn_fence(__ATOMIC_ACQUIRE, "agent");
            xb_add(&bar[XB_XGEN(b.x)], 1u);
            asm volatile("s_waitcnt vmcnt(0)" ::: "memory");
        } else {
            XB_SPIN(xb_ld(&bar[XB_XGEN(b.x)]) == gen, bar);
            __builtin_amdgcn_fence(__ATOMIC_ACQUIRE, "agent");
            asm volatile("s_waitcnt vmcnt(0)" ::: "memory");
        }
    }
    __syncthreads();
}

}

namespace mk {
constexpr int NSLICE = 16, SLW = 128, TBLK = 128, NTB = T / TBLK;
constexpr int CTL_Q = 3584;

__device__ __forceinline__ f32x2 fma2(f32x2 a, f32x2 b, f32x2 c) { return __builtin_elementwise_fma(a, b, c); }

__device__ __forceinline__ int q_next(unsigned* cnt, LAS int* slot, int tid) {
    __syncthreads();
    if (tid == 0) *slot = (int)__hip_atomic_fetch_add(cnt, 1u, __ATOMIC_RELAXED, __HIP_MEMORY_SCOPE_AGENT);
    __syncthreads();
    const int v = *slot;
    return v < NTB ? v : -1;
}

typedef __amdgpu_buffer_rsrc_t rsrc_t;
__device__ __forceinline__ rsrc_t make_rsrc(const void* p, unsigned bytes) { return __builtin_amdgcn_make_buffer_rsrc((void*)p, 0, bytes, 0x00020000); }

constexpr int PL_IDX = 0, PL_AUX = TBLK * 128 * 4;
#define PEER_ISSUE(W, IDP) do { const LAS u32x4* ip_ = (const LAS u32x4*)(IDP); const u32x4 i0_ = ip_[0], i1_ = ip_[1], i2_ = ip_[2], i3_ = ip_[3]; \
        _Pragma("unroll") for (int k = 0; k < 4; ++k) { \
            W[k]      = __builtin_amdgcn_raw_buffer_load_b128(rs, (int)i0_[k] * SLW + c * 16, soff, 0); \
            W[4 + k]  = __builtin_amdgcn_raw_buffer_load_b128(rs, (int)i1_[k] * SLW + c * 16, soff, 0); \
            W[8 + k]  = __builtin_amdgcn_raw_buffer_load_b128(rs, (int)i2_[k] * SLW + c * 16, soff, 0); \
            W[12 + k] = __builtin_amdgcn_raw_buffer_load_b128(rs, (int)i3_[k] * SLW + c * 16, soff, 0); } } while (0)
constexpr float XS8 = 1.f;
typedef _Float16 h2_t __attribute__((ext_vector_type(2)));
template <int MODE>
__device__ __forceinline__ void u_compute(u32x4 (&w)[16], const LAS unsigned* xs, float* __restrict__ PART, int s, int t, int g, int c) {
    if (MODE == 1) { _Pragma("unroll") for (int k = 0; k < 16; ++k) asm volatile("" :: "v"(w[k])); return; }
    if (MODE == 2) { _Pragma("unroll") for (int k = 0; k < 16; ++k) asm volatile("" : "=v"(w[k])); }
    typedef _Float16 h8_t __attribute__((ext_vector_type(8)));
    const h8_t xlo = *(const LAS h8_t*)xs, xhi = *(const LAS h8_t*)(xs + 4);
    h2_t xv[8];
#pragma unroll
    for (int j = 0; j < 4; ++j) { xv[j] = (h2_t){xlo[2 * j], xlo[2 * j + 1]}; xv[4 + j] = (h2_t){xhi[2 * j], xhi[2 * j + 1]}; }
    float r0 = 0.f, r1 = 0.f;
#pragma unroll
    for (int k = 0; k < 16; ++k) {
        float d0 = 0.f, d1 = 0.f;
#pragma unroll
        for (int q = 0; q < 4; ++q) {
            d0 = __builtin_amdgcn_fdot2(__builtin_amdgcn_cvt_scalef32_pk_f16_fp8((int)w[k][q], 1.0f, false), xv[2 * q], d0, false);
            d1 = __builtin_amdgcn_fdot2(__builtin_amdgcn_cvt_scalef32_pk_f16_fp8((int)w[k][q], 1.0f, true), xv[2 * q + 1], d1, false);
        }
        float d = d0 + d1;
        d += dppf<DPP_XOR1>(d); d += dppf<DPP_XOR2>(d); d += dppf<DPP_HMIR>(d);
        if (k < 8) { if (c == k) r0 = d; } else { if (c == k - 8) r1 = d; }
    }
    if (MODE == 2) { asm volatile("" :: "v"(r0), "v"(r1)); return; }
    float* pp = PART + ((size_t)s * T + t) * 128 + 8 * c + g;
    pp[0] = r0; pp[64] = r1;
}
struct UStage { u32x4 id[8]; u32x4 x[4]; };
__device__ __forceinline__ void u_stage_load(UStage& r, int s, int tb, const bf16_t* __restrict__ XB, const int* __restrict__ IDX, int tid) {
    const u32x4* src = (const u32x4*)(IDX + (size_t)tb * TBLK * 128);
#pragma unroll
    for (int j = 0; j < 8; ++j) r.id[j] = src[tid + j * NTHR];
#pragma unroll
    for (int j = 0; j < 4; ++j) { const int e = tid + j * NTHR, tt = e >> 4, ch = e & 15; r.x[j] = *(const u32x4*)(XB + (size_t)(tb * TBLK + tt) * D + s * SLW + ch * 8); }
}
__device__ __forceinline__ void u_stage_store(const UStage& r, LAS unsigned char* lds, int tid) {
#pragma unroll
    for (int j = 0; j < 8; ++j) *(LAS u32x4*)(lds + PL_IDX + (size_t)(tid + j * NTHR) * 16) = r.id[j];
#pragma unroll
    for (int j = 0; j < 4; ++j) { const int e = tid + j * NTHR, tt = e >> 4, ch = e & 15;
        u32x4 o;
#pragma unroll
        for (int e2 = 0; e2 < 4; ++e2) { const h2_t hv = {(_Float16)bflo(r.x[j][e2]), (_Float16)bfhi(r.x[j][e2])}; o[e2] = __builtin_bit_cast(unsigned, hv); }
        *(LAS u32x4*)(lds + PL_AUX + tt * 256 + ch * 16) = o; }
}
template <int MODE>
__device__ __forceinline__ void peer_u_run(int s, int tb, const unsigned char* __restrict__ U8, float* __restrict__ PART, LAS unsigned char* lds, int wave, int lane) {
    const int g = lane >> 3, c = lane & 7;
    const rsrc_t rs = make_rsrc(U8, (unsigned)((size_t)NE * D));
    const int soff = s * NE * SLW;
    constexpr int NTW = TBLK / NWAVES;
    const int tw = wave * NTW, t0 = tb * TBLK + tw;
    const LAS unsigned char* idb = lds + PL_IDX + (size_t)tw * 512 + g * 64;
    const LAS unsigned* xsb = (const LAS unsigned*)(lds + PL_AUX + (size_t)tw * 256) + c * 8;
    u32x4 wa[16], wb[16];
    if (MODE != 2) PEER_ISSUE(wa, idb);
#pragma unroll 1
    for (int i = 0; i < NTW; i += 2) {
        if (MODE != 2) PEER_ISSUE(wb, idb + (i + 1) * 512);
        u_compute<MODE>(wa, xsb + i * 64, PART, s, t0 + i, g, c);
        if (MODE != 2) PEER_ISSUE(wa, idb + min(i + 2, NTW - 1) * 512);
        u_compute<MODE>(wb, xsb + (i + 1) * 64, PART, s, t0 + i + 1, g, c);
    }
}
template <int MODE>
__device__ __forceinline__ void peer_u_block(int s, int tb, const bf16_t* __restrict__ XB, const int* __restrict__ IDX, const unsigned char* __restrict__ U8,
                                             float* __restrict__ PART, LAS unsigned char* lds, int tid, int wave, int lane) {
    UStage r; u_stage_load(r, s, tb, XB, IDX, tid); u_stage_store(r, lds, tid);
    __syncthreads();
    peer_u_run<MODE>(s, tb, U8, PART, lds, wave, lane);
}

__device__ __forceinline__ void peer_act_token(int t, const float* __restrict__ PART, const float* __restrict__ ssp, const int* __restrict__ IDX, const float* __restrict__ GATE,
                                               const float* __restrict__ USC, const float* __restrict__ VSC, _Float16* __restrict__ ACT, int lane) {
    const int p0 = 8 * (lane & 15) + (lane >> 4), p1 = 8 * (lane & 15) + 4 + (lane >> 4);
    float s0 = 0.f, s1 = 0.f;
#pragma unroll
    for (int s = 0; s < NSLICE; ++s) { const float* pp = PART + ((size_t)s * T + t) * 128; s0 += pp[p0]; s1 += pp[p1]; }
    float sp = (lane < 32) ? ssp[(size_t)t * 32 + lane] : 0.f;
    sp = wsum(sp);
    const float rs1 = rsqrtf(sp * (1.f / D) + EPS);
    const int id0 = IDX[(size_t)t * 128 + lane], id1 = IDX[(size_t)t * 128 + 64 + lane];
    ACT[(size_t)t * 128 + lane] = (_Float16)(gelu_erf(s0 * USC[id0] * (rs1 * (1.f / XS8))) * GATE[(size_t)t * 128 + lane] * VSC[id0]);
    ACT[(size_t)t * 128 + 64 + lane] = (_Float16)(gelu_erf(s1 * USC[id1] * (rs1 * (1.f / XS8))) * GATE[(size_t)t * 128 + 64 + lane] * VSC[id1]);
}

__device__ __forceinline__ void v_compute(const u32x4 (&w)[16], const LAS _Float16* avp, bf16_t* __restrict__ XBio, float* __restrict__ OUT32,
                                          float* __restrict__ SS16, int s, int t, int g, int c, int lane) {
    const size_t off = (size_t)t * D + s * SLW + c * 16 + 2 * g;
    const unsigned rw = *(const unsigned*)(XBio + off);
    const f32x2 res = {bflo(rw), bfhi(rw)};
    typedef _Float16 h8_t __attribute__((ext_vector_type(8)));
    const h8_t al = *(const LAS h8_t*)avp, ah8 = *(const LAS h8_t*)(avp + 8);
    h2_t hacc[8];
#pragma unroll
    for (int q = 0; q < 8; ++q) hacc[q] = (h2_t){(_Float16)0.f, (_Float16)0.f};
#pragma unroll
    for (int k = 0; k < 16; ++k) {
        const _Float16 ah = (k < 8) ? al[k & 7] : ah8[k & 7];
        const h2_t a2 = {ah, ah};
#pragma unroll
        for (int q = 0; q < 4; ++q) {
            const auto c0 = __builtin_amdgcn_cvt_scalef32_pk_f16_fp8((int)w[k][q], 1.0f, false), c1 = __builtin_amdgcn_cvt_scalef32_pk_f16_fp8((int)w[k][q], 1.0f, true);
            const h2_t w0 = {(_Float16)c0[0], (_Float16)c0[1]}, w1 = {(_Float16)c1[0], (_Float16)c1[1]};
            hacc[2 * q] = __builtin_elementwise_fma(a2, w0, hacc[2 * q]);
            hacc[2 * q + 1] = __builtin_elementwise_fma(a2, w1, hacc[2 * q + 1]);
        }
    }
    f32x2 acc[8];
#pragma unroll
    for (int q = 0; q < 8; ++q) acc[q] = (f32x2){(float)hacc[q][0], (float)hacc[q][1]};
    f32x2 h4[4];
#pragma unroll
    for (int q = 0; q < 4; ++q) {
        const auto sx = __builtin_amdgcn_permlane32_swap(__float_as_uint(acc[q].x), __float_as_uint(acc[4 + q].x), false, false);
        const auto sy = __builtin_amdgcn_permlane32_swap(__float_as_uint(acc[q].y), __float_as_uint(acc[4 + q].y), false, false);
        h4[q] = (f32x2){__uint_as_float(sx[0]) + __uint_as_float(sx[1]), __uint_as_float(sy[0]) + __uint_as_float(sy[1])};
    }
    f32x2 h2[2];
#pragma unroll
    for (int q = 0; q < 2; ++q) {
        const auto sx = __builtin_amdgcn_permlane16_swap(__float_as_uint(h4[q].x), __float_as_uint(h4[2 + q].x), false, false);
        const auto sy = __builtin_amdgcn_permlane16_swap(__float_as_uint(h4[q].y), __float_as_uint(h4[2 + q].y), false, false);
        h2[q] = (f32x2){__uint_as_float(sx[0]) + __uint_as_float(sx[1]), __uint_as_float(sy[0]) + __uint_as_float(sy[1])};
    }
    const bool up = (g & 1) != 0;
    const f32x2 keep = up ? h2[1] : h2[0], send = up ? h2[0] : h2[1];
    f32x2 o = {keep.x + dppf<DPP_ROR8>(send.x) + res.x, keep.y + dppf<DPP_ROR8>(send.y) + res.y};
    if (OUT32) *(f32x2*)(OUT32 + off) = o;
    else { const unsigned ow = pk2(o.x, o.y); *(unsigned*)(XBio + off) = ow; o = (f32x2){bflo(ow), bfhi(ow)}; }
    const float q2 = wsum(o.x * o.x + o.y * o.y);
    if (lane == 0) SS16[(size_t)t * 16 + s] = q2;
}
constexpr int PLV_ACT = TBLK * 128 * 4;
struct VStage { u32x4 id[8]; u32x4 a[4]; };
__device__ __forceinline__ void v_stage_load(VStage& r, int tb, const _Float16* __restrict__ ACT, const int* __restrict__ IDX, int tid) {
    const u32x4* src = (const u32x4*)(IDX + (size_t)tb * TBLK * 128);
    const u32x4* srca = (const u32x4*)(ACT + (size_t)tb * TBLK * 128);
#pragma unroll
    for (int j = 0; j < 8; ++j) r.id[j] = src[tid + j * NTHR];
#pragma unroll
    for (int j = 0; j < 4; ++j) r.a[j] = srca[tid + j * NTHR];
}
__device__ __forceinline__ void v_stage_store(const VStage& r, LAS unsigned char* lds, int tid) {
#pragma unroll
    for (int j = 0; j < 8; ++j) *(LAS u32x4*)(lds + PL_IDX + (size_t)(tid + j * NTHR) * 16) = r.id[j];
#pragma unroll
    for (int j = 0; j < 4; ++j) *(LAS u32x4*)(lds + PLV_ACT + (size_t)(tid + j * NTHR) * 16) = r.a[j];
}
__device__ __forceinline__ void peer_v_run(int s, int tb, const unsigned char* __restrict__ V8, bf16_t* __restrict__ XBio, float* __restrict__ OUT32, float* __restrict__ SS16,
                                           LAS unsigned char* lds, int wave, int lane) {
    const int g = lane >> 3, c = lane & 7;
    const rsrc_t rs = make_rsrc(V8, (unsigned)((size_t)NE * D));
    const int soff = s * NE * SLW;
    constexpr int NTW = TBLK / NWAVES;
    const int tw = wave * NTW, t0 = tb * TBLK + tw;
    const LAS unsigned char* idb = lds + PL_IDX + (size_t)tw * 512 + g * 64;
    const LAS _Float16* avb = (const LAS _Float16*)(lds + PLV_ACT + (size_t)tw * 256) + g * 16;
    u32x4 wa[16], wb[16];
    PEER_ISSUE(wa, idb);
#pragma unroll 1
    for (int i = 0; i < NTW; i += 2) {
        PEER_ISSUE(wb, idb + (i + 1) * 512);
        v_compute(wa, avb + i * 128, XBio, OUT32, SS16, s, t0 + i, g, c, lane);
        PEER_ISSUE(wa, idb + min(i + 2, NTW - 1) * 512);
        v_compute(wb, avb + (i + 1) * 128, XBio, OUT32, SS16, s, t0 + i + 1, g, c, lane);
    }
}
__device__ __forceinline__ void peer_v_block(int s, int tb, const _Float16* __restrict__ ACT, const int* __restrict__ IDX, const unsigned char* __restrict__ V8,
                                             bf16_t* __restrict__ XBio, float* __restrict__ OUT32, float* __restrict__ SS16,
                                             LAS unsigned char* lds, int tid, int wave, int lane) {
    VStage r; v_stage_load(r, tb, ACT, IDX, tid); v_stage_store(r, lds, tid);
    __syncthreads();
    peer_v_run(s, tb, V8, XBio, OUT32, SS16, lds, wave, lane);
}

__device__ __forceinline__ int slice_of(int xcc, int j) { const int xx = (xcc + (j >> 1)) & 7; return xx + 8 * (j & 1); }

__device__ __forceinline__ void final_norm_row(const bf16_t* __restrict__ xrow, float* __restrict__ orow, const float* __restrict__ ss16, const float* __restrict__ g, int lane) {
    float sp = (lane < 16) ? ss16[lane] : 0.f;
    sp = wsum(sp);
    const float rf = rsqrtf(sp * (1.f / D) + EPS);
    const u32x2* xi = (const u32x2*)xrow + lane;
    f32x4* o = (f32x4*)orow + lane;
    const f32x4* g4 = (const f32x4*)g + lane;
    u32x2 xv[8];
#pragma unroll
    for (int j = 0; j < 8; ++j) xv[j] = xi[64 * j];
#pragma unroll
    for (int j = 0; j < 8; ++j) { const f32x4 gg = g4[64 * j]; f32x4 v = {bflo(xv[j].x), bfhi(xv[j].x), bflo(xv[j].y), bfhi(xv[j].y)}; v = v * rf * gg; o[64 * j] = v; }
}
}

namespace mk {
#define IN(k) (lo <= (k) && (k) < hi)
#define GSYNC() do { if (coop) xcd_barrier(xb); } while (0)
template <int l>
__device__ __forceinline__ void layer_body(const Params& p, LAS unsigned char* lds, unsigned char* ws, int G, int tid, int lane, int wave, int lo, int hi, bool coop, const XcdBarrier& xb) {

    if (IN(1)) _Pragma("unroll") for (int rep = 0; rep < REP1; ++rep) {
        pg8::Gemm g{(const bf16_t*)(ws + WS_XB), (const bf16_t*)(ws + WS_WINT) + (size_t)l * NP * D, T, NP, D};
        pg8::StaticOrder So; So.init(T, NP, G, (int)blockIdx.x);
        EpiScaleBf16<16> E{(bf16_t*)(ws + WS_P), NP, (const float*)(ws + WS_SS)};
        pg8::gemm_phase<EpiScaleBf16<16>, pg8::StaticOrder, true, true>(lds, g, So, E);
        GSYNC();
    }
    if (IN(2)) _Pragma("unroll") for (int rep = 0; rep < REP2; ++rep) {
        for (int u = blockIdx.x; u < 256; u += G) {
            int tq_ = tid; asm volatile("" : "+v"(tq_)); const int tid = tq_, lane = tq_ & 63, wave = __builtin_amdgcn_readfirstlane(tq_ >> 6);
            if (u < 128) hgrn_unit<1>((const bf16_t*)(ws + WS_P), p.in[5], l, nullptr, (float*)(ws + WS_STH), nullptr, u, lds, tid, lane, wave);
            else mlstm_unit<1>((const bf16_t*)(ws + WS_P), p.in[7] + (size_t)l * 4 * 1024, p.in[8] + l * 4, p.in[9] + l * 4, (float*)(ws + WS_STM), nullptr, u - 128, lds, tid, lane, wave);
            __syncthreads();
        }
        GSYNC();
    }
    if (IN(3)) {

        _Pragma("unroll") for (int rr = 0; rr < (REP7 > 1 ? 2 : 1); ++rr)
        for (int u = blockIdx.x; u < 256; u += G) {
            if (rr == 1 && REP7 == 2 && u >= 128) continue;
            if (rr == 1 && REP7 == 3 && u < 128) continue;
            int tq_ = tid; asm volatile("" : "+v"(tq_)); const int tid = tq_, lane = tq_ & 63, wave = __builtin_amdgcn_readfirstlane(tq_ >> 6);
            if (u < 128) hgrn_unit<2>((const bf16_t*)(ws + WS_P), p.in[5], l, p.in[6] + l * 512, (float*)(ws + WS_STH), (bf16_t*)(ws + WS_YB), u, lds, tid, lane, wave);
            else mlstm_unit<2>((const bf16_t*)(ws + WS_P), p.in[7] + (size_t)l * 4 * 1024, p.in[8] + l * 4, p.in[9] + l * 4, (float*)(ws + WS_STM), (bf16_t*)(ws + WS_YB), u - 128, lds, tid, lane, wave);
            __syncthreads();
        }
        _Pragma("unroll") for (int rep = 0; rep < REP3; ++rep)
        for (int u = blockIdx.x; u < 256; u += G) {
            int tq_ = tid; asm volatile("" : "+v"(tq_)); const int tid = tq_, lane = tq_ & 63, wave = __builtin_amdgcn_readfirstlane(tq_ >> 6);
            attn_unit((const bf16_t*)(ws + WS_P), (const f32x2*)(ws + WS_ROPE), p.in[4] + l * 16, (bf16_t*)(ws + WS_YB), u, lds, tid, lane, wave);
            __syncthreads();
        }
        GSYNC();
    }
    if (IN(4)) _Pragma("unroll") for (int rep = 0; rep < REP4; ++rep) {
        pg8::Gemm g{(const bf16_t*)(ws + WS_YB), (const bf16_t*)(ws + WS_WOUTT) + (size_t)l * D * D, T, D, D};
        pg8::StaticOrder So; So.init(T, D, G, (int)blockIdx.x);
        EpiX1 E{l == 0 ? p.in[0] : (const float*)nullptr, (bf16_t*)(ws + WS_XB), (float*)(ws + WS_SSP)};
        pg8::gemm_phase<EpiX1, pg8::StaticOrder, true, true>(lds, g, So, E);
        GSYNC();
    }
    if (IN(5)) _Pragma("unroll") for (int rep = 0; rep < REP5; ++rep) {
        pg8::Gemm g{(const bf16_t*)(ws + WS_XB), (const bf16_t*)(ws + WS_WQT) + (size_t)l * D * D, T, D, D};
        pg8::StaticOrder So; So.init(T, D, G, (int)blockIdx.x);
        EpiScaleBf16<32> E{(bf16_t*)(ws + WS_Q), D, (const float*)(ws + WS_SSP)};
        pg8::gemm_phase<EpiScaleBf16<32>, pg8::StaticOrder, true, true>(lds, g, So, E);
        pg8::Unit u;
        for (int i = 0; So.next(i, u); ++i)
            route_unit((const bf16_t*)(ws + WS_Q), (const bf16_t*)(ws + WS_SUBK) + (size_t)l * 2 * 8 * 128 * 128, u.pm, u.pn, (int*)(ws + WS_IDX), (int*)(ws + WS_IDXU), (float*)(ws + WS_GATE), lds, tid, wave, lane);
        GSYNC();
    }
    if (IN(6)) {

        LAS int* slot = (LAS int*)(lds + LDS_BYTES - 32);
        if (G == 256) {
            const int grp = (int)blockIdx.x & 7, rank = (int)blockIdx.x >> 3;
            _Pragma("unroll") for (int rr = 0; rr < REP6; ++rr) {
            UStage st; u_stage_load(st, grp, rank * 4, (const bf16_t*)(ws + WS_XB), (const int*)(ws + WS_IDX), tid);
            for (int j = 0; j < 8; ++j) {
                const int s = grp + 8 * (j >> 2), tb = rank * 4 + (j & 3);
                __syncthreads();
                u_stage_store(st, lds, tid);
                __syncthreads();
                if (j < 7) u_stage_load(st, grp + 8 * ((j + 1) >> 2), rank * 4 + ((j + 1) & 3), (const bf16_t*)(ws + WS_XB), (const int*)(ws + WS_IDX), tid);
                peer_u_run<0>(s, tb, ws + WS_U8 + (size_t)l * NE * D, (float*)(ws + WS_PART), lds, wave, lane);
            }
            }
        } else {
            const int xcc = (int)xb_xcc_id();
            unsigned* qc = (unsigned*)(ws + WS_CTL) + CTL_Q + ((l * 2 + 0) * 2 + 0) * 16;
            for (int j = 0; j < NSLICE; ++j) {
                const int s = slice_of(xcc, j);
                for (;;) {
                    const int tb = q_next(qc + s, slot, tid);
                    if (tb < 0) break;
                    peer_u_block<0>(s, tb, (const bf16_t*)(ws + WS_XB), (const int*)(ws + WS_IDX), ws + WS_U8 + (size_t)l * NE * D, (float*)(ws + WS_PART), lds, tid, wave, lane);
                }
            }
        }
        GSYNC();
    }
    if (IN(7)) {

        const int gw = blockIdx.x * NWAVES + wave, ngw = G * NWAVES;
        for (int t = gw; t < T; t += ngw)
            peer_act_token(t, (const float*)(ws + WS_PART), (const float*)(ws + WS_SSP), (const int*)(ws + WS_IDX), (const float*)(ws + WS_GATE),
                           (const float*)(ws + WS_USC) + l * NE, (const float*)(ws + WS_VSC) + l * NE, (_Float16*)(ws + WS_ACT), lane);
        GSYNC();
    }
    if (IN(8)) {

        LAS int* slot = (LAS int*)(lds + LDS_BYTES - 32);
        if (G == 256) {
            const int grp = (int)blockIdx.x & 7, rank = (int)blockIdx.x >> 3;
            VStage st; v_stage_load(st, rank * 4, (const _Float16*)(ws + WS_ACT), (const int*)(ws + WS_IDX), tid);
            for (int j = 0; j < 8; ++j) {
                const int s = grp + 8 * (j >> 2), tb = rank * 4 + (j & 3);
                __syncthreads();
                v_stage_store(st, lds, tid);
                __syncthreads();
                if (j < 7) v_stage_load(st, rank * 4 + ((j + 1) & 3), (const _Float16*)(ws + WS_ACT), (const int*)(ws + WS_IDX), tid);
                peer_v_run(s, tb, ws + WS_V8 + (size_t)l * NE * D, (bf16_t*)(ws + WS_XB), (float*)nullptr, (float*)(ws + WS_SS), lds, wave, lane);
            }
        } else {
            const int xcc = (int)xb_xcc_id();
            unsigned* qc = (unsigned*)(ws + WS_CTL) + CTL_Q + ((l * 2 + 1) * 2 + 0) * 16;
            for (int j = 0; j < NSLICE; ++j) {
                const int s = slice_of(xcc, j);
                for (;;) {
                    const int tb = q_next(qc + s, slot, tid);
                    if (tb < 0) break;
                    peer_v_block(s, tb, (const _Float16*)(ws + WS_ACT), (const int*)(ws + WS_IDX), ws + WS_V8 + (size_t)l * NE * D, (bf16_t*)(ws + WS_XB),
                                 (float*)nullptr, (float*)(ws + WS_SS), lds, tid, wave, lane);
                }
            }
        }
    }
    if (l == 1 && IN(9)) {
        GSYNC();
        const int gw = blockIdx.x * NWAVES + wave, ngw = G * NWAVES;
        for (int t = gw; t < T; t += ngw) final_norm_row((const bf16_t*)(ws + WS_XB) + (size_t)t * D, p.out + (size_t)t * D, (const float*)(ws + WS_SS) + (size_t)t * 16, p.in[15], lane);
    }
}
__global__ void __launch_bounds__(NTHR, 2) mega(Params p) {
    extern __shared__ __attribute__((aligned(16))) unsigned char lds_raw[];
    LAS unsigned char* lds = (LAS unsigned char*)lds_raw;
    unsigned char* ws = p.ws;
    const int G = gridDim.x;
    const int tid = threadIdx.x, lane = tid & 63, wave = __builtin_amdgcn_readfirstlane(tid >> 6);
    const int lo = p.ph_lo, hi = p.ph_hi;
    const bool coop = p.pad != 0;
    volatile LAS unsigned* xst = (volatile LAS unsigned*)(lds + LDS_BYTES - 16);
    if (tid < 4) xst[tid] = 0u;
    __syncthreads();
    XcdBarrier xb; xb.bar = (unsigned*)(ws + WS_CTL); xb.x = 0; xb.st = xst;
    if (coop) xb = xcd_barrier_post((unsigned*)(ws + WS_CTL), xst);
    if (IN(0)) { p0_prologue(p, lds); if (REP0 > 1) { if (coop) xcd_barrier(xb); p0_prologue(p, lds, REP0); } if (coop) cooperative_groups::this_grid().sync(); }
    if (p.layer <= 0 && 0 < p.layer_hi) { layer_body<0>(p, lds, ws, G, tid, lane, wave, lo, hi, coop, xb); if (1 < p.layer_hi) GSYNC(); }
    if (p.layer <= 1 && 1 < p.layer_hi) layer_body<1>(p, lds, ws, G, tid, lane, wave, lo, hi, coop, xb);

#undef IN
#undef GSYNC
}
__global__ __launch_bounds__(256) void shim_xprep_kernel(const float* __restrict__ X, bf16_t* __restrict__ XB, float* __restrict__ SS) {
    const int t = blockIdx.x * 4 + (threadIdx.x >> 6), lane = threadIdx.x & 63;
    xprep_row(X + (size_t)t * D, XB + (size_t)t * D, SS + t, lane);
}
}

extern "C" void kernel_launch(void* const* d_in, const int* in_sizes, int n_in, void* d_out, int out_size, void* d_ws, size_t ws_size, hipStream_t stream) {
    using namespace mk;
    static int grid = 0;
    if (grid == 0) {
        int dev = 0, cus = 0, per_cu = 0;
        (void)hipGetDevice(&dev); (void)hipDeviceGetAttribute(&cus, hipDeviceAttributeMultiprocessorCount, dev);
        if (hipFuncSetAttribute((const void*)mega, hipFuncAttributeMaxDynamicSharedMemorySize, LDS_BYTES) != hipSuccess) { fprintf(stderr, "kernel_launch: hipFuncSetAttribute failed\n"); grid = -1; return; }
        if (ws_size < WS_END) { fprintf(stderr, "kernel_launch: workspace too small: need %zu have %zu\n", (size_t)WS_END, ws_size); grid = -1; return; }
        if (hipOccupancyMaxActiveBlocksPerMultiprocessor(&per_cu, (const void*)mega, NTHR, LDS_BYTES) != hipSuccess || per_cu < 1) { fprintf(stderr, "kernel_launch: occupancy query says %d blocks per CU\n", per_cu); grid = -1; return; }
        grid = cus;
    }
    if (grid < 0) return;
    Params p{};
    for (int i = 0; i < 16; ++i) p.in[i] = (const float*)d_in[i];
    p.out = (float*)d_out; p.ws = (unsigned char*)d_ws;
    p.ph_lo = 0; p.ph_hi = 10; p.layer = 0; p.layer_hi = 2; p.pad = 1; p.pad2 = 0;
    if (hipMemsetAsync(d_ws, 0, 16384, stream) != hipSuccess) { fprintf(stderr, "kernel_launch: memset failed\n"); return; }
    void* args[] = {&p};
    hipError_t e = hipLaunchCooperativeKernel((const void*)mega, dim3(grid), dim3(NTHR), args, LDS_BYTES, stream);
    if (e != hipSuccess) fprintf(stderr, "kernel_launch: cooperative launch failed: %s (grid %d)\n", hipGetErrorString(e), grid);
}
```

```cpp
#include <hip/hip_runtime.h>
#include <hip/hip_cooperative_groups.h>
#include <math.h>
#include <stdio.h>
#include <stdint.h>
namespace pg8 {
#define PG8_LAS __attribute__((address_space(3)))
typedef unsigned short bf16_t;
typedef short bf16x8 __attribute__((ext_vector_type(8)));
typedef float f32x4 __attribute__((ext_vector_type(4)));
typedef unsigned u32x4 __attribute__((ext_vector_type(4)));
constexpr int BM = 256, BK = 64, HALF = 128, HTB = HALF * BK * 2  , STAGE_BYTES = 8 * HTB, NXCD = 8, WGM = 8;

__host__ __device__ __forceinline__ int lds_byte(int r, int c) { const int st = (r >> 4) * 2 + (c >> 5), rr = r & 15, cc = c & 31, ob = rr * 64 + cc * 2; return st * 1024 + (ob ^ (((ob >> 9) & 1) << 5)); }
__host__ __device__ __forceinline__ void stage_rc(int b, int& R, int& C) { const int st = b / 1024, sb = b % 1024, swz = sb ^ (((sb >> 9) & 1) << 5); R = (st >> 1) * 16 + swz / 64; C = (st & 1) * 32 + (swz % 64) / 2; }
__host__ __device__ __forceinline__ int perm32(int rho) { const int n = rho >> 4, i = rho & 15; return 8 * (i >> 2) + 4 * n + (i & 3); }

struct Unit { int pm, pn; };
struct Gemm { const bf16_t* A; const bf16_t* Bt; int M, N, K; };

struct StaticOrder {
    int nM, nN, nwg, G, c;
    __host__ __device__ void init(int M, int N, int G_, int c_) { nM = M / BM; nN = N / BM; nwg = nM * nN; G = G_; c = c_; }
    __host__ __device__ bool next(int i, Unit& u) const {
        const long L = (long)i * G + c; if (L >= nwg) return false;
        int wgid = (int)L; { const int q = nwg / NXCD, r = nwg % NXCD, xcd = wgid % NXCD, off = wgid / NXCD; wgid = (xcd < r ? xcd * (q + 1) : r * (q + 1) + (xcd - r) * q) + off; }
        const int nig = WGM * nN, gid = wgid / nig, fm = gid * WGM, gsz = (nM - fm) < WGM ? (nM - fm) : WGM;
        u.pm = fm + ((wgid % nig) % gsz); u.pn = (wgid % nig) / gsz; return true;
    }
    __device__ __forceinline__ void a_ready(const Unit&) const {}
    __device__ __forceinline__ void done(const Unit&) const {}
};

template <class Epi, class Sched, bool ALIGN_EPI = false, bool SP2 = false>
__device__ __forceinline__ void gemm_phase(PG8_LAS unsigned char* lds, const Gemm g, const Sched& S, const Epi& E) {
    const int tid = threadIdx.x, wid = __builtin_amdgcn_readfirstlane(tid >> 6), lane = tid & 63, wr = wid >> 2, wc = wid & 3, fr = lane & 15, fq = lane >> 4;
    const int K = g.K, nt = K / BK;
    unsigned voffA[2], voffB[2];
#pragma unroll
    for (int i = 0; i < 2; ++i) { int R, C; stage_rc(tid * 16 + i * 8192, R, C); const int Rb = Epi::PERM ? ((R & ~31) + perm32(R & 31)) : R;
        voffA[i] = (unsigned)(R * K + C) * 2u; voffB[i] = (unsigned)(Rb * K + C) * 2u; }
    const size_t kstep = (size_t)(BK * 2);
    const size_t hstep = (size_t)HALF * K * 2;
    const size_t tstep = 2 * hstep;
    const unsigned ldsw = (unsigned)wid * 1024u;
    const int aoff = lds_byte(wr * 64 + fr, fq * 8), boff = lds_byte(wc * 32 + fr, fq * 8);
#define PG8_SA(b, h) (((b) * 2 + (h)) * HTB)
#define PG8_SB(b, h) ((4 + (b) * 2 + (h)) * HTB)
#define PG8_STAGE(bufoff, gbase, voff) do { _Pragma("unroll") for (int _i = 0; _i < 2; ++_i) \
        __builtin_amdgcn_global_load_lds((const unsigned*)((const char*)(gbase) + (voff)[_i]), (PG8_LAS unsigned*)(lds + (bufoff) + ldsw + _i * 8192), 16, 0, 0); } while (0)
#define PG8_LDA(dst, b, h) do { _Pragma("unroll") for (int m = 0; m < 4; ++m) _Pragma("unroll") for (int k = 0; k < 2; ++k) dst[m][k] = *(const PG8_LAS bf16x8*)(lds + PG8_SA(b, h) + aoff + m * 2048 + k * 1024); } while (0)
#define PG8_LDB(dst, b, h) do { _Pragma("unroll") for (int n = 0; n < 2; ++n) _Pragma("unroll") for (int k = 0; k < 2; ++k) dst[n][k] = *(const PG8_LAS bf16x8*)(lds + PG8_SB(b, h) + boff + n * 2048 + k * 1024); } while (0)
#define PG8_MMA(ai, bj, At, Bt) do { __builtin_amdgcn_s_setprio(1); _Pragma("unroll") for (int m = 0; m < 4; ++m) _Pragma("unroll") for (int n = 0; n < 2; ++n) _Pragma("unroll") for (int k = 0; k < 2; ++k) \
        acc[ai][bj][m][n] = __builtin_amdgcn_mfma_f32_16x16x32_bf16(Bt[n][k], At[m][k], acc[ai][bj][m][n], 0, 0, 0); __builtin_amdgcn_s_setprio(0); } while (0)
#define PG8_WAIT_V(n) asm volatile("s_waitcnt vmcnt(" #n ")" ::: "memory")
#define PG8_WAIT_L(n) asm volatile("s_waitcnt lgkmcnt(" #n ")" ::: "memory")
#define PG8_BAR __builtin_amdgcn_s_barrier()
#define PG8_SCHED __builtin_amdgcn_sched_barrier(0)
    Unit cur, nxt; int ui = 0;
    if (!S.next(0, cur)) return;
    f32x4 acc[2][2][4][2];
#pragma unroll
    for (int a = 0; a < 2; ++a)
#pragma unroll
        for (int b = 0; b < 2; ++b)
#pragma unroll
            for (int m = 0; m < 4; ++m)
#pragma unroll
                for (int n = 0; n < 2; ++n) acc[a][b][m][n] = (f32x4){0.f, 0.f, 0.f, 0.f};
    bf16x8 At[4][2], B0[2][2], B1[2][2];
    const char* cA = (const char*)g.A + (size_t)cur.pm * tstep; const char* cB = (const char*)g.Bt + (size_t)cur.pn * tstep;
    S.a_ready(cur);
    if constexpr (SP2) {
        PG8_STAGE(PG8_SB(0, 0), cB, voffB); PG8_STAGE(PG8_SB(0, 1), cB + hstep, voffB); PG8_STAGE(PG8_SA(0, 0), cA, voffA); PG8_STAGE(PG8_SA(0, 1), cA + hstep, voffA);
        if (wr == 1) PG8_BAR;
        PG8_WAIT_V(2); PG8_BAR;
        PG8_STAGE(PG8_SB(1, 0), cB + kstep, voffB); PG8_STAGE(PG8_SA(1, 0), cA + kstep, voffA); PG8_STAGE(PG8_SB(1, 1), cB + hstep + kstep, voffB);
        PG8_WAIT_V(6); PG8_BAR;
    } else {
        PG8_STAGE(PG8_SB(0, 0), cB, voffB); PG8_STAGE(PG8_SA(0, 0), cA, voffA); PG8_STAGE(PG8_SB(0, 1), cB + hstep, voffB); PG8_STAGE(PG8_SA(0, 1), cA + hstep, voffA);
        if (wr == 1) PG8_BAR;
        PG8_WAIT_V(4); PG8_BAR;
        PG8_STAGE(PG8_SB(1, 0), cB + kstep, voffB); PG8_STAGE(PG8_SA(1, 0), cA + kstep, voffA); PG8_STAGE(PG8_SB(1, 1), cB + hstep + kstep, voffB);
        PG8_WAIT_V(6); PG8_BAR;
    }
    for (;;) {
        const bool has_next = S.next(ui + 1, nxt);
        const char* nA = has_next ? (const char*)g.A + (size_t)nxt.pm * tstep : cA; const char* nB = has_next ? (const char*)g.Bt + (size_t)nxt.pn * tstep : cB;
        for (int t = 0; t < nt; t += 2) {
            const bool last = (t == nt - 2);
            const char* a1 = cA + (size_t)(t + 1) * kstep;
            const char* a2 = last ? nA : cA + (size_t)(t + 2) * kstep; const char* b2 = last ? nB : cB + (size_t)(t + 2) * kstep;
            const char* a3 = a2 + kstep; const char* b3 = b2 + kstep;
            if (last && has_next) S.a_ready(nxt);
            if constexpr (SP2) {
            PG8_LDB(B0, 0, 0); PG8_LDB(B1, 0, 1); PG8_SCHED; PG8_LDA(At, 0, 0); PG8_STAGE(PG8_SA(1, 1), a1 + hstep, voffA);
            PG8_WAIT_V(8); PG8_WAIT_L(0); PG8_BAR; PG8_MMA(0, 0, At, B0); PG8_MMA(0, 1, At, B1); PG8_BAR; PG8_SCHED;
            PG8_LDA(At, 0, 1); PG8_STAGE(PG8_SB(0, 0), b2, voffB); PG8_STAGE(PG8_SB(0, 1), b2 + hstep, voffB); PG8_STAGE(PG8_SA(0, 0), a2, voffA);
            PG8_WAIT_V(8); PG8_WAIT_L(0); PG8_BAR; PG8_MMA(1, 0, At, B0); PG8_MMA(1, 1, At, B1); PG8_BAR; PG8_SCHED;
            PG8_LDB(B0, 1, 0); PG8_LDB(B1, 1, 1); PG8_SCHED; PG8_LDA(At, 1, 0); PG8_STAGE(PG8_SA(0, 1), a2 + hstep, voffA);
            PG8_WAIT_V(8); PG8_WAIT_L(0); PG8_BAR; PG8_MMA(0, 0, At, B0); PG8_MMA(0, 1, At, B1); PG8_BAR; PG8_SCHED;
            PG8_LDA(At, 1, 1); PG8_STAGE(PG8_SB(1, 0), b3, voffB); PG8_STAGE(PG8_SB(1, 1), b3 + hstep, voffB); PG8_STAGE(PG8_SA(1, 0), a3, voffA);
            PG8_WAIT_V(8); PG8_WAIT_L(0); PG8_BAR; PG8_MMA(1, 0, At, B0); PG8_MMA(1, 1, At, B1); PG8_BAR; PG8_SCHED;
            } else {
            PG8_LDB(B0, 0, 0); PG8_SCHED; PG8_LDA(At, 0, 0); PG8_STAGE(PG8_SA(1, 1), a1 + hstep, voffA);
            PG8_WAIT_L(8); PG8_BAR; PG8_WAIT_L(0); PG8_MMA(0, 0, At, B0); PG8_BAR; PG8_SCHED;
            PG8_LDB(B1, 0, 1); PG8_STAGE(PG8_SB(0, 0), b2, voffB);
            PG8_BAR; PG8_WAIT_L(0); PG8_MMA(0, 1, At, B1); PG8_BAR;
            PG8_LDA(At, 0, 1); PG8_STAGE(PG8_SA(0, 0), a2, voffA);
            PG8_BAR; PG8_WAIT_L(0); PG8_MMA(1, 0, At, B0); PG8_BAR; PG8_SCHED;
            PG8_STAGE(PG8_SB(0, 1), b2 + hstep, voffB);
            PG8_WAIT_V(6); PG8_BAR; PG8_MMA(1, 1, At, B1); PG8_BAR;
            PG8_LDB(B0, 1, 0); PG8_SCHED; PG8_LDA(At, 1, 0); PG8_STAGE(PG8_SA(0, 1), a2 + hstep, voffA);
            PG8_WAIT_L(8); PG8_BAR; PG8_WAIT_L(0); PG8_MMA(0, 0, At, B0); PG8_BAR; PG8_SCHED;
            PG8_LDB(B1, 1, 1); PG8_STAGE(PG8_SB(1, 0), b3, voffB);
            PG8_BAR; PG8_WAIT_L(0); PG8_MMA(0, 1, At, B1); PG8_BAR;
            PG8_LDA(At, 1, 1); PG8_STAGE(PG8_SA(1, 0), a3, voffA);
            PG8_BAR; PG8_WAIT_L(0); PG8_MMA(1, 0, At, B0); PG8_BAR; PG8_SCHED;
            PG8_STAGE(PG8_SB(1, 1), b3 + hstep, voffB);
            PG8_WAIT_V(6); PG8_BAR; PG8_MMA(1, 1, At, B1); PG8_BAR;
            }
        }
        if constexpr (ALIGN_EPI) { if (wr == 0) PG8_BAR; }
        if constexpr (!Epi::AFTER_DRAIN) { E(acc, cur, wr, wc, fr, fq); S.done(cur); }
        if (!has_next) break;
#pragma unroll
        for (int a = 0; a < 2; ++a)
#pragma unroll
            for (int b = 0; b < 2; ++b)
#pragma unroll
                for (int m = 0; m < 4; ++m)
#pragma unroll
                    for (int n = 0; n < 2; ++n) acc[a][b][m][n] = (f32x4){0.f, 0.f, 0.f, 0.f};
        cur = nxt; cA = nA; cB = nB; ++ui;
        if constexpr (ALIGN_EPI) { if (wr == 1) PG8_BAR; }
    }
    PG8_WAIT_V(0);
    if constexpr (!ALIGN_EPI) { if (wr == 0) PG8_BAR; }
    PG8_BAR;
    if constexpr (Epi::AFTER_DRAIN) { E.fused(acc, cur, wr, wc, fr, fq, lds, wid, lane); S.done(cur); }
#undef PG8_SA
#undef PG8_SB
#undef PG8_STAGE
#undef PG8_LDA
#undef PG8_LDB
#undef PG8_MMA
#undef PG8_WAIT_V
#undef PG8_WAIT_L
#undef PG8_BAR
#undef PG8_SCHED
}
}
namespace mk {
#define LAS __attribute__((address_space(3)))
typedef unsigned short bf16_t;
typedef float f32x4 __attribute__((ext_vector_type(4)));
typedef float f32x2 __attribute__((ext_vector_type(2)));
typedef unsigned u32x4 __attribute__((ext_vector_type(4)));
typedef unsigned u32x2 __attribute__((ext_vector_type(2)));
typedef __bf16 bf16x2_t __attribute__((ext_vector_type(2)));
typedef short bf16x8 __attribute__((ext_vector_type(8)));
typedef short s16x4 __attribute__((ext_vector_type(4)));
constexpr int D = 2048, NB = 4, S = 4096, T = NB * S, IN_LD = 5384, NP = 5632, NE = 16384;
constexpr int NTHR = 512, NWAVES = 8;
constexpr int LDS_BYTES = 160 * 1024;
constexpr int LDS_SPARE = 128 * 1024;
constexpr float EPS = 1e-6f;
#ifndef REPS
#define REPS 1,1,1,1,1,1,1,1
#endif
constexpr int REPV[8] = {REPS};
constexpr int REP7 = REPV[7];
constexpr int REP0 = REPV[0], REP1 = REPV[1], REP2 = REPV[2], REP3 = REPV[3], REP4 = REPV[4], REP5 = REPV[5], REP6 = REPV[6];
constexpr int C_QA = 0, C_KA = 1024, C_VA = 1152, C_QH = 1280, C_FH = 1792, C_IH = 2304, C_GH = 2816, C_QM = 3328, C_KM = 3840, C_VM = 4352, C_OM = 4864, C_IM = 5376, C_FM = 5380;

constexpr size_t WS_CTL = 0;
constexpr size_t WS_WINT = 65536;
constexpr size_t WS_WOUTT = WS_WINT + 2 * (size_t)NP * D * 2;
constexpr size_t WS_WQT = WS_WOUTT + 2 * (size_t)D * D * 2;
constexpr size_t WS_SUBK = WS_WQT + 2 * (size_t)D * D * 2;
constexpr size_t WS_U8 = WS_SUBK + 2 * 2 * 8 * 128 * 128 * 2;
constexpr size_t WS_V8 = WS_U8 + 2 * (size_t)NE * D;
constexpr size_t WS_USC = WS_V8 + 2 * (size_t)NE * D;
constexpr size_t WS_VSC = WS_USC + 2 * (size_t)NE * 4;
constexpr size_t WS_ROPE = WS_VSC + 2 * (size_t)NE * 4;
constexpr size_t WS_SS = WS_ROPE + (size_t)S * 32 * 8;
constexpr size_t WS_SSP = WS_SS + (size_t)T * 16 * 4;
constexpr size_t WS_XB = WS_SSP + (size_t)T * 32 * 4;
constexpr size_t WS_P = WS_XB + (size_t)T * D * 2;
constexpr size_t WS_YB = WS_P + (size_t)T * NP * 2;
constexpr size_t WS_Q = WS_YB + (size_t)T * D * 2;
constexpr size_t WS_IDX = WS_Q + (size_t)T * D * 2;
constexpr size_t WS_GATE = WS_IDX + (size_t)T * 128 * 4;
constexpr size_t WS_X1 = WS_GATE + (size_t)T * 128 * 4;
constexpr size_t WS_X2 = WS_X1 + (size_t)T * D * 4;
constexpr size_t WS_IDXU = WS_X2 + (size_t)T * D * 4;
constexpr size_t WS_AMXP = WS_IDXU + (size_t)T * 128 * 4;
constexpr size_t WS_ASC = WS_AMXP + (size_t)T * 32 * 4;
constexpr size_t WS_STH = WS_ASC + (size_t)T * 4;
constexpr size_t WS_STM = WS_STH + (size_t)128 * 16640 * 4;
constexpr size_t WS_END = WS_STM + (size_t)128 * 16640 * 4;
constexpr size_t WS_PART = WS_P;
constexpr size_t WS_ACT = WS_Q;
static_assert((size_t)16 * T * 128 * 4 <= (size_t)T * NP * 2, "PART overlay");
static_assert(WS_END <= ((size_t)1 << 30), "workspace");
struct Params { const float* in[16]; float* out; unsigned char* ws; int ph_lo, ph_hi, layer, layer_hi, pad, pad2; };

__device__ __forceinline__ unsigned pk2(float lo, float hi) { f32x2 v = {lo, hi}; bf16x2_t b = __builtin_convertvector(v, bf16x2_t); return __builtin_bit_cast(unsigned, b); }
__device__ __forceinline__ float bf2f(unsigned short h) { return __uint_as_float((unsigned)h << 16); }
__device__ __forceinline__ float bflo(unsigned w) { return __uint_as_float(w << 16); }
__device__ __forceinline__ float bfhi(unsigned w) { return __uint_as_float(w & 0xffff0000u); }
__device__ __forceinline__ float wsum(float v) {
#pragma unroll
    for (int o = 1; o < 64; o <<= 1) v += __shfl_xor(v, o);
    return v;
}
template <int CTRL> __device__ __forceinline__ float dppf(float x) { return __builtin_bit_cast(float, __builtin_amdgcn_mov_dpp(__builtin_bit_cast(int, x), CTRL, 0xf, 0xf, true)); }
constexpr int DPP_XOR1 = 0xB1, DPP_XOR2 = 0x4E, DPP_HMIR = 0x141, DPP_ROR8 = 0x128;
__device__ __forceinline__ float sum8(float v) { v += dppf<DPP_XOR1>(v); v += dppf<DPP_XOR2>(v); v += dppf<DPP_HMIR>(v); return v; }
__device__ __forceinline__ float sum16(float v) { v = sum8(v); v += dppf<DPP_ROR8>(v); return v; }
__device__ __forceinline__ float wmax(float v) {
#pragma unroll
    for (int o = 1; o < 64; o <<= 1) v = fmaxf(v, __shfl_xor(v, o));
    return v;
}

__device__ __forceinline__ void transpose_item(const float* __restrict__ W, int ldw, int nvalid, const float* __restrict__ gain, bf16_t* __restrict__ WT, int K, int k0, int n0, LAS float* scr, int lane) {
    const int n = n0 + (lane & 31);
    float vv[32];
#pragma unroll
    for (int i = 0; i < 32; ++i) {
        const int kk = 2 * i + (lane >> 5);
        float v = 0.f;
        if (n < nvalid) v = W[(size_t)(k0 + kk) * ldw + n];
        vv[i] = v;
    }
#pragma unroll
    for (int i = 0; i < 32; ++i) {
        const int kk = 2 * i + (lane >> 5);
        float v = vv[i];
        if (gain) v *= gain[k0 + kk];
        scr[kk * 33 + (lane & 31)] = v;
    }
    __builtin_amdgcn_s_waitcnt(0xc07f);
    asm volatile("" ::: "memory");
    const int c = lane & 7;
#pragma unroll
    for (int j = 0; j < 4; ++j) {
        const int nn = (lane >> 3) + 8 * j;
        const LAS float* s = scr + (8 * c) * 33 + nn;
        u32x4 o; o.x = pk2(s[0 * 33], s[1 * 33]); o.y = pk2(s[2 * 33], s[3 * 33]); o.z = pk2(s[4 * 33], s[5 * 33]); o.w = pk2(s[6 * 33], s[7 * 33]);
        *(u32x4*)(WT + (size_t)(n0 + nn) * K + k0 + 8 * c) = o;
    }
    __builtin_amdgcn_s_waitcnt(0xc07f);
    asm volatile("" ::: "memory");
}
__device__ __forceinline__ void xprep_row(const float* __restrict__ xrow, bf16_t* __restrict__ orow, float* __restrict__ ss, int lane) {
    const f32x4* xr = (const f32x4*)xrow + lane;
    f32x4 v[8]; float s = 0.f;
#pragma unroll
    for (int j = 0; j < 8; ++j) { v[j] = xr[64 * j]; s += (v[j].x * v[j].x + v[j].y * v[j].y) + (v[j].z * v[j].z + v[j].w * v[j].w); }
    s = wsum(s);
    u32x2* o = (u32x2*)orow + lane;
#pragma unroll
    for (int j = 0; j < 8; ++j) { u32x2 w; w.x = pk2(v[j].x, v[j].y); w.y = pk2(v[j].z, v[j].w); o[64 * j] = w; }
    if (lane < 16) ss[lane] = (lane == 0) ? s : 0.f;
}
template <int NR, bool INT8>
__device__ __forceinline__ void fp8_rows(const float* __restrict__ src, const float* __restrict__ gain, unsigned char* __restrict__ dst, float* __restrict__ sc, int lane) {
    f32x4 v[NR][8]; float am[NR];
#pragma unroll
    for (int r = 0; r < NR; ++r)
#pragma unroll
        for (int i = 0; i < 8; ++i) v[r][i] = *(const f32x4*)(src + (size_t)r * D + 256 * i + 4 * lane);
#pragma unroll
    for (int r = 0; r < NR; ++r) am[r] = 0.f;
#pragma unroll
    for (int i = 0; i < 8; ++i) {
        f32x4 gg = {1.f, 1.f, 1.f, 1.f};
        if (gain) gg = *(const f32x4*)(gain + 256 * i + 4 * lane);
#pragma unroll
        for (int r = 0; r < NR; ++r) {
            if (gain) v[r][i] = v[r][i] * gg;
            const f32x4 a = v[r][i];
            am[r] = fmaxf(am[r], fmaxf(fmaxf(fabsf(a.x), fabsf(a.y)), fmaxf(fabsf(a.z), fabsf(a.w))));
        }
    }
#pragma unroll
    for (int r = 0; r < NR; ++r) am[r] = wmax(am[r]);
#pragma unroll
    for (int r = 0; r < NR; ++r) {
        const float qmax = INT8 ? 127.f : 256.f;
        const float qs = am[r] > 0.f ? qmax / am[r] : 1.f;
#pragma unroll
        for (int i = 0; i < 8; ++i) {
            const f32x4 a = v[r][i] * qs;
            int pk;
            if (INT8) pk = (__float2int_rn(a.x) & 0xff) | ((__float2int_rn(a.y) & 0xff) << 8) | ((__float2int_rn(a.z) & 0xff) << 16) | (__float2int_rn(a.w) << 24);
            else { pk = __builtin_amdgcn_cvt_pk_fp8_f32(a.x, a.y, 0, false); pk = __builtin_amdgcn_cvt_pk_fp8_f32(a.z, a.w, pk, true); }
            *(unsigned*)(dst + (size_t)r * 128 + ((size_t)(2 * i + (lane >> 5)) * NE) * 128 + (lane & 31) * 4) = (unsigned)pk;
        }
        if (lane == 0) sc[r] = am[r] > 0.f ? am[r] * (INT8 ? (1.f / 127.f) : (1.f / 256.f)) : 1.f;
    }
}

__device__ __forceinline__ void p0_prologue(const Params& p, LAS unsigned char* lds, int mask = 0xff) {
    const int tid = threadIdx.x, lane = tid & 63, wave = tid >> 6;
    const int G = gridDim.x, gw = blockIdx.x * NWAVES + wave, ngw = G * NWAVES;
    const size_t gt = (size_t)blockIdx.x * NTHR + tid, ngt = (size_t)G * NTHR;
    unsigned char* ws = p.ws;
    const float* x = p.in[0]; const float* norm_mix = p.in[1]; const float* w_in = p.in[2]; const float* w_out = p.in[3];
    const float* norm_ffn = p.in[10]; const float* peer_query = p.in[11]; const float* sub_keys = p.in[12]; const float* peer_u = p.in[13]; const float* peer_v = p.in[14];
    if (mask & 1) {
        LAS float* scr = (LAS float*)(lds + wave * 8448);
        constexpr int I_IN = 32 * (NP / 32), I_SQ = 32 * (D / 32), PER_L = I_IN + 2 * I_SQ;
        for (int it = gw; it < 2 * PER_L; it += ngw) {
            const int l = it / PER_L; int r = it % PER_L;
            if (r < I_IN) { transpose_item(w_in + (size_t)l * D * IN_LD, IN_LD, IN_LD, norm_mix + l * D, (bf16_t*)(ws + WS_WINT) + (size_t)l * NP * D, D, (r / (NP / 32)) * 64, (r % (NP / 32)) * 32, scr, lane); continue; }
            r -= I_IN;
            if (r < I_SQ) { transpose_item(w_out + (size_t)l * D * D, D, D, nullptr, (bf16_t*)(ws + WS_WOUTT) + (size_t)l * D * D, D, (r / (D / 32)) * 64, (r % (D / 32)) * 32, scr, lane); continue; }
            r -= I_SQ;
            transpose_item(peer_query + (size_t)l * D * D, D, D, norm_ffn + l * D, (bf16_t*)(ws + WS_WQT) + (size_t)l * D * D, D, (r / (D / 32)) * 64, (r % (D / 32)) * 32, scr, lane);
        }
    }
    if (mask & 2) for (size_t i = gt; i < 2 * 2 * 8 * 128 * 128 / 4; i += ngt) {
        const f32x4 v = ((const f32x4*)sub_keys)[i];
        u32x2 w; w.x = pk2(v.x, v.y); w.y = pk2(v.z, v.w);
        ((u32x2*)(ws + WS_SUBK))[i] = w;
    }
    if (mask & 4) for (int r = 4 * gw; r < 4 * NE; r += 4 * ngw) {
        const int tb = r / (2 * NE), rr = r % (2 * NE), l = rr / NE;
        const float* src = (tb == 0 ? peer_u : peer_v) + (size_t)rr * D;
        unsigned char* dst = ws + (tb == 0 ? WS_U8 : WS_V8) + (size_t)l * NE * D + (size_t)(rr - l * NE) * 128;
        float* sc = (float*)(ws + (tb == 0 ? WS_USC : WS_VSC)) + rr;
        if (tb == 0) fp8_rows<4, true>(src, norm_ffn + l * D, dst, sc, lane);
        else fp8_rows<4, true>(src, nullptr, dst, sc, lane);
    }
    if (mask & 8) for (size_t i = gt; i < (size_t)S * 32; i += ngt) {
        const int fi = (int)(i & 31), pos = (int)(i >> 5);
        const float inv = powf(10000.f, -(float)fi / 32.f);
        const float ang = (float)pos * inv;
        f32x2 cs; cs.x = cosf(ang); cs.y = sinf(ang);
        ((f32x2*)(ws + WS_ROPE))[i] = cs;
    }
    if (mask & 16) for (int t = 2 * gw; t < T; t += 2 * ngw) {
        const f32x4* x0 = (const f32x4*)(x + (size_t)t * D) + lane; const f32x4* x1 = x0 + D / 4;
        f32x4 v0[8], v1[8]; float s0 = 0.f, s1 = 0.f;
#pragma unroll
        for (int j = 0; j < 8; ++j) { v0[j] = x0[64 * j]; v1[j] = x1[64 * j]; }
#pragma unroll
        for (int j = 0; j < 8; ++j) { s0 += (v0[j].x * v0[j].x + v0[j].y * v0[j].y) + (v0[j].z * v0[j].z + v0[j].w * v0[j].w); s1 += (v1[j].x * v1[j].x + v1[j].y * v1[j].y) + (v1[j].z * v1[j].z + v1[j].w * v1[j].w); }
        s0 = wsum(s0); s1 = wsum(s1);
        u32x2* o0 = (u32x2*)((bf16_t*)(ws + WS_XB) + (size_t)t * D) + lane; u32x2* o1 = o0 + D / 4;
#pragma unroll
        for (int j = 0; j < 8; ++j) { u32x2 w; w.x = pk2(v0[j].x, v0[j].y); w.y = pk2(v0[j].z, v0[j].w); o0[64 * j] = w; w.x = pk2(v1[j].x, v1[j].y); w.y = pk2(v1[j].z, v1[j].w); o1[64 * j] = w; }
        float* ss = (float*)(ws + WS_SS) + (size_t)t * 16;
        if (lane < 32) ss[lane] = (lane == 0) ? s0 : (lane == 16) ? s1 : 0.f;
    }
}

template <int NSS>
struct EpiScaleBf16 {
    static constexpr bool PERM = true, AFTER_DRAIN = false;
    bf16_t* O; int ldc; const float* ss;
    __device__ __forceinline__ void operator()(const pg8::f32x4 (&acc)[2][2][4][2], const pg8::Unit& u, int wr, int wc, int fr, int fq) const {
        const int row0 = u.pm * 256 + wr * 64 + fr, col0 = u.pn * 256 + wc * 32 + 8 * fq;
#pragma unroll
        for (int ai = 0; ai < 2; ++ai)
#pragma unroll
            for (int m = 0; m < 4; ++m) {
                const int row = row0 + ai * 128 + m * 16;
                float s;
                {
                    const f32x4* sp = (const f32x4*)(ss + (size_t)row * NSS);
                    f32x4 a = sp[0];
#pragma unroll
                    for (int i = 1; i < NSS / 4; ++i) a = a + sp[i];
                    s = (a.x + a.y) + (a.z + a.w);
                }
                const float r = rsqrtf(s * (1.f / D) + EPS);
                bf16_t* rowp = O + (size_t)row * ldc + col0;
#pragma unroll
                for (int bj = 0; bj < 2; ++bj) {
                    const pg8::f32x4 v0 = acc[ai][bj][m][0] * r, v1 = acc[ai][bj][m][1] * r;
                    u32x4 w; w.x = pk2(v0[0], v0[1]); w.y = pk2(v0[2], v0[3]); w.z = pk2(v1[0], v1[1]); w.w = pk2(v1[2], v1[3]);
                    *(u32x4*)(rowp + bj * 128) = w;
                }
            }
    }
};

struct EpiX1 {
    static constexpr bool PERM = false, AFTER_DRAIN = false;
    const float* xin32;
    bf16_t* X1B; float* ssp; float* amxp;
    __device__ __forceinline__ void operator()(const pg8::f32x4 (&acc)[2][2][4][2], const pg8::Unit& u, int wr, int wc, int fr, int fq) const {
        const int col0 = u.pn * 256 + wc * 32 + 4 * fq;
#pragma unroll
        for (int ai = 0; ai < 2; ++ai)
#pragma unroll
            for (int m = 0; m < 4; ++m) {
                const int row = u.pm * 256 + ai * 128 + wr * 64 + m * 16 + fr;
                float q = 0.f, am = 0.f;
#pragma unroll
                for (int bj = 0; bj < 2; ++bj)
#pragma unroll
                    for (int n = 0; n < 2; ++n) {
                        const size_t off = (size_t)row * D + col0 + bj * 128 + n * 16;
                        pg8::f32x4 r;
                        if (xin32) r = *(const pg8::f32x4*)(xin32 + off);
                        else { const u32x2 rb = *(const u32x2*)(X1B + off); r = (pg8::f32x4){bflo(rb.x), bfhi(rb.x), bflo(rb.y), bfhi(rb.y)}; }
                        const pg8::f32x4 o = r + acc[ai][bj][m][n];
                        u32x2 w; w.x = pk2(o[0], o[1]); w.y = pk2(o[2], o[3]);
                        *(u32x2*)(X1B + off) = w;
                        const float o0 = bflo(w.x), o1 = bfhi(w.x), o2 = bflo(w.y), o3 = bfhi(w.y);
                        q += (o0 * o0 + o1 * o1) + (o2 * o2 + o3 * o3);
                        am = fmaxf(am, fmaxf(fmaxf(fabsf(o0), fabsf(o1)), fmaxf(fabsf(o2), fabsf(o3))));
                    }
                q += __shfl_xor(q, 16); q += __shfl_xor(q, 32);
                am = fmaxf(am, __shfl_xor(am, 16)); am = fmaxf(am, __shfl_xor(am, 32));
                if (fq == 0) { ssp[(size_t)row * 32 + u.pn * 4 + wc] = q; amxp[(size_t)row * 32 + u.pn * 4 + wc] = am; }
            }
    }
};

#define TOPK_INSERT(L, x) do { _Pragma("unroll") for (int _i = 15; _i >= 1; --_i) L[_i] = __builtin_amdgcn_fmed3f(L[_i - 1], L[_i], (x)); L[0] = fmaxf(L[0], (x)); } while (0)
constexpr int SK_LD = 136;
constexpr int ROUTE_SK_OFF = 8 * 8448;
typedef float f32x16 __attribute__((ext_vector_type(16)));
__device__ __forceinline__ float swap32(float x) {
    const auto s = __builtin_amdgcn_permlane32_swap(__float_as_uint(x), __float_as_uint(x), false, false);
    return (__builtin_amdgcn_mbcnt_hi(~0u, __builtin_amdgcn_mbcnt_lo(~0u, 0u)) < 32u) ? __uint_as_float(s[1]) : __uint_as_float(s[0]);
}
__device__ __forceinline__ void route_unit(const bf16_t* __restrict__ Q, const bf16_t* __restrict__ subk_l, int pm, int h, int* __restrict__ IDX, int* __restrict__ IDXU, float* __restrict__ GATE,
                                           LAS unsigned char* lds, int tid, int wave, int lane) {
    const int tk = lane & 31, hi = lane >> 5;
    LAS float* scr = (LAS float*)(lds + wave * 8448);
    LAS bf16_t* SK = (LAS bf16_t*)(lds + ROUTE_SK_OFF);
    __syncthreads();
#pragma unroll
    for (int j = 0; j < 8; ++j) {
        const int e = tid + j * NTHR, half = e >> 11, row = (e >> 4) & 127, ch = e & 15;
        *(LAS u32x4*)(SK + (half * 128 + row) * SK_LD + ch * 8) = *(const u32x4*)(subk_l + ((size_t)(half * 8 + h) * 128 + row) * 128 + ch * 8);
    }
    const int tok = pm * 256 + wave * 32 + tk;
    bf16x8 bq[2][8];
#pragma unroll
    for (int half = 0; half < 2; ++half)
#pragma unroll
        for (int ks = 0; ks < 8; ++ks) bq[half][ks] = *(const bf16x8*)(Q + (size_t)tok * D + h * 256 + half * 128 + ks * 16 + 8 * hi);
    __syncthreads();
    float L1[16], L2[16];
#pragma unroll
    for (int half = 0; half < 2; ++half) {
        float L[16];
#pragma unroll
        for (int i = 0; i < 16; ++i) L[i] = -3.0e38f;
#pragma unroll 1
        for (int mt = 0; mt < 4; ++mt) {
            f32x16 acc;
#pragma unroll
            for (int r = 0; r < 16; ++r) acc[r] = 0.f;
            const LAS bf16_t* kp = SK + (half * 128 + mt * 32 + tk) * SK_LD + 8 * hi;
#pragma unroll
            for (int ks = 0; ks < 8; ++ks) acc = __builtin_amdgcn_mfma_f32_32x32x16_bf16(*(const LAS bf16x8*)(kp + ks * 16), bq[half][ks], acc, 0, 0, 0);
#pragma unroll
            for (int r = 0; r < 16; ++r) {
                const unsigned key = (unsigned)(mt * 32 + (r & 3) + 8 * (r >> 2) + 4 * hi);
                const float xv = __uint_as_float((__float_as_uint(acc[r]) & 0xffffff80u) | key);
                TOPK_INSERT(L, xv);
            }
        }
        { float o[16];
#pragma unroll
          for (int i = 0; i < 16; ++i) o[i] = swap32(L[i]);
#pragma unroll
          for (int i = 0; i < 16; ++i) TOPK_INSERT(L, o[i]); }
#pragma unroll
        for (int i = 0; i < 16; ++i) { if (half == 0) L1[i] = L[i]; else L2[i] = L[i]; }
    }
    float C[16];
#pragma unroll
    for (int i = 0; i < 16; ++i) C[i] = -3.0e38f;
    {
        constexpr int NA[50] = {0,0,0,0,0,0,0,0,0,0,0,0,0,0,0,0, 1,1,1,1,1,1,1,1, 2,2,2,2,2, 3,3,3,3, 4,4,4, 5,5, 6,6, 7,7, 8, 9, 10, 11, 12, 13, 14, 15};
        constexpr int NBb[50] = {0,1,2,3,4,5,6,7,8,9,10,11,12,13,14,15, 0,1,2,3,4,5,6,7, 0,1,2,3,4, 0,1,2,3, 0,1,2, 0,1, 0,1, 0,1, 0, 0, 0, 0, 0, 0, 0, 0};
#pragma unroll
        for (int i = 0; i < 25; ++i) {
            const int a0 = NA[2 * i], b0 = NBb[2 * i], a1 = NA[2 * i + 1], b1 = NBb[2 * i + 1];
            const float s0 = L1[a0] + L2[b0], s1 = L1[a1] + L2[b1];
            const float x0 = __uint_as_float((__float_as_uint(s0) & 0xffffff00u) | (unsigned)(a0 * 16 + b0));
            const float x1 = __uint_as_float((__float_as_uint(s1) & 0xffffff00u) | (unsigned)(a1 * 16 + b1));
            const float xv = hi ? x1 : x0;
            TOPK_INSERT(C, xv);
        }
        float o[16];
#pragma unroll
        for (int i = 0; i < 16; ++i) o[i] = swap32(C[i]);
#pragma unroll
        for (int i = 0; i < 16; ++i) TOPK_INSERT(C, o[i]);
    }
    LAS float* my = scr + lane * 33;
#pragma unroll
    for (int i = 0; i < 16; ++i) { my[i] = L1[i]; my[16 + i] = L2[i]; }
    __builtin_amdgcn_s_waitcnt(0xc07f);
    asm volatile("" ::: "memory");
    const float mx = __uint_as_float(__float_as_uint(C[0]) & 0xffffff00u);
    float e[16], den = 0.f;
#pragma unroll
    for (int i = 0; i < 16; ++i) { e[i] = __expf(__uint_as_float(__float_as_uint(C[i]) & 0xffffff00u) - mx); den += e[i]; }
    const float rden = 1.f / den;
#pragma unroll
    for (int i = 0; i < 16; ++i) {
        if ((i >> 3) == hi) {
            const unsigned ab = __float_as_uint(C[i]) & 0xffu;
            const unsigned i1 = __float_as_uint(my[ab >> 4]) & 0x7fu, i2 = __float_as_uint(my[16 + (ab & 15)]) & 0x7fu;
            const int pp = h * 16 + i, pos = (pp & 7) * 16 + (pp >> 3);
            IDX[(size_t)tok * 128 + pos] = (int)(i1 * 128 + i2);
            GATE[(size_t)tok * 128 + pos] = e[i] * rden;
        }
    }
    __builtin_amdgcn_s_waitcnt(0xc07f);
    asm volatile("" ::: "memory");
}

__device__ __forceinline__ float gelu_erf(float x) { return 0.5f * x * (1.f + erff(x * 0.70710678118654752f)); }
template <bool FINAL>
__device__ __forceinline__ void expert_token(int t, const bf16_t* __restrict__ X1B, const float* __restrict__ X1, const float* __restrict__ ssp, const int* __restrict__ IDX, const float* __restrict__ GATE,
                                             const unsigned char* __restrict__ U8, const float* __restrict__ USC, const unsigned char* __restrict__ V8, const float* __restrict__ VSC,
                                             float* __restrict__ X2, bf16_t* __restrict__ XB, float* __restrict__ SS, const float* __restrict__ norm_final, float* __restrict__ OUT, int lane) {
    float xf[2][16];
#pragma unroll
    for (int j = 0; j < 2; ++j) {
        const u32x4* xp = (const u32x4*)(X1B + (size_t)t * D + j * 1024 + lane * 16);
        const u32x4 a = xp[0], b = xp[1];
#pragma unroll
        for (int q = 0; q < 4; ++q) { xf[j][2 * q] = bflo(a[q]); xf[j][2 * q + 1] = bfhi(a[q]); xf[j][8 + 2 * q] = bflo(b[q]); xf[j][8 + 2 * q + 1] = bfhi(b[q]); }
    }
    float sp = (lane < 32) ? ssp[(size_t)t * 32 + lane] : 0.f;
    sp = wsum(sp);
    const float rs1 = rsqrtf(sp * (1.f / D) + EPS);
    const int id0 = IDX[(size_t)t * 128 + lane], id1 = IDX[(size_t)t * 128 + 64 + lane];
    const float g0 = GATE[(size_t)t * 128 + lane], g1 = GATE[(size_t)t * 128 + 64 + lane];
    const float us0 = USC[id0], us1 = USC[id1], vs0 = VSC[id0], vs1 = VSC[id1];
    float acc[2][16];
#pragma unroll
    for (int j = 0; j < 2; ++j)
#pragma unroll
        for (int i = 0; i < 16; ++i) acc[j][i] = 0.f;
    float act0 = 0.f, act1 = 0.f;
#pragma unroll 1
    for (int e0 = 0; e0 < 128; e0 += 4) {
        u32x4 w[4][2];
#pragma unroll
        for (int e = 0; e < 4; ++e) {
            const int ee = e0 + e;
            const int id = __builtin_amdgcn_readlane(ee < 64 ? id0 : id1, ee & 63);
            const unsigned char* up = U8 + (size_t)id * D + lane * 16;
            w[e][0] = *(const u32x4*)up; w[e][1] = *(const u32x4*)(up + 1024);
        }
        float d[4];
#pragma unroll
        for (int e = 0; e < 4; ++e) {
            float s = 0.f;
#pragma unroll
            for (int j = 0; j < 2; ++j)
#pragma unroll
                for (int q = 0; q < 4; ++q) {
                    const f32x2 lo = __builtin_amdgcn_cvt_pk_f32_fp8((int)w[e][j][q], false), hi = __builtin_amdgcn_cvt_pk_f32_fp8((int)w[e][j][q], true);
                    s = fmaf(lo.x, xf[j][4 * q], s); s = fmaf(lo.y, xf[j][4 * q + 1], s); s = fmaf(hi.x, xf[j][4 * q + 2], s); s = fmaf(hi.y, xf[j][4 * q + 3], s);
                }
            d[e] = wsum(s);
        }
#pragma unroll
        for (int e = 0; e < 4; ++e) {
            const int ee = e0 + e;
            if (ee < 64) { if (lane == ee) act0 = d[e]; } else { if (lane == ee - 64) act1 = d[e]; }
        }
    }
    act0 = gelu_erf(act0 * us0 * rs1) * g0 * vs0;
    act1 = gelu_erf(act1 * us1 * rs1) * g1 * vs1;
#pragma unroll 1
    for (int e0 = 0; e0 < 128; e0 += 4) {
        u32x4 w[4][2];
        float a[4];
#pragma unroll
        for (int e = 0; e < 4; ++e) {
            const int ee = e0 + e;
            const int id = __builtin_amdgcn_readlane(ee < 64 ? id0 : id1, ee & 63);
            a[e] = __int_as_float(__builtin_amdgcn_readlane(__float_as_int(ee < 64 ? act0 : act1), ee & 63));
            const unsigned char* vp = V8 + (size_t)id * D + lane * 16;
            w[e][0] = *(const u32x4*)vp; w[e][1] = *(const u32x4*)(vp + 1024);
        }
#pragma unroll
        for (int e = 0; e < 4; ++e)
#pragma unroll
            for (int j = 0; j < 2; ++j)
#pragma unroll
                for (int q = 0; q < 4; ++q) {
                    const f32x2 lo = __builtin_amdgcn_cvt_pk_f32_fp8((int)w[e][j][q], false), hi = __builtin_amdgcn_cvt_pk_f32_fp8((int)w[e][j][q], true);
                    acc[j][4 * q] = fmaf(a[e], lo.x, acc[j][4 * q]); acc[j][4 * q + 1] = fmaf(a[e], lo.y, acc[j][4 * q + 1]);
                    acc[j][4 * q + 2] = fmaf(a[e], hi.x, acc[j][4 * q + 2]); acc[j][4 * q + 3] = fmaf(a[e], hi.y, acc[j][4 * q + 3]);
                }
    }
    float q2 = 0.f;
#pragma unroll
    for (int j = 0; j < 2; ++j)
#pragma unroll
        for (int q = 0; q < 4; ++q) {
            const f32x4 r = *(const f32x4*)(X1 + (size_t)t * D + j * 1024 + lane * 16 + q * 4);
            acc[j][4 * q] += r.x; acc[j][4 * q + 1] += r.y; acc[j][4 * q + 2] += r.z; acc[j][4 * q + 3] += r.w;
            q2 += (acc[j][4 * q] * acc[j][4 * q] + acc[j][4 * q + 1] * acc[j][4 * q + 1]) + (acc[j][4 * q + 2] * acc[j][4 * q + 2] + acc[j][4 * q + 3] * acc[j][4 * q + 3]);
        }
    q2 = wsum(q2);
    if (FINAL) {
        const float rf = rsqrtf(q2 * (1.f / D) + EPS);
#pragma unroll
        for (int j = 0; j < 2; ++j)
#pragma unroll
            for (int q = 0; q < 4; ++q) {
                const int e = j * 1024 + lane * 16 + q * 4;
                const f32x4 g = *(const f32x4*)(norm_final + e);
                f32x4 o; o.x = acc[j][4 * q] * rf * g.x; o.y = acc[j][4 * q + 1] * rf * g.y; o.z = acc[j][4 * q + 2] * rf * g.z; o.w = acc[j][4 * q + 3] * rf * g.w;
                *(f32x4*)(OUT + (size_t)t * D + e) = o;
            }
    } else {
#pragma unroll
        for (int j = 0; j < 2; ++j) {
#pragma unroll
            for (int q = 0; q < 4; ++q) {
                f32x4 o; o.x = acc[j][4 * q]; o.y = acc[j][4 * q + 1]; o.z = acc[j][4 * q + 2]; o.w = acc[j][4 * q + 3];
                *(f32x4*)(X2 + (size_t)t * D + j * 1024 + lane * 16 + q * 4) = o;
            }
            u32x4 b0, b1;
#pragma unroll
            for (int q = 0; q < 4; ++q) { b0[q] = pk2(acc[j][2 * q], acc[j][2 * q + 1]); b1[q] = pk2(acc[j][8 + 2 * q], acc[j][8 + 2 * q + 1]); }
            u32x4* xo = (u32x4*)(XB + (size_t)t * D + j * 1024 + lane * 16);
            xo[0] = b0; xo[1] = b1;
        }
        if (lane == 0) SS[t] = q2;
    }
}
}

namespace mk {
constexpr int KS_LD = 72, VS_LD = 80;
constexpr int ATT_KS_OFF = 0, ATT_VS_OFF = 256 * KS_LD * 2;
constexpr int ATT_LDS = ATT_VS_OFF + 256 * VS_LD * 2;

__device__ __forceinline__ bf16x8 tr_pair(const LAS bf16_t* p0, const LAS bf16_t* p1) {
    const s16x4 a = __builtin_amdgcn_ds_read_tr16_b64_v4i16((LAS s16x4*)p0);
    const s16x4 b = __builtin_amdgcn_ds_read_tr16_b64_v4i16((LAS s16x4*)p1);
    bf16x8 r; r[0] = a[0]; r[1] = a[1]; r[2] = a[2]; r[3] = a[3]; r[4] = b[0]; r[5] = b[1]; r[6] = b[2]; r[7] = b[3];
    return r;
}

__device__ __forceinline__ void attn_unit(const bf16_t* __restrict__ P, const f32x2* __restrict__ rope, const float* __restrict__ sinks_l, bf16_t* __restrict__ Y,
                                          int unit, LAS unsigned char* lds, int tid, int lane, int wave) {
    const int b = unit >> 6, n = (unit >> 1) & 31, kvh = unit & 1;
    const int tok0 = b * S + n * 128;
    LAS bf16_t* KS = (LAS bf16_t*)(lds + ATT_KS_OFF);
    LAS bf16_t* VS = (LAS bf16_t*)(lds + ATT_VS_OFF);
    {
        const int key = tid >> 1, part = tid & 1;
        const int kpos = n * 128 - 128 + key;
        u32x4 k1a = {0, 0, 0, 0}, k1b = k1a, k2a = k1a, k2b = k1a, v0 = k1a, v1 = k1a, v2 = k1a, v3 = k1a;
        if (kpos >= 0) {
            const bf16_t* kr = P + (size_t)(tok0 - 128 + key) * NP + C_KA + kvh * 64 + part * 16;
            const u32x4 x1a = *(const u32x4*)kr, x1b = *(const u32x4*)(kr + 8), x2a = *(const u32x4*)(kr + 32), x2b = *(const u32x4*)(kr + 40);
            const f32x2* cs = rope + (size_t)kpos * 32 + part * 16;
#pragma unroll
            for (int q = 0; q < 4; ++q) {
                {
                    const f32x2 c0 = cs[2 * q], c1 = cs[2 * q + 1];
                    const float a0 = bflo(x1a[q]), a1 = bfhi(x1a[q]), b0 = bflo(x2a[q]), b1 = bfhi(x2a[q]);
                    k1a[q] = pk2(a0 * c0.x - b0 * c0.y, a1 * c1.x - b1 * c1.y);
                    k2a[q] = pk2(b0 * c0.x + a0 * c0.y, b1 * c1.x + a1 * c1.y);
                }
                {
                    const f32x2 c0 = cs[8 + 2 * q], c1 = cs[8 + 2 * q + 1];
                    const float a0 = bflo(x1b[q]), a1 = bfhi(x1b[q]), b0 = bflo(x2b[q]), b1 = bfhi(x2b[q]);
                    k1b[q] = pk2(a0 * c0.x - b0 * c0.y, a1 * c1.x - b1 * c1.y);
                    k2b[q] = pk2(b0 * c0.x + a0 * c0.y, b1 * c1.x + a1 * c1.y);
                }
            }
            const bf16_t* vr = P + (size_t)(tok0 - 128 + key) * NP + C_VA + kvh * 64 + part * 32;
            v0 = *(const u32x4*)vr; v1 = *(const u32x4*)(vr + 8); v2 = *(const u32x4*)(vr + 16); v3 = *(const u32x4*)(vr + 24);
        }
        LAS bf16_t* kd = KS + key * KS_LD + part * 16;
        *(LAS u32x4*)kd = k1a; *(LAS u32x4*)(kd + 8) = k1b; *(LAS u32x4*)(kd + 32) = k2a; *(LAS u32x4*)(kd + 40) = k2b;
        LAS bf16_t* vd = VS + key * VS_LD + part * 32;
        *(LAS u32x4*)vd = v0; *(LAS u32x4*)(vd + 8) = v1; *(LAS u32x4*)(vd + 16) = v2; *(LAS u32x4*)(vd + 24) = v3;
    }
    __syncthreads();
    const int hq = kvh * 8 + wave;
    const int fr = lane & 15, fq = lane >> 4;
    constexpr float L2E = 1.4426950408889634f;
    const float sink2 = sinks_l[hq] * L2E;
    const int tq = (lane & 15) >> 2, tp = lane & 3;
#pragma unroll 1
    for (int rb = 0; rb < 8; ++rb) {
        const int q0 = rb * 16;
        const int qtok = tok0 + q0 + fr;
        bf16x8 bq0, bq1;
        {
            const bf16_t* qr = P + (size_t)qtok * NP + C_QA + hq * 64 + 8 * fq;
            const u32x4 x1 = *(const u32x4*)qr, x2 = *(const u32x4*)(qr + 32);
            const f32x2* cs = rope + (size_t)(n * 128 + q0 + fr) * 32 + 8 * fq;
            u32x4 o1, o2;
            constexpr float SC = 0.125f * L2E;
#pragma unroll
            for (int q = 0; q < 4; ++q) {
                const f32x2 c0 = cs[2 * q], c1 = cs[2 * q + 1];
                const float a0 = bflo(x1[q]), a1 = bfhi(x1[q]), b0 = bflo(x2[q]), b1 = bfhi(x2[q]);
                o1[q] = pk2((a0 * c0.x - b0 * c0.y) * SC, (a1 * c1.x - b1 * c1.y) * SC);
                o2[q] = pk2((b0 * c0.x + a0 * c0.y) * SC, (b1 * c1.x + a1 * c1.y) * SC);
            }
            bq0 = __builtin_bit_cast(bf16x8, o1); bq1 = __builtin_bit_cast(bf16x8, o2);
        }
        const int wsk = (q0 >> 5) << 5;
        pg8::f32x4 sc[10];
#pragma unroll
        for (int kt = 0; kt < 10; ++kt) {
            const LAS bf16_t* kp = KS + (wsk + kt * 16 + fr) * KS_LD + 8 * fq;
            const bf16x8 a0 = *(const LAS bf16x8*)kp, a1 = *(const LAS bf16x8*)(kp + 32);
            pg8::f32x4 acc = {0.f, 0.f, 0.f, 0.f};
            acc = __builtin_amdgcn_mfma_f32_16x16x32_bf16(a0, bq0, acc, 0, 0, 0);
            acc = __builtin_amdgcn_mfma_f32_16x16x32_bf16(a1, bq1, acc, 0, 0, 0);
            sc[kt] = acc;
        }
        const int qb = q0 + fr;
        const int kmin = (n == 0) ? 128 : 0;
        float mx = sink2;
#pragma unroll
        for (int kt = 0; kt < 10; ++kt)
#pragma unroll
            for (int r = 0; r < 4; ++r) {
                const int kb = wsk + kt * 16 + 4 * fq + r;
                const bool ok = (kb >= qb + 1) && (kb <= qb + 128) && (kb >= kmin);
                sc[kt][r] = ok ? sc[kt][r] : -1e30f;
                mx = fmaxf(mx, sc[kt][r]);
            }
        mx = fmaxf(mx, __shfl_xor(mx, 16)); mx = fmaxf(mx, __shfl_xor(mx, 32));
        float sum = 0.f;
#pragma unroll
        for (int kt = 0; kt < 10; ++kt)
#pragma unroll
            for (int r = 0; r < 4; ++r) { const float pv = __builtin_amdgcn_exp2f(sc[kt][r] - mx); sc[kt][r] = pv; sum += pv; }
        sum += __shfl_xor(sum, 16); sum += __shfl_xor(sum, 32);
        const float rden = 1.f / (sum + __builtin_amdgcn_exp2f(sink2 - mx));
        pg8::f32x4 oacc[4];
#pragma unroll
        for (int mt = 0; mt < 4; ++mt) oacc[mt] = (pg8::f32x4){0.f, 0.f, 0.f, 0.f};
#pragma unroll
        for (int kk = 0; kk < 5; ++kk) {
            u32x4 pb; pb[0] = pk2(sc[2 * kk][0], sc[2 * kk][1]); pb[1] = pk2(sc[2 * kk][2], sc[2 * kk][3]);
            pb[2] = pk2(sc[2 * kk + 1][0], sc[2 * kk + 1][1]); pb[3] = pk2(sc[2 * kk + 1][2], sc[2 * kk + 1][3]);
            const bf16x8 bp = __builtin_bit_cast(bf16x8, pb);
            const LAS bf16_t* v0 = VS + (wsk + (2 * kk) * 16 + 4 * fq + tq) * VS_LD + 4 * tp;
            const LAS bf16_t* v1 = v0 + 16 * VS_LD;
#pragma unroll
            for (int mt = 0; mt < 4; ++mt) {
                const bf16x8 av = tr_pair(v0 + mt * 16, v1 + mt * 16);
                oacc[mt] = __builtin_amdgcn_mfma_f32_16x16x32_bf16(av, bp, oacc[mt], 0, 0, 0);
            }
        }
        bf16_t* yr = Y + (size_t)qtok * D + hq * 64 + 4 * fq;
#pragma unroll
        for (int mt = 0; mt < 4; ++mt) {
            u32x2 w; w.x = pk2(oacc[mt][0] * rden, oacc[mt][1] * rden); w.y = pk2(oacc[mt][2] * rden, oacc[mt][3] * rden);
            *(u32x2*)(yr + mt * 16) = w;
        }
    }
}
}

namespace mk {
constexpr int RL = 144;
constexpr int PSL = 72;
constexpr int OBL = 132;
constexpr int R_QT = 0, R_KT = 64 * RL * 2, R_KD = 2 * 64 * RL * 2, R_V = 3 * 64 * RL * 2, R_SB = 4 * 64 * RL * 2;
constexpr int R_PS = R_SB + 128 * RL * 2;
constexpr int R_VEC = R_PS + 64 * PSL * 2;
constexpr int R_OB = R_KT;
constexpr int REC_LDS = R_VEC + 12288;
static_assert(64 * OBL * 4 <= 2 * 64 * RL * 2, "OB overlay");
constexpr int ST_STRIDE = 16384 + 256;

__device__ __forceinline__ bf16x8 ld_row_split(const LAS bf16_t* p) {
    const s16x4 a = *(const LAS s16x4*)p, b = *(const LAS s16x4*)(p + 16);
    bf16x8 r; r[0] = a[0]; r[1] = a[1]; r[2] = a[2]; r[3] = a[3]; r[4] = b[0]; r[5] = b[1]; r[6] = b[2]; r[7] = b[3];
    return r;
}
__device__ __forceinline__ float clamp80(float x) { return fminf(fmaxf(x, -80.f), 80.f); }
__device__ __forceinline__ float sigm(float x) { return 1.f / (1.f + __expf(-x)); }
__device__ __forceinline__ void st_bf16(LAS bf16_t* p, float v) { *p = (bf16_t)(pk2(v, 0.f) & 0xffffu); }

__device__ __forceinline__ void state_update(pg8::f32x4 (&acc)[8], const LAS bf16_t* KDm, const LAS bf16_t* Vm, int wave, int fq, int tq, int tp) {
    bf16x8 ka[2];
#pragma unroll
    for (int ks = 0; ks < 2; ++ks) { const LAS bf16_t* p = KDm + (ks * 32 + 4 * fq + tq) * RL + 16 * wave + 4 * tp; ka[ks] = tr_pair(p, p + 16 * RL); }
#pragma unroll
    for (int j = 0; j < 8; ++j)
#pragma unroll
        for (int ks = 0; ks < 2; ++ks) {
            const LAS bf16_t* p = Vm + (ks * 32 + 4 * fq + tq) * RL + 16 * j + 4 * tp;
            const bf16x8 vb = tr_pair(p, p + 16 * RL);
            acc[j] = __builtin_amdgcn_mfma_f32_16x16x32_bf16(ka[ks], vb, acc[j], 0, 0, 0);
        }
}
__device__ __forceinline__ void state_to_lds(const pg8::f32x4 (&acc)[8], const float (&rsc)[4], LAS bf16_t* SBm, int wave, int fr, int fq) {
#pragma unroll
    for (int j = 0; j < 8; ++j)
#pragma unroll
        for (int r = 0; r < 4; ++r) st_bf16(SBm + (16 * wave + 4 * fq + r) * RL + 16 * j + fr, acc[j][r] * rsc[r]);
}
__device__ __forceinline__ void score_tile(pg8::f32x4& acc, const LAS bf16_t* Am, const LAS bf16_t* Bm, int ti, int tj, int fr, int fq) {
    acc = (pg8::f32x4){0.f, 0.f, 0.f, 0.f};
#pragma unroll
    for (int ks = 0; ks < 4; ++ks) {
        const bf16x8 a = *(const LAS bf16x8*)(Am + (16 * ti + fr) * RL + ks * 32 + 8 * fq);
        const bf16x8 b = *(const LAS bf16x8*)(Bm + (16 * tj + fr) * RL + ks * 32 + 8 * fq);
        acc = __builtin_amdgcn_mfma_f32_16x16x32_bf16(a, b, acc, 0, 0, 0);
    }
}
struct TileRegs { u32x4 a, b; };
__device__ __forceinline__ TileRegs tile_load(const bf16_t* __restrict__ src, int tid) {
    const int row = tid >> 3, seg = tid & 7;
    const bf16_t* s = src + (size_t)row * NP + seg * 16;
    TileRegs t; t.a = *(const u32x4*)s; t.b = *(const u32x4*)(s + 8); return t;
}
__device__ __forceinline__ void tile_store(const TileRegs& t, LAS bf16_t* dst, int tid) {
    const int row = tid >> 3, seg = tid & 7;
    LAS bf16_t* d = dst + row * RL + seg * 16;
    *(LAS u32x4*)d = t.a; *(LAS u32x4*)(d + 8) = t.b;
}
__device__ __forceinline__ void state_store(const pg8::f32x4 (&acc)[8], float* __restrict__ dst, int wave, int lane) {
#pragma unroll
    for (int j = 0; j < 8; ++j)
#pragma unroll
        for (int r = 0; r < 4; ++r) dst[((wave * 8 + j) * 4 + r) * 64 + lane] = acc[j][r];
}

template <int PASS>
__device__ __forceinline__ void hgrn_unit(const bf16_t* __restrict__ P, const float* __restrict__ lb_logits, int layer, const float* __restrict__ gain_l,
                                          float* __restrict__ STB, bf16_t* __restrict__ Y, int unit, LAS unsigned char* lds, int tid, int lane, int wave) {
    const int chain = unit >> 3, g = unit & 7, b = chain >> 2, h = chain & 3;
    const int t0 = b * S + g * 512;
    const int fr = lane & 15, fq = lane >> 4, tq = (lane & 15) >> 2, tp = lane & 3;
    const int kp = tid & 63, rg = wave, c0 = 2 * kp;
    LAS bf16_t* QT = (LAS bf16_t*)(lds + R_QT); LAS bf16_t* KT = (LAS bf16_t*)(lds + R_KT); LAS bf16_t* KD = (LAS bf16_t*)(lds + R_KD);
    LAS bf16_t* VV = (LAS bf16_t*)(lds + R_V); LAS bf16_t* SB = (LAS bf16_t*)(lds + R_SB); LAS bf16_t* PS = (LAS bf16_t*)(lds + R_PS);
    LAS float* TOT = (LAS float*)(lds + R_VEC);
    LAS float* EREF = TOT + 1024; LAS float* ELAST = EREF + 128;
    LAS float* OB = (LAS float*)(lds + R_OB);
    float lb0 = 0.f, lb1 = 0.f;
    if (layer == 1) {
        const float a0 = lb_logits[h * 128 + c0], a1 = lb_logits[512 + h * 128 + c0], d0 = lb_logits[h * 128 + c0 + 1], d1 = lb_logits[512 + h * 128 + c0 + 1];
        const float m0 = fmaxf(a0, a1), m1 = fmaxf(d0, d1);
        lb0 = __expf(a1 - m0) / (__expf(a0 - m0) + __expf(a1 - m0));
        lb1 = __expf(d1 - m1) / (__expf(d0 - m1) + __expf(d1 - m1));
    }
    pg8::f32x4 acc[8];
#pragma unroll
    for (int j = 0; j < 8; ++j) acc[j] = (pg8::f32x4){0.f, 0.f, 0.f, 0.f};
    if (PASS == 2) {
        for (int jg = 0; jg < g; ++jg) {
            const float* sb = STB + (size_t)(chain * 8 + jg) * ST_STRIDE;
            float dk[4];
#pragma unroll
            for (int r = 0; r < 4; ++r) dk[r] = __expf(sb[16384 + 16 * wave + 4 * fq + r]);
#pragma unroll
            for (int j = 0; j < 8; ++j)
#pragma unroll
                for (int r = 0; r < 4; ++r) acc[j][r] = acc[j][r] * dk[r] + sb[((wave * 8 + j) * 4 + r) * 64 + lane];
        }
    }
    float gl0 = 0.f, gl1 = 0.f;
    unsigned fwn[8], qwn[8];
    {
#pragma unroll
        for (int i = 0; i < 8; ++i) { const bf16_t* pr = P + (size_t)(t0 + rg * 8 + i) * NP + h * 128 + c0; fwn[i] = *(const unsigned*)(pr + C_FH); if (PASS == 2) qwn[i] = *(const unsigned*)(pr + C_QH); }
    }
#pragma unroll 1
    for (int c = 0; c < 8; ++c) {
        const int tr0 = t0 + c * 64;
        float lf0[8], lf1[8], kk0[8], kk1[8], qv0[8], qv1[8];
#pragma unroll
        for (int i = 0; i < 8; ++i) {
            const unsigned fw = fwn[i];
            const float z0 = bflo(fw), z1 = bfhi(fw);
            const float s0 = sigm(z0), s1 = sigm(z1);
            lf0[i] = __logf(fmaxf(lb0 + (1.f - lb0) * s0, 1e-30f)); lf1[i] = __logf(fmaxf(lb1 + (1.f - lb1) * s1, 1e-30f));
            kk0[i] = (1.f - lb0) * (1.f - s0); kk1[i] = (1.f - lb1) * (1.f - s1);
            if (PASS == 2) { const unsigned qw = qwn[i]; const float q0 = bflo(qw), q1 = bfhi(qw); qv0[i] = q0 * sigm(q0); qv1[i] = q1 * sigm(q1); }
        }
#pragma unroll
        for (int i = 1; i < 8; ++i) { lf0[i] += lf0[i - 1]; lf1[i] += lf1[i - 1]; }
        TOT[rg * 128 + c0] = lf0[7]; TOT[rg * 128 + c0 + 1] = lf1[7];
        { const TileRegs vt = tile_load(P + (size_t)tr0 * NP + C_IH + h * 128, tid); tile_store(vt, VV, tid); }
        if (c < 7) {
            const int trn = tr0 + 64;
#pragma unroll
            for (int i = 0; i < 8; ++i) { const bf16_t* pr = P + (size_t)(trn + rg * 8 + i) * NP + h * 128 + c0; fwn[i] = *(const unsigned*)(pr + C_FH); if (PASS == 2) qwn[i] = *(const unsigned*)(pr + C_QH); }
        }
        __syncthreads();
        {
            float pre0 = 0.f, pre1 = 0.f, ref0 = 0.f, ref1 = 0.f, la0 = 0.f, la1 = 0.f;
#pragma unroll
            for (int r = 0; r < 8; ++r) {
                const float a0 = TOT[r * 128 + c0], a1 = TOT[r * 128 + c0 + 1];
                if (r < rg) { pre0 += a0; pre1 += a1; }
                if (r < 4) { ref0 += a0; ref1 += a1; }
                la0 += a0; la1 += a1;
            }
#pragma unroll
            for (int i = 0; i < 8; ++i) {
                const int row = rg * 8 + i;
                const float cu0 = pre0 + lf0[i], cu1 = pre1 + lf1[i];
                if (PASS == 2) {
                    *(LAS unsigned*)(QT + row * RL + c0) = pk2(qv0[i] * __expf(clamp80(cu0 - ref0)), qv1[i] * __expf(clamp80(cu1 - ref1)));
                    *(LAS unsigned*)(KT + row * RL + c0) = pk2(kk0[i] * __expf(clamp80(ref0 - cu0)), kk1[i] * __expf(clamp80(ref1 - cu1)));
                }
                *(LAS unsigned*)(KD + row * RL + c0) = pk2(kk0[i] * __expf(la0 - cu0), kk1[i] * __expf(la1 - cu1));
            }
            if (rg == 0) { EREF[c0] = __expf(ref0); EREF[c0 + 1] = __expf(ref1); ELAST[c0] = __expf(la0); ELAST[c0 + 1] = __expf(la1); }
            gl0 += la0; gl1 += la1;
        }
        __syncthreads();
        TileRegs gcur = {};
        if (PASS == 2) gcur = tile_load(P + (size_t)tr0 * NP + C_GH + h * 128, tid);
        pg8::f32x4 o[4];
        if (PASS == 2) {
            { float rs[4];
#pragma unroll
              for (int r = 0; r < 4; ++r) rs[r] = EREF[16 * wave + 4 * fq + r];
              state_to_lds(acc, rs, SB, wave, fr, fq); }
            { const int ti = wave >> 1;
#pragma unroll
              for (int tjj = 0; tjj < 2; ++tjj) {
                  const int tj = 2 * (wave & 1) + tjj;
                  pg8::f32x4 sa = {0.f, 0.f, 0.f, 0.f};
                  if (tj <= ti) score_tile(sa, QT, KT, ti, tj, fr, fq);
#pragma unroll
                  for (int r = 0; r < 4; ++r) {
                      const int t = 16 * ti + 4 * fq + r, s = 16 * tj + fr;
                      st_bf16(PS + t * PSL + s, (s <= t) ? sa[r] : 0.f);
                  }
              } }
            __syncthreads();
            bf16x8 sbf[4], vbf[2];
#pragma unroll
            for (int ks = 0; ks < 4; ++ks) { const LAS bf16_t* p = SB + (ks * 32 + 4 * fq + tq) * RL + 16 * wave + 4 * tp; sbf[ks] = tr_pair(p, p + 16 * RL); }
#pragma unroll
            for (int ks = 0; ks < 2; ++ks) { const LAS bf16_t* p = VV + (ks * 32 + 4 * fq + tq) * RL + 16 * wave + 4 * tp; vbf[ks] = tr_pair(p, p + 16 * RL); }
#pragma unroll
            for (int ti = 0; ti < 4; ++ti) {
                o[ti] = (pg8::f32x4){0.f, 0.f, 0.f, 0.f};
#pragma unroll
                for (int ks = 0; ks < 4; ++ks) o[ti] = __builtin_amdgcn_mfma_f32_16x16x32_bf16(ld_row_split(QT + (16 * ti + fr) * RL + ks * 32 + 4 * fq), sbf[ks], o[ti], 0, 0, 0);
#pragma unroll
                for (int ks = 0; ks < 2; ++ks) o[ti] = __builtin_amdgcn_mfma_f32_16x16x32_bf16(ld_row_split(PS + (16 * ti + fr) * PSL + ks * 32 + 4 * fq), vbf[ks], o[ti], 0, 0, 0);
            }
        }
        {
#pragma unroll
            for (int r = 0; r < 4; ++r) { const float el = ELAST[16 * wave + 4 * fq + r];
#pragma unroll
                for (int j = 0; j < 8; ++j) acc[j][r] *= el; }
            state_update(acc, KD, VV, wave, fq, tq, tp);
        }
        __syncthreads();
        if (PASS == 2) {
#pragma unroll
            for (int ti = 0; ti < 4; ++ti)
#pragma unroll
                for (int r = 0; r < 4; ++r) OB[(16 * ti + 4 * fq + r) * OBL + 16 * wave + fr] = o[ti][r];
            __syncthreads();
            const int t = tid >> 3, seg = tid & 7;
            float ov[16]; float ss = 0.f;
#pragma unroll
            for (int q = 0; q < 4; ++q) { const f32x4 a = *(const LAS f32x4*)(OB + t * OBL + seg * 16 + 4 * q); ov[4 * q] = a.x; ov[4 * q + 1] = a.y; ov[4 * q + 2] = a.z; ov[4 * q + 3] = a.w;
                ss += (a.x * a.x + a.y * a.y) + (a.z * a.z + a.w * a.w); }
            ss = sum8(ss);
            const float rn = rsqrtf(ss * (1.f / 128.f) + EPS);
            const u32x4 g0 = gcur.a, g1 = gcur.b;
            const float* gnp = gain_l + h * 128 + seg * 16;
            u32x4 y0, y1;
#pragma unroll
            for (int q = 0; q < 4; ++q) {
                const float ga = bflo(g0[q]), gb = bfhi(g0[q]), gc = bflo(g1[q]), gd = bfhi(g1[q]);
                y0[q] = pk2(ov[2 * q] * rn * gnp[2 * q] * (ga * sigm(ga)), ov[2 * q + 1] * rn * gnp[2 * q + 1] * (gb * sigm(gb)));
                y1[q] = pk2(ov[8 + 2 * q] * rn * gnp[8 + 2 * q] * (gc * sigm(gc)), ov[8 + 2 * q + 1] * rn * gnp[8 + 2 * q + 1] * (gd * sigm(gd)));
            }
            bf16_t* yp = Y + (size_t)(tr0 + t) * D + 1024 + h * 128 + seg * 16;
            *(u32x4*)yp = y0; *(u32x4*)(yp + 8) = y1;
        }
    }
    if (PASS == 1) {
        float* sb = STB + (size_t)(chain * 8 + g) * ST_STRIDE;
        state_store(acc, sb, wave, lane);
        if (rg == 0) { sb[16384 + c0] = gl0; sb[16384 + c0 + 1] = gl1; }
    }
}

template <int PASS>
__device__ __forceinline__ void mlstm_unit(const bf16_t* __restrict__ P, const float* __restrict__ conv_l, const float* __restrict__ ib_l, const float* __restrict__ fb_l,
                                           float* __restrict__ STB, bf16_t* __restrict__ Y, int unit, LAS unsigned char* lds, int tid, int lane, int wave) {
    const int chain = unit >> 3, g = unit & 7, b = chain >> 2, h = chain & 3;
    const int t0 = b * S + g * 512;
    const int fr = lane & 15, fq = lane >> 4, tq = (lane & 15) >> 2, tp = lane & 3;
    const int kp = tid & 63, rg = wave, c0 = 2 * kp;
    LAS bf16_t* QM = (LAS bf16_t*)(lds + R_QT); LAS bf16_t* KM = (LAS bf16_t*)(lds + R_KT); LAS bf16_t* KW = (LAS bf16_t*)(lds + R_KD);
    LAS bf16_t* VV = (LAS bf16_t*)(lds + R_V); LAS bf16_t* CB = (LAS bf16_t*)(lds + R_SB); LAS bf16_t* PS = (LAS bf16_t*)(lds + R_PS);
    LAS float* VEC = (LAS float*)(lds + R_VEC);
    LAS float* GA = VEC;
    LAS float* GPM = VEC + 512;
    LAS float* GCUM = VEC + 1024;
    LAS float* NV = VEC + 1536;
    LAS float* DENP = VEC + 1664;
    LAS float* DINT = VEC + 1792;
    LAS float* KSUM = VEC + 1856;
    LAS float* OB = (LAS float*)(lds + R_OB);
    float wq0[4], wq1[4], wk0[4], wk1[4];
#pragma unroll
    for (int j = 0; j < 4; ++j) {
        wq0[j] = conv_l[j * 1024 + h * 128 + c0]; wq1[j] = conv_l[j * 1024 + h * 128 + c0 + 1];
        wk0[j] = conv_l[j * 1024 + 512 + h * 128 + c0]; wk1[j] = conv_l[j * 1024 + 512 + h * 128 + c0 + 1];
    }
    {
        const bf16_t* pr = P + (size_t)(t0 + wave * 64 + lane) * NP;
        const float ip = bf2f(pr[C_IM + h]) + ib_l[h];
        const float z = bf2f(pr[C_FM + h]) + fb_l[h];
        const float lf = fminf(z, 0.f) - __logf(1.f + __expf(-fabsf(z)));
        float cu = lf;
#pragma unroll
        for (int o = 1; o < 64; o <<= 1) { const float t = __shfl_up(cu, o); if (lane >= o) cu += t; }
        const float a = ip - cu;
        float pm = a;
#pragma unroll
        for (int o = 1; o < 64; o <<= 1) { const float t = __shfl_up(pm, o); if (lane >= o) pm = fmaxf(pm, t); }
        GA[wave * 64 + lane] = a; GPM[wave * 64 + lane] = pm; GCUM[wave * 64 + lane] = cu;
    }
    pg8::f32x4 acc[8];
#pragma unroll
    for (int j = 0; j < 8; ++j) acc[j] = (pg8::f32x4){0.f, 0.f, 0.f, 0.f};
    float mprev = (PASS == 1) ? -1e30f : 0.f;
    float nreg = 0.f;
    float fsum = 0.f;
    if (PASS == 2) {
        for (int jg = 0; jg < g; ++jg) {
            const float* sb = STB + (size_t)(chain * 8 + jg) * ST_STRIDE;
            const float mE = sb[16384 + 128], F = sb[16384 + 129];
            const float mn = fmaxf(F + mprev, mE);
            const float s1 = __expf(F + mprev - mn), s2 = __expf(mE - mn);
#pragma unroll
            for (int j = 0; j < 8; ++j)
#pragma unroll
                for (int r = 0; r < 4; ++r) acc[j][r] = acc[j][r] * s1 + s2 * sb[((wave * 8 + j) * 4 + r) * 64 + lane];
            if (tid < 128) nreg = nreg * s1 + s2 * sb[16384 + tid];
            mprev = mn;
        }
    }
    if (tid < 128) NV[tid] = nreg;
    unsigned xqn[11], xkn[11];
#define MLSTM_FETCH(TR0, CC) do { _Pragma("unroll") for (int i = 0; i < 11; ++i) { \
            const int row_ = rg * 8 + i - 3; const int pos_ = g * 512 + (CC) * 64 + row_; unsigned wq_ = 0u, wk_ = 0u; \
            if (pos_ >= 0) { const bf16_t* pr_ = P + (size_t)((TR0) + row_) * NP + h * 128 + c0; if (PASS == 2) wq_ = *(const unsigned*)(pr_ + C_QM); wk_ = *(const unsigned*)(pr_ + C_KM); } \
            xqn[i] = wq_; xkn[i] = wk_; } \
        } while (0)
    MLSTM_FETCH(t0, 0);
    __syncthreads();
#pragma unroll 1
    for (int c = 0; c < 8; ++c) {
        const int tr0 = t0 + c * 64;
        const LAS float* AV = GA + c * 64; const LAS float* PM = GPM + c * 64; const LAS float* CUM = GCUM + c * 64;
        const float M63 = fmaxf(PM[63], mprev), last = CUM[63];
        float ks0 = 0.f, ks1 = 0.f;
#pragma unroll
        for (int i = 0; i < 8; ++i) {
            const int row = rg * 8 + i;
            float k0v = 0.f, k1v = 0.f, q0v = 0.f, q1v = 0.f;
#pragma unroll
            for (int j = 0; j < 4; ++j) { k0v += wk0[j] * bflo(xkn[i + j]); k1v += wk1[j] * bfhi(xkn[i + j]); if (PASS == 2) { q0v += wq0[j] * bflo(xqn[i + j]); q1v += wq1[j] * bfhi(xqn[i + j]); } }
            k0v = k0v * sigm(k0v) * 0.08838834764831845f; k1v = k1v * sigm(k1v) * 0.08838834764831845f;
            const float wsr = __expf(AV[row] - M63);
            const unsigned kw = pk2(k0v * wsr, k1v * wsr);
            *(LAS unsigned*)(KW + row * RL + c0) = kw;
            ks0 += bflo(kw); ks1 += bfhi(kw);
            if (PASS == 2) {
                *(LAS unsigned*)(KM + row * RL + c0) = pk2(k0v, k1v);
                *(LAS unsigned*)(QM + row * RL + c0) = pk2(q0v * sigm(q0v), q1v * sigm(q1v));
            }
        }
        KSUM[rg * 128 + c0] = ks0; KSUM[rg * 128 + c0 + 1] = ks1;
        { const TileRegs vt = tile_load(P + (size_t)tr0 * NP + C_VM + h * 128, tid); tile_store(vt, VV, tid); }
        if (c < 7) MLSTM_FETCH(tr0 + 64, c + 1);
        const float decay = __expf(mprev - M63);
        pg8::f32x4 o1[4], o2[4];
        if (PASS == 2) {
            const float one[4] = {1.f, 1.f, 1.f, 1.f};
            state_to_lds(acc, one, CB, wave, fr, fq);
        }
        __syncthreads();
        TileRegs ocur = {};
        if (PASS == 2) ocur = tile_load(P + (size_t)tr0 * NP + C_OM + h * 128, tid);
        if (PASS == 2) {
            { const int ti = wave >> 1;
              float dp[4] = {0.f, 0.f, 0.f, 0.f};
#pragma unroll
              for (int tjj = 0; tjj < 2; ++tjj) {
                  const int tj = 2 * (wave & 1) + tjj;
                  pg8::f32x4 sa = {0.f, 0.f, 0.f, 0.f};
                  if (tj <= ti) score_tile(sa, QM, KM, ti, tj, fr, fq);
                  const int s = 16 * tj + fr;
                  const float as = AV[s];
#pragma unroll
                  for (int r = 0; r < 4; ++r) {
                      const int t = 16 * ti + 4 * fq + r;
                      const float w = (s <= t) ? sa[r] * __expf(as - fmaxf(PM[t], mprev)) : 0.f;
                      st_bf16(PS + t * PSL + s, w);
                      dp[r] += w;
                  }
              }
#pragma unroll
              for (int r = 0; r < 4; ++r) {
                  const float v = sum16(dp[r]);
                  if (fr == 0) DENP[(16 * ti + 4 * fq + r) * 2 + (wave & 1)] = v;
              } }
            { const int t = tid >> 3, seg = tid & 7;
              const bf16x8 qa = *(const LAS bf16x8*)(QM + t * RL + seg * 16), qb = *(const LAS bf16x8*)(QM + t * RL + seg * 16 + 8);
              float dsum = 0.f;
#pragma unroll
              for (int q = 0; q < 8; ++q) dsum += bf2f((unsigned short)qa[q]) * NV[seg * 16 + q] + bf2f((unsigned short)qb[q]) * NV[seg * 16 + 8 + q];
              dsum = sum8(dsum);
              if (seg == 0) DINT[t] = dsum; }
            __syncthreads();
            bf16x8 cbf[4], vbf[2];
#pragma unroll
            for (int ks = 0; ks < 4; ++ks) { const LAS bf16_t* p = CB + (ks * 32 + 4 * fq + tq) * RL + 16 * wave + 4 * tp; cbf[ks] = tr_pair(p, p + 16 * RL); }
#pragma unroll
            for (int ks = 0; ks < 2; ++ks) { const LAS bf16_t* p = VV + (ks * 32 + 4 * fq + tq) * RL + 16 * wave + 4 * tp; vbf[ks] = tr_pair(p, p + 16 * RL); }
#pragma unroll
            for (int ti = 0; ti < 4; ++ti) {
                o1[ti] = (pg8::f32x4){0.f, 0.f, 0.f, 0.f}; o2[ti] = (pg8::f32x4){0.f, 0.f, 0.f, 0.f};
#pragma unroll
                for (int ks = 0; ks < 4; ++ks) o2[ti] = __builtin_amdgcn_mfma_f32_16x16x32_bf16(ld_row_split(QM + (16 * ti + fr) * RL + ks * 32 + 4 * fq), cbf[ks], o2[ti], 0, 0, 0);
#pragma unroll
                for (int ks = 0; ks < 2; ++ks) o1[ti] = __builtin_amdgcn_mfma_f32_16x16x32_bf16(ld_row_split(PS + (16 * ti + fr) * PSL + ks * 32 + 4 * fq), vbf[ks], o1[ti], 0, 0, 0);
            }
        }
        {
#pragma unroll
            for (int j = 0; j < 8; ++j) acc[j] = acc[j] * decay;
            state_update(acc, KW, VV, wave, fq, tq, tp);
            if (tid < 128) {
                float sumk = 0.f;
#pragma unroll
                for (int r8 = 0; r8 < 8; ++r8) sumk += KSUM[r8 * 128 + tid];
                nreg = nreg * decay + sumk;
            }
        }
        fsum += last;
        const float mnew = last + M63;
        __syncthreads();
        if (tid < 128) NV[tid] = nreg;
        if (PASS == 2) {
#pragma unroll
            for (int ti = 0; ti < 4; ++ti)
#pragma unroll
                for (int r = 0; r < 4; ++r) {
                    const int t = 16 * ti + 4 * fq + r;
                    OB[t * OBL + 16 * wave + fr] = o1[ti][r] + __expf(mprev - fmaxf(PM[t], mprev)) * o2[ti][r];
                }
            __syncthreads();
            const int t = tid >> 3, seg = tid & 7;
            const float Mt = fmaxf(PM[t], mprev);
            const float wi = __expf(mprev - Mt);
            const float den = DENP[t * 2] + DENP[t * 2 + 1] + wi * DINT[t];
            const float hd = 1.f / fmaxf(fabsf(den), __expf(-(CUM[t] + Mt)));
            const u32x4 g0 = ocur.a, g1 = ocur.b;
            const unsigned gw[8] = {g0[0], g0[1], g0[2], g0[3], g1[0], g1[1], g1[2], g1[3]};
            unsigned yw[8];
#pragma unroll
            for (int q = 0; q < 4; ++q) {
                const f32x4 a = *(const LAS f32x4*)(OB + t * OBL + seg * 16 + 4 * q);
                yw[2 * q] = pk2(a.x * hd * sigm(bflo(gw[2 * q])), a.y * hd * sigm(bfhi(gw[2 * q])));
                yw[2 * q + 1] = pk2(a.z * hd * sigm(bflo(gw[2 * q + 1])), a.w * hd * sigm(bfhi(gw[2 * q + 1])));
            }
            u32x4 y0, y1;
            y0[0] = yw[0]; y0[1] = yw[1]; y0[2] = yw[2]; y0[3] = yw[3]; y1[0] = yw[4]; y1[1] = yw[5]; y1[2] = yw[6]; y1[3] = yw[7];
            bf16_t* yp = Y + (size_t)(tr0 + t) * D + 1536 + h * 128 + seg * 16;
            *(u32x4*)yp = y0; *(u32x4*)(yp + 8) = y1;
        }
        mprev = mnew;
        __syncthreads();
    }
#undef MLSTM_FETCH
    if (PASS == 1) {
        float* sb = STB + (size_t)(chain * 8 + g) * ST_STRIDE;
        state_store(acc, sb, wave, lane);
        if (tid < 128) sb[16384 + tid] = nreg;
        if (tid == 0) { sb[16384 + 128] = mprev; sb[16384 + 129] = fsum; }
    }
}
}

namespace mk {
#define XB_TMO      128
#define XB_XCNT(j)  (256  + 64 * (j))
#define XB_XSUB(j)  (1280 + 64 * (j))
#define XB_XGEN(j)  (2304 + 64 * (j))
#define XB_TOP      3328
#define XB_TOPGEN   3392
#define XCD_BAR_WORDS 3456
#define XB_SPIN_CAP (1u << 18)

__device__ __forceinline__ unsigned xb_ld(unsigned* p)              { return __hip_atomic_load(p, __ATOMIC_RELAXED, __HIP_MEMORY_SCOPE_AGENT); }
__device__ __forceinline__ unsigned xb_add(unsigned* p, unsigned v) { return __hip_atomic_fetch_add(p, v, __ATOMIC_RELAXED, __HIP_MEMORY_SCOPE_AGENT); }
__device__ __forceinline__ unsigned xb_xcc_id() { return (unsigned)__builtin_amdgcn_s_getreg((3 << 11) | 20) & 0xFu; }
#define XB_SPIN(cond, bar) do { unsigned _sp = 0; while (cond) { __builtin_amdgcn_s_sleep(1); \
    if ((++_sp & 255u) == 0u) { if (xb_ld(&(bar)[XB_TMO])) break; if (_sp > XB_SPIN_CAP) { atomicAdd(&(bar)[XB_TMO], 1u); break; } } } } while (0)

struct XcdBarrier {
    unsigned* bar; unsigned x;
    volatile LAS unsigned* st;
};

__device__ __forceinline__ XcdBarrier xcd_barrier_post(unsigned* bar, volatile LAS unsigned* st) {
    XcdBarrier b; b.bar = bar; b.x = xb_xcc_id(); b.st = st;
    if (threadIdx.x == 0) (void)xb_add(&bar[XB_XCNT(b.x)], 1u);
    return b;
}
__device__ __forceinline__ void xcd_barrier_complete(unsigned* bar, unsigned x, unsigned& nloc, unsigned& nx) {
    const unsigned G = gridDim.x * gridDim.y * gridDim.z;
    unsigned sum, cnt, mine, sp = 0u;
    for (;;) {
        sum = 0u; cnt = 0u; mine = 0u;
#pragma unroll
        for (unsigned j = 0; j < 16; ++j) { const unsigned c = xb_ld(&bar[XB_XCNT(j)]); sum += c; cnt += (c > 0u) ? 1u : 0u; mine = (j == x) ? c : mine; }
        if (sum == G) break;
        __builtin_amdgcn_s_sleep(1);
        if ((++sp & 255u) == 0u) { if (xb_ld(&bar[XB_TMO])) break; if (sp > XB_SPIN_CAP) { atomicAdd(&bar[XB_TMO], 1u); break; } }
    }
    nloc = mine > 0u ? mine : 1u; nx = cnt > 0u ? cnt : 1u;
}

__device__ __forceinline__ void xcd_barrier(const XcdBarrier& b) {
    asm volatile("s_waitcnt vmcnt(0)" ::: "memory");
    __syncthreads();
    if (threadIdx.x == 0) {
        unsigned* bar = b.bar;
        __builtin_amdgcn_s_waitcnt(0);
        unsigned nloc = b.st[0], nx = b.st[1];
        if (nloc == 0u) { xcd_barrier_complete(bar, b.x, nloc, nx); b.st[0] = nloc; b.st[1] = nx; }
        const unsigned old = xb_add(&bar[XB_XSUB(b.x)], 1u);
        const unsigned gen = old / nloc;
        if (old + 1u == (gen + 1u) * nloc) {
            __builtin_amdgcn_fence(__ATOMIC_RELEASE, "agent");
            asm volatile("s_waitcnt vmcnt(0)" ::: "memory");
            const unsigned og = xb_add(&bar[XB_TOP], 1u);
            const unsigned tg = og / nx;
            if (og + 1u == (tg + 1u) * nx) xb_add(&bar[XB_TOPGEN], 1u);
            else XB_SPIN(xb_ld(&bar[XB_TOPGEN]) == tg, bar);
            __builtin_amdgcn_fence(__ATOMIC_ACQUIRE, "agent");
            xb_add(&bar[XB_XGEN(b.x)], 1u);
            asm volatile("s_waitcnt vmcnt(0)" ::: "memory");
        } else {
            XB_SPIN(xb_ld(&bar[XB_XGEN(b.x)]) == gen, bar);
            __builtin_amdgcn_fence(__ATOMIC_ACQUIRE, "agent");
            asm volatile("s_waitcnt vmcnt(0)" ::: "memory");
        }
    }
    __syncthreads();
}

}

namespace mk {
constexpr int NSLICE = 16, SLW = 128, TBLK = 128, NTB = T / TBLK;
constexpr int CTL_Q = 3584;

__device__ __forceinline__ f32x2 fma2(f32x2 a, f32x2 b, f32x2 c) { return __builtin_elementwise_fma(a, b, c); }

__device__ __forceinline__ int q_next(unsigned* cnt, LAS int* slot, int tid) {
    __syncthreads();
    if (tid == 0) *slot = (int)__hip_atomic_fetch_add(cnt, 1u, __ATOMIC_RELAXED, __HIP_MEMORY_SCOPE_AGENT);
    __syncthreads();
    const int v = *slot;
    return v < NTB ? v : -1;
}

typedef __amdgpu_buffer_rsrc_t rsrc_t;
__device__ __forceinline__ rsrc_t make_rsrc(const void* p, unsigned bytes) { return __builtin_amdgcn_make_buffer_rsrc((void*)p, 0, bytes, 0x00020000); }

constexpr int PL_IDX = 0, PL_AUX = TBLK * 128 * 4;
#define PEER_ISSUE(W, IDP) do { const LAS u32x4* ip_ = (const LAS u32x4*)(IDP); const u32x4 i0_ = ip_[0], i1_ = ip_[1], i2_ = ip_[2], i3_ = ip_[3]; \
        _Pragma("unroll") for (int k = 0; k < 4; ++k) { \
            W[k]      = __builtin_amdgcn_raw_buffer_load_b128(rs, (int)i0_[k] * SLW + c * 16, soff, 0); \
            W[4 + k]  = __builtin_amdgcn_raw_buffer_load_b128(rs, (int)i1_[k] * SLW + c * 16, soff, 0); \
            W[8 + k]  = __builtin_amdgcn_raw_buffer_load_b128(rs, (int)i2_[k] * SLW + c * 16, soff, 0); \
            W[12 + k] = __builtin_amdgcn_raw_buffer_load_b128(rs, (int)i3_[k] * SLW + c * 16, soff, 0); } } while (0)
constexpr float XS8 = 1.f;
typedef _Float16 h2_t __attribute__((ext_vector_type(2)));
template <int CTRL> __device__ __forceinline__ int dppi(int x) { return __builtin_amdgcn_mov_dpp(x, CTRL, 0xf, 0xf, true); }
template <int MODE>
__device__ __forceinline__ void u_compute(u32x4 (&w)[16], const LAS unsigned* xs, float* __restrict__ PART, int s, int t, int g, int c) {
    if (MODE == 1) { _Pragma("unroll") for (int k = 0; k < 16; ++k) asm volatile("" :: "v"(w[k])); return; }
    if (MODE == 2) { _Pragma("unroll") for (int k = 0; k < 16; ++k) asm volatile("" : "=v"(w[k])); }
    const u32x4 xi = *(const LAS u32x4*)xs;
    int r0 = 0, r1 = 0;
#pragma unroll
    for (int k = 0; k < 16; ++k) {
        int d = __builtin_amdgcn_sdot4((int)w[k][0], (int)xi[0], 0, false);
        d = __builtin_amdgcn_sdot4((int)w[k][1], (int)xi[1], d, false);
        d = __builtin_amdgcn_sdot4((int)w[k][2], (int)xi[2], d, false);
        d = __builtin_amdgcn_sdot4((int)w[k][3], (int)xi[3], d, false);
        d += dppi<DPP_XOR1>(d); d += dppi<DPP_XOR2>(d); d += dppi<DPP_HMIR>(d);
        if (k < 8) { if (c == k) r0 = d; } else { if (c == k - 8) r1 = d; }
    }
    if (MODE == 2) { asm volatile("" :: "v"(r0), "v"(r1)); return; }
    float* pp = PART + ((size_t)s * T + t) * 128 + 8 * c + g;
    pp[0] = (float)r0; pp[64] = (float)r1;
}
struct UStage { u32x4 id[8]; u32x4 x[4]; float am[4]; };
__device__ __forceinline__ void u_stage_load(UStage& r, int s, int tb, const bf16_t* __restrict__ XB, const int* __restrict__ IDX, const float* __restrict__ AMXP, int tid) {
    const u32x4* src = (const u32x4*)(IDX + (size_t)tb * TBLK * 128);
#pragma unroll
    for (int j = 0; j < 8; ++j) r.id[j] = src[tid + j * NTHR];
#pragma unroll
    for (int j = 0; j < 4; ++j) { const int e = tid + j * NTHR, tt = e >> 4, ch = e & 15; r.x[j] = *(const u32x4*)(XB + (size_t)(tb * TBLK + tt) * D + s * SLW + ch * 8);
        const float* ap = AMXP + (size_t)(tb * TBLK + tt) * 32 + 2 * ch; r.am[j] = fmaxf(ap[0], ap[1]); }
}
__device__ __forceinline__ void u_stage_store(const UStage& r, LAS unsigned char* lds, int tid) {
#pragma unroll
    for (int j = 0; j < 8; ++j) *(LAS u32x4*)(lds + PL_IDX + (size_t)(tid + j * NTHR) * 16) = r.id[j];
#pragma unroll
    for (int j = 0; j < 4; ++j) { const int e = tid + j * NTHR, tt = e >> 4, ch = e & 15;
        float am = r.am[j];
        am = fmaxf(am, dppf<DPP_XOR1>(am)); am = fmaxf(am, dppf<DPP_XOR2>(am)); am = fmaxf(am, dppf<DPP_HMIR>(am)); am = fmaxf(am, dppf<DPP_ROR8>(am));
        const float xs = am > 0.f ? 127.f / am : 0.f;
        int lo, hi;
        lo = (__float2int_rn(bflo(r.x[j][0]) * xs) & 0xff) | ((__float2int_rn(bfhi(r.x[j][0]) * xs) & 0xff) << 8) | ((__float2int_rn(bflo(r.x[j][1]) * xs) & 0xff) << 16) | (__float2int_rn(bfhi(r.x[j][1]) * xs) << 24);
        hi = (__float2int_rn(bflo(r.x[j][2]) * xs) & 0xff) | ((__float2int_rn(bfhi(r.x[j][2]) * xs) & 0xff) << 8) | ((__float2int_rn(bflo(r.x[j][3]) * xs) & 0xff) << 16) | (__float2int_rn(bfhi(r.x[j][3]) * xs) << 24);
        u32x2 o; o.x = (unsigned)lo; o.y = (unsigned)hi;
        *(LAS u32x2*)(lds + PL_AUX + tt * 128 + ch * 8) = o; }
}
template <int MODE>
__device__ __forceinline__ void peer_u_run(int s, int tb, const unsigned char* __restrict__ U8, float* __restrict__ PART, LAS unsigned char* lds, int wave, int lane) {
    const int g = lane >> 3, c = lane & 7;
    const rsrc_t rs = make_rsrc(U8, (unsigned)((size_t)NE * D));
    const int soff = s * NE * SLW;
    constexpr int NTW = TBLK / NWAVES;
    const int tw = wave * NTW, t0 = tb * TBLK + tw;
    const LAS unsigned char* idb = lds + PL_IDX + (size_t)tw * 512 + g * 64;
    const LAS unsigned* xsb = (const LAS unsigned*)(lds + PL_AUX + (size_t)tw * 128) + c * 4;
    u32x4 wa[16], wb[16];
    if (MODE != 2) PEER_ISSUE(wa, idb);
#pragma unroll 1
    for (int i = 0; i < NTW; i += 2) {
        if (MODE != 2) PEER_ISSUE(wb, idb + (i + 1) * 512);
        u_compute<MODE>(wa, xsb + i * 32, PART, s, t0 + i, g, c);
        if (MODE != 2) PEER_ISSUE(wa, idb + min(i + 2, NTW - 1) * 512);
        u_compute<MODE>(wb, xsb + (i + 1) * 32, PART, s, t0 + i + 1, g, c);
    }
}
template <int MODE>
__device__ __forceinline__ void peer_u_block(int s, int tb, const bf16_t* __restrict__ XB, const int* __restrict__ IDX, const float* __restrict__ AMXP, const unsigned char* __restrict__ U8,
                                             float* __restrict__ PART, LAS unsigned char* lds, int tid, int wave, int lane) {
    UStage r; u_stage_load(r, s, tb, XB, IDX, AMXP, tid); u_stage_store(r, lds, tid);
    __syncthreads();
    peer_u_run<MODE>(s, tb, U8, PART, lds, wave, lane);
}

__device__ __forceinline__ void peer_act_token(int t, const float* __restrict__ PART, const float* __restrict__ ssp, const float* __restrict__ amxp, const int* __restrict__ IDX, const float* __restrict__ GATE,
                                               const float* __restrict__ USC, const float* __restrict__ VSC, signed char* __restrict__ ACT, float* __restrict__ ASC, int lane) {
    const int p0 = 8 * (lane & 15) + (lane >> 4), p1 = 8 * (lane & 15) + 4 + (lane >> 4);
    float s0 = 0.f, s1 = 0.f;
#pragma unroll
    for (int s = 0; s < NSLICE; ++s) { const float* pp = PART + ((size_t)s * T + t) * 128; s0 += pp[p0]; s1 += pp[p1]; }
    float sp = (lane < 32) ? ssp[(size_t)t * 32 + lane] : 0.f;
    sp = wsum(sp);
    float xam = (lane < 32) ? amxp[(size_t)t * 32 + lane] : 0.f;
    xam = wmax(xam);
    const float rs1 = rsqrtf(sp * (1.f / D) + EPS) * (xam * (1.f / 127.f));
    const int id0 = IDX[(size_t)t * 128 + lane], id1 = IDX[(size_t)t * 128 + 64 + lane];
    const float a0 = gelu_erf(s0 * USC[id0] * (rs1 * (1.f / XS8))) * GATE[(size_t)t * 128 + lane] * VSC[id0];
    const float a1 = gelu_erf(s1 * USC[id1] * (rs1 * (1.f / XS8))) * GATE[(size_t)t * 128 + 64 + lane] * VSC[id1];
    const float am = wmax(fmaxf(fabsf(a0), fabsf(a1)));
    const float qs = am > 0.f ? 127.f / am : 0.f;
    ACT[(size_t)t * 128 + lane] = (signed char)__float2int_rn(a0 * qs);
    ACT[(size_t)t * 128 + 64 + lane] = (signed char)__float2int_rn(a1 * qs);
    if (lane == 0) ASC[t] = am * (1.f / 127.f);
}

__device__ __forceinline__ float wsum_fast(float v) {
    v += dppf<DPP_XOR1>(v); v += dppf<DPP_XOR2>(v); v += dppf<DPP_HMIR>(v); v += dppf<DPP_ROR8>(v);
    { const auto s = __builtin_amdgcn_permlane16_swap(__float_as_uint(v), __float_as_uint(v), false, false); v = __uint_as_float(s[0]) + __uint_as_float(s[1]); }
    { const auto s = __builtin_amdgcn_permlane32_swap(__float_as_uint(v), __float_as_uint(v), false, false); v = __uint_as_float(s[0]) + __uint_as_float(s[1]); }
    return v;
}
__device__ __forceinline__ void tr4x4(unsigned d0, unsigned d1, unsigned d2, unsigned d3, unsigned (&t)[4]) {
    const unsigned x0 = __builtin_amdgcn_perm(d1, d0, 0x05010400u), x1 = __builtin_amdgcn_perm(d1, d0, 0x07030602u);
    const unsigned y0 = __builtin_amdgcn_perm(d3, d2, 0x05010400u), y1 = __builtin_amdgcn_perm(d3, d2, 0x07030602u);
    t[0] = __builtin_amdgcn_perm(y0, x0, 0x05040100u); t[1] = __builtin_amdgcn_perm(y0, x0, 0x07060302u);
    t[2] = __builtin_amdgcn_perm(y1, x1, 0x05040100u); t[3] = __builtin_amdgcn_perm(y1, x1, 0x07060302u);
}
template <int VMODE>
__device__ __forceinline__ void v_compute(u32x4 (&w)[16], const LAS unsigned* avp, float ascale, unsigned rw, bf16_t* __restrict__ XBio, float* __restrict__ OUT32,
                                          float* __restrict__ SS16, int s, int t, int g, int c, int lane) {
    const size_t off = (size_t)t * D + s * SLW + c * 16 + 2 * g;
    const f32x2 res = {bflo(rw), bfhi(rw)};
    const u32x4 a4 = *(const LAS u32x4*)avp;
    int acci[16];
#pragma unroll
    for (int i = 0; i < 16; ++i) acci[i] = 0;
#pragma unroll
    for (int k4 = 0; k4 < 4; ++k4)
#pragma unroll
        for (int q = 0; q < 4; ++q) {
            unsigned tt[4];
            tr4x4(w[4 * k4][q], w[4 * k4 + 1][q], w[4 * k4 + 2][q], w[4 * k4 + 3][q], tt);
#pragma unroll
            for (int j = 0; j < 4; ++j) acci[4 * q + j] = __builtin_amdgcn_sdot4((int)tt[j], (int)a4[k4], acci[4 * q + j], false);
        }
    int h4x[4], h4y[4];
#pragma unroll
    for (int q = 0; q < 4; ++q) {
        const auto sx = __builtin_amdgcn_permlane32_swap((unsigned)acci[2 * q], (unsigned)acci[2 * (4 + q)], false, false);
        const auto sy = __builtin_amdgcn_permlane32_swap((unsigned)acci[2 * q + 1], (unsigned)acci[2 * (4 + q) + 1], false, false);
        h4x[q] = (int)sx[0] + (int)sx[1]; h4y[q] = (int)sy[0] + (int)sy[1];
    }
    int h2x[2], h2y[2];
#pragma unroll
    for (int q = 0; q < 2; ++q) {
        const auto sx = __builtin_amdgcn_permlane16_swap((unsigned)h4x[q], (unsigned)h4x[2 + q], false, false);
        const auto sy = __builtin_amdgcn_permlane16_swap((unsigned)h4y[q], (unsigned)h4y[2 + q], false, false);
        h2x[q] = (int)sx[0] + (int)sx[1]; h2y[q] = (int)sy[0] + (int)sy[1];
    }
    const bool up = (g & 1) != 0;
    const int keepx = up ? h2x[1] : h2x[0], sendx = up ? h2x[0] : h2x[1], keepy = up ? h2y[1] : h2y[0], sendy = up ? h2y[0] : h2y[1];
    const int ix = keepx + dppi<DPP_ROR8>(sendx), iy = keepy + dppi<DPP_ROR8>(sendy);
    f32x2 o = {(float)ix * ascale + res.x, (float)iy * ascale + res.y};
    if (OUT32) *(f32x2*)(OUT32 + off) = o;
    else { const unsigned ow = pk2(o.x, o.y); *(unsigned*)(XBio + off) = ow; o = (f32x2){bflo(ow), bfhi(ow)}; }
    const float q2 = wsum_fast(o.x * o.x + o.y * o.y);
    if (lane == 0) SS16[(size_t)t * 16 + s] = q2;
}
constexpr int PLV_ACT = TBLK * 128 * 4;
constexpr int PLV_ASC = PLV_ACT + TBLK * 128;
struct VStage { u32x4 id[8]; u32x4 a[2]; float asc; };
__device__ __forceinline__ void v_stage_load(VStage& r, int tb, const signed char* __restrict__ ACT, const float* __restrict__ ASC, const int* __restrict__ IDX, int tid) {
    const u32x4* src = (const u32x4*)(IDX + (size_t)tb * TBLK * 128);
#pragma unroll
    for (int j = 0; j < 8; ++j) r.id[j] = src[tid + j * NTHR];
    const u32x4* srca = (const u32x4*)(ACT + (size_t)tb * TBLK * 128);
    r.a[0] = srca[tid]; r.a[1] = srca[tid + NTHR];
    r.asc = (tid < TBLK) ? ASC[(size_t)tb * TBLK + tid] : 0.f;
}
__device__ __forceinline__ void v_stage_store(const VStage& r, LAS unsigned char* lds, int tid) {
#pragma unroll
    for (int j = 0; j < 8; ++j) *(LAS u32x4*)(lds + PL_IDX + (size_t)(tid + j * NTHR) * 16) = r.id[j];
    *(LAS u32x4*)(lds + PLV_ACT + (size_t)tid * 16) = r.a[0]; *(LAS u32x4*)(lds + PLV_ACT + (size_t)(tid + NTHR) * 16) = r.a[1];
    if (tid < TBLK) *(LAS float*)(lds + PLV_ASC + tid * 4) = r.asc;
}
template <int VMODE>
__device__ __forceinline__ void peer_v_run(int s, int tb, const unsigned char* __restrict__ V8, bf16_t* __restrict__ XBio, float* __restrict__ OUT32, float* __restrict__ SS16,
                                           LAS unsigned char* lds, int wave, int lane) {
    const int g = lane >> 3, c = lane & 7;
    const rsrc_t rs = make_rsrc(V8, (unsigned)((size_t)NE * D));
    const int soff = s * NE * SLW;
    constexpr int NTW = TBLK / NWAVES;
    const int tw = wave * NTW, t0 = tb * TBLK + tw;
    const LAS unsigned char* idb = lds + PL_IDX + (size_t)tw * 512 + g * 64;
    const LAS unsigned* avb = (const LAS unsigned*)(lds + PLV_ACT + (size_t)tw * 128) + g * 4;
    const LAS float* ascb = (const LAS float*)(lds + PLV_ASC) + tw;
    const bf16_t* rbase = XBio + (size_t)t0 * D + s * SLW + c * 16 + 2 * g;
    u32x4 wa[16], wb[16];
    unsigned ra = *(const unsigned*)rbase, rb;
    PEER_ISSUE(wa, idb);
#pragma unroll 1
    for (int i = 0; i < NTW; i += 2) {
        rb = *(const unsigned*)(rbase + (size_t)(i + 1) * D);
        PEER_ISSUE(wb, idb + (i + 1) * 512);
        v_compute<VMODE>(wa, avb + i * 32, ascb[i], ra, XBio, OUT32, SS16, s, t0 + i, g, c, lane);
        ra = *(const unsigned*)(rbase + (size_t)min(i + 2, NTW - 1) * D);
        PEER_ISSUE(wa, idb + min(i + 2, NTW - 1) * 512);
        v_compute<VMODE>(wb, avb + (i + 1) * 32, ascb[i + 1], rb, XBio, OUT32, SS16, s, t0 + i + 1, g, c, lane);
    }
}
__device__ __forceinline__ void peer_v_block(int s, int tb, const signed char* __restrict__ ACT, const float* __restrict__ ASC, const int* __restrict__ IDX, const unsigned char* __restrict__ V8,
                                             bf16_t* __restrict__ XBio, float* __restrict__ OUT32, float* __restrict__ SS16,
                                             LAS unsigned char* lds, int tid, int wave, int lane) {
    VStage r; v_stage_load(r, tb, ACT, ASC, IDX, tid); v_stage_store(r, lds, tid);
    __syncthreads();
    peer_v_run<0>(s, tb, V8, XBio, OUT32, SS16, lds, wave, lane);
}

__device__ __forceinline__ int slice_of(int xcc, int j) { const int xx = (xcc + (j >> 1)) & 7; return xx + 8 * (j & 1); }

__device__ __forceinline__ void final_norm_row(const bf16_t* __restrict__ xrow, float* __restrict__ orow, const float* __restrict__ ss16, const float* __restrict__ g, int lane) {
    float sp = (lane < 16) ? ss16[lane] : 0.f;
    sp = wsum(sp);
    const float rf = rsqrtf(sp * (1.f / D) + EPS);
    const u32x2* xi = (const u32x2*)xrow + lane;
    f32x4* o = (f32x4*)orow + lane;
    const f32x4* g4 = (const f32x4*)g + lane;
    u32x2 xv[8];
#pragma unroll
    for (int j = 0; j < 8; ++j) xv[j] = xi[64 * j];
#pragma unroll
    for (int j = 0; j < 8; ++j) { const f32x4 gg = g4[64 * j]; f32x4 v = {bflo(xv[j].x), bfhi(xv[j].x), bflo(xv[j].y), bfhi(xv[j].y)}; v = v * rf * gg; o[64 * j] = v; }
}
}

namespace mk {
#define IN(k) (lo <= (k) && (k) < hi)
#define GSYNC() do { if (coop) xcd_barrier(xb); } while (0)
template <int l>
__device__ __forceinline__ void layer_body(const Params& p, LAS unsigned char* lds, unsigned char* ws, int G, int tid, int lane, int wave, int lo, int hi, bool coop, const XcdBarrier& xb) {

    if (IN(1)) _Pragma("unroll") for (int rep = 0; rep < REP1; ++rep) {
        pg8::Gemm g{(const bf16_t*)(ws + WS_XB), (const bf16_t*)(ws + WS_WINT) + (size_t)l * NP * D, T, NP, D};
        pg8::StaticOrder So; So.init(T, NP, G, (int)blockIdx.x);
        EpiScaleBf16<16> E{(bf16_t*)(ws + WS_P), NP, (const float*)(ws + WS_SS)};
        pg8::gemm_phase<EpiScaleBf16<16>, pg8::StaticOrder, true, true>(lds, g, So, E);
        GSYNC();
    }
    if (IN(2)) _Pragma("unroll") for (int rep = 0; rep < REP2; ++rep) {
        for (int u = blockIdx.x; u < 256; u += G) {
            int tq_ = tid; asm volatile("" : "+v"(tq_)); const int tid = tq_, lane = tq_ & 63, wave = __builtin_amdgcn_readfirstlane(tq_ >> 6);
            if (u < 128) hgrn_unit<1>((const bf16_t*)(ws + WS_P), p.in[5], l, nullptr, (float*)(ws + WS_STH), nullptr, u, lds, tid, lane, wave);
            else mlstm_unit<1>((const bf16_t*)(ws + WS_P), p.in[7] + (size_t)l * 4 * 1024, p.in[8] + l * 4, p.in[9] + l * 4, (float*)(ws + WS_STM), nullptr, u - 128, lds, tid, lane, wave);
            __syncthreads();
        }
        GSYNC();
    }
    if (IN(3)) {

        for (int u = blockIdx.x; u < 256; u += G) {
            int tq_ = tid; asm volatile("" : "+v"(tq_)); const int tid = tq_, lane = tq_ & 63, wave = __builtin_amdgcn_readfirstlane(tq_ >> 6);
            if (u < 128) hgrn_unit<2>((const bf16_t*)(ws + WS_P), p.in[5], l, p.in[6] + l * 512, (float*)(ws + WS_STH), (bf16_t*)(ws + WS_YB), u, lds, tid, lane, wave);
            else mlstm_unit<2>((const bf16_t*)(ws + WS_P), p.in[7] + (size_t)l * 4 * 1024, p.in[8] + l * 4, p.in[9] + l * 4, (float*)(ws + WS_STM), (bf16_t*)(ws + WS_YB), u - 128, lds, tid, lane, wave);
            __syncthreads();
        }
        _Pragma("unroll") for (int rep = 0; rep < REP3; ++rep)
        for (int u = blockIdx.x; u < 256; u += G) {
            int tq_ = tid; asm volatile("" : "+v"(tq_)); const int tid = tq_, lane = tq_ & 63, wave = __builtin_amdgcn_readfirstlane(tq_ >> 6);
            attn_unit((const bf16_t*)(ws + WS_P), (const f32x2*)(ws + WS_ROPE), p.in[4] + l * 16, (bf16_t*)(ws + WS_YB), u, lds, tid, lane, wave);
            __syncthreads();
        }
        GSYNC();
    }
    if (IN(4)) _Pragma("unroll") for (int rep = 0; rep < REP4; ++rep) {
        pg8::Gemm g{(const bf16_t*)(ws + WS_YB), (const bf16_t*)(ws + WS_WOUTT) + (size_t)l * D * D, T, D, D};
        pg8::StaticOrder So; So.init(T, D, G, (int)blockIdx.x);
        EpiX1 E{l == 0 ? p.in[0] : (const float*)nullptr, (bf16_t*)(ws + WS_XB), (float*)(ws + WS_SSP), (float*)(ws + WS_AMXP)};
        pg8::gemm_phase<EpiX1, pg8::StaticOrder, true, true>(lds, g, So, E);
        GSYNC();
    }
    if (IN(5)) _Pragma("unroll") for (int rep = 0; rep < REP5; ++rep) {
        pg8::Gemm g{(const bf16_t*)(ws + WS_XB), (const bf16_t*)(ws + WS_WQT) + (size_t)l * D * D, T, D, D};
        pg8::StaticOrder So; So.init(T, D, G, (int)blockIdx.x);
        EpiScaleBf16<32> E{(bf16_t*)(ws + WS_Q), D, (const float*)(ws + WS_SSP)};
        pg8::gemm_phase<EpiScaleBf16<32>, pg8::StaticOrder, true, true>(lds, g, So, E);
        pg8::Unit u;
        for (int i = 0; So.next(i, u); ++i)
            route_unit((const bf16_t*)(ws + WS_Q), (const bf16_t*)(ws + WS_SUBK) + (size_t)l * 2 * 8 * 128 * 128, u.pm, u.pn, (int*)(ws + WS_IDX), (int*)(ws + WS_IDXU), (float*)(ws + WS_GATE), lds, tid, wave, lane);
        GSYNC();
    }
    if (IN(6)) {

        LAS int* slot = (LAS int*)(lds + LDS_BYTES - 32);
        if (G == 256) {
            const int grp = (int)blockIdx.x & 7, rank = (int)blockIdx.x >> 3;
            _Pragma("unroll") for (int rr = 0; rr < REP6; ++rr) {
            UStage st; u_stage_load(st, grp, rank * 4, (const bf16_t*)(ws + WS_XB), (const int*)(ws + WS_IDX), (const float*)(ws + WS_AMXP), tid);
            for (int j = 0; j < 8; ++j) {
                const int s = grp + 8 * (j >> 2), tb = rank * 4 + (j & 3);
                __syncthreads();
                u_stage_store(st, lds, tid);
                __syncthreads();
                if (j < 7) u_stage_load(st, grp + 8 * ((j + 1) >> 2), rank * 4 + ((j + 1) & 3), (const bf16_t*)(ws + WS_XB), (const int*)(ws + WS_IDX), (const float*)(ws + WS_AMXP), tid);
                peer_u_run<0>(s, tb, ws + WS_U8 + (size_t)l * NE * D, (float*)(ws + WS_PART), lds, wave, lane);
            }
            }
        } else {
            const int xcc = (int)xb_xcc_id();
            unsigned* qc = (unsigned*)(ws + WS_CTL) + CTL_Q + ((l * 2 + 0) * 2 + 0) * 16;
            for (int j = 0; j < NSLICE; ++j) {
                const int s = slice_of(xcc, j);
                for (;;) {
                    const int tb = q_next(qc + s, slot, tid);
                    if (tb < 0) break;
                    peer_u_block<0>(s, tb, (const bf16_t*)(ws + WS_XB), (const int*)(ws + WS_IDX), (const float*)(ws + WS_AMXP), ws + WS_U8 + (size_t)l * NE * D, (float*)(ws + WS_PART), lds, tid, wave, lane);
                }
            }
        }
        GSYNC();
    }
    if (IN(7)) {

        const int gw = blockIdx.x * NWAVES + wave, ngw = G * NWAVES;
        for (int t = gw; t < T; t += ngw)
            peer_act_token(t, (const float*)(ws + WS_PART), (const float*)(ws + WS_SSP), (const float*)(ws + WS_AMXP), (const int*)(ws + WS_IDX), (const float*)(ws + WS_GATE),
                           (const float*)(ws + WS_USC) + l * NE, (const float*)(ws + WS_VSC) + l * NE, (signed char*)(ws + WS_ACT), (float*)(ws + WS_ASC), lane);
        GSYNC();
    }
    if (IN(8)) {

        LAS int* slot = (LAS int*)(lds + LDS_BYTES - 32);
        if (G == 256) {
            const int grp = (int)blockIdx.x & 7, rank = (int)blockIdx.x >> 3;
            {
            VStage st; v_stage_load(st, rank * 4, (const signed char*)(ws + WS_ACT), (const float*)(ws + WS_ASC), (const int*)(ws + WS_IDX), tid);
            for (int j = 0; j < 8; ++j) {
                const int s = grp + 8 * (j >> 2), tb = rank * 4 + (j & 3);
                __syncthreads();
                v_stage_store(st, lds, tid);
                __syncthreads();
                if (j < 7) v_stage_load(st, rank * 4 + ((j + 1) & 3), (const signed char*)(ws + WS_ACT), (const float*)(ws + WS_ASC), (const int*)(ws + WS_IDX), tid);
                peer_v_run<0>(s, tb, ws + WS_V8 + (size_t)l * NE * D, (bf16_t*)(ws + WS_XB), (float*)nullptr, (float*)(ws + WS_SS), lds, wave, lane);
            }
            }
        } else {
            const int xcc = (int)xb_xcc_id();
            unsigned* qc = (unsigned*)(ws + WS_CTL) + CTL_Q + ((l * 2 + 1) * 2 + 0) * 16;
            for (int j = 0; j < NSLICE; ++j) {
                const int s = slice_of(xcc, j);
                for (;;) {
                    const int tb = q_next(qc + s, slot, tid);
                    if (tb < 0) break;
                    peer_v_block(s, tb, (const signed char*)(ws + WS_ACT), (const float*)(ws + WS_ASC), (const int*)(ws + WS_IDX), ws + WS_V8 + (size_t)l * NE * D, (bf16_t*)(ws + WS_XB),
                                 (float*)nullptr, (float*)(ws + WS_SS), lds, tid, wave, lane);
                }
            }
        }
    }
    if (l == 1 && IN(9)) {
        GSYNC();
        const int gw = blockIdx.x * NWAVES + wave, ngw = G * NWAVES;
        for (int t = gw; t < T; t += ngw) final_norm_row((const bf16_t*)(ws + WS_XB) + (size_t)t * D, p.out + (size_t)t * D, (const float*)(ws + WS_SS) + (size_t)t * 16, p.in[15], lane);
    }
}
__global__ void __launch_bounds__(NTHR, 2) mega(Params p) {
    extern __shared__ __attribute__((aligned(16))) unsigned char lds_raw[];
    LAS unsigned char* lds = (LAS unsigned char*)lds_raw;
    unsigned char* ws = p.ws;
    const int G = gridDim.x;
    const int tid = threadIdx.x, lane = tid & 63, wave = __builtin_amdgcn_readfirstlane(tid >> 6);
    const int lo = p.ph_lo, hi = p.ph_hi;
    const bool coop = p.pad != 0;
    volatile LAS unsigned* xst = (volatile LAS unsigned*)(lds + LDS_BYTES - 16);
    if (tid < 4) xst[tid] = 0u;
    __syncthreads();
    XcdBarrier xb; xb.bar = (unsigned*)(ws + WS_CTL); xb.x = 0; xb.st = xst;
    if (coop) xb = xcd_barrier_post((unsigned*)(ws + WS_CTL), xst);
    if (IN(0)) { p0_prologue(p, lds); if (REP0 > 1) { if (coop) xcd_barrier(xb); p0_prologue(p, lds, REP0); } if (coop) cooperative_groups::this_grid().sync(); }
    if (p.layer <= 0 && 0 < p.layer_hi) { layer_body<0>(p, lds, ws, G, tid, lane, wave, lo, hi, coop, xb); if (1 < p.layer_hi) GSYNC(); }
    if (p.layer <= 1 && 1 < p.layer_hi) layer_body<1>(p, lds, ws, G, tid, lane, wave, lo, hi, coop, xb);

#undef IN
#undef GSYNC
}
__global__ __launch_bounds__(256) void shim_xprep_kernel(const float* __restrict__ X, bf16_t* __restrict__ XB, float* __restrict__ SS) {
    const int t = blockIdx.x * 4 + (threadIdx.x >> 6), lane = threadIdx.x & 63;
    xprep_row(X + (size_t)t * D, XB + (size_t)t * D, SS + t, lane);
}
}

extern "C" void kernel_launch(void* const* d_in, const int* in_sizes, int n_in, void* d_out, int out_size, void* d_ws, size_t ws_size, hipStream_t stream) {
    using namespace mk;
    static int grid = 0;
    if (grid == 0) {
        int dev = 0, cus = 0, per_cu = 0;
        (void)hipGetDevice(&dev); (void)hipDeviceGetAttribute(&cus, hipDeviceAttributeMultiprocessorCount, dev);
        if (hipFuncSetAttribute((const void*)mega, hipFuncAttributeMaxDynamicSharedMemorySize, LDS_BYTES) != hipSuccess) { fprintf(stderr, "kernel_launch: hipFuncSetAttribute failed\n"); grid = -1; return; }
        if (ws_size < WS_END) { fprintf(stderr, "kernel_launch: workspace too small: need %zu have %zu\n", (size_t)WS_END, ws_size); grid = -1; return; }
        if (hipOccupancyMaxActiveBlocksPerMultiprocessor(&per_cu, (const void*)mega, NTHR, LDS_BYTES) != hipSuccess || per_cu < 1) { fprintf(stderr, "kernel_launch: occupancy query says %d blocks per CU\n", per_cu); grid = -1; return; }
        grid = cus;
    }
    if (grid < 0) return;
    Params p{};
    for (int i = 0; i < 16; ++i) p.in[i] = (const float*)d_in[i];
    p.out = (float*)d_out; p.ws = (unsigned char*)d_ws;
    p.ph_lo = 0; p.ph_hi = 10; p.layer = 0; p.layer_hi = 2; p.pad = 1; p.pad2 = 0;
    if (hipMemsetAsync(d_ws, 0, 16384, stream) != hipSuccess) { fprintf(stderr, "kernel_launch: memset failed\n"); return; }
    void* args[] = {&p};
    hipError_t e = hipLaunchCooperativeKernel((const void*)mega, dim3(grid), dim3(NTHR), args, LDS_BYTES, stream);
    if (e != hipSuccess) fprintf(stderr, "kernel_launch: cooperative launch failed: %s (grid %d)\n", hipGetErrorString(e), grid);
}
```

```cpp
#include <hip/hip_runtime.h>
#include <hip/hip_cooperative_groups.h>
#include <math.h>
#include <stdio.h>
#include <stdint.h>
namespace pg8 {
#define PG8_LAS __attribute__((address_space(3)))
typedef unsigned short bf16_t;
typedef short bf16x8 __attribute__((ext_vector_type(8)));
typedef float f32x4 __attribute__((ext_vector_type(4)));
typedef unsigned u32x4 __attribute__((ext_vector_type(4)));
constexpr int BM = 256, BK = 64, HALF = 128, HTB = HALF * BK * 2  , STAGE_BYTES = 8 * HTB, NXCD = 8, WGM = 8;

__host__ __device__ __forceinline__ int lds_byte(int r, int c) { const int st = (r >> 4) * 2 + (c >> 5), rr = r & 15, cc = c & 31, ob = rr * 64 + cc * 2; return st * 1024 + (ob ^ (((ob >> 9) & 1) << 5)); }
__host__ __device__ __forceinline__ void stage_rc(int b, int& R, int& C) { const int st = b / 1024, sb = b % 1024, swz = sb ^ (((sb >> 9) & 1) << 5); R = (st >> 1) * 16 + swz / 64; C = (st & 1) * 32 + (swz % 64) / 2; }
__host__ __device__ __forceinline__ int perm32(int rho) { const int n = rho >> 4, i = rho & 15; return 8 * (i >> 2) + 4 * n + (i & 3); }

struct Unit { int pm, pn; };
struct Gemm { const bf16_t* A; const bf16_t* Bt; int M, N, K; };

struct StaticOrder {
    int nM, nN, nwg, G, c;
    __host__ __device__ void init(int M, int N, int G_, int c_) { nM = M / BM; nN = N / BM; nwg = nM * nN; G = G_; c = c_; }
    __host__ __device__ bool next(int i, Unit& u) const {
        const long L = (long)i * G + c; if (L >= nwg) return false;
        int wgid = (int)L; { const int q = nwg / NXCD, r = nwg % NXCD, xcd = wgid % NXCD, off = wgid / NXCD; wgid = (xcd < r ? xcd * (q + 1) : r * (q + 1) + (xcd - r) * q) + off; }
        const int nig = WGM * nN, gid = wgid / nig, fm = gid * WGM, gsz = (nM - fm) < WGM ? (nM - fm) : WGM;
        u.pm = fm + ((wgid % nig) % gsz); u.pn = (wgid % nig) / gsz; return true;
    }
    __device__ __forceinline__ void a_ready(const Unit&) const {}
    __device__ __forceinline__ void done(const Unit&) const {}
};

template <class Epi, class Sched, bool ALIGN_EPI = false, bool SP2 = false>
__device__ __forceinline__ void gemm_phase(PG8_LAS unsigned char* lds, const Gemm g, const Sched& S, const Epi& E) {
    const int tid = threadIdx.x, wid = __builtin_amdgcn_readfirstlane(tid >> 6), lane = tid & 63, wr = wid >> 2, wc = wid & 3, fr = lane & 15, fq = lane >> 4;
    const int K = g.K, nt = K / BK;
    unsigned voffA[2], voffB[2];
#pragma unroll
    for (int i = 0; i < 2; ++i) { int R, C; stage_rc(tid * 16 + i * 8192, R, C); const int Rb = Epi::PERM ? ((R & ~31) + perm32(R & 31)) : R;
        voffA[i] = (unsigned)(R * K + C) * 2u; voffB[i] = (unsigned)(Rb * K + C) * 2u; }
    const size_t kstep = (size_t)(BK * 2);
    const size_t hstep = (size_t)HALF * K * 2;
    const size_t tstep = 2 * hstep;
    const unsigned ldsw = (unsigned)wid * 1024u;
    const int aoff = lds_byte(wr * 64 + fr, fq * 8), boff = lds_byte(wc * 32 + fr, fq * 8);
#define PG8_SA(b, h) (((b) * 2 + (h)) * HTB)
#define PG8_SB(b, h) ((4 + (b) * 2 + (h)) * HTB)
#define PG8_STAGE(bufoff, gbase, voff) do { _Pragma("unroll") for (int _i = 0; _i < 2; ++_i) \
        __builtin_amdgcn_global_load_lds((const unsigned*)((const char*)(gbase) + (voff)[_i]), (PG8_LAS unsigned*)(lds + (bufoff) + ldsw + _i * 8192), 16, 0, 0); } while (0)
#define PG8_LDA(dst, b, h) do { _Pragma("unroll") for (int m = 0; m < 4; ++m) _Pragma("unroll") for (int k = 0; k < 2; ++k) dst[m][k] = *(const PG8_LAS bf16x8*)(lds + PG8_SA(b, h) + aoff + m * 2048 + k * 1024); } while (0)
#define PG8_LDB(dst, b, h) do { _Pragma("unroll") for (int n = 0; n < 2; ++n) _Pragma("unroll") for (int k = 0; k < 2; ++k) dst[n][k] = *(const PG8_LAS bf16x8*)(lds + PG8_SB(b, h) + boff + n * 2048 + k * 1024); } while (0)
#define PG8_MMA(ai, bj, At, Bt) do { __builtin_amdgcn_s_setprio(1); _Pragma("unroll") for (int m = 0; m < 4; ++m) _Pragma("unroll") for (int n = 0; n < 2; ++n) _Pragma("unroll") for (int k = 0; k < 2; ++k) \
        acc[ai][bj][m][n] = __builtin_amdgcn_mfma_f32_16x16x32_bf16(Bt[n][k], At[m][k], acc[ai][bj][m][n], 0, 0, 0); __builtin_amdgcn_s_setprio(0); } while (0)
#define PG8_WAIT_V(n) asm volatile("s_waitcnt vmcnt(" #n ")" ::: "memory")
#define PG8_WAIT_L(n) asm volatile("s_waitcnt lgkmcnt(" #n ")" ::: "memory")
#define PG8_BAR __builtin_amdgcn_s_barrier()
#define PG8_SCHED __builtin_amdgcn_sched_barrier(0)
    Unit cur, nxt; int ui = 0;
    if (!S.next(0, cur)) return;
    f32x4 acc[2][2][4][2];
#pragma unroll
    for (int a = 0; a < 2; ++a)
#pragma unroll
        for (int b = 0; b < 2; ++b)
#pragma unroll
            for (int m = 0; m < 4; ++m)
#pragma unroll
                for (int n = 0; n < 2; ++n) acc[a][b][m][n] = (f32x4){0.f, 0.f, 0.f, 0.f};
    bf16x8 At[4][2], B0[2][2], B1[2][2];
    const char* cA = (const char*)g.A + (size_t)cur.pm * tstep; const char* cB = (const char*)g.Bt + (size_t)cur.pn * tstep;
    S.a_ready(cur);
    if constexpr (SP2) {
        PG8_STAGE(PG8_SB(0, 0), cB, voffB); PG8_STAGE(PG8_SB(0, 1), cB + hstep, voffB); PG8_STAGE(PG8_SA(0, 0), cA, voffA); PG8_STAGE(PG8_SA(0, 1), cA + hstep, voffA);
        if (wr == 1) PG8_BAR;
        PG8_WAIT_V(2); PG8_BAR;
        PG8_STAGE(PG8_SB(1, 0), cB + kstep, voffB); PG8_STAGE(PG8_SA(1, 0), cA + kstep, voffA); PG8_STAGE(PG8_SB(1, 1), cB + hstep + kstep, voffB);
        PG8_WAIT_V(6); PG8_BAR;
    } else {
        PG8_STAGE(PG8_SB(0, 0), cB, voffB); PG8_STAGE(PG8_SA(0, 0), cA, voffA); PG8_STAGE(PG8_SB(0, 1), cB + hstep, voffB); PG8_STAGE(PG8_SA(0, 1), cA + hstep, voffA);
        if (wr == 1) PG8_BAR;
        PG8_WAIT_V(4); PG8_BAR;
        PG8_STAGE(PG8_SB(1, 0), cB + kstep, voffB); PG8_STAGE(PG8_SA(1, 0), cA + kstep, voffA); PG8_STAGE(PG8_SB(1, 1), cB + hstep + kstep, voffB);
        PG8_WAIT_V(6); PG8_BAR;
    }
    for (;;) {
        const bool has_next = S.next(ui + 1, nxt);
        const char* nA = has_next ? (const char*)g.A + (size_t)nxt.pm * tstep : cA; const char* nB = has_next ? (const char*)g.Bt + (size_t)nxt.pn * tstep : cB;
        for (int t = 0; t < nt; t += 2) {
            const bool last = (t == nt - 2);
            const char* a1 = cA + (size_t)(t + 1) * kstep;
            const char* a2 = last ? nA : cA + (size_t)(t + 2) * kstep; const char* b2 = last ? nB : cB + (size_t)(t + 2) * kstep;
            const char* a3 = a2 + kstep; const char* b3 = b2 + kstep;
            if (last && has_next) S.a_ready(nxt);
            if constexpr (SP2) {
            PG8_LDB(B0, 0, 0); PG8_LDB(B1, 0, 1); PG8_SCHED; PG8_LDA(At, 0, 0); PG8_STAGE(PG8_SA(1, 1), a1 + hstep, voffA);
            PG8_WAIT_V(8); PG8_WAIT_L(0); PG8_BAR; PG8_MMA(0, 0, At, B0); PG8_MMA(0, 1, At, B1); PG8_BAR; PG8_SCHED;
            PG8_LDA(At, 0, 1); PG8_STAGE(PG8_SB(0, 0), b2, voffB); PG8_STAGE(PG8_SB(0, 1), b2 + hstep, voffB); PG8_STAGE(PG8_SA(0, 0), a2, voffA);
            PG8_WAIT_V(8); PG8_WAIT_L(0); PG8_BAR; PG8_MMA(1, 0, At, B0); PG8_MMA(1, 1, At, B1); PG8_BAR; PG8_SCHED;
            PG8_LDB(B0, 1, 0); PG8_LDB(B1, 1, 1); PG8_SCHED; PG8_LDA(At, 1, 0); PG8_STAGE(PG8_SA(0, 1), a2 + hstep, voffA);
            PG8_WAIT_V(8); PG8_WAIT_L(0); PG8_BAR; PG8_MMA(0, 0, At, B0); PG8_MMA(0, 1, At, B1); PG8_BAR; PG8_SCHED;
            PG8_LDA(At, 1, 1); PG8_STAGE(PG8_SB(1, 0), b3, voffB); PG8_STAGE(PG8_SB(1, 1), b3 + hstep, voffB); PG8_STAGE(PG8_SA(1, 0), a3, voffA);
            PG8_WAIT_V(8); PG8_WAIT_L(0); PG8_BAR; PG8_MMA(1, 0, At, B0); PG8_MMA(1, 1, At, B1); PG8_BAR; PG8_SCHED;
            } else {
            PG8_LDB(B0, 0, 0); PG8_SCHED; PG8_LDA(At, 0, 0); PG8_STAGE(PG8_SA(1, 1), a1 + hstep, voffA);
            PG8_WAIT_L(8); PG8_BAR; PG8_WAIT_L(0); PG8_MMA(0, 0, At, B0); PG8_BAR; PG8_SCHED;
            PG8_LDB(B1, 0, 1); PG8_STAGE(PG8_SB(0, 0), b2, voffB);
            PG8_BAR; PG8_WAIT_L(0); PG8_MMA(0, 1, At, B1); PG8_BAR;
            PG8_LDA(At, 0, 1); PG8_STAGE(PG8_SA(0, 0), a2, voffA);
            PG8_BAR; PG8_WAIT_L(0); PG8_MMA(1, 0, At, B0); PG8_BAR; PG8_SCHED;
            PG8_STAGE(PG8_SB(0, 1), b2 + hstep, voffB);
            PG8_WAIT_V(6); PG8_BAR; PG8_MMA(1, 1, At, B1); PG8_BAR;
            PG8_LDB(B0, 1, 0); PG8_SCHED; PG8_LDA(At, 1, 0); PG8_STAGE(PG8_SA(0, 1), a2 + hstep, voffA);
            PG8_WAIT_L(8); PG8_BAR; PG8_WAIT_L(0); PG8_MMA(0, 0, At, B0); PG8_BAR; PG8_SCHED;
            PG8_LDB(B1, 1, 1); PG8_STAGE(PG8_SB(1, 0), b3, voffB);
            PG8_BAR; PG8_WAIT_L(0); PG8_MMA(0, 1, At, B1); PG8_BAR;
            PG8_LDA(At, 1, 1); PG8_STAGE(PG8_SA(1, 0), a3, voffA);
            PG8_BAR; PG8_WAIT_L(0); PG8_MMA(1, 0, At, B0); PG8_BAR; PG8_SCHED;
            PG8_STAGE(PG8_SB(1, 1), b3 + hstep, voffB);
            PG8_WAIT_V(6); PG8_BAR; PG8_MMA(1, 1, At, B1); PG8_BAR;
            }
        }
        if constexpr (ALIGN_EPI) { if (wr == 0) PG8_BAR; }
        if constexpr (!Epi::AFTER_DRAIN) { E(acc, cur, wr, wc, fr, fq); S.done(cur); }
        if (!has_next) break;
#pragma unroll
        for (int a = 0; a < 2; ++a)
#pragma unroll
            for (int b = 0; b < 2; ++b)
#pragma unroll
                for (int m = 0; m < 4; ++m)
#pragma unroll
                    for (int n = 0; n < 2; ++n) acc[a][b][m][n] = (f32x4){0.f, 0.f, 0.f, 0.f};
        cur = nxt; cA = nA; cB = nB; ++ui;
        if constexpr (ALIGN_EPI) { if (wr == 1) PG8_BAR; }
    }
    PG8_WAIT_V(0);
    if constexpr (!ALIGN_EPI) { if (wr == 0) PG8_BAR; }
    PG8_BAR;
    if constexpr (Epi::AFTER_DRAIN) { E.fused(acc, cur, wr, wc, fr, fq, lds, wid, lane); S.done(cur); }
#undef PG8_SA
#undef PG8_SB
#undef PG8_STAGE
#undef PG8_LDA
#undef PG8_LDB
#undef PG8_MMA
#undef PG8_WAIT_V
#undef PG8_WAIT_L
#undef PG8_BAR
#undef PG8_SCHED
}
}
namespace mk {
#define LAS __attribute__((address_space(3)))
typedef unsigned short bf16_t;
typedef float f32x4 __attribute__((ext_vector_type(4)));
typedef float f32x2 __attribute__((ext_vector_type(2)));
typedef unsigned u32x4 __attribute__((ext_vector_type(4)));
typedef unsigned u32x2 __attribute__((ext_vector_type(2)));
typedef __bf16 bf16x2_t __attribute__((ext_vector_type(2)));
typedef short bf16x8 __attribute__((ext_vector_type(8)));
typedef short s16x4 __attribute__((ext_vector_type(4)));
constexpr int D = 2048, NB = 4, S = 4096, T = NB * S, IN_LD = 5384, NP = 5632, NE = 16384;
constexpr int NTHR = 512, NWAVES = 8;
constexpr int LDS_BYTES = 160 * 1024;
constexpr int LDS_SPARE = 128 * 1024;
constexpr float EPS = 1e-6f;
#ifndef REPS
#define REPS 1,1,1,1,1,1,1,1
#endif
constexpr int REPV[8] = {REPS};
constexpr int REP7 = REPV[7];
constexpr int NHELP = 16;
constexpr int HROWS = 9728;
constexpr int REP0 = REPV[0], REP1 = REPV[1], REP2 = REPV[2], REP3 = REPV[3], REP4 = REPV[4], REP5 = REPV[5], REP6 = REPV[6];
constexpr int C_QA = 0, C_KA = 1024, C_VA = 1152, C_QH = 1280, C_FH = 1792, C_IH = 2304, C_GH = 2816, C_QM = 3328, C_KM = 3840, C_VM = 4352, C_OM = 4864, C_IM = 5376, C_FM = 5380;

constexpr size_t WS_CTL = 0;
constexpr size_t WS_WINT = 65536;
constexpr size_t WS_WOUTT = WS_WINT + 2 * (size_t)NP * D * 2;
constexpr size_t WS_WQT = WS_WOUTT + 2 * (size_t)D * D * 2;
constexpr size_t WS_SUBK = WS_WQT + 2 * (size_t)D * D * 2;
constexpr size_t WS_U8 = WS_SUBK + 2 * 2 * 8 * 128 * 128 * 2;
constexpr size_t WS_V8 = WS_U8 + 2 * (size_t)NE * D;
constexpr size_t WS_USC = WS_V8 + 2 * (size_t)NE * D;
constexpr size_t WS_VSC = WS_USC + 2 * (size_t)NE * 4;
constexpr size_t WS_ROPE = WS_VSC + 2 * (size_t)NE * 4;
constexpr size_t WS_SS = WS_ROPE + (size_t)S * 32 * 8;
constexpr size_t WS_SSP = WS_SS + (size_t)T * 16 * 4;
constexpr size_t WS_XB = WS_SSP + (size_t)T * 32 * 4;
constexpr size_t WS_P = WS_XB + (size_t)T * D * 2;
constexpr size_t WS_YB = WS_P + (size_t)T * NP * 2;
constexpr size_t WS_Q = WS_YB + (size_t)T * D * 2;
constexpr size_t WS_IDX = WS_Q + (size_t)T * D * 2;
constexpr size_t WS_GATE = WS_IDX + (size_t)T * 128 * 4;
constexpr size_t WS_X1 = WS_GATE + (size_t)T * 128 * 4;
constexpr size_t WS_X2 = WS_X1 + (size_t)T * D * 4;
constexpr size_t WS_IDXU = WS_X2 + (size_t)T * D * 4;
constexpr size_t WS_AMXP = WS_IDXU + (size_t)T * 128 * 4;
constexpr size_t WS_ASC = WS_AMXP + (size_t)T * 32 * 4;
constexpr size_t WS_STH = WS_ASC + (size_t)T * 4;
constexpr size_t WS_STM = WS_STH + (size_t)128 * 16640 * 4;
constexpr size_t WS_END = WS_STM + (size_t)128 * 16640 * 4;
constexpr size_t WS_PART = WS_P;
constexpr size_t WS_ACT = WS_Q;
static_assert((size_t)16 * T * 128 * 4 <= (size_t)T * NP * 2, "PART overlay");
static_assert(WS_END <= ((size_t)1 << 30), "workspace");
struct Params { const float* in[16]; float* out; unsigned char* ws; int ph_lo, ph_hi, layer, layer_hi, pad, pad2; };

__device__ __forceinline__ unsigned pk2(float lo, float hi) { f32x2 v = {lo, hi}; bf16x2_t b = __builtin_convertvector(v, bf16x2_t); return __builtin_bit_cast(unsigned, b); }
__device__ __forceinline__ float bf2f(unsigned short h) { return __uint_as_float((unsigned)h << 16); }
__device__ __forceinline__ float bflo(unsigned w) { return __uint_as_float(w << 16); }
__device__ __forceinline__ float bfhi(unsigned w) { return __uint_as_float(w & 0xffff0000u); }
__device__ __forceinline__ float wsum(float v) {
#pragma unroll
    for (int o = 1; o < 64; o <<= 1) v += __shfl_xor(v, o);
    return v;
}
template <int CTRL> __device__ __forceinline__ float dppf(float x) { return __builtin_bit_cast(float, __builtin_amdgcn_mov_dpp(__builtin_bit_cast(int, x), CTRL, 0xf, 0xf, true)); }
constexpr int DPP_XOR1 = 0xB1, DPP_XOR2 = 0x4E, DPP_HMIR = 0x141, DPP_ROR8 = 0x128;
__device__ __forceinline__ float sum8(float v) { v += dppf<DPP_XOR1>(v); v += dppf<DPP_XOR2>(v); v += dppf<DPP_HMIR>(v); return v; }
__device__ __forceinline__ float sum16(float v) { v = sum8(v); v += dppf<DPP_ROR8>(v); return v; }
__device__ __forceinline__ float wmax(float v) {
#pragma unroll
    for (int o = 1; o < 64; o <<= 1) v = fmaxf(v, __shfl_xor(v, o));
    return v;
}

__device__ __forceinline__ void transpose_item(const float* __restrict__ W, int ldw, int nvalid, const float* __restrict__ gain, bf16_t* __restrict__ WT, int K, int k0, int n0, LAS float* scr, int lane) {
    const int j = lane & 31, h = lane >> 5;
    const int n = n0 + 2 * j;
    f32x2 vv[32];
#pragma unroll
    for (int i = 0; i < 32; ++i) {
        const int kk = 2 * i + h;
        f32x2 v = {0.f, 0.f};
        if (n < nvalid) v = *(const f32x2*)(W + (size_t)(k0 + kk) * ldw + n);
        vv[i] = v;
    }
#pragma unroll
    for (int i = 0; i < 32; ++i) {
        const int kk = 2 * i + h;
        f32x2 v = vv[i];
        if (gain) { const float gk = gain[k0 + kk]; v.x *= gk; v.y *= gk; }
        *(LAS f32x2*)(scr + kk * 66 + 2 * j) = v;
    }
    __builtin_amdgcn_s_waitcnt(0xc07f);
    asm volatile("" ::: "memory");
    const int c = lane & 7;
#pragma unroll
    for (int jj = 0; jj < 8; ++jj) {
        const int nn = (lane >> 3) + 8 * jj;
        const LAS float* s = scr + (8 * c) * 66 + nn;
        u32x4 o; o.x = pk2(s[0 * 66], s[1 * 66]); o.y = pk2(s[2 * 66], s[3 * 66]); o.z = pk2(s[4 * 66], s[5 * 66]); o.w = pk2(s[6 * 66], s[7 * 66]);
        *(u32x4*)(WT + (size_t)(n0 + nn) * K + k0 + 8 * c) = o;
    }
    __builtin_amdgcn_s_waitcnt(0xc07f);
    asm volatile("" ::: "memory");
}
__device__ __forceinline__ void xprep_row(const float* __restrict__ xrow, bf16_t* __restrict__ orow, float* __restrict__ ss, int lane) {
    const f32x4* xr = (const f32x4*)xrow + lane;
    f32x4 v[8]; float s = 0.f;
#pragma unroll
    for (int j = 0; j < 8; ++j) { v[j] = xr[64 * j]; s += (v[j].x * v[j].x + v[j].y * v[j].y) + (v[j].z * v[j].z + v[j].w * v[j].w); }
    s = wsum(s);
    u32x2* o = (u32x2*)orow + lane;
#pragma unroll
    for (int j = 0; j < 8; ++j) { u32x2 w; w.x = pk2(v[j].x, v[j].y); w.y = pk2(v[j].z, v[j].w); o[64 * j] = w; }
    if (lane < 16) ss[lane] = (lane == 0) ? s : 0.f;
}
template <int NR>
__device__ __forceinline__ void fp8_rows_load(const float* __restrict__ src, f32x4 (&v)[NR][8], int lane) {
#pragma unroll
    for (int r = 0; r < NR; ++r)
#pragma unroll
        for (int i = 0; i < 8; ++i) v[r][i] = *(const f32x4*)(src + (size_t)r * D + 256 * i + 4 * lane);
}
template <int NR, bool INT8>
__device__ __forceinline__ void fp8_rows_finish(f32x4 (&v)[NR][8], const float* __restrict__ gain, unsigned char* __restrict__ dst, float* __restrict__ sc, int lane) {
    float am[NR];
#pragma unroll
    for (int r = 0; r < NR; ++r) am[r] = 0.f;
#pragma unroll
    for (int i = 0; i < 8; ++i) {
        f32x4 gg = {1.f, 1.f, 1.f, 1.f};
        if (gain) gg = *(const f32x4*)(gain + 256 * i + 4 * lane);
#pragma unroll
        for (int r = 0; r < NR; ++r) {
            if (gain) v[r][i] = v[r][i] * gg;
            const f32x4 a = v[r][i];
            am[r] = fmaxf(am[r], fmaxf(fmaxf(fabsf(a.x), fabsf(a.y)), fmaxf(fabsf(a.z), fabsf(a.w))));
        }
    }
#pragma unroll
    for (int r = 0; r < NR; ++r) am[r] = wmax(am[r]);
#pragma unroll
    for (int r = 0; r < NR; ++r) {
        const float qmax = INT8 ? 127.f : 256.f;
        const float qs = am[r] > 0.f ? qmax / am[r] : 1.f;
#pragma unroll
        for (int i = 0; i < 8; ++i) {
            const f32x4 a = v[r][i] * qs;
            int pk;
            if (INT8) pk = (__float2int_rn(a.x) & 0xff) | ((__float2int_rn(a.y) & 0xff) << 8) | ((__float2int_rn(a.z) & 0xff) << 16) | (__float2int_rn(a.w) << 24);
            else { pk = __builtin_amdgcn_cvt_pk_fp8_f32(a.x, a.y, 0, false); pk = __builtin_amdgcn_cvt_pk_fp8_f32(a.z, a.w, pk, true); }
            *(unsigned*)(dst + (size_t)r * 128 + ((size_t)(2 * i + (lane >> 5)) * NE) * 128 + (lane & 31) * 4) = (unsigned)pk;
        }
        if (lane == 0) sc[2 * r] = am[r] > 0.f ? am[r] * (INT8 ? (1.f / 127.f) : (1.f / 256.f)) : 1.f;
    }
}

__device__ __forceinline__ void tables_convert(const Params& p, int l, int r_lo, int r_hi, int w, int nw, int lane) {
    unsigned char* ws = p.ws;
    const float* norm_ffn = p.in[10]; const float* peer_u = p.in[13]; const float* peer_v = p.in[14];
    const int REND = r_hi;
    const int rstep = 2 * nw;
#define TC_SRC(R) (((R) / NE == 0 ? peer_u : peer_v) + ((size_t)l * NE + (size_t)((R) % NE)) * D)
#define TC_FIN(V, R) do { const int tb_ = (R) / NE, e_ = (R) % NE; \
        fp8_rows_finish<2, true>(V, tb_ == 0 ? norm_ffn + l * D : (const float*)nullptr, ws + (tb_ == 0 ? WS_U8 : WS_V8) + (size_t)l * NE * D + (size_t)e_ * 128, \
                                 (float*)(ws + WS_USC) + 2 * ((size_t)l * NE + e_) + tb_, lane); } while (0)
    f32x4 va[2][8], vb[2][8];
    int r = r_lo + 2 * w;
    if (r < REND) fp8_rows_load<2>(TC_SRC(r), va, lane);
    while (r < REND) {
        const int rn = r + rstep;
        if (rn < REND) fp8_rows_load<2>(TC_SRC(rn), vb, lane);
        TC_FIN(va, r);
        if (rn >= REND) break;
        const int rn2 = rn + rstep;
        if (rn2 < REND) fp8_rows_load<2>(TC_SRC(rn2), va, lane);
        TC_FIN(vb, rn);
        r = rn2;
    }
#undef TC_SRC
#undef TC_FIN
}

__device__ __forceinline__ void p0_prologue(const Params& p, LAS unsigned char* lds, int mask = 0xff) {
    const int tid = threadIdx.x, lane = tid & 63, wave = tid >> 6;
    const int G = gridDim.x, gw = blockIdx.x * NWAVES + wave, ngw = G * NWAVES;
    const size_t gt = (size_t)blockIdx.x * NTHR + tid, ngt = (size_t)G * NTHR;
    unsigned char* ws = p.ws;
    const float* x = p.in[0]; const float* norm_mix = p.in[1]; const float* w_in = p.in[2]; const float* w_out = p.in[3];
    const float* norm_ffn = p.in[10]; const float* peer_query = p.in[11]; const float* sub_keys = p.in[12]; const float* peer_u = p.in[13]; const float* peer_v = p.in[14];
    if (mask & 1) {
        LAS float* scr = (LAS float*)(lds + wave * 16896);
        constexpr int I_IN = 32 * (NP / 64), I_SQ = 32 * (D / 64), PER_L = I_IN + 2 * I_SQ;
        for (int it = gw; it < 2 * PER_L; it += ngw) {
            const int l = it / PER_L; int r = it % PER_L;
            if (r < I_IN) { transpose_item(w_in + (size_t)l * D * IN_LD, IN_LD, IN_LD, norm_mix + l * D, (bf16_t*)(ws + WS_WINT) + (size_t)l * NP * D, D, (r / (NP / 64)) * 64, (r % (NP / 64)) * 64, scr, lane); continue; }
            r -= I_IN;
            if (r < I_SQ) { transpose_item(w_out + (size_t)l * D * D, D, D, nullptr, (bf16_t*)(ws + WS_WOUTT) + (size_t)l * D * D, D, (r / (D / 64)) * 64, (r % (D / 64)) * 64, scr, lane); continue; }
            r -= I_SQ;
            transpose_item(peer_query + (size_t)l * D * D, D, D, norm_ffn + l * D, (bf16_t*)(ws + WS_WQT) + (size_t)l * D * D, D, (r / (D / 64)) * 64, (r % (D / 64)) * 64, scr, lane);
        }
    }
    if (mask & 2) for (size_t i = gt; i < 2 * 2 * 8 * 128 * 128 / 4; i += ngt) {
        const f32x4 v = ((const f32x4*)sub_keys)[i];
        u32x2 w; w.x = pk2(v.x, v.y); w.y = pk2(v.z, v.w);
        ((u32x2*)(ws + WS_SUBK))[i] = w;
    }
    if (mask & 4) { const int r0 = (mask & 0x100) ? HROWS : 0; tables_convert(p, 0, r0, 2 * NE, gw, ngw, lane); tables_convert(p, 1, r0, 2 * NE, gw, ngw, lane); }
    if (mask & 8) for (size_t i = gt; i < (size_t)S * 32; i += ngt) {
        const int fi = (int)(i & 31), pos = (int)(i >> 5);
        const float inv = powf(10000.f, -(float)fi / 32.f);
        const float ang = (float)pos * inv;
        f32x2 cs; cs.x = cosf(ang); cs.y = sinf(ang);
        ((f32x2*)(ws + WS_ROPE))[i] = cs;
    }
    if (mask & 16) for (int t = 2 * gw; t < T; t += 2 * ngw) {
        const f32x4* x0 = (const f32x4*)(x + (size_t)t * D) + lane; const f32x4* x1 = x0 + D / 4;
        f32x4 v0[8], v1[8]; float s0 = 0.f, s1 = 0.f;
#pragma unroll
        for (int j = 0; j < 8; ++j) { v0[j] = x0[64 * j]; v1[j] = x1[64 * j]; }
#pragma unroll
        for (int j = 0; j < 8; ++j) { s0 += (v0[j].x * v0[j].x + v0[j].y * v0[j].y) + (v0[j].z * v0[j].z + v0[j].w * v0[j].w); s1 += (v1[j].x * v1[j].x + v1[j].y * v1[j].y) + (v1[j].z * v1[j].z + v1[j].w * v1[j].w); }
        s0 = wsum(s0); s1 = wsum(s1);
        u32x2* o0 = (u32x2*)((bf16_t*)(ws + WS_XB) + (size_t)t * D) + lane; u32x2* o1 = o0 + D / 4;
#pragma unroll
        for (int j = 0; j < 8; ++j) { u32x2 w; w.x = pk2(v0[j].x, v0[j].y); w.y = pk2(v0[j].z, v0[j].w); o0[64 * j] = w; w.x = pk2(v1[j].x, v1[j].y); w.y = pk2(v1[j].z, v1[j].w); o1[64 * j] = w; }
        float* ss = (float*)(ws + WS_SS) + (size_t)t * 16;
        if (lane < 32) ss[lane] = (lane == 0) ? s0 : (lane == 16) ? s1 : 0.f;
    }
}

template <int NSS>
struct EpiScaleBf16 {
    static constexpr bool PERM = true, AFTER_DRAIN = false;
    bf16_t* O; int ldc; const float* ss;
    __device__ __forceinline__ void operator()(const pg8::f32x4 (&acc)[2][2][4][2], const pg8::Unit& u, int wr, int wc, int fr, int fq) const {
        const int row0 = u.pm * 256 + wr * 64 + fr, col0 = u.pn * 256 + wc * 32 + 8 * fq;
#pragma unroll
        for (int ai = 0; ai < 2; ++ai)
#pragma unroll
            for (int m = 0; m < 4; ++m) {
                const int row = row0 + ai * 128 + m * 16;
                float s;
                {
                    const f32x4* sp = (const f32x4*)(ss + (size_t)row * NSS);
                    f32x4 a = sp[fq];
                    if (NSS == 32) a = a + sp[4 + fq];
                    s = (a.x + a.y) + (a.z + a.w);
                    { const auto w = __builtin_amdgcn_permlane16_swap(__float_as_uint(s), __float_as_uint(s), false, false); s = __uint_as_float(w[0]) + __uint_as_float(w[1]); }
                    { const auto w = __builtin_amdgcn_permlane32_swap(__float_as_uint(s), __float_as_uint(s), false, false); s = __uint_as_float(w[0]) + __uint_as_float(w[1]); }
                }
                const float r = rsqrtf(s * (1.f / D) + EPS);
                bf16_t* rowp = O + (size_t)row * ldc + col0;
#pragma unroll
                for (int bj = 0; bj < 2; ++bj) {
                    const pg8::f32x4 v0 = acc[ai][bj][m][0] * r, v1 = acc[ai][bj][m][1] * r;
                    u32x4 w; w.x = pk2(v0[0], v0[1]); w.y = pk2(v0[2], v0[3]); w.z = pk2(v1[0], v1[1]); w.w = pk2(v1[2], v1[3]);
                    *(u32x4*)(rowp + bj * 128) = w;
                }
            }
    }
};

struct EpiX1 {
    static constexpr bool PERM = true, AFTER_DRAIN = false;
    const float* xin32;
    bf16_t* X1B; float* ssp; float* amxp;
    __device__ __forceinline__ void operator()(const pg8::f32x4 (&acc)[2][2][4][2], const pg8::Unit& u, int wr, int wc, int fr, int fq) const {
        const int col0 = u.pn * 256 + wc * 32 + 8 * fq;
#pragma unroll
        for (int ai = 0; ai < 2; ++ai)
#pragma unroll
            for (int m = 0; m < 4; ++m) {
                const int row = u.pm * 256 + ai * 128 + wr * 64 + m * 16 + fr;
                float q = 0.f, am = 0.f;
#pragma unroll
                for (int bj = 0; bj < 2; ++bj) {
                    const size_t off = (size_t)row * D + col0 + bj * 128;
                    pg8::f32x4 r0, r1;
                    if (xin32) { r0 = *(const pg8::f32x4*)(xin32 + off); r1 = *(const pg8::f32x4*)(xin32 + off + 4); }
                    else { const u32x4 rb = *(const u32x4*)(X1B + off); r0 = (pg8::f32x4){bflo(rb.x), bfhi(rb.x), bflo(rb.y), bfhi(rb.y)}; r1 = (pg8::f32x4){bflo(rb.z), bfhi(rb.z), bflo(rb.w), bfhi(rb.w)}; }
                    const pg8::f32x4 o0 = r0 + acc[ai][bj][m][0], o1 = r1 + acc[ai][bj][m][1];
                    u32x4 w; w.x = pk2(o0[0], o0[1]); w.y = pk2(o0[2], o0[3]); w.z = pk2(o1[0], o1[1]); w.w = pk2(o1[2], o1[3]);
                    *(u32x4*)(X1B + off) = w;
#pragma unroll
                    for (int k = 0; k < 4; ++k) {
                        const float a = bflo(w[k]), b = bfhi(w[k]);
                        q += a * a + b * b;
                        am = fmaxf(am, fmaxf(fabsf(a), fabsf(b)));
                    }
                }
                q += __shfl_xor(q, 16); q += __shfl_xor(q, 32);
                am = fmaxf(am, __shfl_xor(am, 16)); am = fmaxf(am, __shfl_xor(am, 32));
                if (fq == 0) { ssp[(size_t)row * 32 + u.pn * 4 + wc] = q; amxp[(size_t)row * 32 + u.pn * 4 + wc] = am; }
            }
    }
};

#define TOPK_INSERT(L, x) do { _Pragma("unroll") for (int _i = 15; _i >= 1; --_i) L[_i] = __builtin_amdgcn_fmed3f(L[_i - 1], L[_i], (x)); L[0] = fmaxf(L[0], (x)); } while (0)
constexpr int SK_LD = 136;
constexpr int ROUTE_SK_OFF = 8 * 8448;
typedef float f32x16 __attribute__((ext_vector_type(16)));
__device__ __forceinline__ float swap32(float x) {
    const auto s = __builtin_amdgcn_permlane32_swap(__float_as_uint(x), __float_as_uint(x), false, false);
    return (__builtin_amdgcn_mbcnt_hi(~0u, __builtin_amdgcn_mbcnt_lo(~0u, 0u)) < 32u) ? __uint_as_float(s[1]) : __uint_as_float(s[0]);
}
__device__ __forceinline__ void route_unit(const bf16_t* __restrict__ Q, const bf16_t* __restrict__ subk_l, int pm, int h, int* __restrict__ IDX, int* __restrict__ IDXU, float* __restrict__ GATE,
                                           LAS unsigned char* lds, int tid, int wave, int lane) {
    const int tk = lane & 31, hi = lane >> 5;
    LAS float* scr = (LAS float*)(lds + wave * 8448);
    LAS bf16_t* SK = (LAS bf16_t*)(lds + ROUTE_SK_OFF);
    __syncthreads();
#pragma unroll
    for (int j = 0; j < 8; ++j) {
        const int e = tid + j * NTHR, half = e >> 11, row = (e >> 4) & 127, ch = e & 15;
        *(LAS u32x4*)(SK + (half * 128 + row) * SK_LD + ch * 8) = *(const u32x4*)(subk_l + ((size_t)(half * 8 + h) * 128 + row) * 128 + ch * 8);
    }
    const int tok = pm * 256 + wave * 32 + tk;
    bf16x8 bq[2][8];
#pragma unroll
    for (int half = 0; half < 2; ++half)
#pragma unroll
        for (int ks = 0; ks < 8; ++ks) bq[half][ks] = *(const bf16x8*)(Q + (size_t)tok * D + h * 256 + half * 128 + ks * 16 + 8 * hi);
    __syncthreads();
    float L1[16], L2[16];
#pragma unroll
    for (int half = 0; half < 2; ++half) {
        float L[16];
#pragma unroll
        for (int i = 0; i < 16; ++i) L[i] = -3.0e38f;
#pragma unroll 1
        for (int mt = 0; mt < 4; ++mt) {
            f32x16 acc;
#pragma unroll
            for (int r = 0; r < 16; ++r) acc[r] = 0.f;
            const LAS bf16_t* kp = SK + (half * 128 + mt * 32 + tk) * SK_LD + 8 * hi;
#pragma unroll
            for (int ks = 0; ks < 8; ++ks) acc = __builtin_amdgcn_mfma_f32_32x32x16_bf16(*(const LAS bf16x8*)(kp + ks * 16), bq[half][ks], acc, 0, 0, 0);
#pragma unroll
            for (int r = 0; r < 16; ++r) {
                const unsigned key = (unsigned)(mt * 32 + (r & 3) + 8 * (r >> 2) + 4 * hi);
                const float xv = __uint_as_float((__float_as_uint(acc[r]) & 0xffffff80u) | key);
                TOPK_INSERT(L, xv);
            }
        }
        { float o[16];
#pragma unroll
          for (int i = 0; i < 16; ++i) o[i] = swap32(L[i]);
#pragma unroll
          for (int i = 0; i < 16; ++i) TOPK_INSERT(L, o[i]); }
#pragma unroll
        for (int i = 0; i < 16; ++i) { if (half == 0) L1[i] = L[i]; else L2[i] = L[i]; }
    }
    float C[16];
#pragma unroll
    for (int i = 0; i < 16; ++i) C[i] = -3.0e38f;
    {
        constexpr int NA[50] = {0,0,0,0,0,0,0,0,0,0,0,0,0,0,0,0, 1,1,1,1,1,1,1,1, 2,2,2,2,2, 3,3,3,3, 4,4,4, 5,5, 6,6, 7,7, 8, 9, 10, 11, 12, 13, 14, 15};
        constexpr int NBb[50] = {0,1,2,3,4,5,6,7,8,9,10,11,12,13,14,15, 0,1,2,3,4,5,6,7, 0,1,2,3,4, 0,1,2,3, 0,1,2, 0,1, 0,1, 0,1, 0, 0, 0, 0, 0, 0, 0, 0};
#pragma unroll
        for (int i = 0; i < 25; ++i) {
            const int a0 = NA[2 * i], b0 = NBb[2 * i], a1 = NA[2 * i + 1], b1 = NBb[2 * i + 1];
            const float s0 = L1[a0] + L2[b0], s1 = L1[a1] + L2[b1];
            const float x0 = __uint_as_float((__float_as_uint(s0) & 0xffffff00u) | (unsigned)(a0 * 16 + b0));
            const float x1 = __uint_as_float((__float_as_uint(s1) & 0xffffff00u) | (unsigned)(a1 * 16 + b1));
            const float xv = hi ? x1 : x0;
            TOPK_INSERT(C, xv);
        }
        float o[16];
#pragma unroll
        for (int i = 0; i < 16; ++i) o[i] = swap32(C[i]);
#pragma unroll
        for (int i = 0; i < 16; ++i) TOPK_INSERT(C, o[i]);
    }
    LAS float* my = scr + lane * 33;
#pragma unroll
    for (int i = 0; i < 16; ++i) { my[i] = L1[i]; my[16 + i] = L2[i]; }
    __builtin_amdgcn_s_waitcnt(0xc07f);
    asm volatile("" ::: "memory");
    const float mx = __uint_as_float(__float_as_uint(C[0]) & 0xffffff00u);
    float e[16], den = 0.f;
#pragma unroll
    for (int i = 0; i < 16; ++i) { e[i] = __expf(__uint_as_float(__float_as_uint(C[i]) & 0xffffff00u) - mx); den += e[i]; }
    const float rden = 1.f / den;
    {
        u32x4 iv[2]; f32x4 gv[2];
        const unsigned hm = hi ? 0xffffffffu : 0u;
#pragma unroll
        for (int j = 0; j < 8; ++j) {
            const unsigned cju = (__float_as_uint(C[8 + j]) & hm) | (__float_as_uint(C[j]) & ~hm);
            const float ej = __uint_as_float((__float_as_uint(e[8 + j]) & hm) | (__float_as_uint(e[j]) & ~hm));
            const unsigned ab = cju & 0xffu;
            const unsigned i1 = __float_as_uint(my[ab >> 4]) & 0x7fu, i2 = __float_as_uint(my[16 + (ab & 15)]) & 0x7fu;
            iv[j >> 2][j & 3] = i1 * 128 + i2;
            gv[j >> 2][j & 3] = ej * rden;
        }
        u32x4* ip = (u32x4*)(IDX + (size_t)tok * 128 + h * 16 + 8 * hi);
        f32x4* gp = (f32x4*)(GATE + (size_t)tok * 128 + h * 16 + 8 * hi);
        ip[0] = iv[0]; ip[1] = iv[1]; gp[0] = gv[0]; gp[1] = gv[1];
    }
    __builtin_amdgcn_s_waitcnt(0xc07f);
    asm volatile("" ::: "memory");
}

__device__ __forceinline__ float gelu_erf(float x) { return 0.5f * x * (1.f + erff(x * 0.70710678118654752f)); }
template <bool FINAL>
__device__ __forceinline__ void expert_token(int t, const bf16_t* __restrict__ X1B, const float* __restrict__ X1, const float* __restrict__ ssp, const int* __restrict__ IDX, const float* __restrict__ GATE,
                                             const unsigned char* __restrict__ U8, const float* __restrict__ USC, const unsigned char* __restrict__ V8, const float* __restrict__ VSC,
                                             float* __restrict__ X2, bf16_t* __restrict__ XB, float* __restrict__ SS, const float* __restrict__ norm_final, float* __restrict__ OUT, int lane) {
    float xf[2][16];
#pragma unroll
    for (int j = 0; j < 2; ++j) {
        const u32x4* xp = (const u32x4*)(X1B + (size_t)t * D + j * 1024 + lane * 16);
        const u32x4 a = xp[0], b = xp[1];
#pragma unroll
        for (int q = 0; q < 4; ++q) { xf[j][2 * q] = bflo(a[q]); xf[j][2 * q + 1] = bfhi(a[q]); xf[j][8 + 2 * q] = bflo(b[q]); xf[j][8 + 2 * q + 1] = bfhi(b[q]); }
    }
    float sp = (lane < 32) ? ssp[(size_t)t * 32 + lane] : 0.f;
    sp = wsum(sp);
    const float rs1 = rsqrtf(sp * (1.f / D) + EPS);
    const int id0 = IDX[(size_t)t * 128 + lane], id1 = IDX[(size_t)t * 128 + 64 + lane];
    const float g0 = GATE[(size_t)t * 128 + lane], g1 = GATE[(size_t)t * 128 + 64 + lane];
    const float us0 = USC[id0], us1 = USC[id1], vs0 = VSC[id0], vs1 = VSC[id1];
    float acc[2][16];
#pragma unroll
    for (int j = 0; j < 2; ++j)
#pragma unroll
        for (int i = 0; i < 16; ++i) acc[j][i] = 0.f;
    float act0 = 0.f, act1 = 0.f;
#pragma unroll 1
    for (int e0 = 0; e0 < 128; e0 += 4) {
        u32x4 w[4][2];
#pragma unroll
        for (int e = 0; e < 4; ++e) {
            const int ee = e0 + e;
            const int id = __builtin_amdgcn_readlane(ee < 64 ? id0 : id1, ee & 63);
            const unsigned char* up = U8 + (size_t)id * D + lane * 16;
            w[e][0] = *(const u32x4*)up; w[e][1] = *(const u32x4*)(up + 1024);
        }
        float d[4];
#pragma unroll
        for (int e = 0; e < 4; ++e) {
            float s = 0.f;
#pragma unroll
            for (int j = 0; j < 2; ++j)
#pragma unroll
                for (int q = 0; q < 4; ++q) {
                    const f32x2 lo = __builtin_amdgcn_cvt_pk_f32_fp8((int)w[e][j][q], false), hi = __builtin_amdgcn_cvt_pk_f32_fp8((int)w[e][j][q], true);
                    s = fmaf(lo.x, xf[j][4 * q], s); s = fmaf(lo.y, xf[j][4 * q + 1], s); s = fmaf(hi.x, xf[j][4 * q + 2], s); s = fmaf(hi.y, xf[j][4 * q + 3], s);
                }
            d[e] = wsum(s);
        }
#pragma unroll
        for (int e = 0; e < 4; ++e) {
            const int ee = e0 + e;
            if (ee < 64) { if (lane == ee) act0 = d[e]; } else { if (lane == ee - 64) act1 = d[e]; }
        }
    }
    act0 = gelu_erf(act0 * us0 * rs1) * g0 * vs0;
    act1 = gelu_erf(act1 * us1 * rs1) * g1 * vs1;
#pragma unroll 1
    for (int e0 = 0; e0 < 128; e0 += 4) {
        u32x4 w[4][2];
        float a[4];
#pragma unroll
        for (int e = 0; e < 4; ++e) {
            const int ee = e0 + e;
            const int id = __builtin_amdgcn_readlane(ee < 64 ? id0 : id1, ee & 63);
            a[e] = __int_as_float(__builtin_amdgcn_readlane(__float_as_int(ee < 64 ? act0 : act1), ee & 63));
            const unsigned char* vp = V8 + (size_t)id * D + lane * 16;
            w[e][0] = *(const u32x4*)vp; w[e][1] = *(const u32x4*)(vp + 1024);
        }
#pragma unroll
        for (int e = 0; e < 4; ++e)
#pragma unroll
            for (int j = 0; j < 2; ++j)
#pragma unroll
                for (int q = 0; q < 4; ++q) {
                    const f32x2 lo = __builtin_amdgcn_cvt_pk_f32_fp8((int)w[e][j][q], false), hi = __builtin_amdgcn_cvt_pk_f32_fp8((int)w[e][j][q], true);
                    acc[j][4 * q] = fmaf(a[e], lo.x, acc[j][4 * q]); acc[j][4 * q + 1] = fmaf(a[e], lo.y, acc[j][4 * q + 1]);
                    acc[j][4 * q + 2] = fmaf(a[e], hi.x, acc[j][4 * q + 2]); acc[j][4 * q + 3] = fmaf(a[e], hi.y, acc[j][4 * q + 3]);
                }
    }
    float q2 = 0.f;
#pragma unroll
    for (int j = 0; j < 2; ++j)
#pragma unroll
        for (int q = 0; q < 4; ++q) {
            const f32x4 r = *(const f32x4*)(X1 + (size_t)t * D + j * 1024 + lane * 16 + q * 4);
            acc[j][4 * q] += r.x; acc[j][4 * q + 1] += r.y; acc[j][4 * q + 2] += r.z; acc[j][4 * q + 3] += r.w;
            q2 += (acc[j][4 * q] * acc[j][4 * q] + acc[j][4 * q + 1] * acc[j][4 * q + 1]) + (acc[j][4 * q + 2] * acc[j][4 * q + 2] + acc[j][4 * q + 3] * acc[j][4 * q + 3]);
        }
    q2 = wsum(q2);
    if (FINAL) {
        const float rf = rsqrtf(q2 * (1.f / D) + EPS);
#pragma unroll
        for (int j = 0; j < 2; ++j)
#pragma unroll
            for (int q = 0; q < 4; ++q) {
                const int e = j * 1024 + lane * 16 + q * 4;
                const f32x4 g = *(const f32x4*)(norm_final + e);
                f32x4 o; o.x = acc[j][4 * q] * rf * g.x; o.y = acc[j][4 * q + 1] * rf * g.y; o.z = acc[j][4 * q + 2] * rf * g.z; o.w = acc[j][4 * q + 3] * rf * g.w;
                *(f32x4*)(OUT + (size_t)t * D + e) = o;
            }
    } else {
#pragma unroll
        for (int j = 0; j < 2; ++j) {
#pragma unroll
            for (int q = 0; q < 4; ++q) {
                f32x4 o; o.x = acc[j][4 * q]; o.y = acc[j][4 * q + 1]; o.z = acc[j][4 * q + 2]; o.w = acc[j][4 * q + 3];
                *(f32x4*)(X2 + (size_t)t * D + j * 1024 + lane * 16 + q * 4) = o;
            }
            u32x4 b0, b1;
#pragma unroll
            for (int q = 0; q < 4; ++q) { b0[q] = pk2(acc[j][2 * q], acc[j][2 * q + 1]); b1[q] = pk2(acc[j][8 + 2 * q], acc[j][8 + 2 * q + 1]); }
            u32x4* xo = (u32x4*)(XB + (size_t)t * D + j * 1024 + lane * 16);
            xo[0] = b0; xo[1] = b1;
        }
        if (lane == 0) SS[t] = q2;
    }
}
}

namespace mk {
constexpr int KS_LD = 72, VS_LD = 80;
constexpr int ATT_KS_OFF = 0, ATT_VS_OFF = 256 * KS_LD * 2;
constexpr int ATT_LDS = ATT_VS_OFF + 256 * VS_LD * 2;

__device__ __forceinline__ bf16x8 tr_pair(const LAS bf16_t* p0, const LAS bf16_t* p1) {
    const s16x4 a = __builtin_amdgcn_ds_read_tr16_b64_v4i16((LAS s16x4*)p0);
    const s16x4 b = __builtin_amdgcn_ds_read_tr16_b64_v4i16((LAS s16x4*)p1);
    bf16x8 r; r[0] = a[0]; r[1] = a[1]; r[2] = a[2]; r[3] = a[3]; r[4] = b[0]; r[5] = b[1]; r[6] = b[2]; r[7] = b[3];
    return r;
}

__device__ __forceinline__ void attn_unit(const bf16_t* __restrict__ P, const f32x2* __restrict__ rope, const float* __restrict__ sinks_l, bf16_t* __restrict__ Y,
                                          int unit, LAS unsigned char* lds, int tid, int lane, int wave) {
    const int b = unit >> 6, n = (unit >> 1) & 31, kvh = unit & 1;
    const int tok0 = b * S + n * 128;
    LAS bf16_t* KS = (LAS bf16_t*)(lds + ATT_KS_OFF);
    LAS bf16_t* VS = (LAS bf16_t*)(lds + ATT_VS_OFF);
    {
        const int key = tid >> 1, part = tid & 1;
        const int kpos = n * 128 - 128 + key;
        u32x4 k1a = {0, 0, 0, 0}, k1b = k1a, k2a = k1a, k2b = k1a, v0 = k1a, v1 = k1a, v2 = k1a, v3 = k1a;
        if (kpos >= 0) {
            const bf16_t* kr = P + (size_t)(tok0 - 128 + key) * NP + C_KA + kvh * 64 + part * 16;
            const u32x4 x1a = *(const u32x4*)kr, x1b = *(const u32x4*)(kr + 8), x2a = *(const u32x4*)(kr + 32), x2b = *(const u32x4*)(kr + 40);
            const f32x4* cs4 = (const f32x4*)(rope + (size_t)kpos * 32 + part * 16);
            f32x4 cv[8];
#pragma unroll
            for (int q = 0; q < 8; ++q) cv[q] = cs4[q];
#pragma unroll
            for (int q = 0; q < 4; ++q) {
                {
                    const f32x2 c0 = {cv[q].x, cv[q].y}, c1 = {cv[q].z, cv[q].w};
                    const float a0 = bflo(x1a[q]), a1 = bfhi(x1a[q]), b0 = bflo(x2a[q]), b1 = bfhi(x2a[q]);
                    k1a[q] = pk2(a0 * c0.x - b0 * c0.y, a1 * c1.x - b1 * c1.y);
                    k2a[q] = pk2(b0 * c0.x + a0 * c0.y, b1 * c1.x + a1 * c1.y);
                }
                {
                    const f32x2 c0 = {cv[4 + q].x, cv[4 + q].y}, c1 = {cv[4 + q].z, cv[4 + q].w};
                    const float a0 = bflo(x1b[q]), a1 = bfhi(x1b[q]), b0 = bflo(x2b[q]), b1 = bfhi(x2b[q]);
                    k1b[q] = pk2(a0 * c0.x - b0 * c0.y, a1 * c1.x - b1 * c1.y);
                    k2b[q] = pk2(b0 * c0.x + a0 * c0.y, b1 * c1.x + a1 * c1.y);
                }
            }
            const bf16_t* vr = P + (size_t)(tok0 - 128 + key) * NP + C_VA + kvh * 64 + part * 32;
            v0 = *(const u32x4*)vr; v1 = *(const u32x4*)(vr + 8); v2 = *(const u32x4*)(vr + 16); v3 = *(const u32x4*)(vr + 24);
        }
        LAS bf16_t* kd = KS + key * KS_LD + part * 16;
        *(LAS u32x4*)kd = k1a; *(LAS u32x4*)(kd + 8) = k1b; *(LAS u32x4*)(kd + 32) = k2a; *(LAS u32x4*)(kd + 40) = k2b;
        LAS bf16_t* vd = VS + key * VS_LD + part * 32;
        *(LAS u32x4*)vd = v0; *(LAS u32x4*)(vd + 8) = v1; *(LAS u32x4*)(vd + 16) = v2; *(LAS u32x4*)(vd + 24) = v3;
    }
    __syncthreads();
    const int hq = kvh * 8 + wave;
    const int fr = lane & 15, fq = lane >> 4;
    constexpr float L2E = 1.4426950408889634f;
    const float sink2 = sinks_l[hq] * L2E;
    const int tq = (lane & 15) >> 2, tp = lane & 3;
    u32x4 x1n[2], x2n[2]; f32x4 csn[2][4];
#define ATT_FETCH(RP) do { _Pragma("unroll") for (int eb_ = 0; eb_ < 2; ++eb_) { const int qi_ = (RP) * 32 + eb_ * 16 + fr; const bf16_t* qr_ = P + (size_t)(tok0 + qi_) * NP + C_QA + hq * 64 + 8 * fq; \
        x1n[eb_] = *(const u32x4*)qr_; x2n[eb_] = *(const u32x4*)(qr_ + 32); const f32x4* cs_ = (const f32x4*)(rope + (size_t)(n * 128 + qi_) * 32 + 8 * fq); \
        csn[eb_][0] = cs_[0]; csn[eb_][1] = cs_[1]; csn[eb_][2] = cs_[2]; csn[eb_][3] = cs_[3]; } } while (0)
    ATT_FETCH(0);
#pragma unroll 1
    for (int rp = 0; rp < 4; ++rp) {
        const int wsk = rp * 32;
        bf16x8 bq0[2], bq1[2];
        u32x4 x1c[2], x2c[2]; f32x4 csc[2][4];
#pragma unroll
        for (int eb = 0; eb < 2; ++eb) { x1c[eb] = x1n[eb]; x2c[eb] = x2n[eb];
#pragma unroll
            for (int q = 0; q < 4; ++q) csc[eb][q] = csn[eb][q]; }
        if (rp < 3) ATT_FETCH(rp + 1);
#pragma unroll
        for (int eb = 0; eb < 2; ++eb) {
            const u32x4 x1 = x1c[eb], x2 = x2c[eb];
            u32x4 o1, o2;
            constexpr float SC = 0.125f * L2E;
#pragma unroll
            for (int q = 0; q < 4; ++q) {
                const f32x4 cq = csc[eb][q];
                const float a0 = bflo(x1[q]), a1 = bfhi(x1[q]), b0 = bflo(x2[q]), b1 = bfhi(x2[q]);
                o1[q] = pk2((a0 * cq.x - b0 * cq.y) * SC, (a1 * cq.z - b1 * cq.w) * SC);
                o2[q] = pk2((b0 * cq.x + a0 * cq.y) * SC, (b1 * cq.z + a1 * cq.w) * SC);
            }
            bq0[eb] = __builtin_bit_cast(bf16x8, o1); bq1[eb] = __builtin_bit_cast(bf16x8, o2);
        }
        pg8::f32x4 sc[2][10];
#pragma unroll
        for (int kt = 0; kt < 10; ++kt) {
            const LAS bf16_t* kp = KS + (wsk + kt * 16 + fr) * KS_LD + 8 * fq;
            const bf16x8 a0 = *(const LAS bf16x8*)kp, a1 = *(const LAS bf16x8*)(kp + 32);
#pragma unroll
            for (int eb = 0; eb < 2; ++eb) {
                pg8::f32x4 acc = {-1e30f, -1e30f, -1e30f, -1e30f};
                if (!((eb == 0 && kt == 9) || (eb == 1 && kt == 0))) {
                    acc = (pg8::f32x4){0.f, 0.f, 0.f, 0.f};
                    acc = __builtin_amdgcn_mfma_f32_16x16x32_bf16(a0, bq0[eb], acc, 0, 0, 0);
                    acc = __builtin_amdgcn_mfma_f32_16x16x32_bf16(a1, bq1[eb], acc, 0, 0, 0);
                }
                sc[eb][kt] = acc;
            }
        }
        const int kmin = (n == 0) ? 128 : 0;
        float rden[2];
#pragma unroll
        for (int eb = 0; eb < 2; ++eb) {
            const int qb = rp * 32 + eb * 16 + fr;
            float mx = sink2;
#pragma unroll
            for (int kt = 0; kt < 10; ++kt) {
                const bool interior = (kt - eb >= 1 && kt - eb <= 7) && n != 0;
#pragma unroll
                for (int r = 0; r < 4; ++r) {
                    if (!interior) {
                        const int kb = wsk + kt * 16 + 4 * fq + r;
                        const bool ok = (kb >= qb + 1) && (kb <= qb + 128) && (kb >= kmin);
                        sc[eb][kt][r] = ok ? sc[eb][kt][r] : -1e30f;
                    }
                    mx = fmaxf(mx, sc[eb][kt][r]);
                }
            }
            mx = fmaxf(mx, __shfl_xor(mx, 16)); mx = fmaxf(mx, __shfl_xor(mx, 32));
            float sum = 0.f;
#pragma unroll
            for (int kt = 0; kt < 10; ++kt)
#pragma unroll
                for (int r = 0; r < 4; ++r) { const float pv = __builtin_amdgcn_exp2f(sc[eb][kt][r] - mx); sc[eb][kt][r] = pv; sum += pv; }
            sum += __shfl_xor(sum, 16); sum += __shfl_xor(sum, 32);
            rden[eb] = __builtin_amdgcn_rcpf(sum + __builtin_amdgcn_exp2f(sink2 - mx));
        }
        pg8::f32x4 oacc[2][4];
#pragma unroll
        for (int eb = 0; eb < 2; ++eb)
#pragma unroll
            for (int mt = 0; mt < 4; ++mt) oacc[eb][mt] = (pg8::f32x4){0.f, 0.f, 0.f, 0.f};
#pragma unroll
        for (int kk = 0; kk < 5; ++kk) {
            bf16x8 bp[2];
#pragma unroll
            for (int eb = 0; eb < 2; ++eb) {
                u32x4 pb; pb[0] = pk2(sc[eb][2 * kk][0], sc[eb][2 * kk][1]); pb[1] = pk2(sc[eb][2 * kk][2], sc[eb][2 * kk][3]);
                pb[2] = pk2(sc[eb][2 * kk + 1][0], sc[eb][2 * kk + 1][1]); pb[3] = pk2(sc[eb][2 * kk + 1][2], sc[eb][2 * kk + 1][3]);
                bp[eb] = __builtin_bit_cast(bf16x8, pb);
            }
            const LAS bf16_t* v0 = VS + (wsk + (2 * kk) * 16 + 4 * fq + tq) * VS_LD + 4 * tp;
            const LAS bf16_t* v1 = v0 + 16 * VS_LD;
#pragma unroll
            for (int mt = 0; mt < 4; ++mt) {
                const bf16x8 av = tr_pair(v0 + mt * 16, v1 + mt * 16);
                oacc[0][mt] = __builtin_amdgcn_mfma_f32_16x16x32_bf16(av, bp[0], oacc[0][mt], 0, 0, 0);
                oacc[1][mt] = __builtin_amdgcn_mfma_f32_16x16x32_bf16(av, bp[1], oacc[1][mt], 0, 0, 0);
            }
        }
#pragma unroll
        for (int eb = 0; eb < 2; ++eb) {
            bf16_t* yr = Y + (size_t)(tok0 + rp * 32 + eb * 16 + fr) * D + hq * 64 + 4 * fq;
#pragma unroll
            for (int mt = 0; mt < 4; ++mt) {
                u32x2 w; w.x = pk2(oacc[eb][mt][0] * rden[eb], oacc[eb][mt][1] * rden[eb]); w.y = pk2(oacc[eb][mt][2] * rden[eb], oacc[eb][mt][3] * rden[eb]);
                *(u32x2*)(yr + mt * 16) = w;
            }
        }
    }
#undef ATT_FETCH
}

}

namespace mk {
constexpr int RL = 144;
constexpr int PSL = 72;
constexpr int OBL = 132;
constexpr int R_QT = 0, R_KT = 64 * RL * 2, R_KD = 2 * 64 * RL * 2, R_V = 3 * 64 * RL * 2, R_SB = 4 * 64 * RL * 2;
constexpr int R_PS = R_SB + 128 * RL * 2;
constexpr int R_VEC = R_PS + 64 * PSL * 2;
constexpr int R_OB = R_KT;
constexpr int REC_LDS = R_VEC + 12288;
static_assert(64 * OBL * 4 <= 2 * 64 * RL * 2, "OB overlay");
constexpr int ST_STRIDE = 16384 + 256;

__device__ __forceinline__ bf16x8 ld_row_split(const LAS bf16_t* p) {
    const s16x4 a = *(const LAS s16x4*)p, b = *(const LAS s16x4*)(p + 16);
    bf16x8 r; r[0] = a[0]; r[1] = a[1]; r[2] = a[2]; r[3] = a[3]; r[4] = b[0]; r[5] = b[1]; r[6] = b[2]; r[7] = b[3];
    return r;
}
__device__ __forceinline__ float clamp80(float x) { return fminf(fmaxf(x, -80.f), 80.f); }
__device__ __forceinline__ float sigm(float x) { return __builtin_amdgcn_rcpf(1.f + __builtin_amdgcn_exp2f(x * -1.4426950408889634f)); }
__device__ __forceinline__ void st_bf16(LAS bf16_t* p, float v) { *p = (bf16_t)(pk2(v, 0.f) & 0xffffu); }

__device__ __forceinline__ void state_update(pg8::f32x4 (&acc)[8], const LAS bf16_t* KDm, const LAS bf16_t* Vm, int wave, int fq, int tq, int tp) {
    bf16x8 ka[2];
#pragma unroll
    for (int ks = 0; ks < 2; ++ks) { const LAS bf16_t* p = KDm + (ks * 32 + 4 * fq + tq) * RL + 16 * wave + 4 * tp; ka[ks] = tr_pair(p, p + 16 * RL); }
#pragma unroll
    for (int j = 0; j < 8; ++j)
#pragma unroll
        for (int ks = 0; ks < 2; ++ks) {
            const LAS bf16_t* p = Vm + (ks * 32 + 4 * fq + tq) * RL + 16 * j + 4 * tp;
            const bf16x8 vb = tr_pair(p, p + 16 * RL);
            acc[j] = __builtin_amdgcn_mfma_f32_16x16x32_bf16(ka[ks], vb, acc[j], 0, 0, 0);
        }
}
__device__ __forceinline__ void state_to_lds(const pg8::f32x4 (&acc)[8], const float (&rsc)[4], LAS bf16_t* SBm, int wave, int fr, int fq) {
#pragma unroll
    for (int j = 0; j < 8; ++j)
#pragma unroll
        for (int r = 0; r < 4; ++r) st_bf16(SBm + (16 * wave + 4 * fq + r) * RL + 16 * j + fr, acc[j][r] * rsc[r]);
}
__device__ __forceinline__ void score_tile(pg8::f32x4& acc, const LAS bf16_t* Am, const LAS bf16_t* Bm, int ti, int tj, int fr, int fq) {
    acc = (pg8::f32x4){0.f, 0.f, 0.f, 0.f};
#pragma unroll
    for (int ks = 0; ks < 4; ++ks) {
        const bf16x8 a = *(const LAS bf16x8*)(Am + (16 * ti + fr) * RL + ks * 32 + 8 * fq);
        const bf16x8 b = *(const LAS bf16x8*)(Bm + (16 * tj + fr) * RL + ks * 32 + 8 * fq);
        acc = __builtin_amdgcn_mfma_f32_16x16x32_bf16(a, b, acc, 0, 0, 0);
    }
}
struct TileRegs { u32x4 a, b; };
__device__ __forceinline__ TileRegs tile_load(const bf16_t* __restrict__ src, int tid) {
    const int row = tid >> 3, seg = tid & 7;
    const bf16_t* s = src + (size_t)row * NP + seg * 16;
    TileRegs t; t.a = *(const u32x4*)s; t.b = *(const u32x4*)(s + 8); return t;
}
__device__ __forceinline__ void tile_store(const TileRegs& t, LAS bf16_t* dst, int tid) {
    const int row = tid >> 3, seg = tid & 7;
    LAS bf16_t* d = dst + row * RL + seg * 16;
    *(LAS u32x4*)d = t.a; *(LAS u32x4*)(d + 8) = t.b;
}
__device__ __forceinline__ void state_store(const pg8::f32x4 (&acc)[8], float* __restrict__ dst, int wave, int lane) {
#pragma unroll
    for (int j = 0; j < 8; ++j)
#pragma unroll
        for (int r = 0; r < 4; ++r) dst[((wave * 8 + j) * 4 + r) * 64 + lane] = acc[j][r];
}

template <int PASS>
__device__ __forceinline__ void hgrn_unit(const bf16_t* __restrict__ P, const float* __restrict__ lb_logits, int layer, const float* __restrict__ gain_l,
                                          float* __restrict__ STB, bf16_t* __restrict__ Y, int unit, LAS unsigned char* lds, int tid, int lane, int wave) {
    const int chain = unit >> 3, g = unit & 7, b = chain >> 2, h = chain & 3;
    const int t0 = b * S + g * 512;
    const int fr = lane & 15, fq = lane >> 4, tq = (lane & 15) >> 2, tp = lane & 3;
    const int kp = tid & 63, rg = wave, c0 = 2 * kp;
    LAS bf16_t* QT = (LAS bf16_t*)(lds + R_QT); LAS bf16_t* KT = (LAS bf16_t*)(lds + R_KT); LAS bf16_t* KD = (LAS bf16_t*)(lds + R_KD);
    LAS bf16_t* VV = (LAS bf16_t*)(lds + R_V); LAS bf16_t* SB = (LAS bf16_t*)(lds + R_SB); LAS bf16_t* PS = (LAS bf16_t*)(lds + R_PS);
    LAS float* TOT = (LAS float*)(lds + R_VEC);
    LAS float* EREF = TOT + 1024; LAS float* ELAST = EREF + 128;
    LAS float* OB = (LAS float*)(lds + R_OB);
    float lb0 = 0.f, lb1 = 0.f;
    if (layer == 1) {
        const float a0 = lb_logits[h * 128 + c0], a1 = lb_logits[512 + h * 128 + c0], d0 = lb_logits[h * 128 + c0 + 1], d1 = lb_logits[512 + h * 128 + c0 + 1];
        const float m0 = fmaxf(a0, a1), m1 = fmaxf(d0, d1);
        lb0 = __expf(a1 - m0) / (__expf(a0 - m0) + __expf(a1 - m0));
        lb1 = __expf(d1 - m1) / (__expf(d0 - m1) + __expf(d1 - m1));
    }
    pg8::f32x4 acc[8];
#pragma unroll
    for (int j = 0; j < 8; ++j) acc[j] = (pg8::f32x4){0.f, 0.f, 0.f, 0.f};
    if (PASS == 2) {
        for (int jg = 0; jg < g; ++jg) {
            const float* sb = STB + (size_t)(chain * 8 + jg) * ST_STRIDE;
            float dk[4];
#pragma unroll
            for (int r = 0; r < 4; ++r) dk[r] = __expf(sb[16384 + 16 * wave + 4 * fq + r]);
#pragma unroll
            for (int j = 0; j < 8; ++j)
#pragma unroll
                for (int r = 0; r < 4; ++r) acc[j][r] = acc[j][r] * dk[r] + sb[((wave * 8 + j) * 4 + r) * 64 + lane];
        }
    }
    float gl0 = 0.f, gl1 = 0.f;
    unsigned fwn[8], qwn[8];
    {
#pragma unroll
        for (int i = 0; i < 8; ++i) { const bf16_t* pr = P + (size_t)(t0 + rg * 8 + i) * NP + h * 128 + c0; fwn[i] = *(const unsigned*)(pr + C_FH); if (PASS == 2) qwn[i] = *(const unsigned*)(pr + C_QH); }
    }
    TileRegs vnx = tile_load(P + (size_t)t0 * NP + C_IH + h * 128, tid);
#pragma unroll 1
    for (int c = 0; c < 8; ++c) {
        const int tr0 = t0 + c * 64;
        float lf0[8], lf1[8], kk0[8], kk1[8], qv0[8], qv1[8];
#pragma unroll
        for (int i = 0; i < 8; ++i) {
            const unsigned fw = fwn[i];
            const float z0 = bflo(fw), z1 = bfhi(fw);
            const float s0 = sigm(z0), s1 = sigm(z1);
            lf0[i] = __logf(fmaxf(lb0 + (1.f - lb0) * s0, 1e-30f)); lf1[i] = __logf(fmaxf(lb1 + (1.f - lb1) * s1, 1e-30f));
            kk0[i] = (1.f - lb0) * (1.f - s0); kk1[i] = (1.f - lb1) * (1.f - s1);
            if (PASS == 2) { const unsigned qw = qwn[i]; const float q0 = bflo(qw), q1 = bfhi(qw); qv0[i] = q0 * sigm(q0); qv1[i] = q1 * sigm(q1); }
        }
#pragma unroll
        for (int i = 1; i < 8; ++i) { lf0[i] += lf0[i - 1]; lf1[i] += lf1[i - 1]; }
        TOT[rg * 128 + c0] = lf0[7]; TOT[rg * 128 + c0 + 1] = lf1[7];
        tile_store(vnx, VV, tid);
        if (c < 7) vnx = tile_load(P + (size_t)(tr0 + 64) * NP + C_IH + h * 128, tid);
        if (c < 7) {
            const int trn = tr0 + 64;
#pragma unroll
            for (int i = 0; i < 8; ++i) { const bf16_t* pr = P + (size_t)(trn + rg * 8 + i) * NP + h * 128 + c0; fwn[i] = *(const unsigned*)(pr + C_FH); if (PASS == 2) qwn[i] = *(const unsigned*)(pr + C_QH); }
        }
        __syncthreads();
        {
            float pre0 = 0.f, pre1 = 0.f, ref0 = 0.f, ref1 = 0.f, la0 = 0.f, la1 = 0.f;
#pragma unroll
            for (int r = 0; r < 8; ++r) {
                const float a0 = TOT[r * 128 + c0], a1 = TOT[r * 128 + c0 + 1];
                if (r < rg) { pre0 += a0; pre1 += a1; }
                if (r < 4) { ref0 += a0; ref1 += a1; }
                la0 += a0; la1 += a1;
            }
#pragma unroll
            for (int i = 0; i < 8; ++i) {
                const int row = rg * 8 + i;
                const float cu0 = pre0 + lf0[i], cu1 = pre1 + lf1[i];
                if (PASS == 2) {
                    *(LAS unsigned*)(QT + row * RL + c0) = pk2(qv0[i] * __expf(clamp80(cu0 - ref0)), qv1[i] * __expf(clamp80(cu1 - ref1)));
                    *(LAS unsigned*)(KT + row * RL + c0) = pk2(kk0[i] * __expf(clamp80(ref0 - cu0)), kk1[i] * __expf(clamp80(ref1 - cu1)));
                }
                *(LAS unsigned*)(KD + row * RL + c0) = pk2(kk0[i] * __expf(la0 - cu0), kk1[i] * __expf(la1 - cu1));
            }
            if (rg == 0) { EREF[c0] = __expf(ref0); EREF[c0 + 1] = __expf(ref1); ELAST[c0] = __expf(la0); ELAST[c0 + 1] = __expf(la1); }
            gl0 += la0; gl1 += la1;
        }
        __syncthreads();
        TileRegs gcur = {};
        if (PASS == 2) gcur = tile_load(P + (size_t)tr0 * NP + C_GH + h * 128, tid);
        pg8::f32x4 o[4];
        if (PASS == 2) {
            { float rs[4];
#pragma unroll
              for (int r = 0; r < 4; ++r) rs[r] = EREF[16 * wave + 4 * fq + r];
              state_to_lds(acc, rs, SB, wave, fr, fq); }
            { const int ti = wave >> 1;
#pragma unroll
              for (int tjj = 0; tjj < 2; ++tjj) {
                  const int tj = 2 * (wave & 1) + tjj;
                  pg8::f32x4 sa = {0.f, 0.f, 0.f, 0.f};
                  if (tj <= ti) score_tile(sa, QT, KT, ti, tj, fr, fq);
#pragma unroll
                  for (int r = 0; r < 4; ++r) {
                      const int t = 16 * ti + 4 * fq + r, s = 16 * tj + fr;
                      st_bf16(PS + t * PSL + s, (s <= t) ? sa[r] : 0.f);
                  }
              } }
        }
        {
#pragma unroll
            for (int r = 0; r < 4; ++r) { const float el = ELAST[16 * wave + 4 * fq + r];
#pragma unroll
                for (int j = 0; j < 8; ++j) acc[j][r] *= el; }
            state_update(acc, KD, VV, wave, fq, tq, tp);
        }
        if (PASS == 2) {
            __syncthreads();
            bf16x8 sbf[4], vbf[2];
#pragma unroll
            for (int ks = 0; ks < 4; ++ks) { const LAS bf16_t* p = SB + (ks * 32 + 4 * fq + tq) * RL + 16 * wave + 4 * tp; sbf[ks] = tr_pair(p, p + 16 * RL); }
#pragma unroll
            for (int ks = 0; ks < 2; ++ks) { const LAS bf16_t* p = VV + (ks * 32 + 4 * fq + tq) * RL + 16 * wave + 4 * tp; vbf[ks] = tr_pair(p, p + 16 * RL); }
#pragma unroll
            for (int ti = 0; ti < 4; ++ti) {
                o[ti] = (pg8::f32x4){0.f, 0.f, 0.f, 0.f};
#pragma unroll
                for (int ks = 0; ks < 4; ++ks) o[ti] = __builtin_amdgcn_mfma_f32_16x16x32_bf16(ld_row_split(QT + (16 * ti + fr) * RL + ks * 32 + 4 * fq), sbf[ks], o[ti], 0, 0, 0);
#pragma unroll
                for (int ks = 0; ks < 2; ++ks) o[ti] = __builtin_amdgcn_mfma_f32_16x16x32_bf16(ld_row_split(PS + (16 * ti + fr) * PSL + ks * 32 + 4 * fq), vbf[ks], o[ti], 0, 0, 0);
            }
        }
        __syncthreads();
        if (PASS == 2) {
#pragma unroll
            for (int ti = 0; ti < 4; ++ti)
#pragma unroll
                for (int r = 0; r < 4; ++r) OB[(16 * ti + 4 * fq + r) * OBL + 16 * wave + fr] = o[ti][r];
            __syncthreads();
            const int t = tid >> 3, seg = tid & 7;
            float ov[16]; float ss = 0.f;
#pragma unroll
            for (int q = 0; q < 4; ++q) { const f32x4 a = *(const LAS f32x4*)(OB + t * OBL + seg * 16 + 4 * q); ov[4 * q] = a.x; ov[4 * q + 1] = a.y; ov[4 * q + 2] = a.z; ov[4 * q + 3] = a.w;
                ss += (a.x * a.x + a.y * a.y) + (a.z * a.z + a.w * a.w); }
            ss = sum8(ss);
            const float rn = rsqrtf(ss * (1.f / 128.f) + EPS);
            const u32x4 g0 = gcur.a, g1 = gcur.b;
            const float* gnp = gain_l + h * 128 + seg * 16;
            u32x4 y0, y1;
#pragma unroll
            for (int q = 0; q < 4; ++q) {
                const float ga = bflo(g0[q]), gb = bfhi(g0[q]), gc = bflo(g1[q]), gd = bfhi(g1[q]);
                y0[q] = pk2(ov[2 * q] * rn * gnp[2 * q] * (ga * sigm(ga)), ov[2 * q + 1] * rn * gnp[2 * q + 1] * (gb * sigm(gb)));
                y1[q] = pk2(ov[8 + 2 * q] * rn * gnp[8 + 2 * q] * (gc * sigm(gc)), ov[8 + 2 * q + 1] * rn * gnp[8 + 2 * q + 1] * (gd * sigm(gd)));
            }
            bf16_t* yp = Y + (size_t)(tr0 + t) * D + 1024 + h * 128 + seg * 16;
            *(u32x4*)yp = y0; *(u32x4*)(yp + 8) = y1;
        }
    }
    if (PASS == 1) {
        float* sb = STB + (size_t)(chain * 8 + g) * ST_STRIDE;
        state_store(acc, sb, wave, lane);
        if (rg == 0) { sb[16384 + c0] = gl0; sb[16384 + c0 + 1] = gl1; }
    }
}

template <int PASS>
__device__ __forceinline__ void mlstm_unit(const bf16_t* __restrict__ P, const float* __restrict__ conv_l, const float* __restrict__ ib_l, const float* __restrict__ fb_l,
                                           float* __restrict__ STB, bf16_t* __restrict__ Y, int unit, LAS unsigned char* lds, int tid, int lane, int wave) {
    const int chain = unit >> 3, g = unit & 7, b = chain >> 2, h = chain & 3;
    const int t0 = b * S + g * 512;
    const int fr = lane & 15, fq = lane >> 4, tq = (lane & 15) >> 2, tp = lane & 3;
    const int kp = tid & 63, rg = wave, c0 = 2 * kp;
    LAS bf16_t* QM = (LAS bf16_t*)(lds + R_QT); LAS bf16_t* KM = (LAS bf16_t*)(lds + R_KT); LAS bf16_t* KW = (LAS bf16_t*)(lds + R_KD);
    LAS bf16_t* VV = (LAS bf16_t*)(lds + R_V); LAS bf16_t* CB = (LAS bf16_t*)(lds + R_SB); LAS bf16_t* PS = (LAS bf16_t*)(lds + R_PS);
    LAS float* VEC = (LAS float*)(lds + R_VEC);
    LAS float* GA = VEC;
    LAS float* GPM = VEC + 512;
    LAS float* GCUM = VEC + 1024;
    LAS float* NV = VEC + 1536;
    LAS float* DENP = VEC + 1664;
    LAS float* DINT = VEC + 1792;
    LAS float* KSUM = VEC + 1856;
    LAS float* OB = (LAS float*)(lds + R_OB);
    float wq0[4], wq1[4], wk0[4], wk1[4];
#pragma unroll
    for (int j = 0; j < 4; ++j) {
        wq0[j] = conv_l[j * 1024 + h * 128 + c0]; wq1[j] = conv_l[j * 1024 + h * 128 + c0 + 1];
        wk0[j] = conv_l[j * 1024 + 512 + h * 128 + c0]; wk1[j] = conv_l[j * 1024 + 512 + h * 128 + c0 + 1];
    }
    {
        const bf16_t* pr = P + (size_t)(t0 + wave * 64 + lane) * NP;
        const float ip = bf2f(pr[C_IM + h]) + ib_l[h];
        const float z = bf2f(pr[C_FM + h]) + fb_l[h];
        const float lf = fminf(z, 0.f) - __logf(1.f + __expf(-fabsf(z)));
        float cu = lf;
#pragma unroll
        for (int o = 1; o < 64; o <<= 1) { const float t = __shfl_up(cu, o); if (lane >= o) cu += t; }
        const float a = ip - cu;
        float pm = a;
#pragma unroll
        for (int o = 1; o < 64; o <<= 1) { const float t = __shfl_up(pm, o); if (lane >= o) pm = fmaxf(pm, t); }
        GA[wave * 64 + lane] = a; GPM[wave * 64 + lane] = pm; GCUM[wave * 64 + lane] = cu;
    }
    pg8::f32x4 acc[8];
#pragma unroll
    for (int j = 0; j < 8; ++j) acc[j] = (pg8::f32x4){0.f, 0.f, 0.f, 0.f};
    float mprev = (PASS == 1) ? -1e30f : 0.f;
    float nreg = 0.f;
    float fsum = 0.f;
    if (PASS == 2) {
        for (int jg = 0; jg < g; ++jg) {
            const float* sb = STB + (size_t)(chain * 8 + jg) * ST_STRIDE;
            const float mE = sb[16384 + 128], F = sb[16384 + 129];
            const float mn = fmaxf(F + mprev, mE);
            const float s1 = __expf(F + mprev - mn), s2 = __expf(mE - mn);
#pragma unroll
            for (int j = 0; j < 8; ++j)
#pragma unroll
                for (int r = 0; r < 4; ++r) acc[j][r] = acc[j][r] * s1 + s2 * sb[((wave * 8 + j) * 4 + r) * 64 + lane];
            if (tid < 128) nreg = nreg * s1 + s2 * sb[16384 + tid];
            mprev = mn;
        }
    }
    if (tid < 128) NV[tid] = nreg;
    unsigned xqn[11], xkn[11];
#define MLSTM_FETCH(TR0, CC) do { _Pragma("unroll") for (int i = 0; i < 11; ++i) { \
            const int row_ = rg * 8 + i - 3; const int pos_ = g * 512 + (CC) * 64 + row_; unsigned wq_ = 0u, wk_ = 0u; \
            if (pos_ >= 0) { const bf16_t* pr_ = P + (size_t)((TR0) + row_) * NP + h * 128 + c0; if (PASS == 2) wq_ = *(const unsigned*)(pr_ + C_QM); wk_ = *(const unsigned*)(pr_ + C_KM); } \
            xqn[i] = wq_; xkn[i] = wk_; } \
        } while (0)
    MLSTM_FETCH(t0, 0);
    TileRegs vnx = tile_load(P + (size_t)t0 * NP + C_VM + h * 128, tid);
    __syncthreads();
#pragma unroll 1
    for (int c = 0; c < 8; ++c) {
        const int tr0 = t0 + c * 64;
        const LAS float* AV = GA + c * 64; const LAS float* PM = GPM + c * 64; const LAS float* CUM = GCUM + c * 64;
        const float M63 = fmaxf(PM[63], mprev), last = CUM[63];
        float ks0 = 0.f, ks1 = 0.f;
#pragma unroll
        for (int i = 0; i < 8; ++i) {
            const int row = rg * 8 + i;
            float k0v = 0.f, k1v = 0.f, q0v = 0.f, q1v = 0.f;
#pragma unroll
            for (int j = 0; j < 4; ++j) { k0v += wk0[j] * bflo(xkn[i + j]); k1v += wk1[j] * bfhi(xkn[i + j]); if (PASS == 2) { q0v += wq0[j] * bflo(xqn[i + j]); q1v += wq1[j] * bfhi(xqn[i + j]); } }
            k0v = k0v * sigm(k0v) * 0.08838834764831845f; k1v = k1v * sigm(k1v) * 0.08838834764831845f;
            const float wsr = __expf(AV[row] - M63);
            const unsigned kw = pk2(k0v * wsr, k1v * wsr);
            *(LAS unsigned*)(KW + row * RL + c0) = kw;
            ks0 += bflo(kw); ks1 += bfhi(kw);
            if (PASS == 2) {
                *(LAS unsigned*)(KM + row * RL + c0) = pk2(k0v, k1v);
                *(LAS unsigned*)(QM + row * RL + c0) = pk2(q0v * sigm(q0v), q1v * sigm(q1v));
            }
        }
        KSUM[rg * 128 + c0] = ks0; KSUM[rg * 128 + c0 + 1] = ks1;
        tile_store(vnx, VV, tid);
        if (c < 7) vnx = tile_load(P + (size_t)(tr0 + 64) * NP + C_VM + h * 128, tid);
        if (c < 7) MLSTM_FETCH(tr0 + 64, c + 1);
        const float decay = __expf(mprev - M63);
        pg8::f32x4 o1[4], o2[4];
        if (PASS == 2) {
            const float one[4] = {1.f, 1.f, 1.f, 1.f};
            state_to_lds(acc, one, CB, wave, fr, fq);
        }
        __syncthreads();
        TileRegs ocur = {};
        if (PASS == 2) ocur = tile_load(P + (size_t)tr0 * NP + C_OM + h * 128, tid);
        if (PASS == 2) {
            { const int ti = wave >> 1;
              float dp[4] = {0.f, 0.f, 0.f, 0.f};
#pragma unroll
              for (int tjj = 0; tjj < 2; ++tjj) {
                  const int tj = 2 * (wave & 1) + tjj;
                  pg8::f32x4 sa = {0.f, 0.f, 0.f, 0.f};
                  if (tj <= ti) score_tile(sa, QM, KM, ti, tj, fr, fq);
                  const int s = 16 * tj + fr;
                  const float as = AV[s];
#pragma unroll
                  for (int r = 0; r < 4; ++r) {
                      const int t = 16 * ti + 4 * fq + r;
                      const float w = (s <= t) ? sa[r] * __expf(as - fmaxf(PM[t], mprev)) : 0.f;
                      st_bf16(PS + t * PSL + s, w);
                      dp[r] += w;
                  }
              }
#pragma unroll
              for (int r = 0; r < 4; ++r) {
                  const float v = sum16(dp[r]);
                  if (fr == 0) DENP[(16 * ti + 4 * fq + r) * 2 + (wave & 1)] = v;
              } }
            { const int t = tid >> 3, seg = tid & 7;
              const bf16x8 qa = *(const LAS bf16x8*)(QM + t * RL + seg * 16), qb = *(const LAS bf16x8*)(QM + t * RL + seg * 16 + 8);
              float dsum = 0.f;
#pragma unroll
              for (int q = 0; q < 8; ++q) dsum += bf2f((unsigned short)qa[q]) * NV[seg * 16 + q] + bf2f((unsigned short)qb[q]) * NV[seg * 16 + 8 + q];
              dsum = sum8(dsum);
              if (seg == 0) DINT[t] = dsum; }
            {
                bf16x8 cbf[4];
#pragma unroll
                for (int ks = 0; ks < 4; ++ks) { const LAS bf16_t* p = CB + (ks * 32 + 4 * fq + tq) * RL + 16 * wave + 4 * tp; cbf[ks] = tr_pair(p, p + 16 * RL); }
#pragma unroll
                for (int ti = 0; ti < 4; ++ti) {
                    o2[ti] = (pg8::f32x4){0.f, 0.f, 0.f, 0.f};
#pragma unroll
                    for (int ks = 0; ks < 4; ++ks) o2[ti] = __builtin_amdgcn_mfma_f32_16x16x32_bf16(ld_row_split(QM + (16 * ti + fr) * RL + ks * 32 + 4 * fq), cbf[ks], o2[ti], 0, 0, 0);
                }
            }
        }
        {
#pragma unroll
            for (int j = 0; j < 8; ++j) acc[j] = acc[j] * decay;
            state_update(acc, KW, VV, wave, fq, tq, tp);
            if (tid < 128) {
                float sumk = 0.f;
#pragma unroll
                for (int r8 = 0; r8 < 8; ++r8) sumk += KSUM[r8 * 128 + tid];
                nreg = nreg * decay + sumk;
            }
        }
        if (PASS == 2) {
            __syncthreads();
            bf16x8 vbf[2];
#pragma unroll
            for (int ks = 0; ks < 2; ++ks) { const LAS bf16_t* p = VV + (ks * 32 + 4 * fq + tq) * RL + 16 * wave + 4 * tp; vbf[ks] = tr_pair(p, p + 16 * RL); }
#pragma unroll
            for (int ti = 0; ti < 4; ++ti) {
                o1[ti] = (pg8::f32x4){0.f, 0.f, 0.f, 0.f};
#pragma unroll
                for (int ks = 0; ks < 2; ++ks) o1[ti] = __builtin_amdgcn_mfma_f32_16x16x32_bf16(ld_row_split(PS + (16 * ti + fr) * PSL + ks * 32 + 4 * fq), vbf[ks], o1[ti], 0, 0, 0);
            }
        }
        fsum += last;
        const float mnew = last + M63;
        __syncthreads();
        if (tid < 128) NV[tid] = nreg;
        if (PASS == 2) {
#pragma unroll
            for (int ti = 0; ti < 4; ++ti)
#pragma unroll
                for (int r = 0; r < 4; ++r) {
                    const int t = 16 * ti + 4 * fq + r;
                    OB[t * OBL + 16 * wave + fr] = o1[ti][r] + __expf(mprev - fmaxf(PM[t], mprev)) * o2[ti][r];
                }
            __syncthreads();
            const int t = tid >> 3, seg = tid & 7;
            const float Mt = fmaxf(PM[t], mprev);
            const float wi = __expf(mprev - Mt);
            const float den = DENP[t * 2] + DENP[t * 2 + 1] + wi * DINT[t];
            const float hd = __builtin_amdgcn_rcpf(fmaxf(fabsf(den), __expf(-(CUM[t] + Mt))));
            const u32x4 g0 = ocur.a, g1 = ocur.b;
            const unsigned gw[8] = {g0[0], g0[1], g0[2], g0[3], g1[0], g1[1], g1[2], g1[3]};
            unsigned yw[8];
#pragma unroll
            for (int q = 0; q < 4; ++q) {
                const f32x4 a = *(const LAS f32x4*)(OB + t * OBL + seg * 16 + 4 * q);
                yw[2 * q] = pk2(a.x * hd * sigm(bflo(gw[2 * q])), a.y * hd * sigm(bfhi(gw[2 * q])));
                yw[2 * q + 1] = pk2(a.z * hd * sigm(bflo(gw[2 * q + 1])), a.w * hd * sigm(bfhi(gw[2 * q + 1])));
            }
            u32x4 y0, y1;
            y0[0] = yw[0]; y0[1] = yw[1]; y0[2] = yw[2]; y0[3] = yw[3]; y1[0] = yw[4]; y1[1] = yw[5]; y1[2] = yw[6]; y1[3] = yw[7];
            bf16_t* yp = Y + (size_t)(tr0 + t) * D + 1536 + h * 128 + seg * 16;
            *(u32x4*)yp = y0; *(u32x4*)(yp + 8) = y1;
        }
        mprev = mnew;
        __syncthreads();
    }
#undef MLSTM_FETCH
    if (PASS == 1) {
        float* sb = STB + (size_t)(chain * 8 + g) * ST_STRIDE;
        state_store(acc, sb, wave, lane);
        if (tid < 128) sb[16384 + tid] = nreg;
        if (tid == 0) { sb[16384 + 128] = mprev; sb[16384 + 129] = fsum; }
    }
}
}

namespace mk {
#define XB_TMO      128
#define XB_XCNT(j)  (256  + 64 * (j))
#define XB_XSUB(j)  (1280 + 64 * (j))
#define XB_XGEN(j)  (2304 + 64 * (j))
#define XB_TOP      3328
#define XB_TOPGEN   3392
#define XCD_BAR_WORDS 3456
#define XB_SPIN_CAP (1u << 18)

__device__ __forceinline__ unsigned xb_ld(unsigned* p)              { return __hip_atomic_load(p, __ATOMIC_RELAXED, __HIP_MEMORY_SCOPE_AGENT); }
__device__ __forceinline__ unsigned xb_add(unsigned* p, unsigned v) { return __hip_atomic_fetch_add(p, v, __ATOMIC_RELAXED, __HIP_MEMORY_SCOPE_AGENT); }
__device__ __forceinline__ unsigned xb_xcc_id() { return (unsigned)__builtin_amdgcn_s_getreg((3 << 11) | 20) & 0xFu; }
#define XB_SPIN(cond, bar) do { unsigned _sp = 0; while (cond) { __builtin_amdgcn_s_sleep(1); \
    if ((++_sp & 255u) == 0u) { if (xb_ld(&(bar)[XB_TMO])) break; if (_sp > XB_SPIN_CAP) { atomicAdd(&(bar)[XB_TMO], 1u); break; } } } } while (0)

struct XcdBarrier {
    unsigned* bar; unsigned x;
    volatile LAS unsigned* st;
};

__device__ __forceinline__ XcdBarrier xcd_barrier_post(unsigned* bar, volatile LAS unsigned* st) {
    XcdBarrier b; b.bar = bar; b.x = xb_xcc_id(); b.st = st;
    if (threadIdx.x == 0) (void)xb_add(&bar[XB_XCNT(b.x)], 1u);
    return b;
}
__device__ __forceinline__ void xcd_barrier_complete(unsigned* bar, unsigned x, unsigned& nloc, unsigned& nx) {
    const unsigned G = gridDim.x * gridDim.y * gridDim.z;
    unsigned sum, cnt, mine, sp = 0u;
    for (;;) {
        sum = 0u; cnt = 0u; mine = 0u;
#pragma unroll
        for (unsigned j = 0; j < 16; ++j) { const unsigned c = xb_ld(&bar[XB_XCNT(j)]); sum += c; cnt += (c > 0u) ? 1u : 0u; mine = (j == x) ? c : mine; }
        if (sum == G) break;
        __builtin_amdgcn_s_sleep(1);
        if ((++sp & 255u) == 0u) { if (xb_ld(&bar[XB_TMO])) break; if (sp > XB_SPIN_CAP) { atomicAdd(&bar[XB_TMO], 1u); break; } }
    }
    nloc = mine > 0u ? mine : 1u; nx = cnt > 0u ? cnt : 1u;
}

__device__ __forceinline__ void xcd_barrier(const XcdBarrier& b) {
    asm volatile("s_waitcnt vmcnt(0)" ::: "memory");
    __syncthreads();
    if (threadIdx.x == 0) {
        unsigned* bar = b.bar;
        __builtin_amdgcn_s_waitcnt(0);
        unsigned nloc = b.st[0], nx = b.st[1];
        if (nloc == 0u) { xcd_barrier_complete(bar, b.x, nloc, nx); b.st[0] = nloc; b.st[1] = nx; }
        const unsigned old = xb_add(&bar[XB_XSUB(b.x)], 1u);
        const unsigned gen = old / nloc;
        if (old + 1u == (gen + 1u) * nloc) {
            __builtin_amdgcn_fence(__ATOMIC_RELEASE, "agent");
            asm volatile("s_waitcnt vmcnt(0)" ::: "memory");
            const unsigned og = xb_add(&bar[XB_TOP], 1u);
            const unsigned tg = og / nx;
            if (og + 1u == (tg + 1u) * nx) xb_add(&bar[XB_TOPGEN], 1u);
            else XB_SPIN(xb_ld(&bar[XB_TOPGEN]) == tg, bar);
            __builtin_amdgcn_fence(__ATOMIC_ACQUIRE, "agent");
            xb_add(&bar[XB_XGEN(b.x)], 1u);
            asm volatile("s_waitcnt vmcnt(0)" ::: "memory");
        } else {
            XB_SPIN(xb_ld(&bar[XB_XGEN(b.x)]) == gen, bar);
            __builtin_amdgcn_fence(__ATOMIC_ACQUIRE, "agent");
            asm volatile("s_waitcnt vmcnt(0)" ::: "memory");
        }
    }
    __syncthreads();
}

}

namespace mk {
constexpr int NSLICE = 16, SLW = 128, TBLK = 128, NTB = T / TBLK;
constexpr int CTL_Q = 3584;

__device__ __forceinline__ f32x2 fma2(f32x2 a, f32x2 b, f32x2 c) { return __builtin_elementwise_fma(a, b, c); }

__device__ __forceinline__ int q_next(unsigned* cnt, LAS int* slot, int tid) {
    __syncthreads();
    if (tid == 0) *slot = (int)__hip_atomic_fetch_add(cnt, 1u, __ATOMIC_RELAXED, __HIP_MEMORY_SCOPE_AGENT);
    __syncthreads();
    const int v = *slot;
    return v < NTB ? v : -1;
}

typedef __amdgpu_buffer_rsrc_t rsrc_t;
__device__ __forceinline__ rsrc_t make_rsrc(const void* p, unsigned bytes) { return __builtin_amdgcn_make_buffer_rsrc((void*)p, 0, bytes, 0x00020000); }

constexpr int PL_IDX = 0, PL_AUX = TBLK * 128 * 4;
#define PEER_ISSUE(W, IDP) do { const LAS u32x4* ip_ = (const LAS u32x4*)(IDP); const u32x4 i0_ = ip_[0], i1_ = ip_[1], i2_ = ip_[2], i3_ = ip_[3]; \
        _Pragma("unroll") for (int k = 0; k < 4; ++k) { \
            W[k]      = __builtin_amdgcn_raw_buffer_load_b128(rs, (int)i0_[k] * SLW + c * 16, soff, 0); \
            W[4 + k]  = __builtin_amdgcn_raw_buffer_load_b128(rs, (int)i1_[k] * SLW + c * 16, soff, 0); \
            W[8 + k]  = __builtin_amdgcn_raw_buffer_load_b128(rs, (int)i2_[k] * SLW + c * 16, soff, 0); \
            W[12 + k] = __builtin_amdgcn_raw_buffer_load_b128(rs, (int)i3_[k] * SLW + c * 16, soff, 0); } } while (0)
constexpr float XS8 = 1.f;
typedef _Float16 h2_t __attribute__((ext_vector_type(2)));
template <int CTRL> __device__ __forceinline__ int dppi(int x) { return __builtin_amdgcn_mov_dpp(x, CTRL, 0xf, 0xf, true); }
template <int MODE>
__device__ __forceinline__ void u_compute(u32x4 (&w)[16], const LAS unsigned* xs, float* __restrict__ PART, int s, int t, int g, int c) {
    if (MODE == 1) { _Pragma("unroll") for (int k = 0; k < 16; ++k) asm volatile("" :: "v"(w[k])); return; }
    if (MODE == 2) { _Pragma("unroll") for (int k = 0; k < 16; ++k) asm volatile("" : "=v"(w[k])); }
    const u32x4 xi = *(const LAS u32x4*)xs;
    int r0 = 0, r1 = 0;
#pragma unroll
    for (int k = 0; k < 16; ++k) {
        int d = __builtin_amdgcn_sdot4((int)w[k][0], (int)xi[0], 0, false);
        d = __builtin_amdgcn_sdot4((int)w[k][1], (int)xi[1], d, false);
        d = __builtin_amdgcn_sdot4((int)w[k][2], (int)xi[2], d, false);
        d = __builtin_amdgcn_sdot4((int)w[k][3], (int)xi[3], d, false);
        d += dppi<DPP_XOR1>(d); d += dppi<DPP_XOR2>(d); d += dppi<DPP_HMIR>(d);
        if ((k >> 1) == c) { if (k & 1) r1 = d; else r0 = d; }
    }
    if (MODE == 2) { asm volatile("" :: "v"(r0), "v"(r1)); return; }
    ((unsigned*)PART)[((size_t)s * T + t) * 64 + 8 * g + c] = pk2((float)r0, (float)r1);
}
struct UStage { u32x4 id[8]; u32x4 x[4]; float am[4]; };
__device__ __forceinline__ void u_stage_load(UStage& r, int s, int tb, const bf16_t* __restrict__ XB, const int* __restrict__ IDX, const float* __restrict__ AMXP, int tid) {
    const u32x4* src = (const u32x4*)(IDX + (size_t)tb * TBLK * 128);
#pragma unroll
    for (int j = 0; j < 8; ++j) r.id[j] = src[tid + j * NTHR];
#pragma unroll
    for (int j = 0; j < 4; ++j) { const int e = tid + j * NTHR, tt = e >> 4, ch = e & 15; r.x[j] = *(const u32x4*)(XB + (size_t)(tb * TBLK + tt) * D + s * SLW + ch * 8);
        const float* ap = AMXP + (size_t)(tb * TBLK + tt) * 32 + 2 * ch; r.am[j] = fmaxf(ap[0], ap[1]); }
}
__device__ __forceinline__ void u_stage_store(const UStage& r, LAS unsigned char* lds, int tid) {
#pragma unroll
    for (int j = 0; j < 8; ++j) *(LAS u32x4*)(lds + PL_IDX + (size_t)(tid + j * NTHR) * 16) = r.id[j];
#pragma unroll
    for (int j = 0; j < 4; ++j) { const int e = tid + j * NTHR, tt = e >> 4, ch = e & 15;
        float am = r.am[j];
        am = fmaxf(am, dppf<DPP_XOR1>(am)); am = fmaxf(am, dppf<DPP_XOR2>(am)); am = fmaxf(am, dppf<DPP_HMIR>(am)); am = fmaxf(am, dppf<DPP_ROR8>(am));
        const float xs = am > 0.f ? 127.f * __builtin_amdgcn_rcpf(am) : 0.f;
        int lo, hi;
        lo = (__float2int_rn(bflo(r.x[j][0]) * xs) & 0xff) | ((__float2int_rn(bfhi(r.x[j][0]) * xs) & 0xff) << 8) | ((__float2int_rn(bflo(r.x[j][1]) * xs) & 0xff) << 16) | (__float2int_rn(bfhi(r.x[j][1]) * xs) << 24);
        hi = (__float2int_rn(bflo(r.x[j][2]) * xs) & 0xff) | ((__float2int_rn(bfhi(r.x[j][2]) * xs) & 0xff) << 8) | ((__float2int_rn(bflo(r.x[j][3]) * xs) & 0xff) << 16) | (__float2int_rn(bfhi(r.x[j][3]) * xs) << 24);
        u32x2 o; o.x = (unsigned)lo; o.y = (unsigned)hi;
        *(LAS u32x2*)(lds + PL_AUX + tt * 128 + ch * 8) = o; }
}
template <int MODE>
__device__ __forceinline__ void peer_u_run(int s, int tb, const unsigned char* __restrict__ U8, float* __restrict__ PART, LAS unsigned char* lds, int wave, int lane) {
    const int g = lane >> 3, c = lane & 7;
    const rsrc_t rs = make_rsrc(U8, (unsigned)((size_t)NE * D));
    const int soff = s * NE * SLW;
    constexpr int NTW = TBLK / NWAVES;
    const int tw = wave * NTW, t0 = tb * TBLK + tw;
    const LAS unsigned char* idb = lds + PL_IDX + (size_t)tw * 512 + g * 64;
    const LAS unsigned* xsb = (const LAS unsigned*)(lds + PL_AUX + (size_t)tw * 128) + c * 4;
    u32x4 wa[16], wb[16];
    if (MODE != 2) PEER_ISSUE(wa, idb);
#pragma unroll 1
    for (int i = 0; i < NTW; i += 2) {
        if (MODE != 2) PEER_ISSUE(wb, idb + (i + 1) * 512);
        u_compute<MODE>(wa, xsb + i * 32, PART, s, t0 + i, g, c);
        if (MODE != 2) PEER_ISSUE(wa, idb + min(i + 2, NTW - 1) * 512);
        u_compute<MODE>(wb, xsb + (i + 1) * 32, PART, s, t0 + i + 1, g, c);
    }
}
template <int MODE>
__device__ __forceinline__ void peer_u_block(int s, int tb, const bf16_t* __restrict__ XB, const int* __restrict__ IDX, const float* __restrict__ AMXP, const unsigned char* __restrict__ U8,
                                             float* __restrict__ PART, LAS unsigned char* lds, int tid, int wave, int lane) {
    UStage r; u_stage_load(r, s, tb, XB, IDX, AMXP, tid); u_stage_store(r, lds, tid);
    __syncthreads();
    peer_u_run<MODE>(s, tb, U8, PART, lds, wave, lane);
}

__device__ __forceinline__ void peer_act_token(int t, const float* __restrict__ PART, const float* __restrict__ ssp, const float* __restrict__ amxp, const int* __restrict__ IDX, const float* __restrict__ GATE,
                                               const f32x2* __restrict__ SC2, signed char* __restrict__ ACT, float* __restrict__ ASC, int lane) {
    float s0 = 0.f, s1 = 0.f;
    { unsigned w[NSLICE];
#pragma unroll
      for (int s = 0; s < NSLICE; ++s) w[s] = ((const unsigned*)PART)[((size_t)s * T + t) * 64 + lane];
#pragma unroll
      for (int s = 0; s < NSLICE; ++s) { s0 += bflo(w[s]); s1 += bfhi(w[s]); } }
    float sp = (lane < 32) ? ssp[(size_t)t * 32 + lane] : 0.f;
    sp = wsum(sp);
    float xam = (lane < 32) ? amxp[(size_t)t * 32 + lane] : 0.f;
    xam = wmax(xam);
    const float rs1 = rsqrtf(sp * (1.f / D) + EPS) * (xam * (1.f / 127.f));
    const u32x2 id = *(const u32x2*)(IDX + (size_t)t * 128 + 2 * lane);
    const f32x2 gt = *(const f32x2*)(GATE + (size_t)t * 128 + 2 * lane);
    const f32x2 c0 = SC2[id.x], c1 = SC2[id.y];
    const float a0 = gelu_erf(s0 * c0.x * rs1) * gt.x * c0.y;
    const float a1 = gelu_erf(s1 * c1.x * rs1) * gt.y * c1.y;
    const float am = wmax(fmaxf(fabsf(a0), fabsf(a1)));
    const float qs = am > 0.f ? 127.f * __builtin_amdgcn_rcpf(am) : 0.f;
    const unsigned short pk = (unsigned short)((__float2int_rn(a0 * qs) & 0xff) | ((__float2int_rn(a1 * qs) & 0xff) << 8));
    *(unsigned short*)(ACT + (size_t)t * 128 + 2 * lane) = pk;
    if (lane == 0) ASC[t] = am * (1.f / 127.f);
}

__device__ __forceinline__ float wsum_fast(float v) {
    v += dppf<DPP_XOR1>(v); v += dppf<DPP_XOR2>(v); v += dppf<DPP_HMIR>(v); v += dppf<DPP_ROR8>(v);
    { const auto s = __builtin_amdgcn_permlane16_swap(__float_as_uint(v), __float_as_uint(v), false, false); v = __uint_as_float(s[0]) + __uint_as_float(s[1]); }
    { const auto s = __builtin_amdgcn_permlane32_swap(__float_as_uint(v), __float_as_uint(v), false, false); v = __uint_as_float(s[0]) + __uint_as_float(s[1]); }
    return v;
}
__device__ __forceinline__ void tr4x4(unsigned d0, unsigned d1, unsigned d2, unsigned d3, unsigned (&t)[4]) {
    const unsigned x0 = __builtin_amdgcn_perm(d1, d0, 0x05010400u), x1 = __builtin_amdgcn_perm(d1, d0, 0x07030602u);
    const unsigned y0 = __builtin_amdgcn_perm(d3, d2, 0x05010400u), y1 = __builtin_amdgcn_perm(d3, d2, 0x07030602u);
    t[0] = __builtin_amdgcn_perm(y0, x0, 0x05040100u); t[1] = __builtin_amdgcn_perm(y0, x0, 0x07060302u);
    t[2] = __builtin_amdgcn_perm(y1, x1, 0x05040100u); t[3] = __builtin_amdgcn_perm(y1, x1, 0x07060302u);
}
template <int VMODE>
__device__ __forceinline__ void v_compute(u32x4 (&w)[16], const LAS unsigned* avp, float ascale, unsigned rw, bf16_t* __restrict__ XBio, float* __restrict__ OUT32,
                                          float* __restrict__ SS16, int s, int t, int g, int c, int lane) {
    const size_t off = (size_t)t * D + s * SLW + c * 16 + 2 * g;
    const f32x2 res = {bflo(rw), bfhi(rw)};
    const u32x4 a4 = *(const LAS u32x4*)avp;
    int acci[16];
#pragma unroll
    for (int i = 0; i < 16; ++i) acci[i] = 0;
#pragma unroll
    for (int k4 = 0; k4 < 4; ++k4)
#pragma unroll
        for (int q = 0; q < 4; ++q) {
            unsigned tt[4];
            tr4x4(w[4 * k4][q], w[4 * k4 + 1][q], w[4 * k4 + 2][q], w[4 * k4 + 3][q], tt);
#pragma unroll
            for (int j = 0; j < 4; ++j) acci[4 * q + j] = __builtin_amdgcn_sdot4((int)tt[j], (int)a4[k4], acci[4 * q + j], false);
        }
    int h4x[4], h4y[4];
#pragma unroll
    for (int q = 0; q < 4; ++q) {
        const auto sx = __builtin_amdgcn_permlane32_swap((unsigned)acci[2 * q], (unsigned)acci[2 * (4 + q)], false, false);
        const auto sy = __builtin_amdgcn_permlane32_swap((unsigned)acci[2 * q + 1], (unsigned)acci[2 * (4 + q) + 1], false, false);
        h4x[q] = (int)sx[0] + (int)sx[1]; h4y[q] = (int)sy[0] + (int)sy[1];
    }
    int h2x[2], h2y[2];
#pragma unroll
    for (int q = 0; q < 2; ++q) {
        const auto sx = __builtin_amdgcn_permlane16_swap((unsigned)h4x[q], (unsigned)h4x[2 + q], false, false);
        const auto sy = __builtin_amdgcn_permlane16_swap((unsigned)h4y[q], (unsigned)h4y[2 + q], false, false);
        h2x[q] = (int)sx[0] + (int)sx[1]; h2y[q] = (int)sy[0] + (int)sy[1];
    }
    const bool up = (g & 1) != 0;
    const int keepx = up ? h2x[1] : h2x[0], sendx = up ? h2x[0] : h2x[1], keepy = up ? h2y[1] : h2y[0], sendy = up ? h2y[0] : h2y[1];
    const int ix = keepx + dppi<DPP_ROR8>(sendx), iy = keepy + dppi<DPP_ROR8>(sendy);
    f32x2 o = {(float)ix * ascale + res.x, (float)iy * ascale + res.y};
    if (OUT32) *(f32x2*)(OUT32 + off) = o;
    else { const unsigned ow = pk2(o.x, o.y); *(unsigned*)(XBio + off) = ow; o = (f32x2){bflo(ow), bfhi(ow)}; }
    const float q2 = wsum_fast(o.x * o.x + o.y * o.y);
    if (lane == 0) SS16[(size_t)t * 16 + s] = q2;
}
constexpr int PLV_ACT = TBLK * 128 * 4;
constexpr int PLV_ASC = PLV_ACT + TBLK * 128;
struct VStage { u32x4 id[8]; u32x4 a[2]; float asc; };
__device__ __forceinline__ void v_stage_load(VStage& r, int tb, const signed char* __restrict__ ACT, const float* __restrict__ ASC, const int* __restrict__ IDX, int tid) {
    const u32x4* src = (const u32x4*)(IDX + (size_t)tb * TBLK * 128);
#pragma unroll
    for (int j = 0; j < 8; ++j) r.id[j] = src[tid + j * NTHR];
    const u32x4* srca = (const u32x4*)(ACT + (size_t)tb * TBLK * 128);
    r.a[0] = srca[tid]; r.a[1] = srca[tid + NTHR];
    r.asc = (tid < TBLK) ? ASC[(size_t)tb * TBLK + tid] : 0.f;
}
__device__ __forceinline__ void v_stage_store(const VStage& r, LAS unsigned char* lds, int tid) {
#pragma unroll
    for (int j = 0; j < 8; ++j) *(LAS u32x4*)(lds + PL_IDX + (size_t)(tid + j * NTHR) * 16) = r.id[j];
    *(LAS u32x4*)(lds + PLV_ACT + (size_t)tid * 16) = r.a[0]; *(LAS u32x4*)(lds + PLV_ACT + (size_t)(tid + NTHR) * 16) = r.a[1];
    if (tid < TBLK) *(LAS float*)(lds + PLV_ASC + tid * 4) = r.asc;
}
template <int VMODE>
__device__ __forceinline__ void peer_v_run(int s, int tb, const unsigned char* __restrict__ V8, bf16_t* __restrict__ XBio, float* __restrict__ OUT32, float* __restrict__ SS16,
                                           LAS unsigned char* lds, int wave, int lane) {
    const int g = lane >> 3, c = lane & 7;
    const rsrc_t rs = make_rsrc(V8, (unsigned)((size_t)NE * D));
    const int soff = s * NE * SLW;
    constexpr int NTW = TBLK / NWAVES;
    const int tw = wave * NTW, t0 = tb * TBLK + tw;
    const LAS unsigned char* idb = lds + PL_IDX + (size_t)tw * 512 + g * 64;
    const LAS unsigned* avb = (const LAS unsigned*)(lds + PLV_ACT + (size_t)tw * 128) + g * 4;
    const LAS float* ascb = (const LAS float*)(lds + PLV_ASC) + tw;
    const bf16_t* rbase = XBio + (size_t)t0 * D + s * SLW + c * 16 + 2 * g;
    u32x4 wa[16], wb[16];
    unsigned ra = *(const unsigned*)rbase, rb;
    PEER_ISSUE(wa, idb);
#pragma unroll 1
    for (int i = 0; i < NTW; i += 2) {
        rb = *(const unsigned*)(rbase + (size_t)(i + 1) * D);
        PEER_ISSUE(wb, idb + (i + 1) * 512);
        v_compute<VMODE>(wa, avb + i * 32, ascb[i], ra, XBio, OUT32, SS16, s, t0 + i, g, c, lane);
        ra = *(const unsigned*)(rbase + (size_t)min(i + 2, NTW - 1) * D);
        PEER_ISSUE(wa, idb + min(i + 2, NTW - 1) * 512);
        v_compute<VMODE>(wb, avb + (i + 1) * 32, ascb[i + 1], rb, XBio, OUT32, SS16, s, t0 + i + 1, g, c, lane);
    }
}
__device__ __forceinline__ void peer_v_block(int s, int tb, const signed char* __restrict__ ACT, const float* __restrict__ ASC, const int* __restrict__ IDX, const unsigned char* __restrict__ V8,
                                             bf16_t* __restrict__ XBio, float* __restrict__ OUT32, float* __restrict__ SS16,
                                             LAS unsigned char* lds, int tid, int wave, int lane) {
    VStage r; v_stage_load(r, tb, ACT, ASC, IDX, tid); v_stage_store(r, lds, tid);
    __syncthreads();
    peer_v_run<0>(s, tb, V8, XBio, OUT32, SS16, lds, wave, lane);
}

__device__ __forceinline__ int slice_of(int xcc, int j) { const int xx = (xcc + (j >> 1)) & 7; return xx + 8 * (j & 1); }

__device__ __forceinline__ void final_norm_row(const bf16_t* __restrict__ xrow, float* __restrict__ orow, const float* __restrict__ ss16, const float* __restrict__ g, int lane) {
    float sp = (lane < 16) ? ss16[lane] : 0.f;
    sp = wsum(sp);
    const float rf = rsqrtf(sp * (1.f / D) + EPS);
    const u32x2* xi = (const u32x2*)xrow + lane;
    f32x4* o = (f32x4*)orow + lane;
    const f32x4* g4 = (const f32x4*)g + lane;
    u32x2 xv[8];
#pragma unroll
    for (int j = 0; j < 8; ++j) xv[j] = xi[64 * j];
#pragma unroll
    for (int j = 0; j < 8; ++j) { const f32x4 gg = g4[64 * j]; f32x4 v = {bflo(xv[j].x), bfhi(xv[j].x), bflo(xv[j].y), bfhi(xv[j].y)}; v = v * rf * gg; o[64 * j] = v; }
}
}

namespace mk {
#define IN(k) (lo <= (k) && (k) < hi)
#define GSYNC() do { if (coop) xcd_barrier(xb); } while (0)
template <int l>
__device__ __forceinline__ void layer_body(const Params& p, LAS unsigned char* lds, unsigned char* ws, int G, int tid, int lane, int wave, int lo, int hi, bool coop, const XcdBarrier& xb) {

    if (IN(1)) _Pragma("unroll") for (int rep = 0; rep < REP1; ++rep) {
        const int nh = (G == 256) ? NHELP : 0, Gg = G - nh;
        if ((int)blockIdx.x < Gg) {
            pg8::Gemm g{(const bf16_t*)(ws + WS_XB), (const bf16_t*)(ws + WS_WINT) + (size_t)l * NP * D, T, NP, D};
            pg8::StaticOrder So; So.init(T, NP, Gg, (int)blockIdx.x);
            EpiScaleBf16<16> E{(bf16_t*)(ws + WS_P), NP, (const float*)(ws + WS_SS)};
            pg8::gemm_phase<EpiScaleBf16<16>, pg8::StaticOrder, true, true>(lds, g, So, E);
        } else {
            tables_convert(p, l, 0, HROWS, ((int)blockIdx.x - Gg) * NWAVES + wave, nh * NWAVES, lane);
        }
        GSYNC();
    }
    if (IN(2)) _Pragma("unroll") for (int rep = 0; rep < REP2; ++rep) {
        for (int u = blockIdx.x; u < 256; u += G) {
            int tq_ = tid; asm volatile("" : "+v"(tq_)); const int tid = tq_, lane = tq_ & 63, wave = __builtin_amdgcn_readfirstlane(tq_ >> 6);
            if (u < 128) hgrn_unit<1>((const bf16_t*)(ws + WS_P), p.in[5], l, nullptr, (float*)(ws + WS_STH), nullptr, u, lds, tid, lane, wave);
            else mlstm_unit<1>((const bf16_t*)(ws + WS_P), p.in[7] + (size_t)l * 4 * 1024, p.in[8] + l * 4, p.in[9] + l * 4, (float*)(ws + WS_STM), nullptr, u - 128, lds, tid, lane, wave);
            __syncthreads();
        }
        GSYNC();
    }
    if (IN(3)) {
        _Pragma("unroll") for (int rep = 0; rep < REP4; ++rep)
        for (int u = blockIdx.x; u < 256; u += G) {
            int tq_ = tid; asm volatile("" : "+v"(tq_)); const int tid = tq_, lane = tq_ & 63, wave = __builtin_amdgcn_readfirstlane(tq_ >> 6);
            if (u < 128) hgrn_unit<2>((const bf16_t*)(ws + WS_P), p.in[5], l, p.in[6] + l * 512, (float*)(ws + WS_STH), (bf16_t*)(ws + WS_YB), u, lds, tid, lane, wave);
            else mlstm_unit<2>((const bf16_t*)(ws + WS_P), p.in[7] + (size_t)l * 4 * 1024, p.in[8] + l * 4, p.in[9] + l * 4, (float*)(ws + WS_STM), (bf16_t*)(ws + WS_YB), u - 128, lds, tid, lane, wave);
            __syncthreads();
        }
        _Pragma("unroll") for (int rep = 0; rep < REP3; ++rep)
        for (int u = blockIdx.x; u < 256; u += G) {
            int tq_ = tid; asm volatile("" : "+v"(tq_)); const int tid = tq_, lane = tq_ & 63, wave = __builtin_amdgcn_readfirstlane(tq_ >> 6);
            attn_unit((const bf16_t*)(ws + WS_P), (const f32x2*)(ws + WS_ROPE), p.in[4] + l * 16, (bf16_t*)(ws + WS_YB), u, lds, tid, lane, wave);
            __syncthreads();
        }
        GSYNC();
    }
    if (IN(4)) {
        pg8::Gemm g{(const bf16_t*)(ws + WS_YB), (const bf16_t*)(ws + WS_WOUTT) + (size_t)l * D * D, T, D, D};
        pg8::StaticOrder So; So.init(T, D, G, (int)blockIdx.x);
        EpiX1 E{l == 0 ? p.in[0] : (const float*)nullptr, (bf16_t*)(ws + WS_XB), (float*)(ws + WS_SSP), (float*)(ws + WS_AMXP)};
        pg8::gemm_phase<EpiX1, pg8::StaticOrder, true, true>(lds, g, So, E);
        GSYNC();
    }
    if (IN(5)) _Pragma("unroll") for (int rep = 0; rep < REP5; ++rep) {
        pg8::Gemm g{(const bf16_t*)(ws + WS_XB), (const bf16_t*)(ws + WS_WQT) + (size_t)l * D * D, T, D, D};
        pg8::StaticOrder So; So.init(T, D, G, (int)blockIdx.x);
        EpiScaleBf16<32> E{(bf16_t*)(ws + WS_Q), D, (const float*)(ws + WS_SSP)};
        pg8::gemm_phase<EpiScaleBf16<32>, pg8::StaticOrder, true, true>(lds, g, So, E);
        pg8::Unit u;
        for (int i = 0; So.next(i, u); ++i)
            route_unit((const bf16_t*)(ws + WS_Q), (const bf16_t*)(ws + WS_SUBK) + (size_t)l * 2 * 8 * 128 * 128, u.pm, u.pn, (int*)(ws + WS_IDX), (int*)(ws + WS_IDXU), (float*)(ws + WS_GATE), lds, tid, wave, lane);
        GSYNC();
    }
    if (IN(6)) {

        LAS int* slot = (LAS int*)(lds + LDS_BYTES - 32);
        if (G == 256) {
            const int grp = (int)blockIdx.x & 7, rank = (int)blockIdx.x >> 3;
            _Pragma("unroll") for (int rr = 0; rr < REP6; ++rr) {
            UStage st; u_stage_load(st, grp, rank * 4, (const bf16_t*)(ws + WS_XB), (const int*)(ws + WS_IDX), (const float*)(ws + WS_AMXP), tid);
            for (int j = 0; j < 8; ++j) {
                const int s = grp + 8 * (j >> 2), tb = rank * 4 + (j & 3);
                __syncthreads();
                u_stage_store(st, lds, tid);
                __syncthreads();
                if (j < 7) u_stage_load(st, grp + 8 * ((j + 1) >> 2), rank * 4 + ((j + 1) & 3), (const bf16_t*)(ws + WS_XB), (const int*)(ws + WS_IDX), (const float*)(ws + WS_AMXP), tid);
                peer_u_run<0>(s, tb, ws + WS_U8 + (size_t)l * NE * D, (float*)(ws + WS_PART), lds, wave, lane);
            }
            }
        } else {
            const int xcc = (int)xb_xcc_id();
            unsigned* qc = (unsigned*)(ws + WS_CTL) + CTL_Q + ((l * 2 + 0) * 2 + 0) * 16;
            for (int j = 0; j < NSLICE; ++j) {
                const int s = slice_of(xcc, j);
                for (;;) {
                    const int tb = q_next(qc + s, slot, tid);
                    if (tb < 0) break;
                    peer_u_block<0>(s, tb, (const bf16_t*)(ws + WS_XB), (const int*)(ws + WS_IDX), (const float*)(ws + WS_AMXP), ws + WS_U8 + (size_t)l * NE * D, (float*)(ws + WS_PART), lds, tid, wave, lane);
                }
            }
        }
        GSYNC();
    }
    if (IN(7)) {

        const int gw = blockIdx.x * NWAVES + wave, ngw = G * NWAVES;
        _Pragma("unroll") for (int rep = 0; rep < REP7; ++rep)
        for (int t = gw; t < T; t += ngw)
            peer_act_token(t, (const float*)(ws + WS_PART), (const float*)(ws + WS_SSP), (const float*)(ws + WS_AMXP), (const int*)(ws + WS_IDX), (const float*)(ws + WS_GATE),
                           (const f32x2*)(ws + WS_USC) + l * NE, (signed char*)(ws + WS_ACT), (float*)(ws + WS_ASC), lane);
        GSYNC();
    }
    if (IN(8)) {

        LAS int* slot = (LAS int*)(lds + LDS_BYTES - 32);
        if (G == 256) {
            const int grp = (int)blockIdx.x & 7, rank = (int)blockIdx.x >> 3;
            {
            VStage st; v_stage_load(st, rank * 4, (const signed char*)(ws + WS_ACT), (const float*)(ws + WS_ASC), (const int*)(ws + WS_IDX), tid);
            for (int j = 0; j < 8; ++j) {
                const int s = grp + 8 * (j >> 2), tb = rank * 4 + (j & 3);
                __syncthreads();
                v_stage_store(st, lds, tid);
                __syncthreads();
                if (j < 7) v_stage_load(st, rank * 4 + ((j + 1) & 3), (const signed char*)(ws + WS_ACT), (const float*)(ws + WS_ASC), (const int*)(ws + WS_IDX), tid);
                peer_v_run<0>(s, tb, ws + WS_V8 + (size_t)l * NE * D, (bf16_t*)(ws + WS_XB), (float*)nullptr, (float*)(ws + WS_SS), lds, wave, lane);
            }
            }
        } else {
            const int xcc = (int)xb_xcc_id();
            unsigned* qc = (unsigned*)(ws + WS_CTL) + CTL_Q + ((l * 2 + 1) * 2 + 0) * 16;
            for (int j = 0; j < NSLICE; ++j) {
                const int s = slice_of(xcc, j);
                for (;;) {
                    const int tb = q_next(qc + s, slot, tid);
                    if (tb < 0) break;
                    peer_v_block(s, tb, (const signed char*)(ws + WS_ACT), (const float*)(ws + WS_ASC), (const int*)(ws + WS_IDX), ws + WS_V8 + (size_t)l * NE * D, (bf16_t*)(ws + WS_XB),
                                 (float*)nullptr, (float*)(ws + WS_SS), lds, tid, wave, lane);
                }
            }
        }
    }
    if (l == 1 && IN(9)) {
        GSYNC();
        const int gw = blockIdx.x * NWAVES + wave, ngw = G * NWAVES;
        for (int t = gw; t < T; t += ngw) final_norm_row((const bf16_t*)(ws + WS_XB) + (size_t)t * D, p.out + (size_t)t * D, (const float*)(ws + WS_SS) + (size_t)t * 16, p.in[15], lane);
    }
}
__global__ void __launch_bounds__(NTHR, 2) mega(Params p) {
    extern __shared__ __attribute__((aligned(16))) unsigned char lds_raw[];
    LAS unsigned char* lds = (LAS unsigned char*)lds_raw;
    unsigned char* ws = p.ws;
    const int G = gridDim.x;
    const int tid = threadIdx.x, lane = tid & 63, wave = __builtin_amdgcn_readfirstlane(tid >> 6);
    const int lo = p.ph_lo, hi = p.ph_hi;
    const bool coop = p.pad != 0;
    volatile LAS unsigned* xst = (volatile LAS unsigned*)(lds + LDS_BYTES - 16);
    if (tid < 4) xst[tid] = 0u;
    __syncthreads();
    XcdBarrier xb; xb.bar = (unsigned*)(ws + WS_CTL); xb.x = 0; xb.st = xst;
    if (coop) xb = xcd_barrier_post((unsigned*)(ws + WS_CTL), xst);
    if (IN(0)) { const int hm = (G == 256 && NHELP > 0) ? 0x100 : 0; p0_prologue(p, lds, 0xff | hm); if (REP0 > 1) { if (coop) xcd_barrier(xb); p0_prologue(p, lds, REP0 | hm); } if (coop) cooperative_groups::this_grid().sync(); }
    if (p.layer <= 0 && 0 < p.layer_hi) { layer_body<0>(p, lds, ws, G, tid, lane, wave, lo, hi, coop, xb); if (1 < p.layer_hi) GSYNC(); }
    if (p.layer <= 1 && 1 < p.layer_hi) layer_body<1>(p, lds, ws, G, tid, lane, wave, lo, hi, coop, xb);

#undef IN
#undef GSYNC
}
__global__ __launch_bounds__(256) void shim_xprep_kernel(const float* __restrict__ X, bf16_t* __restrict__ XB, float* __restrict__ SS) {
    const int t = blockIdx.x * 4 + (threadIdx.x >> 6), lane = threadIdx.x & 63;
    xprep_row(X + (size_t)t * D, XB + (size_t)t * D, SS + t, lane);
}
}

extern "C" void kernel_launch(void* const* d_in, const int* in_sizes, int n_in, void* d_out, int out_size, void* d_ws, size_t ws_size, hipStream_t stream) {
    using namespace mk;
    static int grid = 0;
    if (grid == 0) {
        int dev = 0, cus = 0, per_cu = 0;
        (void)hipGetDevice(&dev); (void)hipDeviceGetAttribute(&cus, hipDeviceAttributeMultiprocessorCount, dev);
        if (hipFuncSetAttribute((const void*)mega, hipFuncAttributeMaxDynamicSharedMemorySize, LDS_BYTES) != hipSuccess) { fprintf(stderr, "kernel_launch: hipFuncSetAttribute failed\n"); grid = -1; return; }
        if (ws_size < WS_END) { fprintf(stderr, "kernel_launch: workspace too small: need %zu have %zu\n", (size_t)WS_END, ws_size); grid = -1; return; }
        if (hipOccupancyMaxActiveBlocksPerMultiprocessor(&per_cu, (const void*)mega, NTHR, LDS_BYTES) != hipSuccess || per_cu < 1) { fprintf(stderr, "kernel_launch: occupancy query says %d blocks per CU\n", per_cu); grid = -1; return; }
        grid = cus;
    }
    if (grid < 0) return;
    Params p{};
    for (int i = 0; i < 16; ++i) p.in[i] = (const float*)d_in[i];
    p.out = (float*)d_out; p.ws = (unsigned char*)d_ws;
    p.ph_lo = 0; p.ph_hi = 10; p.layer = 0; p.layer_hi = 2; p.pad = 1; p.pad2 = 0;
    if (hipMemsetAsync(d_ws, 0, 16384, stream) != hipSuccess) { fprintf(stderr, "kernel_launch: memset failed\n"); return; }
    void* args[] = {&p};
    hipError_t e = hipLaunchCooperativeKernel((const void*)mega, dim3(grid), dim3(NTHR), args, LDS_BYTES, stream);
    if (e != hipSuccess) fprintf(stderr, "kernel_launch: cooperative launch failed: %s (grid %d)\n", hipGetErrorString(e), grid);
}
```

```cpp
#include <hip/hip_runtime.h>
#include <hip/hip_cooperative_groups.h>
#include <math.h>
#include <stdio.h>
#include <stdint.h>
namespace pg8 {
#define PG8_LAS __attribute__((address_space(3)))
typedef unsigned short bf16_t;
typedef short bf16x8 __attribute__((ext_vector_type(8)));
typedef float f32x4 __attribute__((ext_vector_type(4)));
typedef unsigned u32x4 __attribute__((ext_vector_type(4)));
constexpr int BM = 256, BK = 64, HALF = 128, HTB = HALF * BK * 2  , STAGE_BYTES = 8 * HTB, NXCD = 8, WGM = 8;

__host__ __device__ __forceinline__ int lds_byte(int r, int c) { const int st = (r >> 4) * 2 + (c >> 5), rr = r & 15, cc = c & 31, ob = rr * 64 + cc * 2; return st * 1024 + (ob ^ (((ob >> 9) & 1) << 5)); }
__host__ __device__ __forceinline__ void stage_rc(int b, int& R, int& C) { const int st = b / 1024, sb = b % 1024, swz = sb ^ (((sb >> 9) & 1) << 5); R = (st >> 1) * 16 + swz / 64; C = (st & 1) * 32 + (swz % 64) / 2; }
__host__ __device__ __forceinline__ int perm32(int rho) { const int n = rho >> 4, i = rho & 15; return 8 * (i >> 2) + 4 * n + (i & 3); }

struct Unit { int pm, pn; };
struct Gemm { const bf16_t* A; const bf16_t* Bt; int M, N, K; };

struct StaticOrder {
    int nM, nN, nwg, G, c;
    __host__ __device__ void init(int M, int N, int G_, int c_) { nM = M / BM; nN = N / BM; nwg = nM * nN; G = G_; c = c_; }
    __host__ __device__ bool next(int i, Unit& u) const {
        const long L = (long)i * G + c; if (L >= nwg) return false;
        int wgid = (int)L; { const int q = nwg / NXCD, r = nwg % NXCD, xcd = wgid % NXCD, off = wgid / NXCD; wgid = (xcd < r ? xcd * (q + 1) : r * (q + 1) + (xcd - r) * q) + off; }
        const int nig = WGM * nN, gid = wgid / nig, fm = gid * WGM, gsz = (nM - fm) < WGM ? (nM - fm) : WGM;
        u.pm = fm + ((wgid % nig) % gsz); u.pn = (wgid % nig) / gsz; return true;
    }
    __device__ __forceinline__ void a_ready(const Unit&) const {}
    __device__ __forceinline__ void done(const Unit&) const {}
};

template <class Epi, class Sched, bool ALIGN_EPI = false, bool SP2 = false>
__device__ __forceinline__ void gemm_phase(PG8_LAS unsigned char* lds, const Gemm g, const Sched& S, const Epi& E) {
    const int tid = threadIdx.x, wid = __builtin_amdgcn_readfirstlane(tid >> 6), lane = tid & 63, wr = wid >> 2, wc = wid & 3, fr = lane & 15, fq = lane >> 4;
    const int K = g.K, nt = K / BK;
    unsigned voffA[2], voffB[2];
#pragma unroll
    for (int i = 0; i < 2; ++i) { int R, C; stage_rc(tid * 16 + i * 8192, R, C); const int Rb = Epi::PERM ? ((R & ~31) + perm32(R & 31)) : R;
        voffA[i] = (unsigned)(R * K + C) * 2u; voffB[i] = (unsigned)(Rb * K + C) * 2u; }
    const size_t kstep = (size_t)(BK * 2);
    const size_t hstep = (size_t)HALF * K * 2;
    const size_t tstep = 2 * hstep;
    const unsigned ldsw = (unsigned)wid * 1024u;
    const int aoff = lds_byte(wr * 64 + fr, fq * 8), boff = lds_byte(wc * 32 + fr, fq * 8);
#define PG8_SA(b, h) (((b) * 2 + (h)) * HTB)
#define PG8_SB(b, h) ((4 + (b) * 2 + (h)) * HTB)
#define PG8_STAGE(bufoff, gbase, voff) do { _Pragma("unroll") for (int _i = 0; _i < 2; ++_i) \
        __builtin_amdgcn_global_load_lds((const unsigned*)((const char*)(gbase) + (voff)[_i]), (PG8_LAS unsigned*)(lds + (bufoff) + ldsw + _i * 8192), 16, 0, 0); } while (0)
#define PG8_LDA(dst, b, h) do { _Pragma("unroll") for (int m = 0; m < 4; ++m) _Pragma("unroll") for (int k = 0; k < 2; ++k) dst[m][k] = *(const PG8_LAS bf16x8*)(lds + PG8_SA(b, h) + aoff + m * 2048 + k * 1024); } while (0)
#define PG8_LDB(dst, b, h) do { _Pragma("unroll") for (int n = 0; n < 2; ++n) _Pragma("unroll") for (int k = 0; k < 2; ++k) dst[n][k] = *(const PG8_LAS bf16x8*)(lds + PG8_SB(b, h) + boff + n * 2048 + k * 1024); } while (0)
#define PG8_MMA(ai, bj, At, Bt) do { __builtin_amdgcn_s_setprio(1); _Pragma("unroll") for (int m = 0; m < 4; ++m) _Pragma("unroll") for (int n = 0; n < 2; ++n) _Pragma("unroll") for (int k = 0; k < 2; ++k) \
        acc[ai][bj][m][n] = __builtin_amdgcn_mfma_f32_16x16x32_bf16(Bt[n][k], At[m][k], acc[ai][bj][m][n], 0, 0, 0); __builtin_amdgcn_s_setprio(0); } while (0)
#define PG8_WAIT_V(n) asm volatile("s_waitcnt vmcnt(" #n ")" ::: "memory")
#define PG8_WAIT_L(n) asm volatile("s_waitcnt lgkmcnt(" #n ")" ::: "memory")
#define PG8_BAR __builtin_amdgcn_s_barrier()
#define PG8_SCHED __builtin_amdgcn_sched_barrier(0)
    Unit cur, nxt; int ui = 0;
    if (!S.next(0, cur)) return;
    f32x4 acc[2][2][4][2];
#pragma unroll
    for (int a = 0; a < 2; ++a)
#pragma unroll
        for (int b = 0; b < 2; ++b)
#pragma unroll
            for (int m = 0; m < 4; ++m)
#pragma unroll
                for (int n = 0; n < 2; ++n) acc[a][b][m][n] = (f32x4){0.f, 0.f, 0.f, 0.f};
    bf16x8 At[4][2], B0[2][2], B1[2][2];
    const char* cA = (const char*)g.A + (size_t)cur.pm * tstep; const char* cB = (const char*)g.Bt + (size_t)cur.pn * tstep;
    S.a_ready(cur);
    if constexpr (SP2) {
        PG8_STAGE(PG8_SB(0, 0), cB, voffB); PG8_STAGE(PG8_SB(0, 1), cB + hstep, voffB); PG8_STAGE(PG8_SA(0, 0), cA, voffA); PG8_STAGE(PG8_SA(0, 1), cA + hstep, voffA);
        if (wr == 1) PG8_BAR;
        PG8_WAIT_V(2); PG8_BAR;
        PG8_STAGE(PG8_SB(1, 0), cB + kstep, voffB); PG8_STAGE(PG8_SA(1, 0), cA + kstep, voffA); PG8_STAGE(PG8_SB(1, 1), cB + hstep + kstep, voffB);
        PG8_WAIT_V(6); PG8_BAR;
    } else {
        PG8_STAGE(PG8_SB(0, 0), cB, voffB); PG8_STAGE(PG8_SA(0, 0), cA, voffA); PG8_STAGE(PG8_SB(0, 1), cB + hstep, voffB); PG8_STAGE(PG8_SA(0, 1), cA + hstep, voffA);
        if (wr == 1) PG8_BAR;
        PG8_WAIT_V(4); PG8_BAR;
        PG8_STAGE(PG8_SB(1, 0), cB + kstep, voffB); PG8_STAGE(PG8_SA(1, 0), cA + kstep, voffA); PG8_STAGE(PG8_SB(1, 1), cB + hstep + kstep, voffB);
        PG8_WAIT_V(6); PG8_BAR;
    }
    for (;;) {
        const bool has_next = S.next(ui + 1, nxt);
        const char* nA = has_next ? (const char*)g.A + (size_t)nxt.pm * tstep : cA; const char* nB = has_next ? (const char*)g.Bt + (size_t)nxt.pn * tstep : cB;
        for (int t = 0; t < nt; t += 2) {
            const bool last = (t == nt - 2);
            const char* a1 = cA + (size_t)(t + 1) * kstep;
            const char* a2 = last ? nA : cA + (size_t)(t + 2) * kstep; const char* b2 = last ? nB : cB + (size_t)(t + 2) * kstep;
            const char* a3 = a2 + kstep; const char* b3 = b2 + kstep;
            if (last && has_next) S.a_ready(nxt);
            if constexpr (SP2) {
            PG8_LDB(B0, 0, 0); PG8_LDB(B1, 0, 1); PG8_SCHED; PG8_LDA(At, 0, 0); PG8_STAGE(PG8_SA(1, 1), a1 + hstep, voffA);
            PG8_WAIT_V(8); PG8_WAIT_L(0); PG8_BAR; PG8_MMA(0, 0, At, B0); PG8_MMA(0, 1, At, B1); PG8_BAR; PG8_SCHED;
            PG8_LDA(At, 0, 1); PG8_STAGE(PG8_SB(0, 0), b2, voffB); PG8_STAGE(PG8_SB(0, 1), b2 + hstep, voffB); PG8_STAGE(PG8_SA(0, 0), a2, voffA);
            PG8_WAIT_V(8); PG8_WAIT_L(0); PG8_BAR; PG8_MMA(1, 0, At, B0); PG8_MMA(1, 1, At, B1); PG8_BAR; PG8_SCHED;
            PG8_LDB(B0, 1, 0); PG8_LDB(B1, 1, 1); PG8_SCHED; PG8_LDA(At, 1, 0); PG8_STAGE(PG8_SA(0, 1), a2 + hstep, voffA);
            PG8_WAIT_V(8); PG8_WAIT_L(0); PG8_BAR; PG8_MMA(0, 0, At, B0); PG8_MMA(0, 1, At, B1); PG8_BAR; PG8_SCHED;
            PG8_LDA(At, 1, 1); PG8_STAGE(PG8_SB(1, 0), b3, voffB); PG8_STAGE(PG8_SB(1, 1), b3 + hstep, voffB); PG8_STAGE(PG8_SA(1, 0), a3, voffA);
            PG8_WAIT_V(8); PG8_WAIT_L(0); PG8_BAR; PG8_MMA(1, 0, At, B0); PG8_MMA(1, 1, At, B1); PG8_BAR; PG8_SCHED;
            } else {
            PG8_LDB(B0, 0, 0); PG8_SCHED; PG8_LDA(At, 0, 0); PG8_STAGE(PG8_SA(1, 1), a1 + hstep, voffA);
            PG8_WAIT_L(8); PG8_BAR; PG8_WAIT_L(0); PG8_MMA(0, 0, At, B0); PG8_BAR; PG8_SCHED;
            PG8_LDB(B1, 0, 1); PG8_STAGE(PG8_SB(0, 0), b2, voffB);
            PG8_BAR; PG8_WAIT_L(0); PG8_MMA(0, 1, At, B1); PG8_BAR;
            PG8_LDA(At, 0, 1); PG8_STAGE(PG8_SA(0, 0), a2, voffA);
            PG8_BAR; PG8_WAIT_L(0); PG8_MMA(1, 0, At, B0); PG8_BAR; PG8_SCHED;
            PG8_STAGE(PG8_SB(0, 1), b2 + hstep, voffB);
            PG8_WAIT_V(6); PG8_BAR; PG8_MMA(1, 1, At, B1); PG8_BAR;
            PG8_LDB(B0, 1, 0); PG8_SCHED; PG8_LDA(At, 1, 0); PG8_STAGE(PG8_SA(0, 1), a2 + hstep, voffA);
            PG8_WAIT_L(8); PG8_BAR; PG8_WAIT_L(0); PG8_MMA(0, 0, At, B0); PG8_BAR; PG8_SCHED;
            PG8_LDB(B1, 1, 1); PG8_STAGE(PG8_SB(1, 0), b3, voffB);
            PG8_BAR; PG8_WAIT_L(0); PG8_MMA(0, 1, At, B1); PG8_BAR;
            PG8_LDA(At, 1, 1); PG8_STAGE(PG8_SA(1, 0), a3, voffA);
            PG8_BAR; PG8_WAIT_L(0); PG8_MMA(1, 0, At, B0); PG8_BAR; PG8_SCHED;
            PG8_STAGE(PG8_SB(1, 1), b3 + hstep, voffB);
            PG8_WAIT_V(6); PG8_BAR; PG8_MMA(1, 1, At, B1); PG8_BAR;
            }
        }
        if constexpr (ALIGN_EPI) { if (wr == 0) PG8_BAR; }
        if constexpr (!Epi::AFTER_DRAIN) { E(acc, cur, wr, wc, fr, fq); S.done(cur); }
        if (!has_next) break;
#pragma unroll
        for (int a = 0; a < 2; ++a)
#pragma unroll
            for (int b = 0; b < 2; ++b)
#pragma unroll
                for (int m = 0; m < 4; ++m)
#pragma unroll
                    for (int n = 0; n < 2; ++n) acc[a][b][m][n] = (f32x4){0.f, 0.f, 0.f, 0.f};
        cur = nxt; cA = nA; cB = nB; ++ui;
        if constexpr (ALIGN_EPI) { if (wr == 1) PG8_BAR; }
    }
    PG8_WAIT_V(0);
    if constexpr (!ALIGN_EPI) { if (wr == 0) PG8_BAR; }
    PG8_BAR;
    if constexpr (Epi::AFTER_DRAIN) { E.fused(acc, cur, wr, wc, fr, fq, lds, wid, lane); S.done(cur); }
#undef PG8_SA
#undef PG8_SB
#undef PG8_STAGE
#undef PG8_LDA
#undef PG8_LDB
#undef PG8_MMA
#undef PG8_WAIT_V
#undef PG8_WAIT_L
#undef PG8_BAR
#undef PG8_SCHED
}
}
namespace mk {
#define LAS __attribute__((address_space(3)))
typedef unsigned short bf16_t;
typedef float f32x4 __attribute__((ext_vector_type(4)));
typedef float f32x2 __attribute__((ext_vector_type(2)));
typedef unsigned u32x4 __attribute__((ext_vector_type(4)));
typedef unsigned u32x2 __attribute__((ext_vector_type(2)));
typedef __bf16 bf16x2_t __attribute__((ext_vector_type(2)));
typedef short bf16x8 __attribute__((ext_vector_type(8)));
typedef short s16x4 __attribute__((ext_vector_type(4)));
constexpr int D = 2048, NB = 4, S = 4096, T = NB * S, IN_LD = 5384, NP = 5632, NE = 16384;
constexpr int NTHR = 512, NWAVES = 8;
constexpr int LDS_BYTES = 160 * 1024;
constexpr int LDS_SPARE = 128 * 1024;
constexpr float EPS = 1e-6f;
#ifndef REPS
#define REPS 1,1,1,1,1,1,1,1
#endif
constexpr int REPV[8] = {REPS};
constexpr int REP7 = REPV[7];
constexpr int NHELP = 16;
constexpr int HROWS = 9728;
constexpr int REP0 = REPV[0], REP1 = REPV[1], REP2 = REPV[2], REP3 = REPV[3], REP4 = REPV[4], REP5 = REPV[5], REP6 = REPV[6];
constexpr int C_QA = 0, C_KA = 1024, C_VA = 1152, C_QH = 1280, C_FH = 1792, C_IH = 2304, C_GH = 2816, C_QM = 3328, C_KM = 3840, C_VM = 4352, C_OM = 4864, C_IM = 5376, C_FM = 5380;

constexpr size_t WS_CTL = 0;
constexpr size_t WS_WINT = 65536;
constexpr size_t WS_WOUTT = WS_WINT + 2 * (size_t)NP * D * 2;
constexpr size_t WS_WQT = WS_WOUTT + 2 * (size_t)D * D * 2;
constexpr size_t WS_SUBK = WS_WQT + 2 * (size_t)D * D * 2;
constexpr size_t WS_U8 = WS_SUBK + 2 * 2 * 8 * 128 * 128 * 2;
constexpr size_t WS_V8 = WS_U8 + 2 * (size_t)NE * D;
constexpr size_t WS_USC = WS_V8 + 2 * (size_t)NE * D;
constexpr size_t WS_VSC = WS_USC + 2 * (size_t)NE * 4;
constexpr size_t WS_ROPE = WS_VSC + 2 * (size_t)NE * 4;
constexpr size_t WS_SS = WS_ROPE + (size_t)S * 32 * 8;
constexpr size_t WS_SSP = WS_SS + (size_t)T * 16 * 4;
constexpr size_t WS_XB = WS_SSP + (size_t)T * 32 * 4;
constexpr size_t WS_P = WS_XB + (size_t)T * D * 2;
constexpr size_t WS_YB = WS_P + (size_t)T * NP * 2;
constexpr size_t WS_Q = WS_YB + (size_t)T * D * 2;
constexpr size_t WS_IDX = WS_Q + (size_t)T * D * 2;
constexpr size_t WS_GATE = WS_IDX + (size_t)T * 128 * 4;
constexpr size_t WS_X1 = WS_GATE + (size_t)T * 128 * 4;
constexpr size_t WS_X2 = WS_X1 + (size_t)T * D * 4;
constexpr size_t WS_IDXU = WS_X2 + (size_t)T * D * 4;
constexpr size_t WS_AMXP = WS_IDXU + (size_t)T * 128 * 4;
constexpr size_t WS_ASC = WS_AMXP + (size_t)T * 32 * 4;
constexpr size_t WS_STH = WS_ASC + (size_t)T * 4;
constexpr size_t WS_STM = WS_STH + (size_t)128 * 16640 * 4;
constexpr size_t WS_END = WS_STM + (size_t)128 * 16640 * 4;
constexpr size_t WS_PART = WS_P;
constexpr size_t WS_ACT = WS_Q;
static_assert((size_t)16 * T * 128 * 4 <= (size_t)T * NP * 2, "PART overlay");
static_assert(WS_END <= ((size_t)1 << 30), "workspace");
struct Params { const float* in[16]; float* out; unsigned char* ws; int ph_lo, ph_hi, layer, layer_hi, pad, pad2; };

__device__ __forceinline__ unsigned pk2(float lo, float hi) { f32x2 v = {lo, hi}; bf16x2_t b = __builtin_convertvector(v, bf16x2_t); return __builtin_bit_cast(unsigned, b); }
__device__ __forceinline__ float bf2f(unsigned short h) { return __uint_as_float((unsigned)h << 16); }
__device__ __forceinline__ float bflo(unsigned w) { return __uint_as_float(w << 16); }
__device__ __forceinline__ float bfhi(unsigned w) { return __uint_as_float(w & 0xffff0000u); }
__device__ __forceinline__ float wsum(float v) {
#pragma unroll
    for (int o = 1; o < 64; o <<= 1) v += __shfl_xor(v, o);
    return v;
}
template <int CTRL> __device__ __forceinline__ float dppf(float x) { return __builtin_bit_cast(float, __builtin_amdgcn_mov_dpp(__builtin_bit_cast(int, x), CTRL, 0xf, 0xf, true)); }
constexpr int DPP_XOR1 = 0xB1, DPP_XOR2 = 0x4E, DPP_HMIR = 0x141, DPP_ROR8 = 0x128;
__device__ __forceinline__ float sum8(float v) { v += dppf<DPP_XOR1>(v); v += dppf<DPP_XOR2>(v); v += dppf<DPP_HMIR>(v); return v; }
__device__ __forceinline__ float sum16(float v) { v = sum8(v); v += dppf<DPP_ROR8>(v); return v; }
__device__ __forceinline__ float wmax(float v) {
#pragma unroll
    for (int o = 1; o < 64; o <<= 1) v = fmaxf(v, __shfl_xor(v, o));
    return v;
}

__device__ __forceinline__ void transpose_item(const float* __restrict__ W, int ldw, int nvalid, const float* __restrict__ gain, bf16_t* __restrict__ WT, int K, int k0, int n0, LAS float* scr, int lane) {
    const int j = lane & 31, h = lane >> 5;
    const int n = n0 + 2 * j;
    f32x2 vv[32];
#pragma unroll
    for (int i = 0; i < 32; ++i) {
        const int kk = 2 * i + h;
        f32x2 v = {0.f, 0.f};
        if (n < nvalid) v = *(const f32x2*)(W + (size_t)(k0 + kk) * ldw + n);
        vv[i] = v;
    }
#pragma unroll
    for (int i = 0; i < 32; ++i) {
        const int kk = 2 * i + h;
        f32x2 v = vv[i];
        if (gain) { const float gk = gain[k0 + kk]; v.x *= gk; v.y *= gk; }
        *(LAS f32x2*)(scr + kk * 66 + 2 * j) = v;
    }
    __builtin_amdgcn_s_waitcnt(0xc07f);
    asm volatile("" ::: "memory");
    const int c = lane & 7;
#pragma unroll
    for (int jj = 0; jj < 8; ++jj) {
        const int nn = (lane >> 3) + 8 * jj;
        const LAS float* s = scr + (8 * c) * 66 + nn;
        u32x4 o; o.x = pk2(s[0 * 66], s[1 * 66]); o.y = pk2(s[2 * 66], s[3 * 66]); o.z = pk2(s[4 * 66], s[5 * 66]); o.w = pk2(s[6 * 66], s[7 * 66]);
        *(u32x4*)(WT + (size_t)(n0 + nn) * K + k0 + 8 * c) = o;
    }
    __builtin_amdgcn_s_waitcnt(0xc07f);
    asm volatile("" ::: "memory");
}
__device__ __forceinline__ void xprep_row(const float* __restrict__ xrow, bf16_t* __restrict__ orow, float* __restrict__ ss, int lane) {
    const f32x4* xr = (const f32x4*)xrow + lane;
    f32x4 v[8]; float s = 0.f;
#pragma unroll
    for (int j = 0; j < 8; ++j) { v[j] = xr[64 * j]; s += (v[j].x * v[j].x + v[j].y * v[j].y) + (v[j].z * v[j].z + v[j].w * v[j].w); }
    s = wsum(s);
    u32x2* o = (u32x2*)orow + lane;
#pragma unroll
    for (int j = 0; j < 8; ++j) { u32x2 w; w.x = pk2(v[j].x, v[j].y); w.y = pk2(v[j].z, v[j].w); o[64 * j] = w; }
    if (lane < 16) ss[lane] = (lane == 0) ? s : 0.f;
}
template <int NR>
__device__ __forceinline__ void fp8_rows_load(const float* __restrict__ src, f32x4 (&v)[NR][8], int lane) {
#pragma unroll
    for (int r = 0; r < NR; ++r)
#pragma unroll
        for (int i = 0; i < 8; ++i) v[r][i] = *(const f32x4*)(src + (size_t)r * D + 256 * i + 4 * lane);
}
template <int NR, bool INT8>
__device__ __forceinline__ void fp8_rows_finish(f32x4 (&v)[NR][8], const float* __restrict__ gain, unsigned char* __restrict__ dst, float* __restrict__ sc, int lane) {
    float am[NR];
#pragma unroll
    for (int r = 0; r < NR; ++r) am[r] = 0.f;
#pragma unroll
    for (int i = 0; i < 8; ++i) {
        f32x4 gg = {1.f, 1.f, 1.f, 1.f};
        if (gain) gg = *(const f32x4*)(gain + 256 * i + 4 * lane);
#pragma unroll
        for (int r = 0; r < NR; ++r) {
            if (gain) v[r][i] = v[r][i] * gg;
            const f32x4 a = v[r][i];
            am[r] = fmaxf(am[r], fmaxf(fmaxf(fabsf(a.x), fabsf(a.y)), fmaxf(fabsf(a.z), fabsf(a.w))));
        }
    }
#pragma unroll
    for (int r = 0; r < NR; ++r) am[r] = wmax(am[r]);
#pragma unroll
    for (int r = 0; r < NR; ++r) {
        const float qmax = INT8 ? 127.f : 256.f;
        const float qs = am[r] > 0.f ? qmax / am[r] : 1.f;
#pragma unroll
        for (int i = 0; i < 8; ++i) {
            const f32x4 a = v[r][i] * qs;
            int pk;
            if (INT8) pk = (__float2int_rn(a.x) & 0xff) | ((__float2int_rn(a.y) & 0xff) << 8) | ((__float2int_rn(a.z) & 0xff) << 16) | (__float2int_rn(a.w) << 24);
            else { pk = __builtin_amdgcn_cvt_pk_fp8_f32(a.x, a.y, 0, false); pk = __builtin_amdgcn_cvt_pk_fp8_f32(a.z, a.w, pk, true); }
            *(unsigned*)(dst + (size_t)r * 128 + ((size_t)(2 * i + (lane >> 5)) * NE) * 128 + (lane & 31) * 4) = (unsigned)pk;
        }
        if (lane == 0) sc[2 * r] = am[r] > 0.f ? am[r] * (INT8 ? (1.f / 127.f) : (1.f / 256.f)) : 1.f;
    }
}

__device__ __forceinline__ void tables_convert(const Params& p, int l, int r_lo, int r_hi, int w, int nw, int lane) {
    unsigned char* ws = p.ws;
    const float* norm_ffn = p.in[10]; const float* peer_u = p.in[13]; const float* peer_v = p.in[14];
    const int REND = r_hi;
    const int rstep = 2 * nw;
#define TC_SRC(R) (((R) / NE == 0 ? peer_u : peer_v) + ((size_t)l * NE + (size_t)((R) % NE)) * D)
#define TC_FIN(V, R) do { const int tb_ = (R) / NE, e_ = (R) % NE; \
        fp8_rows_finish<2, true>(V, tb_ == 0 ? norm_ffn + l * D : (const float*)nullptr, ws + (tb_ == 0 ? WS_U8 : WS_V8) + (size_t)l * NE * D + (size_t)e_ * 128, \
                                 (float*)(ws + WS_USC) + 2 * ((size_t)l * NE + e_) + tb_, lane); } while (0)
    f32x4 va[2][8], vb[2][8];
    int r = r_lo + 2 * w;
    if (r < REND) fp8_rows_load<2>(TC_SRC(r), va, lane);
    while (r < REND) {
        const int rn = r + rstep;
        if (rn < REND) fp8_rows_load<2>(TC_SRC(rn), vb, lane);
        TC_FIN(va, r);
        if (rn >= REND) break;
        const int rn2 = rn + rstep;
        if (rn2 < REND) fp8_rows_load<2>(TC_SRC(rn2), va, lane);
        TC_FIN(vb, rn);
        r = rn2;
    }
#undef TC_SRC
#undef TC_FIN
}

__device__ __forceinline__ void p0_prologue(const Params& p, LAS unsigned char* lds, int mask = 0xff) {
    const int tid = threadIdx.x, lane = tid & 63, wave = tid >> 6;
    const int G = gridDim.x, gw = blockIdx.x * NWAVES + wave, ngw = G * NWAVES;
    const size_t gt = (size_t)blockIdx.x * NTHR + tid, ngt = (size_t)G * NTHR;
    unsigned char* ws = p.ws;
    const float* x = p.in[0]; const float* norm_mix = p.in[1]; const float* w_in = p.in[2]; const float* w_out = p.in[3];
    const float* norm_ffn = p.in[10]; const float* peer_query = p.in[11]; const float* sub_keys = p.in[12]; const float* peer_u = p.in[13]; const float* peer_v = p.in[14];
    if (mask & 1) {
        LAS float* scr = (LAS float*)(lds + wave * 16896);
        constexpr int I_IN = 32 * (NP / 64), I_SQ = 32 * (D / 64), PER_L = I_IN + 2 * I_SQ;
        for (int it = gw; it < 2 * PER_L; it += ngw) {
            const int l = it / PER_L; int r = it % PER_L;
            if (r < I_IN) { transpose_item(w_in + (size_t)l * D * IN_LD, IN_LD, IN_LD, norm_mix + l * D, (bf16_t*)(ws + WS_WINT) + (size_t)l * NP * D, D, (r / (NP / 64)) * 64, (r % (NP / 64)) * 64, scr, lane); continue; }
            r -= I_IN;
            if (r < I_SQ) { transpose_item(w_out + (size_t)l * D * D, D, D, nullptr, (bf16_t*)(ws + WS_WOUTT) + (size_t)l * D * D, D, (r / (D / 64)) * 64, (r % (D / 64)) * 64, scr, lane); continue; }
            r -= I_SQ;
            transpose_item(peer_query + (size_t)l * D * D, D, D, norm_ffn + l * D, (bf16_t*)(ws + WS_WQT) + (size_t)l * D * D, D, (r / (D / 64)) * 64, (r % (D / 64)) * 64, scr, lane);
        }
    }
    if (mask & 2) for (size_t i = gt; i < 2 * 2 * 8 * 128 * 128 / 4; i += ngt) {
        const f32x4 v = ((const f32x4*)sub_keys)[i];
        u32x2 w; w.x = pk2(v.x, v.y); w.y = pk2(v.z, v.w);
        ((u32x2*)(ws + WS_SUBK))[i] = w;
    }
    if (mask & 4) { const int r0 = (mask & 0x100) ? HROWS : 0; tables_convert(p, 0, r0, 2 * NE, gw, ngw, lane); tables_convert(p, 1, r0, 2 * NE, gw, ngw, lane); }
    if (mask & 8) for (size_t i = gt; i < (size_t)S * 32; i += ngt) {
        const int fi = (int)(i & 31), pos = (int)(i >> 5);
        const float inv = powf(10000.f, -(float)fi / 32.f);
        const float ang = (float)pos * inv;
        f32x2 cs; cs.x = cosf(ang); cs.y = sinf(ang);
        ((f32x2*)(ws + WS_ROPE))[i] = cs;
    }
    if (mask & 16) for (int t = 2 * gw; t < T; t += 2 * ngw) {
        const f32x4* x0 = (const f32x4*)(x + (size_t)t * D) + lane; const f32x4* x1 = x0 + D / 4;
        f32x4 v0[8], v1[8]; float s0 = 0.f, s1 = 0.f;
#pragma unroll
        for (int j = 0; j < 8; ++j) { v0[j] = x0[64 * j]; v1[j] = x1[64 * j]; }
#pragma unroll
        for (int j = 0; j < 8; ++j) { s0 += (v0[j].x * v0[j].x + v0[j].y * v0[j].y) + (v0[j].z * v0[j].z + v0[j].w * v0[j].w); s1 += (v1[j].x * v1[j].x + v1[j].y * v1[j].y) + (v1[j].z * v1[j].z + v1[j].w * v1[j].w); }
        s0 = wsum(s0); s1 = wsum(s1);
        u32x2* o0 = (u32x2*)((bf16_t*)(ws + WS_XB) + (size_t)t * D) + lane; u32x2* o1 = o0 + D / 4;
#pragma unroll
        for (int j = 0; j < 8; ++j) { u32x2 w; w.x = pk2(v0[j].x, v0[j].y); w.y = pk2(v0[j].z, v0[j].w); o0[64 * j] = w; w.x = pk2(v1[j].x, v1[j].y); w.y = pk2(v1[j].z, v1[j].w); o1[64 * j] = w; }
        float* ss = (float*)(ws + WS_SS) + (size_t)t * 16;
        if (lane < 32) ss[lane] = (lane == 0) ? s0 : (lane == 16) ? s1 : 0.f;
    }
}

template <int NSS>
struct EpiScaleBf16 {
    static constexpr bool PERM = true, AFTER_DRAIN = false;
    bf16_t* O; int ldc; const float* ss;
    __device__ __forceinline__ void operator()(const pg8::f32x4 (&acc)[2][2][4][2], const pg8::Unit& u, int wr, int wc, int fr, int fq) const {
        const int row0 = u.pm * 256 + wr * 64 + fr, col0 = u.pn * 256 + wc * 32 + 8 * fq;
#pragma unroll
        for (int ai = 0; ai < 2; ++ai)
#pragma unroll
            for (int m = 0; m < 4; ++m) {
                const int row = row0 + ai * 128 + m * 16;
                float s;
                {
                    const f32x4* sp = (const f32x4*)(ss + (size_t)row * NSS);
                    f32x4 a = sp[fq];
                    if (NSS == 32) a = a + sp[4 + fq];
                    s = (a.x + a.y) + (a.z + a.w);
                    { const auto w = __builtin_amdgcn_permlane16_swap(__float_as_uint(s), __float_as_uint(s), false, false); s = __uint_as_float(w[0]) + __uint_as_float(w[1]); }
                    { const auto w = __builtin_amdgcn_permlane32_swap(__float_as_uint(s), __float_as_uint(s), false, false); s = __uint_as_float(w[0]) + __uint_as_float(w[1]); }
                }
                const float r = rsqrtf(s * (1.f / D) + EPS);
                bf16_t* rowp = O + (size_t)row * ldc + col0;
#pragma unroll
                for (int bj = 0; bj < 2; ++bj) {
                    const pg8::f32x4 v0 = acc[ai][bj][m][0] * r, v1 = acc[ai][bj][m][1] * r;
                    u32x4 w; w.x = pk2(v0[0], v0[1]); w.y = pk2(v0[2], v0[3]); w.z = pk2(v1[0], v1[1]); w.w = pk2(v1[2], v1[3]);
                    *(u32x4*)(rowp + bj * 128) = w;
                }
            }
    }
};

struct EpiX1 {
    static constexpr bool PERM = true, AFTER_DRAIN = false;
    const float* xin32;
    bf16_t* X1B; float* ssp; float* amxp;
    __device__ __forceinline__ void operator()(const pg8::f32x4 (&acc)[2][2][4][2], const pg8::Unit& u, int wr, int wc, int fr, int fq) const {
        const int col0 = u.pn * 256 + wc * 32 + 8 * fq;
#pragma unroll
        for (int ai = 0; ai < 2; ++ai) {
            const int rbase = u.pm * 256 + ai * 128 + wr * 64 + fr;
            pg8::f32x4 r0[4][2], r1[4][2];
            if (xin32) {
#pragma unroll
                for (int m = 0; m < 4; ++m)
#pragma unroll
                    for (int bj = 0; bj < 2; ++bj) { const float* xp = xin32 + (size_t)(rbase + m * 16) * D + col0 + bj * 128; r0[m][bj] = *(const pg8::f32x4*)xp; r1[m][bj] = *(const pg8::f32x4*)(xp + 4); }
            } else {
                u32x4 rb[4][2];
#pragma unroll
                for (int m = 0; m < 4; ++m)
#pragma unroll
                    for (int bj = 0; bj < 2; ++bj) rb[m][bj] = *(const u32x4*)(X1B + (size_t)(rbase + m * 16) * D + col0 + bj * 128);
#pragma unroll
                for (int m = 0; m < 4; ++m)
#pragma unroll
                    for (int bj = 0; bj < 2; ++bj) { const u32x4 b = rb[m][bj]; r0[m][bj] = (pg8::f32x4){bflo(b.x), bfhi(b.x), bflo(b.y), bfhi(b.y)}; r1[m][bj] = (pg8::f32x4){bflo(b.z), bfhi(b.z), bflo(b.w), bfhi(b.w)}; }
            }
#pragma unroll
            for (int m = 0; m < 4; ++m) {
                const int row = rbase + m * 16;
                float q = 0.f, am = 0.f;
#pragma unroll
                for (int bj = 0; bj < 2; ++bj) {
                    const size_t off = (size_t)row * D + col0 + bj * 128;
                    const pg8::f32x4 o0 = r0[m][bj] + acc[ai][bj][m][0], o1 = r1[m][bj] + acc[ai][bj][m][1];
                    u32x4 w; w.x = pk2(o0[0], o0[1]); w.y = pk2(o0[2], o0[3]); w.z = pk2(o1[0], o1[1]); w.w = pk2(o1[2], o1[3]);
                    *(u32x4*)(X1B + off) = w;
#pragma unroll
                    for (int k = 0; k < 4; ++k) {
                        const float a = bflo(w[k]), b = bfhi(w[k]);
                        q += a * a + b * b;
                        am = fmaxf(am, fmaxf(fabsf(a), fabsf(b)));
                    }
                }
                q += __shfl_xor(q, 16); q += __shfl_xor(q, 32);
                am = fmaxf(am, __shfl_xor(am, 16)); am = fmaxf(am, __shfl_xor(am, 32));
                if (fq == 0) { ssp[(size_t)row * 32 + u.pn * 4 + wc] = q; amxp[(size_t)row * 32 + u.pn * 4 + wc] = am; }
            }
        }
    }
};

#define TOPK_INSERT(L, x) do { _Pragma("unroll") for (int _i = 15; _i >= 1; --_i) L[_i] = __builtin_amdgcn_fmed3f(L[_i - 1], L[_i], (x)); L[0] = fmaxf(L[0], (x)); } while (0)
constexpr int SK_LD = 136;
constexpr int ROUTE_SK_OFF = 8 * 8448;
typedef float f32x16 __attribute__((ext_vector_type(16)));
__device__ __forceinline__ float swap32(float x) {
    const auto s = __builtin_amdgcn_permlane32_swap(__float_as_uint(x), __float_as_uint(x), false, false);
    return (__builtin_amdgcn_mbcnt_hi(~0u, __builtin_amdgcn_mbcnt_lo(~0u, 0u)) < 32u) ? __uint_as_float(s[1]) : __uint_as_float(s[0]);
}
__device__ __forceinline__ void route_unit(const bf16_t* __restrict__ Q, const bf16_t* __restrict__ subk_l, int pm, int h, int* __restrict__ IDX, int* __restrict__ IDXU, float* __restrict__ GATE,
                                           LAS unsigned char* lds, int tid, int wave, int lane) {
    const int tk = lane & 31, hi = lane >> 5;
    LAS float* scr = (LAS float*)(lds + wave * 8448);
    LAS bf16_t* SK = (LAS bf16_t*)(lds + ROUTE_SK_OFF);
    __syncthreads();
#pragma unroll
    for (int j = 0; j < 8; ++j) {
        const int e = tid + j * NTHR, half = e >> 11, row = (e >> 4) & 127, ch = e & 15;
        *(LAS u32x4*)(SK + (half * 128 + row) * SK_LD + ch * 8) = *(const u32x4*)(subk_l + ((size_t)(half * 8 + h) * 128 + row) * 128 + ch * 8);
    }
    const int tok = pm * 256 + wave * 32 + tk;
    bf16x8 bq[2][8];
#pragma unroll
    for (int half = 0; half < 2; ++half)
#pragma unroll
        for (int ks = 0; ks < 8; ++ks) bq[half][ks] = *(const bf16x8*)(Q + (size_t)tok * D + h * 256 + half * 128 + ks * 16 + 8 * hi);
    __syncthreads();
    float L1[16], L2[16];
#pragma unroll
    for (int half = 0; half < 2; ++half) {
        float L[16];
#pragma unroll
        for (int i = 0; i < 16; ++i) L[i] = -3.0e38f;
#pragma unroll 1
        for (int mt = 0; mt < 4; ++mt) {
            f32x16 acc;
#pragma unroll
            for (int r = 0; r < 16; ++r) acc[r] = 0.f;
            const LAS bf16_t* kp = SK + (half * 128 + mt * 32 + tk) * SK_LD + 8 * hi;
#pragma unroll
            for (int ks = 0; ks < 8; ++ks) acc = __builtin_amdgcn_mfma_f32_32x32x16_bf16(*(const LAS bf16x8*)(kp + ks * 16), bq[half][ks], acc, 0, 0, 0);
#pragma unroll
            for (int r = 0; r < 16; ++r) {
                const unsigned key = (unsigned)(mt * 32 + (r & 3) + 8 * (r >> 2) + 4 * hi);
                const float xv = __uint_as_float((__float_as_uint(acc[r]) & 0xffffff80u) | key);
                TOPK_INSERT(L, xv);
            }
        }
        { float o[16];
#pragma unroll
          for (int i = 0; i < 16; ++i) o[i] = swap32(L[i]);
#pragma unroll
          for (int i = 0; i < 16; ++i) TOPK_INSERT(L, o[i]); }
#pragma unroll
        for (int i = 0; i < 16; ++i) { if (half == 0) L1[i] = L[i]; else L2[i] = L[i]; }
    }
    float C[16];
#pragma unroll
    for (int i = 0; i < 16; ++i) C[i] = -3.0e38f;
    {
        constexpr int NA[50] = {0,0,0,0,0,0,0,0,0,0,0,0,0,0,0,0, 1,1,1,1,1,1,1,1, 2,2,2,2,2, 3,3,3,3, 4,4,4, 5,5, 6,6, 7,7, 8, 9, 10, 11, 12, 13, 14, 15};
        constexpr int NBb[50] = {0,1,2,3,4,5,6,7,8,9,10,11,12,13,14,15, 0,1,2,3,4,5,6,7, 0,1,2,3,4, 0,1,2,3, 0,1,2, 0,1, 0,1, 0,1, 0, 0, 0, 0, 0, 0, 0, 0};
#pragma unroll
        for (int i = 0; i < 25; ++i) {
            const int a0 = NA[2 * i], b0 = NBb[2 * i], a1 = NA[2 * i + 1], b1 = NBb[2 * i + 1];
            const float s0 = L1[a0] + L2[b0], s1 = L1[a1] + L2[b1];
            const float x0 = __uint_as_float((__float_as_uint(s0) & 0xffffff00u) | (unsigned)(a0 * 16 + b0));
            const float x1 = __uint_as_float((__float_as_uint(s1) & 0xffffff00u) | (unsigned)(a1 * 16 + b1));
            const float xv = hi ? x1 : x0;
            TOPK_INSERT(C, xv);
        }
        float o[16];
#pragma unroll
        for (int i = 0; i < 16; ++i) o[i] = swap32(C[i]);
#pragma unroll
        for (int i = 0; i < 16; ++i) TOPK_INSERT(C, o[i]);
    }
    LAS float* my = scr + lane * 33;
#pragma unroll
    for (int i = 0; i < 16; ++i) { my[i] = L1[i]; my[16 + i] = L2[i]; }
    __builtin_amdgcn_s_waitcnt(0xc07f);
    asm volatile("" ::: "memory");
    const float mx = __uint_as_float(__float_as_uint(C[0]) & 0xffffff00u);
    float e[16], den = 0.f;
#pragma unroll
    for (int i = 0; i < 16; ++i) { e[i] = __expf(__uint_as_float(__float_as_uint(C[i]) & 0xffffff00u) - mx); den += e[i]; }
    const float rden = 1.f / den;
    {
        u32x4 iv[2]; f32x4 gv[2];
        const unsigned hm = hi ? 0xffffffffu : 0u;
#pragma unroll
        for (int j = 0; j < 8; ++j) {
            const unsigned cju = (__float_as_uint(C[8 + j]) & hm) | (__float_as_uint(C[j]) & ~hm);
            const float ej = __uint_as_float((__float_as_uint(e[8 + j]) & hm) | (__float_as_uint(e[j]) & ~hm));
            const unsigned ab = cju & 0xffu;
            const unsigned i1 = __float_as_uint(my[ab >> 4]) & 0x7fu, i2 = __float_as_uint(my[16 + (ab & 15)]) & 0x7fu;
            iv[j >> 2][j & 3] = i1 * 128 + i2;
            gv[j >> 2][j & 3] = ej * rden;
        }
        u32x4* ip = (u32x4*)(IDX + (size_t)tok * 128 + h * 16 + 8 * hi);
        f32x4* gp = (f32x4*)(GATE + (size_t)tok * 128 + h * 16 + 8 * hi);
        ip[0] = iv[0]; ip[1] = iv[1]; gp[0] = gv[0]; gp[1] = gv[1];
    }
    __builtin_amdgcn_s_waitcnt(0xc07f);
    asm volatile("" ::: "memory");
}

__device__ __forceinline__ float gelu_erf(float x) { return 0.5f * x * (1.f + erff(x * 0.70710678118654752f)); }
template <bool FINAL>
__device__ __forceinline__ void expert_token(int t, const bf16_t* __restrict__ X1B, const float* __restrict__ X1, const float* __restrict__ ssp, const int* __restrict__ IDX, const float* __restrict__ GATE,
                                             const unsigned char* __restrict__ U8, const float* __restrict__ USC, const unsigned char* __restrict__ V8, const float* __restrict__ VSC,
                                             float* __restrict__ X2, bf16_t* __restrict__ XB, float* __restrict__ SS, const float* __restrict__ norm_final, float* __restrict__ OUT, int lane) {
    float xf[2][16];
#pragma unroll
    for (int j = 0; j < 2; ++j) {
        const u32x4* xp = (const u32x4*)(X1B + (size_t)t * D + j * 1024 + lane * 16);
        const u32x4 a = xp[0], b = xp[1];
#pragma unroll
        for (int q = 0; q < 4; ++q) { xf[j][2 * q] = bflo(a[q]); xf[j][2 * q + 1] = bfhi(a[q]); xf[j][8 + 2 * q] = bflo(b[q]); xf[j][8 + 2 * q + 1] = bfhi(b[q]); }
    }
    float sp = (lane < 32) ? ssp[(size_t)t * 32 + lane] : 0.f;
    sp = wsum(sp);
    const float rs1 = rsqrtf(sp * (1.f / D) + EPS);
    const int id0 = IDX[(size_t)t * 128 + lane], id1 = IDX[(size_t)t * 128 + 64 + lane];
    const float g0 = GATE[(size_t)t * 128 + lane], g1 = GATE[(size_t)t * 128 + 64 + lane];
    const float us0 = USC[id0], us1 = USC[id1], vs0 = VSC[id0], vs1 = VSC[id1];
    float acc[2][16];
#pragma unroll
    for (int j = 0; j < 2; ++j)
#pragma unroll
        for (int i = 0; i < 16; ++i) acc[j][i] = 0.f;
    float act0 = 0.f, act1 = 0.f;
#pragma unroll 1
    for (int e0 = 0; e0 < 128; e0 += 4) {
        u32x4 w[4][2];
#pragma unroll
        for (int e = 0; e < 4; ++e) {
            const int ee = e0 + e;
            const int id = __builtin_amdgcn_readlane(ee < 64 ? id0 : id1, ee & 63);
            const unsigned char* up = U8 + (size_t)id * D + lane * 16;
            w[e][0] = *(const u32x4*)up; w[e][1] = *(const u32x4*)(up + 1024);
        }
        float d[4];
#pragma unroll
        for (int e = 0; e < 4; ++e) {
            float s = 0.f;
#pragma unroll
            for (int j = 0; j < 2; ++j)
#pragma unroll
                for (int q = 0; q < 4; ++q) {
                    const f32x2 lo = __builtin_amdgcn_cvt_pk_f32_fp8((int)w[e][j][q], false), hi = __builtin_amdgcn_cvt_pk_f32_fp8((int)w[e][j][q], true);
                    s = fmaf(lo.x, xf[j][4 * q], s); s = fmaf(lo.y, xf[j][4 * q + 1], s); s = fmaf(hi.x, xf[j][4 * q + 2], s); s = fmaf(hi.y, xf[j][4 * q + 3], s);
                }
            d[e] = wsum(s);
        }
#pragma unroll
        for (int e = 0; e < 4; ++e) {
            const int ee = e0 + e;
            if (ee < 64) { if (lane == ee) act0 = d[e]; } else { if (lane == ee - 64) act1 = d[e]; }
        }
    }
    act0 = gelu_erf(act0 * us0 * rs1) * g0 * vs0;
    act1 = gelu_erf(act1 * us1 * rs1) * g1 * vs1;
#pragma unroll 1
    for (int e0 = 0; e0 < 128; e0 += 4) {
        u32x4 w[4][2];
        float a[4];
#pragma unroll
        for (int e = 0; e < 4; ++e) {
            const int ee = e0 + e;
            const int id = __builtin_amdgcn_readlane(ee < 64 ? id0 : id1, ee & 63);
            a[e] = __int_as_float(__builtin_amdgcn_readlane(__float_as_int(ee < 64 ? act0 : act1), ee & 63));
            const unsigned char* vp = V8 + (size_t)id * D + lane * 16;
            w[e][0] = *(const u32x4*)vp; w[e][1] = *(const u32x4*)(vp + 1024);
        }
#pragma unroll
        for (int e = 0; e < 4; ++e)
#pragma unroll
            for (int j = 0; j < 2; ++j)
#pragma unroll
                for (int q = 0; q < 4; ++q) {
                    const f32x2 lo = __builtin_amdgcn_cvt_pk_f32_fp8((int)w[e][j][q], false), hi = __builtin_amdgcn_cvt_pk_f32_fp8((int)w[e][j][q], true);
                    acc[j][4 * q] = fmaf(a[e], lo.x, acc[j][4 * q]); acc[j][4 * q + 1] = fmaf(a[e], lo.y, acc[j][4 * q + 1]);
                    acc[j][4 * q + 2] = fmaf(a[e], hi.x, acc[j][4 * q + 2]); acc[j][4 * q + 3] = fmaf(a[e], hi.y, acc[j][4 * q + 3]);
                }
    }
    float q2 = 0.f;
#pragma unroll
    for (int j = 0; j < 2; ++j)
#pragma unroll
        for (int q = 0; q < 4; ++q) {
            const f32x4 r = *(const f32x4*)(X1 + (size_t)t * D + j * 1024 + lane * 16 + q * 4);
            acc[j][4 * q] += r.x; acc[j][4 * q + 1] += r.y; acc[j][4 * q + 2] += r.z; acc[j][4 * q + 3] += r.w;
            q2 += (acc[j][4 * q] * acc[j][4 * q] + acc[j][4 * q + 1] * acc[j][4 * q + 1]) + (acc[j][4 * q + 2] * acc[j][4 * q + 2] + acc[j][4 * q + 3] * acc[j][4 * q + 3]);
        }
    q2 = wsum(q2);
    if (FINAL) {
        const float rf = rsqrtf(q2 * (1.f / D) + EPS);
#pragma unroll
        for (int j = 0; j < 2; ++j)
#pragma unroll
            for (int q = 0; q < 4; ++q) {
                const int e = j * 1024 + lane * 16 + q * 4;
                const f32x4 g = *(const f32x4*)(norm_final + e);
                f32x4 o; o.x = acc[j][4 * q] * rf * g.x; o.y = acc[j][4 * q + 1] * rf * g.y; o.z = acc[j][4 * q + 2] * rf * g.z; o.w = acc[j][4 * q + 3] * rf * g.w;
                *(f32x4*)(OUT + (size_t)t * D + e) = o;
            }
    } else {
#pragma unroll
        for (int j = 0; j < 2; ++j) {
#pragma unroll
            for (int q = 0; q < 4; ++q) {
                f32x4 o; o.x = acc[j][4 * q]; o.y = acc[j][4 * q + 1]; o.z = acc[j][4 * q + 2]; o.w = acc[j][4 * q + 3];
                *(f32x4*)(X2 + (size_t)t * D + j * 1024 + lane * 16 + q * 4) = o;
            }
            u32x4 b0, b1;
#pragma unroll
            for (int q = 0; q < 4; ++q) { b0[q] = pk2(acc[j][2 * q], acc[j][2 * q + 1]); b1[q] = pk2(acc[j][8 + 2 * q], acc[j][8 + 2 * q + 1]); }
            u32x4* xo = (u32x4*)(XB + (size_t)t * D + j * 1024 + lane * 16);
            xo[0] = b0; xo[1] = b1;
        }
        if (lane == 0) SS[t] = q2;
    }
}
}

namespace mk {
constexpr int KS_LD = 72, VS_LD = 80;
constexpr int ATT_KS_OFF = 0, ATT_VS_OFF = 256 * KS_LD * 2;
constexpr int ATT_LDS = ATT_VS_OFF + 256 * VS_LD * 2;

__device__ __forceinline__ bf16x8 tr_pair(const LAS bf16_t* p0, const LAS bf16_t* p1) {
    const s16x4 a = __builtin_amdgcn_ds_read_tr16_b64_v4i16((LAS s16x4*)p0);
    const s16x4 b = __builtin_amdgcn_ds_read_tr16_b64_v4i16((LAS s16x4*)p1);
    bf16x8 r; r[0] = a[0]; r[1] = a[1]; r[2] = a[2]; r[3] = a[3]; r[4] = b[0]; r[5] = b[1]; r[6] = b[2]; r[7] = b[3];
    return r;
}

__device__ __forceinline__ void attn_unit(const bf16_t* __restrict__ P, const f32x2* __restrict__ rope, const float* __restrict__ sinks_l, bf16_t* __restrict__ Y,
                                          int unit, LAS unsigned char* lds, int tid, int lane, int wave) {
    const int b = unit >> 6, n = (unit >> 1) & 31, kvh = unit & 1;
    const int tok0 = b * S + n * 128;
    LAS bf16_t* KS = (LAS bf16_t*)(lds + ATT_KS_OFF);
    LAS bf16_t* VS = (LAS bf16_t*)(lds + ATT_VS_OFF);
    {
        const int key = tid >> 1, part = tid & 1;
        const int kpos = n * 128 - 128 + key;
        u32x4 k1a = {0, 0, 0, 0}, k1b = k1a, k2a = k1a, k2b = k1a, v0 = k1a, v1 = k1a, v2 = k1a, v3 = k1a;
        if (kpos >= 0) {
            const bf16_t* kr = P + (size_t)(tok0 - 128 + key) * NP + C_KA + kvh * 64 + part * 16;
            const u32x4 x1a = *(const u32x4*)kr, x1b = *(const u32x4*)(kr + 8), x2a = *(const u32x4*)(kr + 32), x2b = *(const u32x4*)(kr + 40);
            const f32x4* cs4 = (const f32x4*)(rope + (size_t)kpos * 32 + part * 16);
            f32x4 cv[8];
#pragma unroll
            for (int q = 0; q < 8; ++q) cv[q] = cs4[q];
#pragma unroll
            for (int q = 0; q < 4; ++q) {
                {
                    const f32x2 c0 = {cv[q].x, cv[q].y}, c1 = {cv[q].z, cv[q].w};
                    const float a0 = bflo(x1a[q]), a1 = bfhi(x1a[q]), b0 = bflo(x2a[q]), b1 = bfhi(x2a[q]);
                    k1a[q] = pk2(a0 * c0.x - b0 * c0.y, a1 * c1.x - b1 * c1.y);
                    k2a[q] = pk2(b0 * c0.x + a0 * c0.y, b1 * c1.x + a1 * c1.y);
                }
                {
                    const f32x2 c0 = {cv[4 + q].x, cv[4 + q].y}, c1 = {cv[4 + q].z, cv[4 + q].w};
                    const float a0 = bflo(x1b[q]), a1 = bfhi(x1b[q]), b0 = bflo(x2b[q]), b1 = bfhi(x2b[q]);
                    k1b[q] = pk2(a0 * c0.x - b0 * c0.y, a1 * c1.x - b1 * c1.y);
                    k2b[q] = pk2(b0 * c0.x + a0 * c0.y, b1 * c1.x + a1 * c1.y);
                }
            }
            const bf16_t* vr = P + (size_t)(tok0 - 128 + key) * NP + C_VA + kvh * 64 + part * 32;
            v0 = *(const u32x4*)vr; v1 = *(const u32x4*)(vr + 8); v2 = *(const u32x4*)(vr + 16); v3 = *(const u32x4*)(vr + 24);
        }
        LAS bf16_t* kd = KS + key * KS_LD + part * 16;
        *(LAS u32x4*)kd = k1a; *(LAS u32x4*)(kd + 8) = k1b; *(LAS u32x4*)(kd + 32) = k2a; *(LAS u32x4*)(kd + 40) = k2b;
        LAS bf16_t* vd = VS + key * VS_LD + part * 32;
        *(LAS u32x4*)vd = v0; *(LAS u32x4*)(vd + 8) = v1; *(LAS u32x4*)(vd + 16) = v2; *(LAS u32x4*)(vd + 24) = v3;
    }
    __syncthreads();
    const int hq = kvh * 8 + wave;
    const int fr = lane & 15, fq = lane >> 4;
    constexpr float L2E = 1.4426950408889634f;
    const float sink2 = sinks_l[hq] * L2E;
    const int tq = (lane & 15) >> 2, tp = lane & 3;
    u32x4 x1n[2], x2n[2]; f32x4 csn[2][4];
#define ATT_FETCH(RP) do { _Pragma("unroll") for (int eb_ = 0; eb_ < 2; ++eb_) { const int qi_ = (RP) * 32 + eb_ * 16 + fr; const bf16_t* qr_ = P + (size_t)(tok0 + qi_) * NP + C_QA + hq * 64 + 8 * fq; \
        x1n[eb_] = *(const u32x4*)qr_; x2n[eb_] = *(const u32x4*)(qr_ + 32); const f32x4* cs_ = (const f32x4*)(rope + (size_t)(n * 128 + qi_) * 32 + 8 * fq); \
        csn[eb_][0] = cs_[0]; csn[eb_][1] = cs_[1]; csn[eb_][2] = cs_[2]; csn[eb_][3] = cs_[3]; } } while (0)
    ATT_FETCH(0);
#pragma unroll 1
    for (int rp = 0; rp < 4; ++rp) {
        const int wsk = rp * 32;
        bf16x8 bq0[2], bq1[2];
        u32x4 x1c[2], x2c[2]; f32x4 csc[2][4];
#pragma unroll
        for (int eb = 0; eb < 2; ++eb) { x1c[eb] = x1n[eb]; x2c[eb] = x2n[eb];
#pragma unroll
            for (int q = 0; q < 4; ++q) csc[eb][q] = csn[eb][q]; }
        if (rp < 3) ATT_FETCH(rp + 1);
#pragma unroll
        for (int eb = 0; eb < 2; ++eb) {
            const u32x4 x1 = x1c[eb], x2 = x2c[eb];
            u32x4 o1, o2;
            constexpr float SC = 0.125f * L2E;
#pragma unroll
            for (int q = 0; q < 4; ++q) {
                const f32x4 cq = csc[eb][q];
                const float a0 = bflo(x1[q]), a1 = bfhi(x1[q]), b0 = bflo(x2[q]), b1 = bfhi(x2[q]);
                o1[q] = pk2((a0 * cq.x - b0 * cq.y) * SC, (a1 * cq.z - b1 * cq.w) * SC);
                o2[q] = pk2((b0 * cq.x + a0 * cq.y) * SC, (b1 * cq.z + a1 * cq.w) * SC);
            }
            bq0[eb] = __builtin_bit_cast(bf16x8, o1); bq1[eb] = __builtin_bit_cast(bf16x8, o2);
        }
        pg8::f32x4 sc[2][10];
#pragma unroll
        for (int kt = 0; kt < 10; ++kt) {
            const LAS bf16_t* kp = KS + (wsk + kt * 16 + fr) * KS_LD + 8 * fq;
            const bf16x8 a0 = *(const LAS bf16x8*)kp, a1 = *(const LAS bf16x8*)(kp + 32);
#pragma unroll
            for (int eb = 0; eb < 2; ++eb) {
                pg8::f32x4 acc = {-1e30f, -1e30f, -1e30f, -1e30f};
                if (!((eb == 0 && kt == 9) || (eb == 1 && kt == 0))) {
                    acc = (pg8::f32x4){0.f, 0.f, 0.f, 0.f};
                    acc = __builtin_amdgcn_mfma_f32_16x16x32_bf16(a0, bq0[eb], acc, 0, 0, 0);
                    acc = __builtin_amdgcn_mfma_f32_16x16x32_bf16(a1, bq1[eb], acc, 0, 0, 0);
                }
                sc[eb][kt] = acc;
            }
        }
        const int kmin = (n == 0) ? 128 : 0;
        float rden[2];
#pragma unroll
        for (int eb = 0; eb < 2; ++eb) {
            const int qb = rp * 32 + eb * 16 + fr;
            float mx = sink2;
#pragma unroll
            for (int kt = 0; kt < 10; ++kt) {
                const bool interior = (kt - eb >= 1 && kt - eb <= 7) && n != 0;
#pragma unroll
                for (int r = 0; r < 4; ++r) {
                    if (!interior) {
                        const int kb = wsk + kt * 16 + 4 * fq + r;
                        const bool ok = (kb >= qb + 1) && (kb <= qb + 128) && (kb >= kmin);
                        sc[eb][kt][r] = ok ? sc[eb][kt][r] : -1e30f;
                    }
                    mx = fmaxf(mx, sc[eb][kt][r]);
                }
            }
            mx = fmaxf(mx, __shfl_xor(mx, 16)); mx = fmaxf(mx, __shfl_xor(mx, 32));
            float sum = 0.f;
#pragma unroll
            for (int kt = 0; kt < 10; ++kt)
#pragma unroll
                for (int r = 0; r < 4; ++r) { const float pv = __builtin_amdgcn_exp2f(sc[eb][kt][r] - mx); sc[eb][kt][r] = pv; sum += pv; }
            sum += __shfl_xor(sum, 16); sum += __shfl_xor(sum, 32);
            rden[eb] = __builtin_amdgcn_rcpf(sum + __builtin_amdgcn_exp2f(sink2 - mx));
        }
        pg8::f32x4 oacc[2][4];
#pragma unroll
        for (int eb = 0; eb < 2; ++eb)
#pragma unroll
            for (int mt = 0; mt < 4; ++mt) oacc[eb][mt] = (pg8::f32x4){0.f, 0.f, 0.f, 0.f};
#pragma unroll
        for (int kk = 0; kk < 5; ++kk) {
            bf16x8 bp[2];
#pragma unroll
            for (int eb = 0; eb < 2; ++eb) {
                u32x4 pb; pb[0] = pk2(sc[eb][2 * kk][0], sc[eb][2 * kk][1]); pb[1] = pk2(sc[eb][2 * kk][2], sc[eb][2 * kk][3]);
                pb[2] = pk2(sc[eb][2 * kk + 1][0], sc[eb][2 * kk + 1][1]); pb[3] = pk2(sc[eb][2 * kk + 1][2], sc[eb][2 * kk + 1][3]);
                bp[eb] = __builtin_bit_cast(bf16x8, pb);
            }
            const LAS bf16_t* v0 = VS + (wsk + (2 * kk) * 16 + 4 * fq + tq) * VS_LD + 4 * tp;
            const LAS bf16_t* v1 = v0 + 16 * VS_LD;
#pragma unroll
            for (int mt = 0; mt < 4; ++mt) {
                const bf16x8 av = tr_pair(v0 + mt * 16, v1 + mt * 16);
                oacc[0][mt] = __builtin_amdgcn_mfma_f32_16x16x32_bf16(av, bp[0], oacc[0][mt], 0, 0, 0);
                oacc[1][mt] = __builtin_amdgcn_mfma_f32_16x16x32_bf16(av, bp[1], oacc[1][mt], 0, 0, 0);
            }
        }
#pragma unroll
        for (int eb = 0; eb < 2; ++eb) {
            bf16_t* yr = Y + (size_t)(tok0 + rp * 32 + eb * 16 + fr) * D + hq * 64 + 4 * fq;
#pragma unroll
            for (int mt = 0; mt < 4; ++mt) {
                u32x2 w; w.x = pk2(oacc[eb][mt][0] * rden[eb], oacc[eb][mt][1] * rden[eb]); w.y = pk2(oacc[eb][mt][2] * rden[eb], oacc[eb][mt][3] * rden[eb]);
                *(u32x2*)(yr + mt * 16) = w;
            }
        }
    }
#undef ATT_FETCH
}

}

namespace mk {
constexpr int RL = 144;
constexpr int PSL = 72;
constexpr int OBL = 132;
constexpr int R_QT = 0, R_KT = 64 * RL * 2, R_KD = 2 * 64 * RL * 2, R_V = 3 * 64 * RL * 2, R_SB = 4 * 64 * RL * 2;
constexpr int R_PS = R_SB + 128 * RL * 2;
constexpr int R_VEC = R_PS + 64 * PSL * 2;
constexpr int R_OB = R_KT;
constexpr int REC_LDS = R_VEC + 12288;
static_assert(64 * OBL * 4 <= 2 * 64 * RL * 2, "OB overlay");
constexpr int ST_STRIDE = 16384 + 256;

__device__ __forceinline__ bf16x8 ld_row_split(const LAS bf16_t* p) {
    const s16x4 a = *(const LAS s16x4*)p, b = *(const LAS s16x4*)(p + 16);
    bf16x8 r; r[0] = a[0]; r[1] = a[1]; r[2] = a[2]; r[3] = a[3]; r[4] = b[0]; r[5] = b[1]; r[6] = b[2]; r[7] = b[3];
    return r;
}
__device__ __forceinline__ float clamp80(float x) { return fminf(fmaxf(x, -80.f), 80.f); }
__device__ __forceinline__ float sigm(float x) { return __builtin_amdgcn_rcpf(1.f + __builtin_amdgcn_exp2f(x * -1.4426950408889634f)); }
__device__ __forceinline__ void st_bf16(LAS bf16_t* p, float v) { *p = (bf16_t)(pk2(v, 0.f) & 0xffffu); }

__device__ __forceinline__ void state_update(pg8::f32x4 (&acc)[8], const LAS bf16_t* KDm, const LAS bf16_t* Vm, int wave, int fq, int tq, int tp) {
    bf16x8 ka[2];
#pragma unroll
    for (int ks = 0; ks < 2; ++ks) { const LAS bf16_t* p = KDm + (ks * 32 + 4 * fq + tq) * RL + 16 * wave + 4 * tp; ka[ks] = tr_pair(p, p + 16 * RL); }
#pragma unroll
    for (int j = 0; j < 8; ++j)
#pragma unroll
        for (int ks = 0; ks < 2; ++ks) {
            const LAS bf16_t* p = Vm + (ks * 32 + 4 * fq + tq) * RL + 16 * j + 4 * tp;
            const bf16x8 vb = tr_pair(p, p + 16 * RL);
            acc[j] = __builtin_amdgcn_mfma_f32_16x16x32_bf16(ka[ks], vb, acc[j], 0, 0, 0);
        }
}
__device__ __forceinline__ void state_to_lds(const pg8::f32x4 (&acc)[8], const float (&rsc)[4], LAS bf16_t* SBm, int wave, int fr, int fq) {
#pragma unroll
    for (int j = 0; j < 8; ++j)
#pragma unroll
        for (int r = 0; r < 4; ++r) st_bf16(SBm + (16 * wave + 4 * fq + r) * RL + 16 * j + fr, acc[j][r] * rsc[r]);
}
__device__ __forceinline__ void score_tile(pg8::f32x4& acc, const LAS bf16_t* Am, const LAS bf16_t* Bm, int ti, int tj, int fr, int fq) {
    acc = (pg8::f32x4){0.f, 0.f, 0.f, 0.f};
#pragma unroll
    for (int ks = 0; ks < 4; ++ks) {
        const bf16x8 a = *(const LAS bf16x8*)(Am + (16 * ti + fr) * RL + ks * 32 + 8 * fq);
        const bf16x8 b = *(const LAS bf16x8*)(Bm + (16 * tj + fr) * RL + ks * 32 + 8 * fq);
        acc = __builtin_amdgcn_mfma_f32_16x16x32_bf16(a, b, acc, 0, 0, 0);
    }
}
struct TileRegs { u32x4 a, b; };
__device__ __forceinline__ TileRegs tile_load(const bf16_t* __restrict__ src, int tid) {
    const int row = tid >> 3, seg = tid & 7;
    const bf16_t* s = src + (size_t)row * NP + seg * 16;
    TileRegs t; t.a = *(const u32x4*)s; t.b = *(const u32x4*)(s + 8); return t;
}
__device__ __forceinline__ void tile_store(const TileRegs& t, LAS bf16_t* dst, int tid) {
    const int row = tid >> 3, seg = tid & 7;
    LAS bf16_t* d = dst + row * RL + seg * 16;
    *(LAS u32x4*)d = t.a; *(LAS u32x4*)(d + 8) = t.b;
}
__device__ __forceinline__ void state_store(const pg8::f32x4 (&acc)[8], float* __restrict__ dst, int wave, int lane) {
#pragma unroll
    for (int j = 0; j < 8; ++j)
#pragma unroll
        for (int r = 0; r < 4; ++r) dst[((wave * 8 + j) * 4 + r) * 64 + lane] = acc[j][r];
}

template <int PASS>
__device__ __forceinline__ void hgrn_unit(const bf16_t* __restrict__ P, const float* __restrict__ lb_logits, int layer, const float* __restrict__ gain_l,
                                          float* __restrict__ STB, bf16_t* __restrict__ Y, int unit, LAS unsigned char* lds, int tid, int lane, int wave) {
    const int chain = unit >> 3, g = unit & 7, b = chain >> 2, h = chain & 3;
    const int t0 = b * S + g * 512;
    const int fr = lane & 15, fq = lane >> 4, tq = (lane & 15) >> 2, tp = lane & 3;
    const int kp = tid & 63, rg = wave, c0 = 2 * kp;
    LAS bf16_t* QT = (LAS bf16_t*)(lds + R_QT); LAS bf16_t* KT = (LAS bf16_t*)(lds + R_KT); LAS bf16_t* KD = (LAS bf16_t*)(lds + R_KD);
    LAS bf16_t* VV = (LAS bf16_t*)(lds + R_V); LAS bf16_t* SB = (LAS bf16_t*)(lds + R_SB); LAS bf16_t* PS = (LAS bf16_t*)(lds + R_PS);
    LAS float* TOT = (LAS float*)(lds + R_VEC);
    LAS float* EREF = TOT + 1024; LAS float* ELAST = EREF + 128;
    LAS float* OB = (LAS float*)(lds + R_OB);
    float lb0 = 0.f, lb1 = 0.f;
    if (layer == 1) {
        const float a0 = lb_logits[h * 128 + c0], a1 = lb_logits[512 + h * 128 + c0], d0 = lb_logits[h * 128 + c0 + 1], d1 = lb_logits[512 + h * 128 + c0 + 1];
        const float m0 = fmaxf(a0, a1), m1 = fmaxf(d0, d1);
        lb0 = __expf(a1 - m0) / (__expf(a0 - m0) + __expf(a1 - m0));
        lb1 = __expf(d1 - m1) / (__expf(d0 - m1) + __expf(d1 - m1));
    }
    pg8::f32x4 acc[8];
#pragma unroll
    for (int j = 0; j < 8; ++j) acc[j] = (pg8::f32x4){0.f, 0.f, 0.f, 0.f};
    if (PASS == 2) {
        for (int jg = 0; jg < g; ++jg) {
            const float* sb = STB + (size_t)(chain * 8 + jg) * ST_STRIDE;
            float dk[4];
#pragma unroll
            for (int r = 0; r < 4; ++r) dk[r] = __expf(sb[16384 + 16 * wave + 4 * fq + r]);
#pragma unroll
            for (int j = 0; j < 8; ++j)
#pragma unroll
                for (int r = 0; r < 4; ++r) acc[j][r] = acc[j][r] * dk[r] + sb[((wave * 8 + j) * 4 + r) * 64 + lane];
        }
    }
    float gl0 = 0.f, gl1 = 0.f;
    unsigned fwn[8], qwn[8];
    {
#pragma unroll
        for (int i = 0; i < 8; ++i) { const bf16_t* pr = P + (size_t)(t0 + rg * 8 + i) * NP + h * 128 + c0; fwn[i] = *(const unsigned*)(pr + C_FH); if (PASS == 2) qwn[i] = *(const unsigned*)(pr + C_QH); }
    }
    TileRegs vnx = tile_load(P + (size_t)t0 * NP + C_IH + h * 128, tid);
#pragma unroll 1
    for (int c = 0; c < 8; ++c) {
        const int tr0 = t0 + c * 64;
        float lf0[8], lf1[8], kk0[8], kk1[8], qv0[8], qv1[8];
#pragma unroll
        for (int i = 0; i < 8; ++i) {
            const unsigned fw = fwn[i];
            const float z0 = bflo(fw), z1 = bfhi(fw);
            const float s0 = sigm(z0), s1 = sigm(z1);
            lf0[i] = __logf(fmaxf(lb0 + (1.f - lb0) * s0, 1e-30f)); lf1[i] = __logf(fmaxf(lb1 + (1.f - lb1) * s1, 1e-30f));
            kk0[i] = (1.f - lb0) * (1.f - s0); kk1[i] = (1.f - lb1) * (1.f - s1);
            if (PASS == 2) { const unsigned qw = qwn[i]; const float q0 = bflo(qw), q1 = bfhi(qw); qv0[i] = q0 * sigm(q0); qv1[i] = q1 * sigm(q1); }
        }
#pragma unroll
        for (int i = 1; i < 8; ++i) { lf0[i] += lf0[i - 1]; lf1[i] += lf1[i - 1]; }
        TOT[rg * 128 + c0] = lf0[7]; TOT[rg * 128 + c0 + 1] = lf1[7];
        tile_store(vnx, VV, tid);
        if (c < 7) vnx = tile_load(P + (size_t)(tr0 + 64) * NP + C_IH + h * 128, tid);
        if (c < 7) {
            const int trn = tr0 + 64;
#pragma unroll
            for (int i = 0; i < 8; ++i) { const bf16_t* pr = P + (size_t)(trn + rg * 8 + i) * NP + h * 128 + c0; fwn[i] = *(const unsigned*)(pr + C_FH); if (PASS == 2) qwn[i] = *(const unsigned*)(pr + C_QH); }
        }
        __syncthreads();
        {
            float pre0 = 0.f, pre1 = 0.f, ref0 = 0.f, ref1 = 0.f, la0 = 0.f, la1 = 0.f;
#pragma unroll
            for (int r = 0; r < 8; ++r) {
                const float a0 = TOT[r * 128 + c0], a1 = TOT[r * 128 + c0 + 1];
                if (r < rg) { pre0 += a0; pre1 += a1; }
                if (r < 4) { ref0 += a0; ref1 += a1; }
                la0 += a0; la1 += a1;
            }
#pragma unroll
            for (int i = 0; i < 8; ++i) {
                const int row = rg * 8 + i;
                const float cu0 = pre0 + lf0[i], cu1 = pre1 + lf1[i];
                if (PASS == 2) {
                    *(LAS unsigned*)(QT + row * RL + c0) = pk2(qv0[i] * __expf(clamp80(cu0 - ref0)), qv1[i] * __expf(clamp80(cu1 - ref1)));
                    *(LAS unsigned*)(KT + row * RL + c0) = pk2(kk0[i] * __expf(clamp80(ref0 - cu0)), kk1[i] * __expf(clamp80(ref1 - cu1)));
                }
                *(LAS unsigned*)(KD + row * RL + c0) = pk2(kk0[i] * __expf(la0 - cu0), kk1[i] * __expf(la1 - cu1));
            }
            if (rg == 0) { EREF[c0] = __expf(ref0); EREF[c0 + 1] = __expf(ref1); ELAST[c0] = __expf(la0); ELAST[c0 + 1] = __expf(la1); }
            gl0 += la0; gl1 += la1;
        }
        __syncthreads();
        TileRegs gcur = {};
        if (PASS == 2) gcur = tile_load(P + (size_t)tr0 * NP + C_GH + h * 128, tid);
        pg8::f32x4 o[4];
        if (PASS == 2) {
            { float rs[4];
#pragma unroll
              for (int r = 0; r < 4; ++r) rs[r] = EREF[16 * wave + 4 * fq + r];
              state_to_lds(acc, rs, SB, wave, fr, fq); }
            { const int ti = wave >> 1;
#pragma unroll
              for (int tjj = 0; tjj < 2; ++tjj) {
                  const int tj = 2 * (wave & 1) + tjj;
                  pg8::f32x4 sa = {0.f, 0.f, 0.f, 0.f};
                  if (tj <= ti) score_tile(sa, QT, KT, ti, tj, fr, fq);
#pragma unroll
                  for (int r = 0; r < 4; ++r) {
                      const int t = 16 * ti + 4 * fq + r, s = 16 * tj + fr;
                      st_bf16(PS + t * PSL + s, (s <= t) ? sa[r] : 0.f);
                  }
              } }
        }
        {
#pragma unroll
            for (int r = 0; r < 4; ++r) { const float el = ELAST[16 * wave + 4 * fq + r];
#pragma unroll
                for (int j = 0; j < 8; ++j) acc[j][r] *= el; }
            state_update(acc, KD, VV, wave, fq, tq, tp);
        }
        if (PASS == 2) {
            __syncthreads();
            bf16x8 sbf[4], vbf[2];
#pragma unroll
            for (int ks = 0; ks < 4; ++ks) { const LAS bf16_t* p = SB + (ks * 32 + 4 * fq + tq) * RL + 16 * wave + 4 * tp; sbf[ks] = tr_pair(p, p + 16 * RL); }
#pragma unroll
            for (int ks = 0; ks < 2; ++ks) { const LAS bf16_t* p = VV + (ks * 32 + 4 * fq + tq) * RL + 16 * wave + 4 * tp; vbf[ks] = tr_pair(p, p + 16 * RL); }
#pragma unroll
            for (int ti = 0; ti < 4; ++ti) {
                o[ti] = (pg8::f32x4){0.f, 0.f, 0.f, 0.f};
#pragma unroll
                for (int ks = 0; ks < 4; ++ks) o[ti] = __builtin_amdgcn_mfma_f32_16x16x32_bf16(ld_row_split(QT + (16 * ti + fr) * RL + ks * 32 + 4 * fq), sbf[ks], o[ti], 0, 0, 0);
#pragma unroll
                for (int ks = 0; ks < 2; ++ks) o[ti] = __builtin_amdgcn_mfma_f32_16x16x32_bf16(ld_row_split(PS + (16 * ti + fr) * PSL + ks * 32 + 4 * fq), vbf[ks], o[ti], 0, 0, 0);
            }
        }
        __syncthreads();
        if (PASS == 2) {
#pragma unroll
            for (int ti = 0; ti < 4; ++ti)
#pragma unroll
                for (int r = 0; r < 4; ++r) OB[(16 * ti + 4 * fq + r) * OBL + 16 * wave + fr] = o[ti][r];
            __syncthreads();
            const int t = tid >> 3, seg = tid & 7;
            float ov[16]; float ss = 0.f;
#pragma unroll
            for (int q = 0; q < 4; ++q) { const f32x4 a = *(const LAS f32x4*)(OB + t * OBL + seg * 16 + 4 * q); ov[4 * q] = a.x; ov[4 * q + 1] = a.y; ov[4 * q + 2] = a.z; ov[4 * q + 3] = a.w;
                ss += (a.x * a.x + a.y * a.y) + (a.z * a.z + a.w * a.w); }
            ss = sum8(ss);
            const float rn = rsqrtf(ss * (1.f / 128.f) + EPS);
            const u32x4 g0 = gcur.a, g1 = gcur.b;
            const float* gnp = gain_l + h * 128 + seg * 16;
            u32x4 y0, y1;
#pragma unroll
            for (int q = 0; q < 4; ++q) {
                const float ga = bflo(g0[q]), gb = bfhi(g0[q]), gc = bflo(g1[q]), gd = bfhi(g1[q]);
                y0[q] = pk2(ov[2 * q] * rn * gnp[2 * q] * (ga * sigm(ga)), ov[2 * q + 1] * rn * gnp[2 * q + 1] * (gb * sigm(gb)));
                y1[q] = pk2(ov[8 + 2 * q] * rn * gnp[8 + 2 * q] * (gc * sigm(gc)), ov[8 + 2 * q + 1] * rn * gnp[8 + 2 * q + 1] * (gd * sigm(gd)));
            }
            bf16_t* yp = Y + (size_t)(tr0 + t) * D + 1024 + h * 128 + seg * 16;
            *(u32x4*)yp = y0; *(u32x4*)(yp + 8) = y1;
        }
    }
    if (PASS == 1) {
        float* sb = STB + (size_t)(chain * 8 + g) * ST_STRIDE;
        state_store(acc, sb, wave, lane);
        if (rg == 0) { sb[16384 + c0] = gl0; sb[16384 + c0 + 1] = gl1; }
    }
}

template <int PASS>
__device__ __forceinline__ void mlstm_unit(const bf16_t* __restrict__ P, const float* __restrict__ conv_l, const float* __restrict__ ib_l, const float* __restrict__ fb_l,
                                           float* __restrict__ STB, bf16_t* __restrict__ Y, int unit, LAS unsigned char* lds, int tid, int lane, int wave) {
    const int chain = unit >> 3, g = unit & 7, b = chain >> 2, h = chain & 3;
    const int t0 = b * S + g * 512;
    const int fr = lane & 15, fq = lane >> 4, tq = (lane & 15) >> 2, tp = lane & 3;
    const int kp = tid & 63, rg = wave, c0 = 2 * kp;
    LAS bf16_t* QM = (LAS bf16_t*)(lds + R_QT); LAS bf16_t* KM = (LAS bf16_t*)(lds + R_KT); LAS bf16_t* KW = (LAS bf16_t*)(lds + R_KD);
    LAS bf16_t* VV = (LAS bf16_t*)(lds + R_V); LAS bf16_t* CB = (LAS bf16_t*)(lds + R_SB); LAS bf16_t* PS = (LAS bf16_t*)(lds + R_PS);
    LAS float* VEC = (LAS float*)(lds + R_VEC);
    LAS float* GA = VEC;
    LAS float* GPM = VEC + 512;
    LAS float* GCUM = VEC + 1024;
    LAS float* NV = VEC + 1536;
    LAS float* DENP = VEC + 1664;
    LAS float* DINT = VEC + 1792;
    LAS float* KSUM = VEC + 1856;
    LAS float* OB = (LAS float*)(lds + R_OB);
    float wq0[4], wq1[4], wk0[4], wk1[4];
#pragma unroll
    for (int j = 0; j < 4; ++j) {
        wq0[j] = conv_l[j * 1024 + h * 128 + c0]; wq1[j] = conv_l[j * 1024 + h * 128 + c0 + 1];
        wk0[j] = conv_l[j * 1024 + 512 + h * 128 + c0]; wk1[j] = conv_l[j * 1024 + 512 + h * 128 + c0 + 1];
    }
    {
        const bf16_t* pr = P + (size_t)(t0 + wave * 64 + lane) * NP;
        const float ip = bf2f(pr[C_IM + h]) + ib_l[h];
        const float z = bf2f(pr[C_FM + h]) + fb_l[h];
        const float lf = fminf(z, 0.f) - __logf(1.f + __expf(-fabsf(z)));
        float cu = lf;
#pragma unroll
        for (int o = 1; o < 64; o <<= 1) { const float t = __shfl_up(cu, o); if (lane >= o) cu += t; }
        const float a = ip - cu;
        float pm = a;
#pragma unroll
        for (int o = 1; o < 64; o <<= 1) { const float t = __shfl_up(pm, o); if (lane >= o) pm = fmaxf(pm, t); }
        GA[wave * 64 + lane] = a; GPM[wave * 64 + lane] = pm; GCUM[wave * 64 + lane] = cu;
    }
    pg8::f32x4 acc[8];
#pragma unroll
    for (int j = 0; j < 8; ++j) acc[j] = (pg8::f32x4){0.f, 0.f, 0.f, 0.f};
    float mprev = (PASS == 1) ? -1e30f : 0.f;
    float nreg = 0.f;
    float fsum = 0.f;
    if (PASS == 2) {
        for (int jg = 0; jg < g; ++jg) {
            const float* sb = STB + (size_t)(chain * 8 + jg) * ST_STRIDE;
            const float mE = sb[16384 + 128], F = sb[16384 + 129];
            const float mn = fmaxf(F + mprev, mE);
            const float s1 = __expf(F + mprev - mn), s2 = __expf(mE - mn);
#pragma unroll
            for (int j = 0; j < 8; ++j)
#pragma unroll
                for (int r = 0; r < 4; ++r) acc[j][r] = acc[j][r] * s1 + s2 * sb[((wave * 8 + j) * 4 + r) * 64 + lane];
            if (tid < 128) nreg = nreg * s1 + s2 * sb[16384 + tid];
            mprev = mn;
        }
    }
    if (tid < 128) NV[tid] = nreg;
    unsigned xqn[11], xkn[11];
#define MLSTM_FETCH(TR0, CC) do { _Pragma("unroll") for (int i = 0; i < 11; ++i) { \
            const int row_ = rg * 8 + i - 3; const int pos_ = g * 512 + (CC) * 64 + row_; unsigned wq_ = 0u, wk_ = 0u; \
            if (pos_ >= 0) { const bf16_t* pr_ = P + (size_t)((TR0) + row_) * NP + h * 128 + c0; if (PASS == 2) wq_ = *(const unsigned*)(pr_ + C_QM); wk_ = *(const unsigned*)(pr_ + C_KM); } \
            xqn[i] = wq_; xkn[i] = wk_; } \
        } while (0)
    MLSTM_FETCH(t0, 0);
    TileRegs vnx = tile_load(P + (size_t)t0 * NP + C_VM + h * 128, tid);
    __syncthreads();
#pragma unroll 1
    for (int c = 0; c < 8; ++c) {
        const int tr0 = t0 + c * 64;
        const LAS float* AV = GA + c * 64; const LAS float* PM = GPM + c * 64; const LAS float* CUM = GCUM + c * 64;
        const float M63 = fmaxf(PM[63], mprev), last = CUM[63];
        float ks0 = 0.f, ks1 = 0.f;
#pragma unroll
        for (int i = 0; i < 8; ++i) {
            const int row = rg * 8 + i;
            float k0v = 0.f, k1v = 0.f, q0v = 0.f, q1v = 0.f;
#pragma unroll
            for (int j = 0; j < 4; ++j) { k0v += wk0[j] * bflo(xkn[i + j]); k1v += wk1[j] * bfhi(xkn[i + j]); if (PASS == 2) { q0v += wq0[j] * bflo(xqn[i + j]); q1v += wq1[j] * bfhi(xqn[i + j]); } }
            k0v = k0v * sigm(k0v) * 0.08838834764831845f; k1v = k1v * sigm(k1v) * 0.08838834764831845f;
            const float wsr = __expf(AV[row] - M63);
            const unsigned kw = pk2(k0v * wsr, k1v * wsr);
            *(LAS unsigned*)(KW + row * RL + c0) = kw;
            ks0 += bflo(kw); ks1 += bfhi(kw);
            if (PASS == 2) {
                *(LAS unsigned*)(KM + row * RL + c0) = pk2(k0v, k1v);
                *(LAS unsigned*)(QM + row * RL + c0) = pk2(q0v * sigm(q0v), q1v * sigm(q1v));
            }
        }
        KSUM[rg * 128 + c0] = ks0; KSUM[rg * 128 + c0 + 1] = ks1;
        tile_store(vnx, VV, tid);
        if (c < 7) vnx = tile_load(P + (size_t)(tr0 + 64) * NP + C_VM + h * 128, tid);
        if (c < 7) MLSTM_FETCH(tr0 + 64, c + 1);
        const float decay = __expf(mprev - M63);
        pg8::f32x4 o1[4], o2[4];
        if (PASS == 2) {
            const float one[4] = {1.f, 1.f, 1.f, 1.f};
            state_to_lds(acc, one, CB, wave, fr, fq);
        }
        __syncthreads();
        TileRegs ocur = {};
        if (PASS == 2) ocur = tile_load(P + (size_t)tr0 * NP + C_OM + h * 128, tid);
        if (PASS == 2) {
            { const int ti = wave >> 1;
              float dp[4] = {0.f, 0.f, 0.f, 0.f};
#pragma unroll
              for (int tjj = 0; tjj < 2; ++tjj) {
                  const int tj = 2 * (wave & 1) + tjj;
                  pg8::f32x4 sa = {0.f, 0.f, 0.f, 0.f};
                  if (tj <= ti) score_tile(sa, QM, KM, ti, tj, fr, fq);
                  const int s = 16 * tj + fr;
                  const float as = AV[s];
#pragma unroll
                  for (int r = 0; r < 4; ++r) {
                      const int t = 16 * ti + 4 * fq + r;
                      const float w = (s <= t) ? sa[r] * __expf(as - fmaxf(PM[t], mprev)) : 0.f;
                      st_bf16(PS + t * PSL + s, w);
                      dp[r] += w;
                  }
              }
#pragma unroll
              for (int r = 0; r < 4; ++r) {
                  const float v = sum16(dp[r]);
                  if (fr == 0) DENP[(16 * ti + 4 * fq + r) * 2 + (wave & 1)] = v;
              } }
            { const int t = tid >> 3, seg = tid & 7;
              const bf16x8 qa = *(const LAS bf16x8*)(QM + t * RL + seg * 16), qb = *(const LAS bf16x8*)(QM + t * RL + seg * 16 + 8);
              float dsum = 0.f;
#pragma unroll
              for (int q = 0; q < 8; ++q) dsum += bf2f((unsigned short)qa[q]) * NV[seg * 16 + q] + bf2f((unsigned short)qb[q]) * NV[seg * 16 + 8 + q];
              dsum = sum8(dsum);
              if (seg == 0) DINT[t] = dsum; }
            {
                bf16x8 cbf[4];
#pragma unroll
                for (int ks = 0; ks < 4; ++ks) { const LAS bf16_t* p = CB + (ks * 32 + 4 * fq + tq) * RL + 16 * wave + 4 * tp; cbf[ks] = tr_pair(p, p + 16 * RL); }
#pragma unroll
                for (int ti = 0; ti < 4; ++ti) {
                    o2[ti] = (pg8::f32x4){0.f, 0.f, 0.f, 0.f};
#pragma unroll
                    for (int ks = 0; ks < 4; ++ks) o2[ti] = __builtin_amdgcn_mfma_f32_16x16x32_bf16(ld_row_split(QM + (16 * ti + fr) * RL + ks * 32 + 4 * fq), cbf[ks], o2[ti], 0, 0, 0);
                }
            }
        }
        {
#pragma unroll
            for (int j = 0; j < 8; ++j) acc[j] = acc[j] * decay;
            state_update(acc, KW, VV, wave, fq, tq, tp);
            if (tid < 128) {
                float sumk = 0.f;
#pragma unroll
                for (int r8 = 0; r8 < 8; ++r8) sumk += KSUM[r8 * 128 + tid];
                nreg = nreg * decay + sumk;
            }
        }
        if (PASS == 2) {
            __syncthreads();
            bf16x8 vbf[2];
#pragma unroll
            for (int ks = 0; ks < 2; ++ks) { const LAS bf16_t* p = VV + (ks * 32 + 4 * fq + tq) * RL + 16 * wave + 4 * tp; vbf[ks] = tr_pair(p, p + 16 * RL); }
#pragma unroll
            for (int ti = 0; ti < 4; ++ti) {
                o1[ti] = (pg8::f32x4){0.f, 0.f, 0.f, 0.f};
#pragma unroll
                for (int ks = 0; ks < 2; ++ks) o1[ti] = __builtin_amdgcn_mfma_f32_16x16x32_bf16(ld_row_split(PS + (16 * ti + fr) * PSL + ks * 32 + 4 * fq), vbf[ks], o1[ti], 0, 0, 0);
            }
        }
        fsum += last;
        const float mnew = last + M63;
        __syncthreads();
        if (tid < 128) NV[tid] = nreg;
        if (PASS == 2) {
#pragma unroll
            for (int ti = 0; ti < 4; ++ti)
#pragma unroll
                for (int r = 0; r < 4; ++r) {
                    const int t = 16 * ti + 4 * fq + r;
                    OB[t * OBL + 16 * wave + fr] = o1[ti][r] + __expf(mprev - fmaxf(PM[t], mprev)) * o2[ti][r];
                }
            __syncthreads();
            const int t = tid >> 3, seg = tid & 7;
            const float Mt = fmaxf(PM[t], mprev);
            const float wi = __expf(mprev - Mt);
            const float den = DENP[t * 2] + DENP[t * 2 + 1] + wi * DINT[t];
            const float hd = __builtin_amdgcn_rcpf(fmaxf(fabsf(den), __expf(-(CUM[t] + Mt))));
            const u32x4 g0 = ocur.a, g1 = ocur.b;
            const unsigned gw[8] = {g0[0], g0[1], g0[2], g0[3], g1[0], g1[1], g1[2], g1[3]};
            unsigned yw[8];
#pragma unroll
            for (int q = 0; q < 4; ++q) {
                const f32x4 a = *(const LAS f32x4*)(OB + t * OBL + seg * 16 + 4 * q);
                yw[2 * q] = pk2(a.x * hd * sigm(bflo(gw[2 * q])), a.y * hd * sigm(bfhi(gw[2 * q])));
                yw[2 * q + 1] = pk2(a.z * hd * sigm(bflo(gw[2 * q + 1])), a.w * hd * sigm(bfhi(gw[2 * q + 1])));
            }
            u32x4 y0, y1;
            y0[0] = yw[0]; y0[1] = yw[1]; y0[2] = yw[2]; y0[3] = yw[3]; y1[0] = yw[4]; y1[1] = yw[5]; y1[2] = yw[6]; y1[3] = yw[7];
            bf16_t* yp = Y + (size_t)(tr0 + t) * D + 1536 + h * 128 + seg * 16;
            *(u32x4*)yp = y0; *(u32x4*)(yp + 8) = y1;
        }
        mprev = mnew;
        __syncthreads();
    }
#undef MLSTM_FETCH
    if (PASS == 1) {
        float* sb = STB + (size_t)(chain * 8 + g) * ST_STRIDE;
        state_store(acc, sb, wave, lane);
        if (tid < 128) sb[16384 + tid] = nreg;
        if (tid == 0) { sb[16384 + 128] = mprev; sb[16384 + 129] = fsum; }
    }
}
}

namespace mk {
#define XB_TMO      128
#define XB_XCNT(j)  (256  + 64 * (j))
#define XB_XSUB(j)  (1280 + 64 * (j))
#define XB_XGEN(j)  (2304 + 64 * (j))
#define XB_TOP      3328
#define XB_TOPGEN   3392
#define XCD_BAR_WORDS 3456
#define XB_SPIN_CAP (1u << 18)

__device__ __forceinline__ unsigned xb_ld(unsigned* p)              { return __hip_atomic_load(p, __ATOMIC_RELAXED, __HIP_MEMORY_SCOPE_AGENT); }
__device__ __forceinline__ unsigned xb_add(unsigned* p, unsigned v) { return __hip_atomic_fetch_add(p, v, __ATOMIC_RELAXED, __HIP_MEMORY_SCOPE_AGENT); }
__device__ __forceinline__ unsigned xb_xcc_id() { return (unsigned)__builtin_amdgcn_s_getreg((3 << 11) | 20) & 0xFu; }
#define XB_SPIN(cond, bar) do { unsigned _sp = 0; while (cond) { __builtin_amdgcn_s_sleep(1); \
    if ((++_sp & 255u) == 0u) { if (xb_ld(&(bar)[XB_TMO])) break; if (_sp > XB_SPIN_CAP) { atomicAdd(&(bar)[XB_TMO], 1u); break; } } } } while (0)

struct XcdBarrier {
    unsigned* bar; unsigned x;
    volatile LAS unsigned* st;
};

__device__ __forceinline__ XcdBarrier xcd_barrier_post(unsigned* bar, volatile LAS unsigned* st) {
    XcdBarrier b; b.bar = bar; b.x = xb_xcc_id(); b.st = st;
    if (threadIdx.x == 0) (void)xb_add(&bar[XB_XCNT(b.x)], 1u);
    return b;
}
__device__ __forceinline__ void xcd_barrier_complete(unsigned* bar, unsigned x, unsigned& nloc, unsigned& nx) {
    const unsigned G = gridDim.x * gridDim.y * gridDim.z;
    unsigned sum, cnt, mine, sp = 0u;
    for (;;) {
        sum = 0u; cnt = 0u; mine = 0u;
#pragma unroll
        for (unsigned j = 0; j < 16; ++j) { const unsigned c = xb_ld(&bar[XB_XCNT(j)]); sum += c; cnt += (c > 0u) ? 1u : 0u; mine = (j == x) ? c : mine; }
        if (sum == G) break;
        __builtin_amdgcn_s_sleep(1);
        if ((++sp & 255u) == 0u) { if (xb_ld(&bar[XB_TMO])) break; if (sp > XB_SPIN_CAP) { atomicAdd(&bar[XB_TMO], 1u); break; } }
    }
    nloc = mine > 0u ? mine : 1u; nx = cnt > 0u ? cnt : 1u;
}

__device__ __forceinline__ void xcd_barrier(const XcdBarrier& b) {
    asm volatile("s_waitcnt vmcnt(0)" ::: "memory");
    __syncthreads();
    if (threadIdx.x == 0) {
        unsigned* bar = b.bar;
        __builtin_amdgcn_s_waitcnt(0);
        unsigned nloc = b.st[0], nx = b.st[1];
        if (nloc == 0u) { xcd_barrier_complete(bar, b.x, nloc, nx); b.st[0] = nloc; b.st[1] = nx; }
        const unsigned old = xb_add(&bar[XB_XSUB(b.x)], 1u);
        const unsigned gen = old / nloc;
        if (old + 1u == (gen + 1u) * nloc) {
            __builtin_amdgcn_fence(__ATOMIC_RELEASE, "agent");
            asm volatile("s_waitcnt vmcnt(0)" ::: "memory");
            const unsigned og = xb_add(&bar[XB_TOP], 1u);
            const unsigned tg = og / nx;
            if (og + 1u == (tg + 1u) * nx) xb_add(&bar[XB_TOPGEN], 1u);
            else XB_SPIN(xb_ld(&bar[XB_TOPGEN]) == tg, bar);
            __builtin_amdgcn_fence(__ATOMIC_ACQUIRE, "agent");
            xb_add(&bar[XB_XGEN(b.x)], 1u);
            asm volatile("s_waitcnt vmcnt(0)" ::: "memory");
        } else {
            XB_SPIN(xb_ld(&bar[XB_XGEN(b.x)]) == gen, bar);
            __builtin_amdgcn_fence(__ATOMIC_ACQUIRE, "agent");
            asm volatile("s_waitcnt vmcnt(0)" ::: "memory");
        }
    }
    __syncthreads();
}

}

namespace mk {
constexpr int NSLICE = 16, SLW = 128, TBLK = 128, NTB = T / TBLK;
constexpr int CTL_Q = 3584;

__device__ __forceinline__ f32x2 fma2(f32x2 a, f32x2 b, f32x2 c) { return __builtin_elementwise_fma(a, b, c); }

__device__ __forceinline__ int q_next(unsigned* cnt, LAS int* slot, int tid) {
    __syncthreads();
    if (tid == 0) *slot = (int)__hip_atomic_fetch_add(cnt, 1u, __ATOMIC_RELAXED, __HIP_MEMORY_SCOPE_AGENT);
    __syncthreads();
    const int v = *slot;
    return v < NTB ? v : -1;
}

typedef __amdgpu_buffer_rsrc_t rsrc_t;
__device__ __forceinline__ rsrc_t make_rsrc(const void* p, unsigned bytes) { return __builtin_amdgcn_make_buffer_rsrc((void*)p, 0, bytes, 0x00020000); }

constexpr int PL_IDX = 0, PL_AUX = TBLK * 128 * 4;
#define PEER_ISSUE(W, IDP) do { const LAS u32x4* ip_ = (const LAS u32x4*)(IDP); const u32x4 i0_ = ip_[0], i1_ = ip_[1], i2_ = ip_[2], i3_ = ip_[3]; \
        _Pragma("unroll") for (int k = 0; k < 4; ++k) { \
            W[k]      = __builtin_amdgcn_raw_buffer_load_b128(rs, (int)i0_[k] * SLW + c * 16, soff, 0); \
            W[4 + k]  = __builtin_amdgcn_raw_buffer_load_b128(rs, (int)i1_[k] * SLW + c * 16, soff, 0); \
            W[8 + k]  = __builtin_amdgcn_raw_buffer_load_b128(rs, (int)i2_[k] * SLW + c * 16, soff, 0); \
            W[12 + k] = __builtin_amdgcn_raw_buffer_load_b128(rs, (int)i3_[k] * SLW + c * 16, soff, 0); } } while (0)
constexpr float XS8 = 1.f;
typedef _Float16 h2_t __attribute__((ext_vector_type(2)));
template <int CTRL> __device__ __forceinline__ int dppi(int x) { return __builtin_amdgcn_mov_dpp(x, CTRL, 0xf, 0xf, true); }
template <int MODE>
__device__ __forceinline__ void u_compute(u32x4 (&w)[16], const LAS unsigned* xs, float* __restrict__ PART, int s, int t, int g, int c) {
    if (MODE == 1) { _Pragma("unroll") for (int k = 0; k < 16; ++k) asm volatile("" :: "v"(w[k])); return; }
    if (MODE == 2) { _Pragma("unroll") for (int k = 0; k < 16; ++k) asm volatile("" : "=v"(w[k])); }
    const u32x4 xi = *(const LAS u32x4*)xs;
    int r0 = 0, r1 = 0;
#pragma unroll
    for (int k = 0; k < 16; ++k) {
        int d = __builtin_amdgcn_sdot4((int)w[k][0], (int)xi[0], 0, false);
        d = __builtin_amdgcn_sdot4((int)w[k][1], (int)xi[1], d, false);
        d = __builtin_amdgcn_sdot4((int)w[k][2], (int)xi[2], d, false);
        d = __builtin_amdgcn_sdot4((int)w[k][3], (int)xi[3], d, false);
        d += dppi<DPP_XOR1>(d); d += dppi<DPP_XOR2>(d); d += dppi<DPP_HMIR>(d);
        if ((k >> 1) == c) { if (k & 1) r1 = d; else r0 = d; }
    }
    if (MODE == 2) { asm volatile("" :: "v"(r0), "v"(r1)); return; }
    ((unsigned*)PART)[((size_t)s * T + t) * 64 + 8 * g + c] = pk2((float)r0, (float)r1);
}
struct UStage { u32x4 id[8]; u32x4 x[4]; float am[4]; };
__device__ __forceinline__ void u_stage_load(UStage& r, int s, int tb, const bf16_t* __restrict__ XB, const int* __restrict__ IDX, const float* __restrict__ AMXP, int tid) {
    const u32x4* src = (const u32x4*)(IDX + (size_t)tb * TBLK * 128);
#pragma unroll
    for (int j = 0; j < 8; ++j) r.id[j] = src[tid + j * NTHR];
#pragma unroll
    for (int j = 0; j < 4; ++j) { const int e = tid + j * NTHR, tt = e >> 4, ch = e & 15; r.x[j] = *(const u32x4*)(XB + (size_t)(tb * TBLK + tt) * D + s * SLW + ch * 8);
        const float* ap = AMXP + (size_t)(tb * TBLK + tt) * 32 + 2 * ch; r.am[j] = fmaxf(ap[0], ap[1]); }
}
__device__ __forceinline__ void u_stage_store(const UStage& r, LAS unsigned char* lds, int tid) {
#pragma unroll
    for (int j = 0; j < 8; ++j) *(LAS u32x4*)(lds + PL_IDX + (size_t)(tid + j * NTHR) * 16) = r.id[j];
#pragma unroll
    for (int j = 0; j < 4; ++j) { const int e = tid + j * NTHR, tt = e >> 4, ch = e & 15;
        float am = r.am[j];
        am = fmaxf(am, dppf<DPP_XOR1>(am)); am = fmaxf(am, dppf<DPP_XOR2>(am)); am = fmaxf(am, dppf<DPP_HMIR>(am)); am = fmaxf(am, dppf<DPP_ROR8>(am));
        const float xs = am > 0.f ? 127.f * __builtin_amdgcn_rcpf(am) : 0.f;
        int lo, hi;
        lo = (__float2int_rn(bflo(r.x[j][0]) * xs) & 0xff) | ((__float2int_rn(bfhi(r.x[j][0]) * xs) & 0xff) << 8) | ((__float2int_rn(bflo(r.x[j][1]) * xs) & 0xff) << 16) | (__float2int_rn(bfhi(r.x[j][1]) * xs) << 24);
        hi = (__float2int_rn(bflo(r.x[j][2]) * xs) & 0xff) | ((__float2int_rn(bfhi(r.x[j][2]) * xs) & 0xff) << 8) | ((__float2int_rn(bflo(r.x[j][3]) * xs) & 0xff) << 16) | (__float2int_rn(bfhi(r.x[j][3]) * xs) << 24);
        u32x2 o; o.x = (unsigned)lo; o.y = (unsigned)hi;
        *(LAS u32x2*)(lds + PL_AUX + tt * 128 + ch * 8) = o; }
}
template <int MODE>
__device__ __forceinline__ void peer_u_run(int s, int tb, const unsigned char* __restrict__ U8, float* __restrict__ PART, LAS unsigned char* lds, int wave, int lane) {
    const int g = lane >> 3, c = lane & 7;
    const rsrc_t rs = make_rsrc(U8, (unsigned)((size_t)NE * D));
    const int soff = s * NE * SLW;
    constexpr int NTW = TBLK / NWAVES;
    const int tw = wave * NTW, t0 = tb * TBLK + tw;
    const LAS unsigned char* idb = lds + PL_IDX + (size_t)tw * 512 + g * 64;
    const LAS unsigned* xsb = (const LAS unsigned*)(lds + PL_AUX + (size_t)tw * 128) + c * 4;
    u32x4 wa[16], wb[16];
    if (MODE != 2) PEER_ISSUE(wa, idb);
#pragma unroll 1
    for (int i = 0; i < NTW; i += 2) {
        if (MODE != 2) PEER_ISSUE(wb, idb + (i + 1) * 512);
        u_compute<MODE>(wa, xsb + i * 32, PART, s, t0 + i, g, c);
        if (MODE != 2) PEER_ISSUE(wa, idb + min(i + 2, NTW - 1) * 512);
        u_compute<MODE>(wb, xsb + (i + 1) * 32, PART, s, t0 + i + 1, g, c);
    }
}
template <int MODE>
__device__ __forceinline__ void peer_u_block(int s, int tb, const bf16_t* __restrict__ XB, const int* __restrict__ IDX, const float* __restrict__ AMXP, const unsigned char* __restrict__ U8,
                                             float* __restrict__ PART, LAS unsigned char* lds, int tid, int wave, int lane) {
    UStage r; u_stage_load(r, s, tb, XB, IDX, AMXP, tid); u_stage_store(r, lds, tid);
    __syncthreads();
    peer_u_run<MODE>(s, tb, U8, PART, lds, wave, lane);
}

__device__ __forceinline__ void peer_act_token(int t, const float* __restrict__ PART, const float* __restrict__ ssp, const float* __restrict__ amxp, const int* __restrict__ IDX, const float* __restrict__ GATE,
                                               const f32x2* __restrict__ SC2, signed char* __restrict__ ACT, float* __restrict__ ASC, int lane) {
    float s0 = 0.f, s1 = 0.f;
    { unsigned w[NSLICE];
#pragma unroll
      for (int s = 0; s < NSLICE; ++s) w[s] = ((const unsigned*)PART)[((size_t)s * T + t) * 64 + lane];
#pragma unroll
      for (int s = 0; s < NSLICE; ++s) { s0 += bflo(w[s]); s1 += bfhi(w[s]); } }
    float sp = (lane < 32) ? ssp[(size_t)t * 32 + lane] : 0.f;
    sp = wsum(sp);
    float xam = (lane < 32) ? amxp[(size_t)t * 32 + lane] : 0.f;
    xam = wmax(xam);
    const float rs1 = rsqrtf(sp * (1.f / D) + EPS) * (xam * (1.f / 127.f));
    const u32x2 id = *(const u32x2*)(IDX + (size_t)t * 128 + 2 * lane);
    const f32x2 gt = *(const f32x2*)(GATE + (size_t)t * 128 + 2 * lane);
    const f32x2 c0 = SC2[id.x], c1 = SC2[id.y];
    const float a0 = gelu_erf(s0 * c0.x * rs1) * gt.x * c0.y;
    const float a1 = gelu_erf(s1 * c1.x * rs1) * gt.y * c1.y;
    const float am = wmax(fmaxf(fabsf(a0), fabsf(a1)));
    const float qs = am > 0.f ? 127.f * __builtin_amdgcn_rcpf(am) : 0.f;
    const unsigned short pk = (unsigned short)((__float2int_rn(a0 * qs) & 0xff) | ((__float2int_rn(a1 * qs) & 0xff) << 8));
    *(unsigned short*)(ACT + (size_t)t * 128 + 2 * lane) = pk;
    if (lane == 0) ASC[t] = am * (1.f / 127.f);
}

__device__ __forceinline__ float wsum_fast(float v) {
    v += dppf<DPP_XOR1>(v); v += dppf<DPP_XOR2>(v); v += dppf<DPP_HMIR>(v); v += dppf<DPP_ROR8>(v);
    { const auto s = __builtin_amdgcn_permlane16_swap(__float_as_uint(v), __float_as_uint(v), false, false); v = __uint_as_float(s[0]) + __uint_as_float(s[1]); }
    { const auto s = __builtin_amdgcn_permlane32_swap(__float_as_uint(v), __float_as_uint(v), false, false); v = __uint_as_float(s[0]) + __uint_as_float(s[1]); }
    return v;
}
__device__ __forceinline__ void tr4x4(unsigned d0, unsigned d1, unsigned d2, unsigned d3, unsigned (&t)[4]) {
    const unsigned x0 = __builtin_amdgcn_perm(d1, d0, 0x05010400u), x1 = __builtin_amdgcn_perm(d1, d0, 0x07030602u);
    const unsigned y0 = __builtin_amdgcn_perm(d3, d2, 0x05010400u), y1 = __builtin_amdgcn_perm(d3, d2, 0x07030602u);
    t[0] = __builtin_amdgcn_perm(y0, x0, 0x05040100u); t[1] = __builtin_amdgcn_perm(y0, x0, 0x07060302u);
    t[2] = __builtin_amdgcn_perm(y1, x1, 0x05040100u); t[3] = __builtin_amdgcn_perm(y1, x1, 0x07060302u);
}
template <int VMODE>
__device__ __forceinline__ void v_compute(u32x4 (&w)[16], const LAS unsigned* avp, float ascale, unsigned rw, bf16_t* __restrict__ XBio, float* __restrict__ OUT32,
                                          float* __restrict__ SS16, int s, int t, int g, int c, int lane) {
    const size_t off = (size_t)t * D + s * SLW + c * 16 + 2 * g;
    const f32x2 res = {bflo(rw), bfhi(rw)};
    const u32x4 a4 = *(const LAS u32x4*)avp;
    int acci[16];
#pragma unroll
    for (int i = 0; i < 16; ++i) acci[i] = 0;
#pragma unroll
    for (int k4 = 0; k4 < 4; ++k4)
#pragma unroll
        for (int q = 0; q < 4; ++q) {
            unsigned tt[4];
            tr4x4(w[4 * k4][q], w[4 * k4 + 1][q], w[4 * k4 + 2][q], w[4 * k4 + 3][q], tt);
#pragma unroll
            for (int j = 0; j < 4; ++j) acci[4 * q + j] = __builtin_amdgcn_sdot4((int)tt[j], (int)a4[k4], acci[4 * q + j], false);
        }
    int h4x[4], h4y[4];
#pragma unroll
    for (int q = 0; q < 4; ++q) {
        const auto sx = __builtin_amdgcn_permlane32_swap((unsigned)acci[2 * q], (unsigned)acci[2 * (4 + q)], false, false);
        const auto sy = __builtin_amdgcn_permlane32_swap((unsigned)acci[2 * q + 1], (unsigned)acci[2 * (4 + q) + 1], false, false);
        h4x[q] = (int)sx[0] + (int)sx[1]; h4y[q] = (int)sy[0] + (int)sy[1];
    }
    int h2x[2], h2y[2];
#pragma unroll
    for (int q = 0; q < 2; ++q) {
        const auto sx = __builtin_amdgcn_permlane16_swap((unsigned)h4x[q], (unsigned)h4x[2 + q], false, false);
        const auto sy = __builtin_amdgcn_permlane16_swap((unsigned)h4y[q], (unsigned)h4y[2 + q], false, false);
        h2x[q] = (int)sx[0] + (int)sx[1]; h2y[q] = (int)sy[0] + (int)sy[1];
    }
    const bool up = (g & 1) != 0;
    const int keepx = up ? h2x[1] : h2x[0], sendx = up ? h2x[0] : h2x[1], keepy = up ? h2y[1] : h2y[0], sendy = up ? h2y[0] : h2y[1];
    const int ix = keepx + dppi<DPP_ROR8>(sendx), iy = keepy + dppi<DPP_ROR8>(sendy);
    f32x2 o = {(float)ix * ascale + res.x, (float)iy * ascale + res.y};
    if (OUT32) *(f32x2*)(OUT32 + off) = o;
    else { const unsigned ow = pk2(o.x, o.y); *(unsigned*)(XBio + off) = ow; o = (f32x2){bflo(ow), bfhi(ow)}; }
    const float q2 = wsum_fast(o.x * o.x + o.y * o.y);
    if (lane == 0) SS16[(size_t)t * 16 + s] = q2;
}
constexpr int PLV_ACT = TBLK * 128 * 4;
constexpr int PLV_ASC = PLV_ACT + TBLK * 128;
struct VStage { u32x4 id[8]; u32x4 a[2]; float asc; };
__device__ __forceinline__ void v_stage_load(VStage& r, int tb, const signed char* __restrict__ ACT, const float* __restrict__ ASC, const int* __restrict__ IDX, int tid) {
    const u32x4* src = (const u32x4*)(IDX + (size_t)tb * TBLK * 128);
#pragma unroll
    for (int j = 0; j < 8; ++j) r.id[j] = src[tid + j * NTHR];
    const u32x4* srca = (const u32x4*)(ACT + (size_t)tb * TBLK * 128);
    r.a[0] = srca[tid]; r.a[1] = srca[tid + NTHR];
    r.asc = (tid < TBLK) ? ASC[(size_t)tb * TBLK + tid] : 0.f;
}
__device__ __forceinline__ void v_stage_store(const VStage& r, LAS unsigned char* lds, int tid) {
#pragma unroll
    for (int j = 0; j < 8; ++j) *(LAS u32x4*)(lds + PL_IDX + (size_t)(tid + j * NTHR) * 16) = r.id[j];
    *(LAS u32x4*)(lds + PLV_ACT + (size_t)tid * 16) = r.a[0]; *(LAS u32x4*)(lds + PLV_ACT + (size_t)(tid + NTHR) * 16) = r.a[1];
    if (tid < TBLK) *(LAS float*)(lds + PLV_ASC + tid * 4) = r.asc;
}
template <int VMODE>
__device__ __forceinline__ void peer_v_run(int s, int tb, const unsigned char* __restrict__ V8, bf16_t* __restrict__ XBio, float* __restrict__ OUT32, float* __restrict__ SS16,
                                           LAS unsigned char* lds, int wave, int lane) {
    const int g = lane >> 3, c = lane & 7;
    const rsrc_t rs = make_rsrc(V8, (unsigned)((size_t)NE * D));
    const int soff = s * NE * SLW;
    constexpr int NTW = TBLK / NWAVES;
    const int tw = wave * NTW, t0 = tb * TBLK + tw;
    const LAS unsigned char* idb = lds + PL_IDX + (size_t)tw * 512 + g * 64;
    const LAS unsigned* avb = (const LAS unsigned*)(lds + PLV_ACT + (size_t)tw * 128) + g * 4;
    const LAS float* ascb = (const LAS float*)(lds + PLV_ASC) + tw;
    const bf16_t* rbase = XBio + (size_t)t0 * D + s * SLW + c * 16 + 2 * g;
    u32x4 wa[16], wb[16];
    unsigned ra = *(const unsigned*)rbase, rb;
    PEER_ISSUE(wa, idb);
#pragma unroll 1
    for (int i = 0; i < NTW; i += 2) {
        rb = *(const unsigned*)(rbase + (size_t)(i + 1) * D);
        PEER_ISSUE(wb, idb + (i + 1) * 512);
        v_compute<VMODE>(wa, avb + i * 32, ascb[i], ra, XBio, OUT32, SS16, s, t0 + i, g, c, lane);
        ra = *(const unsigned*)(rbase + (size_t)min(i + 2, NTW - 1) * D);
        PEER_ISSUE(wa, idb + min(i + 2, NTW - 1) * 512);
        v_compute<VMODE>(wb, avb + (i + 1) * 32, ascb[i + 1], rb, XBio, OUT32, SS16, s, t0 + i + 1, g, c, lane);
    }
}
__device__ __forceinline__ void peer_v_block(int s, int tb, const signed char* __restrict__ ACT, const float* __restrict__ ASC, const int* __restrict__ IDX, const unsigned char* __restrict__ V8,
                                             bf16_t* __restrict__ XBio, float* __restrict__ OUT32, float* __restrict__ SS16,
                                             LAS unsigned char* lds, int tid, int wave, int lane) {
    VStage r; v_stage_load(r, tb, ACT, ASC, IDX, tid); v_stage_store(r, lds, tid);
    __syncthreads();
    peer_v_run<0>(s, tb, V8, XBio, OUT32, SS16, lds, wave, lane);
}

__device__ __forceinline__ int slice_of(int xcc, int j) { const int xx = (xcc + (j >> 1)) & 7; return xx + 8 * (j & 1); }

__device__ __forceinline__ void final_norm_row(const bf16_t* __restrict__ xrow, float* __restrict__ orow, const float* __restrict__ ss16, const float* __restrict__ g, int lane) {
    float sp = (lane < 16) ? ss16[lane] : 0.f;
    sp = wsum(sp);
    const float rf = rsqrtf(sp * (1.f / D) + EPS);
    const u32x2* xi = (const u32x2*)xrow + lane;
    f32x4* o = (f32x4*)orow + lane;
    const f32x4* g4 = (const f32x4*)g + lane;
    u32x2 xv[8];
#pragma unroll
    for (int j = 0; j < 8; ++j) xv[j] = xi[64 * j];
#pragma unroll
    for (int j = 0; j < 8; ++j) { const f32x4 gg = g4[64 * j]; f32x4 v = {bflo(xv[j].x), bfhi(xv[j].x), bflo(xv[j].y), bfhi(xv[j].y)}; v = v * rf * gg; o[64 * j] = v; }
}
}

namespace mk {
#define IN(k) (lo <= (k) && (k) < hi)
#define GSYNC() do { if (coop) xcd_barrier(xb); } while (0)
template <int l>
__device__ __forceinline__ void layer_body(const Params& p, LAS unsigned char* lds, unsigned char* ws, int G, int tid, int lane, int wave, int lo, int hi, bool coop, const XcdBarrier& xb) {

    if (IN(1)) _Pragma("unroll") for (int rep = 0; rep < REP1; ++rep) {
        const int nh = (G == 256) ? NHELP : 0, Gg = G - nh;
        if ((int)blockIdx.x < Gg) {
            pg8::Gemm g{(const bf16_t*)(ws + WS_XB), (const bf16_t*)(ws + WS_WINT) + (size_t)l * NP * D, T, NP, D};
            pg8::StaticOrder So; So.init(T, NP, Gg, (int)blockIdx.x);
            EpiScaleBf16<16> E{(bf16_t*)(ws + WS_P), NP, (const float*)(ws + WS_SS)};
            pg8::gemm_phase<EpiScaleBf16<16>, pg8::StaticOrder, true, true>(lds, g, So, E);
        } else {
            tables_convert(p, l, 0, HROWS, ((int)blockIdx.x - Gg) * NWAVES + wave, nh * NWAVES, lane);
        }
        GSYNC();
    }
    if (IN(2)) _Pragma("unroll") for (int rep = 0; rep < REP2; ++rep) {
        for (int u = blockIdx.x; u < 256; u += G) {
            int tq_ = tid; asm volatile("" : "+v"(tq_)); const int tid = tq_, lane = tq_ & 63, wave = __builtin_amdgcn_readfirstlane(tq_ >> 6);
            if (u < 128) hgrn_unit<1>((const bf16_t*)(ws + WS_P), p.in[5], l, nullptr, (float*)(ws + WS_STH), nullptr, u, lds, tid, lane, wave);
            else mlstm_unit<1>((const bf16_t*)(ws + WS_P), p.in[7] + (size_t)l * 4 * 1024, p.in[8] + l * 4, p.in[9] + l * 4, (float*)(ws + WS_STM), nullptr, u - 128, lds, tid, lane, wave);
            __syncthreads();
        }
        GSYNC();
    }
    if (IN(3)) {
        _Pragma("unroll") for (int rep = 0; rep < REP4; ++rep)
        for (int u = blockIdx.x; u < 256; u += G) {
            int tq_ = tid; asm volatile("" : "+v"(tq_)); const int tid = tq_, lane = tq_ & 63, wave = __builtin_amdgcn_readfirstlane(tq_ >> 6);
            if (u < 128) hgrn_unit<2>((const bf16_t*)(ws + WS_P), p.in[5], l, p.in[6] + l * 512, (float*)(ws + WS_STH), (bf16_t*)(ws + WS_YB), u, lds, tid, lane, wave);
            else mlstm_unit<2>((const bf16_t*)(ws + WS_P), p.in[7] + (size_t)l * 4 * 1024, p.in[8] + l * 4, p.in[9] + l * 4, (float*)(ws + WS_STM), (bf16_t*)(ws + WS_YB), u - 128, lds, tid, lane, wave);
            __syncthreads();
        }
        _Pragma("unroll") for (int rep = 0; rep < REP3; ++rep)
        for (int u = blockIdx.x; u < 256; u += G) {
            int tq_ = tid; asm volatile("" : "+v"(tq_)); const int tid = tq_, lane = tq_ & 63, wave = __builtin_amdgcn_readfirstlane(tq_ >> 6);
            attn_unit((const bf16_t*)(ws + WS_P), (const f32x2*)(ws + WS_ROPE), p.in[4] + l * 16, (bf16_t*)(ws + WS_YB), u, lds, tid, lane, wave);
            __syncthreads();
        }
        GSYNC();
    }
    if (IN(4)) {
        pg8::Gemm g{(const bf16_t*)(ws + WS_YB), (const bf16_t*)(ws + WS_WOUTT) + (size_t)l * D * D, T, D, D};
        pg8::StaticOrder So; So.init(T, D, G, (int)blockIdx.x);
        EpiX1 E{l == 0 ? p.in[0] : (const float*)nullptr, (bf16_t*)(ws + WS_XB), (float*)(ws + WS_SSP), (float*)(ws + WS_AMXP)};
        pg8::gemm_phase<EpiX1, pg8::StaticOrder, true, true>(lds, g, So, E);
        GSYNC();
    }
    if (IN(5)) _Pragma("unroll") for (int rep = 0; rep < REP5; ++rep) {
        pg8::Gemm g{(const bf16_t*)(ws + WS_XB), (const bf16_t*)(ws + WS_WQT) + (size_t)l * D * D, T, D, D};
        pg8::StaticOrder So; So.init(T, D, G, (int)blockIdx.x);
        EpiScaleBf16<32> E{(bf16_t*)(ws + WS_Q), D, (const float*)(ws + WS_SSP)};
        pg8::gemm_phase<EpiScaleBf16<32>, pg8::StaticOrder, true, true>(lds, g, So, E);
        pg8::Unit u;
        for (int i = 0; So.next(i, u); ++i)
            route_unit((const bf16_t*)(ws + WS_Q), (const bf16_t*)(ws + WS_SUBK) + (size_t)l * 2 * 8 * 128 * 128, u.pm, u.pn, (int*)(ws + WS_IDX), (int*)(ws + WS_IDXU), (float*)(ws + WS_GATE), lds, tid, wave, lane);
        GSYNC();
    }
    if (IN(6)) {

        LAS int* slot = (LAS int*)(lds + LDS_BYTES - 32);
        if (G == 256) {
            const int grp = (int)blockIdx.x & 7, rank = (int)blockIdx.x >> 3;
            _Pragma("unroll") for (int rr = 0; rr < REP6; ++rr) {
            UStage st; u_stage_load(st, grp, rank * 4, (const bf16_t*)(ws + WS_XB), (const int*)(ws + WS_IDX), (const float*)(ws + WS_AMXP), tid);
            for (int j = 0; j < 8; ++j) {
                const int s = grp + 8 * (j >> 2), tb = rank * 4 + (j & 3);
                __syncthreads();
                u_stage_store(st, lds, tid);
                __syncthreads();
                if (j < 7) u_stage_load(st, grp + 8 * ((j + 1) >> 2), rank * 4 + ((j + 1) & 3), (const bf16_t*)(ws + WS_XB), (const int*)(ws + WS_IDX), (const float*)(ws + WS_AMXP), tid);
                peer_u_run<0>(s, tb, ws + WS_U8 + (size_t)l * NE * D, (float*)(ws + WS_PART), lds, wave, lane);
            }
            }
        } else {
            const int xcc = (int)xb_xcc_id();
            unsigned* qc = (unsigned*)(ws + WS_CTL) + CTL_Q + ((l * 2 + 0) * 2 + 0) * 16;
            for (int j = 0; j < NSLICE; ++j) {
                const int s = slice_of(xcc, j);
                for (;;) {
                    const int tb = q_next(qc + s, slot, tid);
                    if (tb < 0) break;
                    peer_u_block<0>(s, tb, (const bf16_t*)(ws + WS_XB), (const int*)(ws + WS_IDX), (const float*)(ws + WS_AMXP), ws + WS_U8 + (size_t)l * NE * D, (float*)(ws + WS_PART), lds, tid, wave, lane);
                }
            }
        }
        GSYNC();
    }
    if (IN(7)) {

        const int gw = blockIdx.x * NWAVES + wave, ngw = G * NWAVES;
        _Pragma("unroll") for (int rep = 0; rep < REP7; ++rep)
        for (int t = gw; t < T; t += ngw)
            peer_act_token(t, (const float*)(ws + WS_PART), (const float*)(ws + WS_SSP), (const float*)(ws + WS_AMXP), (const int*)(ws + WS_IDX), (const float*)(ws + WS_GATE),
                           (const f32x2*)(ws + WS_USC) + l * NE, (signed char*)(ws + WS_ACT), (float*)(ws + WS_ASC), lane);
        GSYNC();
    }
    if (IN(8)) {

        LAS int* slot = (LAS int*)(lds + LDS_BYTES - 32);
        if (G == 256) {
            const int grp = (int)blockIdx.x & 7, rank = (int)blockIdx.x >> 3;
            {
            VStage st; v_stage_load(st, rank * 4, (const signed char*)(ws + WS_ACT), (const float*)(ws + WS_ASC), (const int*)(ws + WS_IDX), tid);
            for (int j = 0; j < 8; ++j) {
                const int s = grp + 8 * (j >> 2), tb = rank * 4 + (j & 3);
                __syncthreads();
                v_stage_store(st, lds, tid);
                __syncthreads();
                if (j < 7) v_stage_load(st, rank * 4 + ((j + 1) & 3), (const signed char*)(ws + WS_ACT), (const float*)(ws + WS_ASC), (const int*)(ws + WS_IDX), tid);
                peer_v_run<0>(s, tb, ws + WS_V8 + (size_t)l * NE * D, (bf16_t*)(ws + WS_XB), (float*)nullptr, (float*)(ws + WS_SS), lds, wave, lane);
            }
            }
        } else {
            const int xcc = (int)xb_xcc_id();
            unsigned* qc = (unsigned*)(ws + WS_CTL) + CTL_Q + ((l * 2 + 1) * 2 + 0) * 16;
            for (int j = 0; j < NSLICE; ++j) {
                const int s = slice_of(xcc, j);
                for (;;) {
                    const int tb = q_next(qc + s, slot, tid);
                    if (tb < 0) break;
                    peer_v_block(s, tb, (const signed char*)(ws + WS_ACT), (const float*)(ws + WS_ASC), (const int*)(ws + WS_IDX), ws + WS_V8 + (size_t)l * NE * D, (bf16_t*)(ws + WS_XB),
                                 (float*)nullptr, (float*)(ws + WS_SS), lds, tid, wave, lane);
                }
            }
        }
    }
    if (l == 1 && IN(9)) {
        GSYNC();
        const int gw = blockIdx.x * NWAVES + wave, ngw = G * NWAVES;
        for (int t = gw; t < T; t += ngw) final_norm_row((const bf16_t*)(ws + WS_XB) + (size_t)t * D, p.out + (size_t)t * D, (const float*)(ws + WS_SS) + (size_t)t * 16, p.in[15], lane);
    }
}
__global__ void __launch_bounds__(NTHR, 2) mega(Params p) {
    extern __shared__ __attribute__((aligned(16))) unsigned char lds_raw[];
    LAS unsigned char* lds = (LAS unsigned char*)lds_raw;
    unsigned char* ws = p.ws;
    const int G = gridDim.x;
    const int tid = threadIdx.x, lane = tid & 63, wave = __builtin_amdgcn_readfirstlane(tid >> 6);
    const int lo = p.ph_lo, hi = p.ph_hi;
    const bool coop = p.pad != 0;
    volatile LAS unsigned* xst = (volatile LAS unsigned*)(lds + LDS_BYTES - 16);
    if (tid < 4) xst[tid] = 0u;
    __syncthreads();
    XcdBarrier xb; xb.bar = (unsigned*)(ws + WS_CTL); xb.x = 0; xb.st = xst;
    if (coop) xb = xcd_barrier_post((unsigned*)(ws + WS_CTL), xst);
    if (IN(0)) { const int hm = (G == 256 && NHELP > 0) ? 0x100 : 0; p0_prologue(p, lds, 0xff | hm); if (REP0 > 1) { if (coop) xcd_barrier(xb); p0_prologue(p, lds, REP0 | hm); } if (coop) cooperative_groups::this_grid().sync(); }
    if (p.layer <= 0 && 0 < p.layer_hi) { layer_body<0>(p, lds, ws, G, tid, lane, wave, lo, hi, coop, xb); if (1 < p.layer_hi) GSYNC(); }
    if (p.layer <= 1 && 1 < p.layer_hi) layer_body<1>(p, lds, ws, G, tid, lane, wave, lo, hi, coop, xb);

#undef IN
#undef GSYNC
}
__global__ __launch_bounds__(256) void shim_xprep_kernel(const float* __restrict__ X, bf16_t* __restrict__ XB, float* __restrict__ SS) {
    const int t = blockIdx.x * 4 + (threadIdx.x >> 6), lane = threadIdx.x & 63;
    xprep_row(X + (size_t)t * D, XB + (size_t)t * D, SS + t, lane);
}
}

extern "C" void kernel_launch(void* const* d_in, const int* in_sizes, int n_in, void* d_out, int out_size, void* d_ws, size_t ws_size, hipStream_t stream) {
    using namespace mk;
    static int grid = 0;
    if (grid == 0) {
        int dev = 0, cus = 0, per_cu = 0;
        (void)hipGetDevice(&dev); (void)hipDeviceGetAttribute(&cus, hipDeviceAttributeMultiprocessorCount, dev);
        if (hipFuncSetAttribute((const void*)mega, hipFuncAttributeMaxDynamicSharedMemorySize, LDS_BYTES) != hipSuccess) { fprintf(stderr, "kernel_launch: hipFuncSetAttribute failed\n"); grid = -1; return; }
        if (ws_size < WS_END) { fprintf(stderr, "kernel_launch: workspace too small: need %zu have %zu\n", (size_t)WS_END, ws_size); grid = -1; return; }
        if (hipOccupancyMaxActiveBlocksPerMultiprocessor(&per_cu, (const void*)mega, NTHR, LDS_BYTES) != hipSuccess || per_cu < 1) { fprintf(stderr, "kernel_launch: occupancy query says %d blocks per CU\n", per_cu); grid = -1; return; }
        grid = cus;
    }
    if (grid < 0) return;
    Params p{};
    for (int i = 0; i < 16; ++i) p.in[i] = (const float*)d_in[i];
    p.out = (float*)d_out; p.ws = (unsigned char*)d_ws;
    p.ph_lo = 0; p.ph_hi = 10; p.layer = 0; p.layer_hi = 2; p.pad = 1; p.pad2 = 0;
    if (hipMemsetAsync(d_ws, 0, 16384, stream) != hipSuccess) { fprintf(stderr, "kernel_launch: memset failed\n"); return; }
    void* args[] = {&p};
    hipError_t e = hipLaunchCooperativeKernel((const void*)mega, dim3(grid), dim3(NTHR), args, LDS_BYTES, stream);
    if (e != hipSuccess) fprintf(stderr, "kernel_launch: cooperative launch failed: %s (grid %d)\n", hipGetErrorString(e), grid);
}
```

```cpp
#include <hip/hip_runtime.h>
#include <hip/hip_cooperative_groups.h>
#include <math.h>
#include <stdio.h>
#include <stdint.h>
namespace pg8 {
#define PG8_LAS __attribute__((address_space(3)))
typedef unsigned short bf16_t;
typedef short bf16x8 __attribute__((ext_vector_type(8)));
typedef float f32x4 __attribute__((ext_vector_type(4)));
typedef unsigned u32x4 __attribute__((ext_vector_type(4)));
constexpr int BM = 256, BK = 64, HALF = 128, HTB = HALF * BK * 2  , STAGE_BYTES = 8 * HTB, NXCD = 8, WGM = 8;

__host__ __device__ __forceinline__ int lds_byte(int r, int c) { const int st = (r >> 4) * 2 + (c >> 5), rr = r & 15, cc = c & 31, ob = rr * 64 + cc * 2; return st * 1024 + (ob ^ (((ob >> 9) & 1) << 5)); }
__host__ __device__ __forceinline__ void stage_rc(int b, int& R, int& C) { const int st = b / 1024, sb = b % 1024, swz = sb ^ (((sb >> 9) & 1) << 5); R = (st >> 1) * 16 + swz / 64; C = (st & 1) * 32 + (swz % 64) / 2; }
__host__ __device__ __forceinline__ int perm32(int rho) { const int n = rho >> 4, i = rho & 15; return 8 * (i >> 2) + 4 * n + (i & 3); }

struct Unit { int pm, pn; };
struct Gemm { const bf16_t* A; const bf16_t* Bt; int M, N, K; };

struct StaticOrder {
    int nM, nN, nwg, G, c;
    __host__ __device__ void init(int M, int N, int G_, int c_) { nM = M / BM; nN = N / BM; nwg = nM * nN; G = G_; c = c_; }
    __host__ __device__ bool next(int i, Unit& u) const {
        const long L = (long)i * G + c; if (L >= nwg) return false;
        int wgid = (int)L; { const int q = nwg / NXCD, r = nwg % NXCD, xcd = wgid % NXCD, off = wgid / NXCD; wgid = (xcd < r ? xcd * (q + 1) : r * (q + 1) + (xcd - r) * q) + off; }
        const int nig = WGM * nN, gid = wgid / nig, fm = gid * WGM, gsz = (nM - fm) < WGM ? (nM - fm) : WGM;
        u.pm = fm + ((wgid % nig) % gsz); u.pn = (wgid % nig) / gsz; return true;
    }
    __device__ __forceinline__ void a_ready(const Unit&) const {}
    __device__ __forceinline__ void done(const Unit&) const {}
};

template <class Epi, class Sched, bool ALIGN_EPI = false, bool SP2 = false>
__device__ __forceinline__ void gemm_phase(PG8_LAS unsigned char* lds, const Gemm g, const Sched& S, const Epi& E) {
    const int tid = threadIdx.x, wid = __builtin_amdgcn_readfirstlane(tid >> 6), lane = tid & 63, wr = wid >> 2, wc = wid & 3, fr = lane & 15, fq = lane >> 4;
    const int K = g.K, nt = K / BK;
    unsigned voffA[2], voffB[2];
#pragma unroll
    for (int i = 0; i < 2; ++i) { int R, C; stage_rc(tid * 16 + i * 8192, R, C); const int Rb = Epi::PERM ? ((R & ~31) + perm32(R & 31)) : R;
        voffA[i] = (unsigned)(R * K + C) * 2u; voffB[i] = (unsigned)(Rb * K + C) * 2u; }
    const size_t kstep = (size_t)(BK * 2);
    const size_t hstep = (size_t)HALF * K * 2;
    const size_t tstep = 2 * hstep;
    const unsigned ldsw = (unsigned)wid * 1024u;
    const int aoff = lds_byte(wr * 64 + fr, fq * 8), boff = lds_byte(wc * 32 + fr, fq * 8);
#define PG8_SA(b, h) (((b) * 2 + (h)) * HTB)
#define PG8_SB(b, h) ((4 + (b) * 2 + (h)) * HTB)
#define PG8_STAGE(bufoff, gbase, voff) do { _Pragma("unroll") for (int _i = 0; _i < 2; ++_i) \
        __builtin_amdgcn_global_load_lds((const unsigned*)((const char*)(gbase) + (voff)[_i]), (PG8_LAS unsigned*)(lds + (bufoff) + ldsw + _i * 8192), 16, 0, 0); } while (0)
#define PG8_LDA(dst, b, h) do { _Pragma("unroll") for (int m = 0; m < 4; ++m) _Pragma("unroll") for (int k = 0; k < 2; ++k) dst[m][k] = *(const PG8_LAS bf16x8*)(lds + PG8_SA(b, h) + aoff + m * 2048 + k * 1024); } while (0)
#define PG8_LDB(dst, b, h) do { _Pragma("unroll") for (int n = 0; n < 2; ++n) _Pragma("unroll") for (int k = 0; k < 2; ++k) dst[n][k] = *(const PG8_LAS bf16x8*)(lds + PG8_SB(b, h) + boff + n * 2048 + k * 1024); } while (0)
#define PG8_MMA(ai, bj, At, Bt) do { __builtin_amdgcn_s_setprio(1); _Pragma("unroll") for (int m = 0; m < 4; ++m) _Pragma("unroll") for (int n = 0; n < 2; ++n) _Pragma("unroll") for (int k = 0; k < 2; ++k) \
        acc[ai][bj][m][n] = __builtin_amdgcn_mfma_f32_16x16x32_bf16(Bt[n][k], At[m][k], acc[ai][bj][m][n], 0, 0, 0); __builtin_amdgcn_s_setprio(0); } while (0)
#define PG8_WAIT_V(n) asm volatile("s_waitcnt vmcnt(" #n ")" ::: "memory")
#define PG8_WAIT_L(n) asm volatile("s_waitcnt lgkmcnt(" #n ")" ::: "memory")
#define PG8_BAR __builtin_amdgcn_s_barrier()
#define PG8_SCHED __builtin_amdgcn_sched_barrier(0)
    Unit cur, nxt; int ui = 0;
    if (!S.next(0, cur)) return;
    f32x4 acc[2][2][4][2];
#pragma unroll
    for (int a = 0; a < 2; ++a)
#pragma unroll
        for (int b = 0; b < 2; ++b)
#pragma unroll
            for (int m = 0; m < 4; ++m)
#pragma unroll
                for (int n = 0; n < 2; ++n) acc[a][b][m][n] = (f32x4){0.f, 0.f, 0.f, 0.f};
    bf16x8 At[4][2], B0[2][2], B1[2][2];
    const char* cA = (const char*)g.A + (size_t)cur.pm * tstep; const char* cB = (const char*)g.Bt + (size_t)cur.pn * tstep;
    S.a_ready(cur);
    if constexpr (SP2) {
        PG8_STAGE(PG8_SB(0, 0), cB, voffB); PG8_STAGE(PG8_SB(0, 1), cB + hstep, voffB); PG8_STAGE(PG8_SA(0, 0), cA, voffA); PG8_STAGE(PG8_SA(0, 1), cA + hstep, voffA);
        if (wr == 1) PG8_BAR;
        PG8_WAIT_V(2); PG8_BAR;
        PG8_STAGE(PG8_SB(1, 0), cB + kstep, voffB); PG8_STAGE(PG8_SA(1, 0), cA + kstep, voffA); PG8_STAGE(PG8_SB(1, 1), cB + hstep + kstep, voffB);
        PG8_WAIT_V(6); PG8_BAR;
    } else {
        PG8_STAGE(PG8_SB(0, 0), cB, voffB); PG8_STAGE(PG8_SA(0, 0), cA, voffA); PG8_STAGE(PG8_SB(0, 1), cB + hstep, voffB); PG8_STAGE(PG8_SA(0, 1), cA + hstep, voffA);
        if (wr == 1) PG8_BAR;
        PG8_WAIT_V(4); PG8_BAR;
        PG8_STAGE(PG8_SB(1, 0), cB + kstep, voffB); PG8_STAGE(PG8_SA(1, 0), cA + kstep, voffA); PG8_STAGE(PG8_SB(1, 1), cB + hstep + kstep, voffB);
        PG8_WAIT_V(6); PG8_BAR;
    }
    for (;;) {
        const bool has_next = S.next(ui + 1, nxt);
        const char* nA = has_next ? (const char*)g.A + (size_t)nxt.pm * tstep : cA; const char* nB = has_next ? (const char*)g.Bt + (size_t)nxt.pn * tstep : cB;
        for (int t = 0; t < nt; t += 2) {
            const bool last = (t == nt - 2);
            const char* a1 = cA + (size_t)(t + 1) * kstep;
            const char* a2 = last ? nA : cA + (size_t)(t + 2) * kstep; const char* b2 = last ? nB : cB + (size_t)(t + 2) * kstep;
            const char* a3 = a2 + kstep; const char* b3 = b2 + kstep;
            if (last && has_next) S.a_ready(nxt);
            if constexpr (SP2) {
            PG8_LDB(B0, 0, 0); PG8_LDB(B1, 0, 1); PG8_SCHED; PG8_LDA(At, 0, 0); PG8_STAGE(PG8_SA(1, 1), a1 + hstep, voffA);
            PG8_WAIT_V(8); PG8_WAIT_L(0); PG8_BAR; PG8_MMA(0, 0, At, B0); PG8_MMA(0, 1, At, B1); PG8_BAR; PG8_SCHED;
            PG8_LDA(At, 0, 1); PG8_STAGE(PG8_SB(0, 0), b2, voffB); PG8_STAGE(PG8_SB(0, 1), b2 + hstep, voffB); PG8_STAGE(PG8_SA(0, 0), a2, voffA);
            PG8_WAIT_V(8); PG8_WAIT_L(0); PG8_BAR; PG8_MMA(1, 0, At, B0); PG8_MMA(1, 1, At, B1); PG8_BAR; PG8_SCHED;
            PG8_LDB(B0, 1, 0); PG8_LDB(B1, 1, 1); PG8_SCHED; PG8_LDA(At, 1, 0); PG8_STAGE(PG8_SA(0, 1), a2 + hstep, voffA);
            PG8_WAIT_V(8); PG8_WAIT_L(0); PG8_BAR; PG8_MMA(0, 0, At, B0); PG8_MMA(0, 1, At, B1); PG8_BAR; PG8_SCHED;
            PG8_LDA(At, 1, 1); PG8_STAGE(PG8_SB(1, 0), b3, voffB); PG8_STAGE(PG8_SB(1, 1), b3 + hstep, voffB); PG8_STAGE(PG8_SA(1, 0), a3, voffA);
            PG8_WAIT_V(8); PG8_WAIT_L(0); PG8_BAR; PG8_MMA(1, 0, At, B0); PG8_MMA(1, 1, At, B1); PG8_BAR; PG8_SCHED;
            } else {
            PG8_LDB(B0, 0, 0); PG8_SCHED; PG8_LDA(At, 0, 0); PG8_STAGE(PG8_SA(1, 1), a1 + hstep, voffA);
            PG8_WAIT_L(8); PG8_BAR; PG8_WAIT_L(0); PG8_MMA(0, 0, At, B0); PG8_BAR; PG8_SCHED;
            PG8_LDB(B1, 0, 1); PG8_STAGE(PG8_SB(0, 0), b2, voffB);
            PG8_BAR; PG8_WAIT_L(0); PG8_MMA(0, 1, At, B1); PG8_BAR;
            PG8_LDA(At, 0, 1); PG8_STAGE(PG8_SA(0, 0), a2, voffA);
            PG8_BAR; PG8_WAIT_L(0); PG8_MMA(1, 0, At, B0); PG8_BAR; PG8_SCHED;
            PG8_STAGE(PG8_SB(0, 1), b2 + hstep, voffB);
            PG8_WAIT_V(6); PG8_BAR; PG8_MMA(1, 1, At, B1); PG8_BAR;
            PG8_LDB(B0, 1, 0); PG8_SCHED; PG8_LDA(At, 1, 0); PG8_STAGE(PG8_SA(0, 1), a2 + hstep, voffA);
            PG8_WAIT_L(8); PG8_BAR; PG8_WAIT_L(0); PG8_MMA(0, 0, At, B0); PG8_BAR; PG8_SCHED;
            PG8_LDB(B1, 1, 1); PG8_STAGE(PG8_SB(1, 0), b3, voffB);
            PG8_BAR; PG8_WAIT_L(0); PG8_MMA(0, 1, At, B1); PG8_BAR;
            PG8_LDA(At, 1, 1); PG8_STAGE(PG8_SA(1, 0), a3, voffA);
            PG8_BAR; PG8_WAIT_L(0); PG8_MMA(1, 0, At, B0); PG8_BAR; PG8_SCHED;
            PG8_STAGE(PG8_SB(1, 1), b3 + hstep, voffB);
            PG8_WAIT_V(6); PG8_BAR; PG8_MMA(1, 1, At, B1); PG8_BAR;
            }
        }
        if constexpr (ALIGN_EPI) { if (wr == 0) PG8_BAR; }
        if constexpr (!Epi::AFTER_DRAIN) { E(acc, cur, wr, wc, fr, fq); S.done(cur); }
        if (!has_next) break;
#pragma unroll
        for (int a = 0; a < 2; ++a)
#pragma unroll
            for (int b = 0; b < 2; ++b)
#pragma unroll
                for (int m = 0; m < 4; ++m)
#pragma unroll
                    for (int n = 0; n < 2; ++n) acc[a][b][m][n] = (f32x4){0.f, 0.f, 0.f, 0.f};
        cur = nxt; cA = nA; cB = nB; ++ui;
        if constexpr (ALIGN_EPI) { if (wr == 1) PG8_BAR; }
    }
    PG8_WAIT_V(0);
    if constexpr (!ALIGN_EPI) { if (wr == 0) PG8_BAR; }
    PG8_BAR;
    if constexpr (Epi::AFTER_DRAIN) { E.fused(acc, cur, wr, wc, fr, fq, lds, wid, lane); S.done(cur); }
#undef PG8_SA
#undef PG8_SB
#undef PG8_STAGE
#undef PG8_LDA
#undef PG8_LDB
#undef PG8_MMA
#undef PG8_WAIT_V
#undef PG8_WAIT_L
#undef PG8_BAR
#undef PG8_SCHED
}
}
namespace mk {
#define LAS __attribute__((address_space(3)))
typedef unsigned short bf16_t;
typedef float f32x4 __attribute__((ext_vector_type(4)));
typedef float f32x2 __attribute__((ext_vector_type(2)));
typedef unsigned u32x4 __attribute__((ext_vector_type(4)));
typedef unsigned u32x2 __attribute__((ext_vector_type(2)));
typedef __bf16 bf16x2_t __attribute__((ext_vector_type(2)));
typedef short bf16x8 __attribute__((ext_vector_type(8)));
typedef short s16x4 __attribute__((ext_vector_type(4)));
constexpr int D = 2048, NB = 4, S = 4096, T = NB * S, IN_LD = 5384, NP = 5632, NE = 16384;
constexpr int NTHR = 512, NWAVES = 8;
constexpr int LDS_BYTES = 160 * 1024;
constexpr int LDS_SPARE = 128 * 1024;
constexpr float EPS = 1e-6f;
#ifndef REPS
#define REPS 1,1,1,1,1,1,1,1
#endif
constexpr int REPV[8] = {REPS};
constexpr int REP7 = REPV[7];
constexpr int NHELP = 16;
constexpr int HROWS = 9728;
constexpr int REP0 = REPV[0], REP1 = REPV[1], REP2 = REPV[2], REP3 = REPV[3], REP4 = REPV[4], REP5 = REPV[5], REP6 = REPV[6];
constexpr int C_QA = 0, C_KA = 1024, C_VA = 1152, C_QH = 1280, C_FH = 1792, C_IH = 2304, C_GH = 2816, C_QM = 3328, C_KM = 3840, C_VM = 4352, C_OM = 4864, C_IM = 5376, C_FM = 5380;

constexpr size_t WS_CTL = 0;
constexpr size_t WS_WINT = 65536;
constexpr size_t WS_WOUTT = WS_WINT + 2 * (size_t)NP * D * 2;
constexpr size_t WS_WQT = WS_WOUTT + 2 * (size_t)D * D * 2;
constexpr size_t WS_SUBK = WS_WQT + 2 * (size_t)D * D * 2;
constexpr size_t WS_U8 = WS_SUBK + 2 * 2 * 8 * 128 * 128 * 2;
constexpr size_t WS_V8 = WS_U8 + 2 * (size_t)NE * D;
constexpr size_t WS_USC = WS_V8 + 2 * (size_t)NE * D;
constexpr size_t WS_VSC = WS_USC + 2 * (size_t)NE * 4;
constexpr size_t WS_ROPE = WS_VSC + 2 * (size_t)NE * 4;
constexpr size_t WS_SS = WS_ROPE + (size_t)S * 32 * 8;
constexpr size_t WS_SSP = WS_SS + (size_t)T * 16 * 4;
constexpr size_t WS_XB = WS_SSP + (size_t)T * 32 * 4;
constexpr size_t WS_P = WS_XB + (size_t)T * D * 2;
constexpr size_t WS_YB = WS_P + (size_t)T * NP * 2;
constexpr size_t WS_Q = WS_YB + (size_t)T * D * 2;
constexpr size_t WS_IDX = WS_Q + (size_t)T * D * 2;
constexpr size_t WS_GATE = WS_IDX + (size_t)T * 128 * 4;
constexpr size_t WS_X1 = WS_GATE + (size_t)T * 128 * 4;
constexpr size_t WS_X2 = WS_X1 + (size_t)T * D * 4;
constexpr size_t WS_IDXU = WS_X2 + (size_t)T * D * 4;
constexpr size_t WS_AMXP = WS_IDXU + (size_t)T * 128 * 4;
constexpr size_t WS_ASC = WS_AMXP + (size_t)T * 32 * 4;
constexpr size_t WS_STH = WS_ASC + (size_t)T * 4;
constexpr size_t WS_STM = WS_STH + (size_t)128 * 16640 * 4;
constexpr size_t WS_END = WS_STM + (size_t)128 * 16640 * 4;
constexpr size_t WS_PART = WS_P;
constexpr size_t WS_ACT = WS_Q;
static_assert((size_t)16 * T * 128 * 4 <= (size_t)T * NP * 2, "PART overlay");
static_assert(WS_END <= ((size_t)1 << 30), "workspace");
struct Params { const float* in[16]; float* out; unsigned char* ws; int ph_lo, ph_hi, layer, layer_hi, pad, pad2; };

__device__ __forceinline__ unsigned pk2(float lo, float hi) { f32x2 v = {lo, hi}; bf16x2_t b = __builtin_convertvector(v, bf16x2_t); return __builtin_bit_cast(unsigned, b); }
__device__ __forceinline__ float bf2f(unsigned short h) { return __uint_as_float((unsigned)h << 16); }
__device__ __forceinline__ float bflo(unsigned w) { return __uint_as_float(w << 16); }
__device__ __forceinline__ float bfhi(unsigned w) { return __uint_as_float(w & 0xffff0000u); }
__device__ __forceinline__ float wsum(float v) {
#pragma unroll
    for (int o = 1; o < 64; o <<= 1) v += __shfl_xor(v, o);
    return v;
}
template <int CTRL> __device__ __forceinline__ float dppf(float x) { return __builtin_bit_cast(float, __builtin_amdgcn_mov_dpp(__builtin_bit_cast(int, x), CTRL, 0xf, 0xf, true)); }
constexpr int DPP_XOR1 = 0xB1, DPP_XOR2 = 0x4E, DPP_HMIR = 0x141, DPP_ROR8 = 0x128;
__device__ __forceinline__ float sum8(float v) { v += dppf<DPP_XOR1>(v); v += dppf<DPP_XOR2>(v); v += dppf<DPP_HMIR>(v); return v; }
__device__ __forceinline__ float sum16(float v) { v = sum8(v); v += dppf<DPP_ROR8>(v); return v; }
__device__ __forceinline__ float wmax(float v) {
#pragma unroll
    for (int o = 1; o < 64; o <<= 1) v = fmaxf(v, __shfl_xor(v, o));
    return v;
}

typedef __amdgpu_buffer_rsrc_t rsrc_t;
__device__ __forceinline__ rsrc_t make_rsrc(const void* p, unsigned bytes) { return __builtin_amdgcn_make_buffer_rsrc((void*)p, 0, bytes, 0x00020000); }
__device__ __forceinline__ void st_wt(u32x4 v, rsrc_t rc, unsigned boff) { __builtin_amdgcn_raw_buffer_store_b128(v, rc, (int)boff, 0, 16); }
__device__ __forceinline__ void st_wt(u32x2 v, rsrc_t rc, unsigned boff) { __builtin_amdgcn_raw_buffer_store_b64(v, rc, (int)boff, 0, 16); }
__device__ __forceinline__ void st_wt(unsigned v, rsrc_t rc, unsigned boff) { __builtin_amdgcn_raw_buffer_store_b32(v, rc, (int)boff, 0, 16); }
__device__ __forceinline__ void st_wt(float v, rsrc_t rc, unsigned boff) { __builtin_amdgcn_raw_buffer_store_b32(__float_as_uint(v), rc, (int)boff, 0, 16); }
__device__ __forceinline__ void transpose_item(const float* __restrict__ W, int ldw, int nvalid, const float* __restrict__ gain, bf16_t* __restrict__ WT, int K, int k0, int n0, LAS float* scr, int lane) {
    const int j = lane & 31, h = lane >> 5;
    const int n = n0 + 2 * j;
    f32x2 vv[32];
#pragma unroll
    for (int i = 0; i < 32; ++i) {
        const int kk = 2 * i + h;
        f32x2 v = {0.f, 0.f};
        if (n < nvalid) v = *(const f32x2*)(W + (size_t)(k0 + kk) * ldw + n);
        vv[i] = v;
    }
#pragma unroll
    for (int i = 0; i < 32; ++i) {
        const int kk = 2 * i + h;
        f32x2 v = vv[i];
        if (gain) { const float gk = gain[k0 + kk]; v.x *= gk; v.y *= gk; }
        *(LAS f32x2*)(scr + kk * 66 + 2 * j) = v;
    }
    __builtin_amdgcn_s_waitcnt(0xc07f);
    asm volatile("" ::: "memory");
    const int c = lane & 7;
#pragma unroll
    for (int jj = 0; jj < 8; ++jj) {
        const int nn = (lane >> 3) + 8 * jj;
        const LAS float* s = scr + (8 * c) * 66 + nn;
        u32x4 o; o.x = pk2(s[0 * 66], s[1 * 66]); o.y = pk2(s[2 * 66], s[3 * 66]); o.z = pk2(s[4 * 66], s[5 * 66]); o.w = pk2(s[6 * 66], s[7 * 66]);
        *(u32x4*)(WT + (size_t)(n0 + nn) * K + k0 + 8 * c) = o;
    }
    __builtin_amdgcn_s_waitcnt(0xc07f);
    asm volatile("" ::: "memory");
}
__device__ __forceinline__ void xprep_row(const float* __restrict__ xrow, bf16_t* __restrict__ orow, float* __restrict__ ss, int lane) {
    const f32x4* xr = (const f32x4*)xrow + lane;
    f32x4 v[8]; float s = 0.f;
#pragma unroll
    for (int j = 0; j < 8; ++j) { v[j] = xr[64 * j]; s += (v[j].x * v[j].x + v[j].y * v[j].y) + (v[j].z * v[j].z + v[j].w * v[j].w); }
    s = wsum(s);
    u32x2* o = (u32x2*)orow + lane;
#pragma unroll
    for (int j = 0; j < 8; ++j) { u32x2 w; w.x = pk2(v[j].x, v[j].y); w.y = pk2(v[j].z, v[j].w); o[64 * j] = w; }
    if (lane < 16) ss[lane] = (lane == 0) ? s : 0.f;
}
template <int NR>
__device__ __forceinline__ void fp8_rows_load(const float* __restrict__ src, f32x4 (&v)[NR][8], int lane) {
#pragma unroll
    for (int r = 0; r < NR; ++r)
#pragma unroll
        for (int i = 0; i < 8; ++i) v[r][i] = *(const f32x4*)(src + (size_t)r * D + 256 * i + 4 * lane);
}
template <int NR, bool INT8>
__device__ __forceinline__ void fp8_rows_finish(f32x4 (&v)[NR][8], const float* __restrict__ gain, unsigned char* __restrict__ dst, float* __restrict__ sc, int lane) {
    float am[NR];
#pragma unroll
    for (int r = 0; r < NR; ++r) am[r] = 0.f;
#pragma unroll
    for (int i = 0; i < 8; ++i) {
        f32x4 gg = {1.f, 1.f, 1.f, 1.f};
        if (gain) gg = *(const f32x4*)(gain + 256 * i + 4 * lane);
#pragma unroll
        for (int r = 0; r < NR; ++r) {
            if (gain) v[r][i] = v[r][i] * gg;
            const f32x4 a = v[r][i];
            am[r] = fmaxf(am[r], fmaxf(fmaxf(fabsf(a.x), fabsf(a.y)), fmaxf(fabsf(a.z), fabsf(a.w))));
        }
    }
#pragma unroll
    for (int r = 0; r < NR; ++r) am[r] = wmax(am[r]);
#pragma unroll
    for (int r = 0; r < NR; ++r) {
        const float qmax = INT8 ? 127.f : 256.f;
        const float qs = am[r] > 0.f ? qmax / am[r] : 1.f;
#pragma unroll
        for (int i = 0; i < 8; ++i) {
            const f32x4 a = v[r][i] * qs;
            int pk;
            if (INT8) pk = (__float2int_rn(a.x) & 0xff) | ((__float2int_rn(a.y) & 0xff) << 8) | ((__float2int_rn(a.z) & 0xff) << 16) | (__float2int_rn(a.w) << 24);
            else { pk = __builtin_amdgcn_cvt_pk_fp8_f32(a.x, a.y, 0, false); pk = __builtin_amdgcn_cvt_pk_fp8_f32(a.z, a.w, pk, true); }
            *(unsigned*)(dst + (size_t)r * 128 + ((size_t)(2 * i + (lane >> 5)) * NE) * 128 + (lane & 31) * 4) = (unsigned)pk;
        }
        if (lane == 0) sc[2 * r] = am[r] > 0.f ? am[r] * (INT8 ? (1.f / 127.f) : (1.f / 256.f)) : 1.f;
    }
}

__device__ __forceinline__ void tables_convert(const Params& p, int l, int r_lo, int r_hi, int w, int nw, int lane) {
    unsigned char* ws = p.ws;
    const float* norm_ffn = p.in[10]; const float* peer_u = p.in[13]; const float* peer_v = p.in[14];
    const int REND = r_hi;
    const int rstep = 2 * nw;
#define TC_SRC(R) (((R) / NE == 0 ? peer_u : peer_v) + ((size_t)l * NE + (size_t)((R) % NE)) * D)
#define TC_FIN(V, R) do { const int tb_ = (R) / NE, e_ = (R) % NE; \
        fp8_rows_finish<2, true>(V, tb_ == 0 ? norm_ffn + l * D : (const float*)nullptr, ws + (tb_ == 0 ? WS_U8 : WS_V8) + (size_t)l * NE * D + (size_t)e_ * 128, \
                                 (float*)(ws + WS_USC) + 2 * ((size_t)l * NE + e_) + tb_, lane); } while (0)
    f32x4 va[2][8], vb[2][8];
    int r = r_lo + 2 * w;
    if (r < REND) fp8_rows_load<2>(TC_SRC(r), va, lane);
    while (r < REND) {
        const int rn = r + rstep;
        if (rn < REND) fp8_rows_load<2>(TC_SRC(rn), vb, lane);
        TC_FIN(va, r);
        if (rn >= REND) break;
        const int rn2 = rn + rstep;
        if (rn2 < REND) fp8_rows_load<2>(TC_SRC(rn2), va, lane);
        TC_FIN(vb, rn);
        r = rn2;
    }
#undef TC_SRC
#undef TC_FIN
}

__device__ __forceinline__ void p0_prologue(const Params& p, LAS unsigned char* lds, int mask = 0xff) {
    const int tid = threadIdx.x, lane = tid & 63, wave = tid >> 6;
    const int G = gridDim.x, gw = blockIdx.x * NWAVES + wave, ngw = G * NWAVES;
    const size_t gt = (size_t)blockIdx.x * NTHR + tid, ngt = (size_t)G * NTHR;
    unsigned char* ws = p.ws;
    const float* x = p.in[0]; const float* norm_mix = p.in[1]; const float* w_in = p.in[2]; const float* w_out = p.in[3];
    const float* norm_ffn = p.in[10]; const float* peer_query = p.in[11]; const float* sub_keys = p.in[12]; const float* peer_u = p.in[13]; const float* peer_v = p.in[14];
    if (mask & 1) {
        LAS float* scr = (LAS float*)(lds + wave * 16896);
        constexpr int I_IN = 32 * (NP / 64), I_SQ = 32 * (D / 64), PER_L = I_IN + 2 * I_SQ;
        for (int it = gw; it < 2 * PER_L; it += ngw) {
            const int l = it / PER_L; int r = it % PER_L;
            if (r < I_IN) { transpose_item(w_in + (size_t)l * D * IN_LD, IN_LD, IN_LD, norm_mix + l * D, (bf16_t*)(ws + WS_WINT) + (size_t)l * NP * D, D, (r / (NP / 64)) * 64, (r % (NP / 64)) * 64, scr, lane); continue; }
            r -= I_IN;
            if (r < I_SQ) { transpose_item(w_out + (size_t)l * D * D, D, D, nullptr, (bf16_t*)(ws + WS_WOUTT) + (size_t)l * D * D, D, (r / (D / 64)) * 64, (r % (D / 64)) * 64, scr, lane); continue; }
            r -= I_SQ;
            transpose_item(peer_query + (size_t)l * D * D, D, D, norm_ffn + l * D, (bf16_t*)(ws + WS_WQT) + (size_t)l * D * D, D, (r / (D / 64)) * 64, (r % (D / 64)) * 64, scr, lane);
        }
    }
    if (mask & 2) for (size_t i = gt; i < 2 * 2 * 8 * 128 * 128 / 4; i += ngt) {
        const f32x4 v = ((const f32x4*)sub_keys)[i];
        u32x2 w; w.x = pk2(v.x, v.y); w.y = pk2(v.z, v.w);
        ((u32x2*)(ws + WS_SUBK))[i] = w;
    }
    if (mask & 4) { const int r0 = (mask & 0x100) ? HROWS : 0; tables_convert(p, 0, r0, 2 * NE, gw, ngw, lane); tables_convert(p, 1, r0, 2 * NE, gw, ngw, lane); }
    if (mask & 8) for (size_t i = gt; i < (size_t)S * 32; i += ngt) {
        const int fi = (int)(i & 31), pos = (int)(i >> 5);
        const float inv = powf(10000.f, -(float)fi / 32.f);
        const float ang = (float)pos * inv;
        f32x2 cs; cs.x = cosf(ang); cs.y = sinf(ang);
        ((f32x2*)(ws + WS_ROPE))[i] = cs;
    }
    if (mask & 16) for (int t = 2 * gw; t < T; t += 2 * ngw) {
        const f32x4* x0 = (const f32x4*)(x + (size_t)t * D) + 2 * lane; const f32x4* x1 = x0 + D / 4;
        f32x4 v0[8], v1[8]; float s0 = 0.f, s1 = 0.f;
#pragma unroll
        for (int j = 0; j < 4; ++j) { v0[2 * j] = x0[128 * j]; v0[2 * j + 1] = x0[128 * j + 1]; v1[2 * j] = x1[128 * j]; v1[2 * j + 1] = x1[128 * j + 1]; }
#pragma unroll
        for (int j = 0; j < 8; ++j) { s0 += (v0[j].x * v0[j].x + v0[j].y * v0[j].y) + (v0[j].z * v0[j].z + v0[j].w * v0[j].w); s1 += (v1[j].x * v1[j].x + v1[j].y * v1[j].y) + (v1[j].z * v1[j].z + v1[j].w * v1[j].w); }
        s0 = wsum(s0); s1 = wsum(s1);
        const rsrc_t xrc = make_rsrc((bf16_t*)(ws + WS_XB) + (size_t)t * D, (unsigned)(2 * D * 2));
#pragma unroll
        for (int j = 0; j < 4; ++j) {
            u32x4 w; w.x = pk2(v0[2 * j].x, v0[2 * j].y); w.y = pk2(v0[2 * j].z, v0[2 * j].w); w.z = pk2(v0[2 * j + 1].x, v0[2 * j + 1].y); w.w = pk2(v0[2 * j + 1].z, v0[2 * j + 1].w);
            st_wt(w, xrc, (unsigned)((lane + 64 * j) * 16));
            w.x = pk2(v1[2 * j].x, v1[2 * j].y); w.y = pk2(v1[2 * j].z, v1[2 * j].w); w.z = pk2(v1[2 * j + 1].x, v1[2 * j + 1].y); w.w = pk2(v1[2 * j + 1].z, v1[2 * j + 1].w);
            st_wt(w, xrc, (unsigned)(D * 2 + (lane + 64 * j) * 16));
        }
        float* ss = (float*)(ws + WS_SS) + (size_t)t * 16;
        if (lane < 32) ss[lane] = (lane == 0) ? s0 : (lane == 16) ? s1 : 0.f;
    }
}

template <int NSS>
struct EpiScaleBf16 {
    static constexpr bool PERM = true, AFTER_DRAIN = false;
    bf16_t* O; int ldc; const float* ss;
    __device__ __forceinline__ void operator()(const pg8::f32x4 (&acc)[2][2][4][2], const pg8::Unit& u, int wr, int wc, int fr, int fq) const {
        const int row0 = u.pm * 256 + wr * 64 + fr, col0 = u.pn * 256 + wc * 32 + 8 * fq;
        const rsrc_t orc = make_rsrc(O, (unsigned)((size_t)T * ldc * 2));
        float rs[2][4];
        {
            f32x4 a[2][4];
#pragma unroll
            for (int ai = 0; ai < 2; ++ai)
#pragma unroll
                for (int m = 0; m < 4; ++m) {
                    const f32x4* sp = (const f32x4*)(ss + (size_t)(row0 + ai * 128 + m * 16) * NSS);
                    a[ai][m] = sp[fq];
                    if (NSS == 32) a[ai][m] = a[ai][m] + sp[4 + fq];
                }
#pragma unroll
            for (int ai = 0; ai < 2; ++ai)
#pragma unroll
                for (int m = 0; m < 4; ++m) {
                    float s = (a[ai][m].x + a[ai][m].y) + (a[ai][m].z + a[ai][m].w);
                    { const auto w = __builtin_amdgcn_permlane16_swap(__float_as_uint(s), __float_as_uint(s), false, false); s = __uint_as_float(w[0]) + __uint_as_float(w[1]); }
                    { const auto w = __builtin_amdgcn_permlane32_swap(__float_as_uint(s), __float_as_uint(s), false, false); s = __uint_as_float(w[0]) + __uint_as_float(w[1]); }
                    rs[ai][m] = rsqrtf(s * (1.f / D) + EPS);
                }
        }
#pragma unroll
        for (int ai = 0; ai < 2; ++ai)
#pragma unroll
            for (int m = 0; m < 4; ++m) {
                const int row = row0 + ai * 128 + m * 16;
                const float r = rs[ai][m];
                const unsigned boff = (unsigned)(((size_t)row * ldc + col0) * 2);
#pragma unroll
                for (int bj = 0; bj < 2; ++bj) {
                    const pg8::f32x4 v0 = acc[ai][bj][m][0] * r, v1 = acc[ai][bj][m][1] * r;
                    u32x4 w; w.x = pk2(v0[0], v0[1]); w.y = pk2(v0[2], v0[3]); w.z = pk2(v1[0], v1[1]); w.w = pk2(v1[2], v1[3]);
                    __builtin_amdgcn_raw_buffer_store_b128(w, orc, (int)(boff + bj * 256), 0, 16);
                }
            }
    }
};

struct EpiX1 {
    static constexpr bool PERM = true, AFTER_DRAIN = false;
    const float* xin32;
    bf16_t* X1B; float* ssp; float* amxp;
    __device__ __forceinline__ void operator()(const pg8::f32x4 (&acc)[2][2][4][2], const pg8::Unit& u, int wr, int wc, int fr, int fq) const {
        const int col0 = u.pn * 256 + wc * 32 + 8 * fq;
#pragma unroll
        for (int ai = 0; ai < 2; ++ai) {
            const int rbase = u.pm * 256 + ai * 128 + wr * 64 + fr;
            pg8::f32x4 r0[4][2], r1[4][2];
            if (xin32) {
#pragma unroll
                for (int m = 0; m < 4; ++m)
#pragma unroll
                    for (int bj = 0; bj < 2; ++bj) { const float* xp = xin32 + (size_t)(rbase + m * 16) * D + col0 + bj * 128; r0[m][bj] = *(const pg8::f32x4*)xp; r1[m][bj] = *(const pg8::f32x4*)(xp + 4); }
            } else {
                u32x4 rb[4][2];
#pragma unroll
                for (int m = 0; m < 4; ++m)
#pragma unroll
                    for (int bj = 0; bj < 2; ++bj) rb[m][bj] = *(const u32x4*)(X1B + (size_t)(rbase + m * 16) * D + col0 + bj * 128);
#pragma unroll
                for (int m = 0; m < 4; ++m)
#pragma unroll
                    for (int bj = 0; bj < 2; ++bj) { const u32x4 b = rb[m][bj]; r0[m][bj] = (pg8::f32x4){bflo(b.x), bfhi(b.x), bflo(b.y), bfhi(b.y)}; r1[m][bj] = (pg8::f32x4){bflo(b.z), bfhi(b.z), bflo(b.w), bfhi(b.w)}; }
            }
#pragma unroll
            for (int m = 0; m < 4; ++m) {
                const int row = rbase + m * 16;
                float q = 0.f, am = 0.f;
#pragma unroll
                for (int bj = 0; bj < 2; ++bj) {
                    const size_t off = (size_t)row * D + col0 + bj * 128;
                    const pg8::f32x4 o0 = r0[m][bj] + acc[ai][bj][m][0], o1 = r1[m][bj] + acc[ai][bj][m][1];
                    u32x4 w; w.x = pk2(o0[0], o0[1]); w.y = pk2(o0[2], o0[3]); w.z = pk2(o1[0], o1[1]); w.w = pk2(o1[2], o1[3]);
                    *(u32x4*)(X1B + off) = w;
#pragma unroll
                    for (int k = 0; k < 4; ++k) {
                        const float a = bflo(w[k]), b = bfhi(w[k]);
                        q += a * a + b * b;
                        am = fmaxf(am, fmaxf(fabsf(a), fabsf(b)));
                    }
                }
                q += __shfl_xor(q, 16); q += __shfl_xor(q, 32);
                am = fmaxf(am, __shfl_xor(am, 16)); am = fmaxf(am, __shfl_xor(am, 32));
                if (fq == 0) { ssp[(size_t)row * 32 + u.pn * 4 + wc] = q; amxp[(size_t)row * 32 + u.pn * 4 + wc] = am; }
            }
        }
    }
};

#define TOPK_INSERT(L, x) do { _Pragma("unroll") for (int _i = 15; _i >= 1; --_i) L[_i] = __builtin_amdgcn_fmed3f(L[_i - 1], L[_i], (x)); L[0] = fmaxf(L[0], (x)); } while (0)
#define TOPK_MERGE16(L, O) do { _Pragma("unroll") for (int _i = 0; _i < 16; ++_i) L[_i] = fmaxf(L[_i], (O)[15 - _i]); \
        _Pragma("unroll") for (int _st = 8; _st >= 1; _st >>= 1) _Pragma("unroll") for (int _i = 0; _i < 16; ++_i) if ((_i & _st) == 0) { \
            const float _a = L[_i], _b = L[_i + _st]; L[_i] = fmaxf(_a, _b); L[_i + _st] = fminf(_a, _b); } } while (0)
constexpr int SK_LD = 136;
constexpr int ROUTE_SK_OFF = 8 * 8448;
typedef float f32x16 __attribute__((ext_vector_type(16)));
__device__ __forceinline__ float swap32(float x) {
    const auto s = __builtin_amdgcn_permlane32_swap(__float_as_uint(x), __float_as_uint(x), false, false);
    return (__builtin_amdgcn_mbcnt_hi(~0u, __builtin_amdgcn_mbcnt_lo(~0u, 0u)) < 32u) ? __uint_as_float(s[1]) : __uint_as_float(s[0]);
}
__device__ __forceinline__ void route_unit(const bf16_t* __restrict__ Q, const bf16_t* __restrict__ subk_l, int pm, int h, int* __restrict__ IDX, int* __restrict__ IDXU, float* __restrict__ GATE,
                                           LAS unsigned char* lds, int tid, int wave, int lane) {
    const int tk = lane & 31, hi = lane >> 5;
    LAS float* scr = (LAS float*)(lds + wave * 8448);
    LAS bf16_t* SK = (LAS bf16_t*)(lds + ROUTE_SK_OFF);
    __syncthreads();
#pragma unroll
    for (int j = 0; j < 8; ++j) {
        const int e = tid + j * NTHR, half = e >> 11, row = (e >> 4) & 127, ch = e & 15;
        *(LAS u32x4*)(SK + (half * 128 + row) * SK_LD + ch * 8) = *(const u32x4*)(subk_l + ((size_t)(half * 8 + h) * 128 + row) * 128 + ch * 8);
    }
    const int tok = pm * 256 + wave * 32 + tk;
    bf16x8 bq[2][8];
#pragma unroll
    for (int half = 0; half < 2; ++half)
#pragma unroll
        for (int ks = 0; ks < 8; ++ks) bq[half][ks] = *(const bf16x8*)(Q + (size_t)tok * D + h * 256 + half * 128 + ks * 16 + 8 * hi);
    __syncthreads();
    float L1[16], L2[16];
#pragma unroll
    for (int half = 0; half < 2; ++half) {
        float L[16];
#pragma unroll
        for (int i = 0; i < 16; ++i) L[i] = -3.0e38f;
#pragma unroll 1
        for (int mt = 0; mt < 4; ++mt) {
            f32x16 acc;
#pragma unroll
            for (int r = 0; r < 16; ++r) acc[r] = 0.f;
            const LAS bf16_t* kp = SK + (half * 128 + mt * 32 + tk) * SK_LD + 8 * hi;
#pragma unroll
            for (int ks = 0; ks < 8; ++ks) acc = __builtin_amdgcn_mfma_f32_32x32x16_bf16(*(const LAS bf16x8*)(kp + ks * 16), bq[half][ks], acc, 0, 0, 0);
#pragma unroll
            for (int r = 0; r < 16; ++r) {
                const unsigned key = (unsigned)(mt * 32 + (r & 3) + 8 * (r >> 2) + 4 * hi);
                const float xv = __uint_as_float((__float_as_uint(acc[r]) & 0xffffff80u) | key);
                TOPK_INSERT(L, xv);
            }
        }
        { float o[16];
#pragma unroll
          for (int i = 0; i < 16; ++i) o[i] = swap32(L[i]);
          TOPK_MERGE16(L, o); }
#pragma unroll
        for (int i = 0; i < 16; ++i) { if (half == 0) L1[i] = L[i]; else L2[i] = L[i]; }
    }
    float C[16];
#pragma unroll
    for (int i = 0; i < 16; ++i) C[i] = -3.0e38f;
    {
        constexpr int NA[50] = {0,0,0,0,0,0,0,0,0,0,0,0,0,0,0,0, 1,1,1,1,1,1,1,1, 2,2,2,2,2, 3,3,3,3, 4,4,4, 5,5, 6,6, 7,7, 8, 9, 10, 11, 12, 13, 14, 15};
        constexpr int NBb[50] = {0,1,2,3,4,5,6,7,8,9,10,11,12,13,14,15, 0,1,2,3,4,5,6,7, 0,1,2,3,4, 0,1,2,3, 0,1,2, 0,1, 0,1, 0,1, 0, 0, 0, 0, 0, 0, 0, 0};
#pragma unroll
        for (int i = 0; i < 25; ++i) {
            const int a0 = NA[2 * i], b0 = NBb[2 * i], a1 = NA[2 * i + 1], b1 = NBb[2 * i + 1];
            const float s0 = L1[a0] + L2[b0], s1 = L1[a1] + L2[b1];
            const float x0 = __uint_as_float((__float_as_uint(s0) & 0xffffff00u) | (unsigned)(a0 * 16 + b0));
            const float x1 = __uint_as_float((__float_as_uint(s1) & 0xffffff00u) | (unsigned)(a1 * 16 + b1));
            const float xv = hi ? x1 : x0;
            TOPK_INSERT(C, xv);
        }
        float o[16];
#pragma unroll
        for (int i = 0; i < 16; ++i) o[i] = swap32(C[i]);
        TOPK_MERGE16(C, o);
    }
    LAS float* my = scr + lane * 33;
#pragma unroll
    for (int i = 0; i < 16; ++i) { my[i] = L1[i]; my[16 + i] = L2[i]; }
    __builtin_amdgcn_s_waitcnt(0xc07f);
    asm volatile("" ::: "memory");
    const float mx = __uint_as_float(__float_as_uint(C[0]) & 0xffffff00u);
    float e[16], den = 0.f;
#pragma unroll
    for (int i = 0; i < 16; ++i) { e[i] = __expf(__uint_as_float(__float_as_uint(C[i]) & 0xffffff00u) - mx); den += e[i]; }
    const float rden = 1.f / den;
    {
        u32x4 iv[2]; f32x4 gv[2];
        const unsigned hm = hi ? 0xffffffffu : 0u;
#pragma unroll
        for (int j = 0; j < 8; ++j) {
            const unsigned cju = (__float_as_uint(C[8 + j]) & hm) | (__float_as_uint(C[j]) & ~hm);
            const float ej = __uint_as_float((__float_as_uint(e[8 + j]) & hm) | (__float_as_uint(e[j]) & ~hm));
            const unsigned ab = cju & 0xffu;
            const unsigned i1 = __float_as_uint(my[ab >> 4]) & 0x7fu, i2 = __float_as_uint(my[16 + (ab & 15)]) & 0x7fu;
            iv[j >> 2][j & 3] = i1 * 128 + i2;
            gv[j >> 2][j & 3] = ej * rden;
        }
        u32x4* ip = (u32x4*)(IDX + (size_t)tok * 128 + h * 16 + 8 * hi);
        f32x4* gp = (f32x4*)(GATE + (size_t)tok * 128 + h * 16 + 8 * hi);
        { const rsrc_t irc = make_rsrc(IDX, (unsigned)((size_t)T * 128 * 4)), grc = make_rsrc(GATE, (unsigned)((size_t)T * 128 * 4));
          const unsigned ob = (unsigned)(((size_t)tok * 128 + h * 16 + 8 * hi) * 4);
          st_wt(iv[0], irc, ob); st_wt(iv[1], irc, ob + 16u); st_wt(__builtin_bit_cast(u32x4, gv[0]), grc, ob); st_wt(__builtin_bit_cast(u32x4, gv[1]), grc, ob + 16u); }
    }
    __builtin_amdgcn_s_waitcnt(0xc07f);
    asm volatile("" ::: "memory");
}

__device__ __forceinline__ float gelu_erf(float x) { return 0.5f * x * (1.f + erff(x * 0.70710678118654752f)); }
template <bool FINAL>
__device__ __forceinline__ void expert_token(int t, const bf16_t* __restrict__ X1B, const float* __restrict__ X1, const float* __restrict__ ssp, const int* __restrict__ IDX, const float* __restrict__ GATE,
                                             const unsigned char* __restrict__ U8, const float* __restrict__ USC, const unsigned char* __restrict__ V8, const float* __restrict__ VSC,
                                             float* __restrict__ X2, bf16_t* __restrict__ XB, float* __restrict__ SS, const float* __restrict__ norm_final, float* __restrict__ OUT, int lane) {
    float xf[2][16];
#pragma unroll
    for (int j = 0; j < 2; ++j) {
        const u32x4* xp = (const u32x4*)(X1B + (size_t)t * D + j * 1024 + lane * 16);
        const u32x4 a = xp[0], b = xp[1];
#pragma unroll
        for (int q = 0; q < 4; ++q) { xf[j][2 * q] = bflo(a[q]); xf[j][2 * q + 1] = bfhi(a[q]); xf[j][8 + 2 * q] = bflo(b[q]); xf[j][8 + 2 * q + 1] = bfhi(b[q]); }
    }
    float sp = (lane < 32) ? ssp[(size_t)t * 32 + lane] : 0.f;
    sp = wsum(sp);
    const float rs1 = rsqrtf(sp * (1.f / D) + EPS);
    const int id0 = IDX[(size_t)t * 128 + lane], id1 = IDX[(size_t)t * 128 + 64 + lane];
    const float g0 = GATE[(size_t)t * 128 + lane], g1 = GATE[(size_t)t * 128 + 64 + lane];
    const float us0 = USC[id0], us1 = USC[id1], vs0 = VSC[id0], vs1 = VSC[id1];
    float acc[2][16];
#pragma unroll
    for (int j = 0; j < 2; ++j)
#pragma unroll
        for (int i = 0; i < 16; ++i) acc[j][i] = 0.f;
    float act0 = 0.f, act1 = 0.f;
#pragma unroll 1
    for (int e0 = 0; e0 < 128; e0 += 4) {
        u32x4 w[4][2];
#pragma unroll
        for (int e = 0; e < 4; ++e) {
            const int ee = e0 + e;
            const int id = __builtin_amdgcn_readlane(ee < 64 ? id0 : id1, ee & 63);
            const unsigned char* up = U8 + (size_t)id * D + lane * 16;
            w[e][0] = *(const u32x4*)up; w[e][1] = *(const u32x4*)(up + 1024);
        }
        float d[4];
#pragma unroll
        for (int e = 0; e < 4; ++e) {
            float s = 0.f;
#pragma unroll
            for (int j = 0; j < 2; ++j)
#pragma unroll
                for (int q = 0; q < 4; ++q) {
                    const f32x2 lo = __builtin_amdgcn_cvt_pk_f32_fp8((int)w[e][j][q], false), hi = __builtin_amdgcn_cvt_pk_f32_fp8((int)w[e][j][q], true);
                    s = fmaf(lo.x, xf[j][4 * q], s); s = fmaf(lo.y, xf[j][4 * q + 1], s); s = fmaf(hi.x, xf[j][4 * q + 2], s); s = fmaf(hi.y, xf[j][4 * q + 3], s);
                }
            d[e] = wsum(s);
        }
#pragma unroll
        for (int e = 0; e < 4; ++e) {
            const int ee = e0 + e;
            if (ee < 64) { if (lane == ee) act0 = d[e]; } else { if (lane == ee - 64) act1 = d[e]; }
        }
    }
    act0 = gelu_erf(act0 * us0 * rs1) * g0 * vs0;
    act1 = gelu_erf(act1 * us1 * rs1) * g1 * vs1;
#pragma unroll 1
    for (int e0 = 0; e0 < 128; e0 += 4) {
        u32x4 w[4][2];
        float a[4];
#pragma unroll
        for (int e = 0; e < 4; ++e) {
            const int ee = e0 + e;
            const int id = __builtin_amdgcn_readlane(ee < 64 ? id0 : id1, ee & 63);
            a[e] = __int_as_float(__builtin_amdgcn_readlane(__float_as_int(ee < 64 ? act0 : act1), ee & 63));
            const unsigned char* vp = V8 + (size_t)id * D + lane * 16;
            w[e][0] = *(const u32x4*)vp; w[e][1] = *(const u32x4*)(vp + 1024);
        }
#pragma unroll
        for (int e = 0; e < 4; ++e)
#pragma unroll
            for (int j = 0; j < 2; ++j)
#pragma unroll
                for (int q = 0; q < 4; ++q) {
                    const f32x2 lo = __builtin_amdgcn_cvt_pk_f32_fp8((int)w[e][j][q], false), hi = __builtin_amdgcn_cvt_pk_f32_fp8((int)w[e][j][q], true);
                    acc[j][4 * q] = fmaf(a[e], lo.x, acc[j][4 * q]); acc[j][4 * q + 1] = fmaf(a[e], lo.y, acc[j][4 * q + 1]);
                    acc[j][4 * q + 2] = fmaf(a[e], hi.x, acc[j][4 * q + 2]); acc[j][4 * q + 3] = fmaf(a[e], hi.y, acc[j][4 * q + 3]);
                }
    }
    float q2 = 0.f;
#pragma unroll
    for (int j = 0; j < 2; ++j)
#pragma unroll
        for (int q = 0; q < 4; ++q) {
            const f32x4 r = *(const f32x4*)(X1 + (size_t)t * D + j * 1024 + lane * 16 + q * 4);
            acc[j][4 * q] += r.x; acc[j][4 * q + 1] += r.y; acc[j][4 * q + 2] += r.z; acc[j][4 * q + 3] += r.w;
            q2 += (acc[j][4 * q] * acc[j][4 * q] + acc[j][4 * q + 1] * acc[j][4 * q + 1]) + (acc[j][4 * q + 2] * acc[j][4 * q + 2] + acc[j][4 * q + 3] * acc[j][4 * q + 3]);
        }
    q2 = wsum(q2);
    if (FINAL) {
        const float rf = rsqrtf(q2 * (1.f / D) + EPS);
#pragma unroll
        for (int j = 0; j < 2; ++j)
#pragma unroll
            for (int q = 0; q < 4; ++q) {
                const int e = j * 1024 + lane * 16 + q * 4;
                const f32x4 g = *(const f32x4*)(norm_final + e);
                f32x4 o; o.x = acc[j][4 * q] * rf * g.x; o.y = acc[j][4 * q + 1] * rf * g.y; o.z = acc[j][4 * q + 2] * rf * g.z; o.w = acc[j][4 * q + 3] * rf * g.w;
                *(f32x4*)(OUT + (size_t)t * D + e) = o;
            }
    } else {
#pragma unroll
        for (int j = 0; j < 2; ++j) {
#pragma unroll
            for (int q = 0; q < 4; ++q) {
                f32x4 o; o.x = acc[j][4 * q]; o.y = acc[j][4 * q + 1]; o.z = acc[j][4 * q + 2]; o.w = acc[j][4 * q + 3];
                *(f32x4*)(X2 + (size_t)t * D + j * 1024 + lane * 16 + q * 4) = o;
            }
            u32x4 b0, b1;
#pragma unroll
            for (int q = 0; q < 4; ++q) { b0[q] = pk2(acc[j][2 * q], acc[j][2 * q + 1]); b1[q] = pk2(acc[j][8 + 2 * q], acc[j][8 + 2 * q + 1]); }
            u32x4* xo = (u32x4*)(XB + (size_t)t * D + j * 1024 + lane * 16);
            xo[0] = b0; xo[1] = b1;
        }
        if (lane == 0) SS[t] = q2;
    }
}
}

namespace mk {
constexpr int KS_LD = 72, VS_LD = 80;
constexpr int ATT_KS_OFF = 0, ATT_VS_OFF = 256 * KS_LD * 2;
constexpr int ATT_LDS = ATT_VS_OFF + 256 * VS_LD * 2;

__device__ __forceinline__ bf16x8 tr_pair(const LAS bf16_t* p0, const LAS bf16_t* p1) {
    const s16x4 a = __builtin_amdgcn_ds_read_tr16_b64_v4i16((LAS s16x4*)p0);
    const s16x4 b = __builtin_amdgcn_ds_read_tr16_b64_v4i16((LAS s16x4*)p1);
    bf16x8 r; r[0] = a[0]; r[1] = a[1]; r[2] = a[2]; r[3] = a[3]; r[4] = b[0]; r[5] = b[1]; r[6] = b[2]; r[7] = b[3];
    return r;
}

__device__ __forceinline__ void attn_unit(const bf16_t* __restrict__ P, const f32x2* __restrict__ rope, const float* __restrict__ sinks_l, bf16_t* __restrict__ Y,
                                          int unit, LAS unsigned char* lds, int tid, int lane, int wave) {
    const int b = unit >> 6, n = (unit >> 1) & 31, kvh = unit & 1;
    const int tok0 = b * S + n * 128;
    LAS bf16_t* KS = (LAS bf16_t*)(lds + ATT_KS_OFF);
    LAS bf16_t* VS = (LAS bf16_t*)(lds + ATT_VS_OFF);
    {
        const int key = tid >> 1, part = tid & 1;
        const int kpos = n * 128 - 128 + key;
        u32x4 k1a = {0, 0, 0, 0}, k1b = k1a, k2a = k1a, k2b = k1a, v0 = k1a, v1 = k1a, v2 = k1a, v3 = k1a;
        if (kpos >= 0) {
            const bf16_t* kr = P + (size_t)(tok0 - 128 + key) * NP + C_KA + kvh * 64 + part * 16;
            const u32x4 x1a = *(const u32x4*)kr, x1b = *(const u32x4*)(kr + 8), x2a = *(const u32x4*)(kr + 32), x2b = *(const u32x4*)(kr + 40);
            const f32x4* cs4 = (const f32x4*)(rope + (size_t)kpos * 32 + part * 16);
            f32x4 cv[8];
#pragma unroll
            for (int q = 0; q < 8; ++q) cv[q] = cs4[q];
#pragma unroll
            for (int q = 0; q < 4; ++q) {
                {
                    const f32x2 c0 = {cv[q].x, cv[q].y}, c1 = {cv[q].z, cv[q].w};
                    const float a0 = bflo(x1a[q]), a1 = bfhi(x1a[q]), b0 = bflo(x2a[q]), b1 = bfhi(x2a[q]);
                    k1a[q] = pk2(a0 * c0.x - b0 * c0.y, a1 * c1.x - b1 * c1.y);
                    k2a[q] = pk2(b0 * c0.x + a0 * c0.y, b1 * c1.x + a1 * c1.y);
                }
                {
                    const f32x2 c0 = {cv[4 + q].x, cv[4 + q].y}, c1 = {cv[4 + q].z, cv[4 + q].w};
                    const float a0 = bflo(x1b[q]), a1 = bfhi(x1b[q]), b0 = bflo(x2b[q]), b1 = bfhi(x2b[q]);
                    k1b[q] = pk2(a0 * c0.x - b0 * c0.y, a1 * c1.x - b1 * c1.y);
                    k2b[q] = pk2(b0 * c0.x + a0 * c0.y, b1 * c1.x + a1 * c1.y);
                }
            }
            const bf16_t* vr = P + (size_t)(tok0 - 128 + key) * NP + C_VA + kvh * 64 + part * 32;
            v0 = *(const u32x4*)vr; v1 = *(const u32x4*)(vr + 8); v2 = *(const u32x4*)(vr + 16); v3 = *(const u32x4*)(vr + 24);
        }
        LAS bf16_t* kd = KS + key * KS_LD + part * 16;
        *(LAS u32x4*)kd = k1a; *(LAS u32x4*)(kd + 8) = k1b; *(LAS u32x4*)(kd + 32) = k2a; *(LAS u32x4*)(kd + 40) = k2b;
        LAS bf16_t* vd = VS + key * VS_LD + part * 32;
        *(LAS u32x4*)vd = v0; *(LAS u32x4*)(vd + 8) = v1; *(LAS u32x4*)(vd + 16) = v2; *(LAS u32x4*)(vd + 24) = v3;
    }
    __syncthreads();
    const int hq = kvh * 8 + wave;
    const int fr = lane & 15, fq = lane >> 4;
    constexpr float L2E = 1.4426950408889634f;
    const float sink2 = sinks_l[hq] * L2E;
    const int tq = (lane & 15) >> 2, tp = lane & 3;
    u32x4 x1n[2], x2n[2]; f32x4 csn[2][4];
#define ATT_FETCH(RP) do { _Pragma("unroll") for (int eb_ = 0; eb_ < 2; ++eb_) { const int qi_ = (RP) * 32 + eb_ * 16 + fr; const bf16_t* qr_ = P + (size_t)(tok0 + qi_) * NP + C_QA + hq * 64 + 8 * fq; \
        x1n[eb_] = *(const u32x4*)qr_; x2n[eb_] = *(const u32x4*)(qr_ + 32); const f32x4* cs_ = (const f32x4*)(rope + (size_t)(n * 128 + qi_) * 32 + 8 * fq); \
        csn[eb_][0] = cs_[0]; csn[eb_][1] = cs_[1]; csn[eb_][2] = cs_[2]; csn[eb_][3] = cs_[3]; } } while (0)
    ATT_FETCH(0);
#pragma unroll 1
    for (int rp = 0; rp < 4; ++rp) {
        const int wsk = rp * 32;
        bf16x8 bq0[2], bq1[2];
        u32x4 x1c[2], x2c[2]; f32x4 csc[2][4];
#pragma unroll
        for (int eb = 0; eb < 2; ++eb) { x1c[eb] = x1n[eb]; x2c[eb] = x2n[eb];
#pragma unroll
            for (int q = 0; q < 4; ++q) csc[eb][q] = csn[eb][q]; }
        if (rp < 3) ATT_FETCH(rp + 1);
#pragma unroll
        for (int eb = 0; eb < 2; ++eb) {
            const u32x4 x1 = x1c[eb], x2 = x2c[eb];
            u32x4 o1, o2;
            constexpr float SC = 0.125f * L2E;
#pragma unroll
            for (int q = 0; q < 4; ++q) {
                const f32x4 cq = csc[eb][q];
                const float a0 = bflo(x1[q]), a1 = bfhi(x1[q]), b0 = bflo(x2[q]), b1 = bfhi(x2[q]);
                o1[q] = pk2((a0 * cq.x - b0 * cq.y) * SC, (a1 * cq.z - b1 * cq.w) * SC);
                o2[q] = pk2((b0 * cq.x + a0 * cq.y) * SC, (b1 * cq.z + a1 * cq.w) * SC);
            }
            bq0[eb] = __builtin_bit_cast(bf16x8, o1); bq1[eb] = __builtin_bit_cast(bf16x8, o2);
        }
        pg8::f32x4 sc[2][10];
#pragma unroll
        for (int kt = 0; kt < 10; ++kt) {
            const LAS bf16_t* kp = KS + (wsk + kt * 16 + fr) * KS_LD + 8 * fq;
            const bf16x8 a0 = *(const LAS bf16x8*)kp, a1 = *(const LAS bf16x8*)(kp + 32);
#pragma unroll
            for (int eb = 0; eb < 2; ++eb) {
                pg8::f32x4 acc = {-1e30f, -1e30f, -1e30f, -1e30f};
                if (!((eb == 0 && kt == 9) || (eb == 1 && kt == 0))) {
                    acc = (pg8::f32x4){0.f, 0.f, 0.f, 0.f};
                    acc = __builtin_amdgcn_mfma_f32_16x16x32_bf16(a0, bq0[eb], acc, 0, 0, 0);
                    acc = __builtin_amdgcn_mfma_f32_16x16x32_bf16(a1, bq1[eb], acc, 0, 0, 0);
                }
                sc[eb][kt] = acc;
            }
        }
        const int kmin = (n == 0) ? 128 : 0;
        float rden[2];
#pragma unroll
        for (int eb = 0; eb < 2; ++eb) {
            const int qb = rp * 32 + eb * 16 + fr;
            float mx = sink2;
#pragma unroll
            for (int kt = 0; kt < 10; ++kt) {
                if ((eb == 0 && kt == 9) || (eb == 1 && kt == 0)) continue;
                const bool interior = (kt - eb >= 1 && kt - eb <= 7) && n != 0;
#pragma unroll
                for (int r = 0; r < 4; ++r) {
                    if (!interior) {
                        const int kb = wsk + kt * 16 + 4 * fq + r;
                        const bool ok = (kb >= qb + 1) && (kb <= qb + 128) && (kb >= kmin);
                        sc[eb][kt][r] = ok ? sc[eb][kt][r] : -1e30f;
                    }
                    mx = fmaxf(mx, sc[eb][kt][r]);
                }
            }
            mx = fmaxf(mx, __shfl_xor(mx, 16)); mx = fmaxf(mx, __shfl_xor(mx, 32));
            float sum = 0.f;
#pragma unroll
            for (int kt = 0; kt < 10; ++kt) {
                if ((eb == 0 && kt == 9) || (eb == 1 && kt == 0)) { sc[eb][kt] = (pg8::f32x4){0.f, 0.f, 0.f, 0.f}; continue; }
#pragma unroll
                for (int r = 0; r < 4; ++r) { const float pv = __builtin_amdgcn_exp2f(sc[eb][kt][r] - mx); sc[eb][kt][r] = pv; sum += pv; }
            }
            sum += __shfl_xor(sum, 16); sum += __shfl_xor(sum, 32);
            rden[eb] = __builtin_amdgcn_rcpf(sum + __builtin_amdgcn_exp2f(sink2 - mx));
        }
        pg8::f32x4 oacc[2][4];
#pragma unroll
        for (int eb = 0; eb < 2; ++eb)
#pragma unroll
            for (int mt = 0; mt < 4; ++mt) oacc[eb][mt] = (pg8::f32x4){0.f, 0.f, 0.f, 0.f};
#pragma unroll
        for (int kk = 0; kk < 5; ++kk) {
            bf16x8 bp[2];
#pragma unroll
            for (int eb = 0; eb < 2; ++eb) {
                u32x4 pb; pb[0] = pk2(sc[eb][2 * kk][0], sc[eb][2 * kk][1]); pb[1] = pk2(sc[eb][2 * kk][2], sc[eb][2 * kk][3]);
                pb[2] = pk2(sc[eb][2 * kk + 1][0], sc[eb][2 * kk + 1][1]); pb[3] = pk2(sc[eb][2 * kk + 1][2], sc[eb][2 * kk + 1][3]);
                bp[eb] = __builtin_bit_cast(bf16x8, pb);
            }
            const LAS bf16_t* v0 = VS + (wsk + (2 * kk) * 16 + 4 * fq + tq) * VS_LD + 4 * tp;
            const LAS bf16_t* v1 = v0 + 16 * VS_LD;
#pragma unroll
            for (int mt = 0; mt < 4; ++mt) {
                const bf16x8 av = tr_pair(v0 + mt * 16, v1 + mt * 16);
                oacc[0][mt] = __builtin_amdgcn_mfma_f32_16x16x32_bf16(av, bp[0], oacc[0][mt], 0, 0, 0);
                oacc[1][mt] = __builtin_amdgcn_mfma_f32_16x16x32_bf16(av, bp[1], oacc[1][mt], 0, 0, 0);
            }
        }
#pragma unroll
        for (int eb = 0; eb < 2; ++eb) {
            bf16_t* yr = Y + (size_t)(tok0 + rp * 32 + eb * 16 + fr) * D + hq * 64 + 4 * fq;
#pragma unroll
            for (int mt = 0; mt < 4; ++mt) {
                u32x2 w; w.x = pk2(oacc[eb][mt][0] * rden[eb], oacc[eb][mt][1] * rden[eb]); w.y = pk2(oacc[eb][mt][2] * rden[eb], oacc[eb][mt][3] * rden[eb]);
                *(u32x2*)(yr + mt * 16) = w;
            }
        }
    }
#undef ATT_FETCH
}

}

namespace mk {
constexpr int RL = 144;
constexpr int PSL = 72;
constexpr int OBL = 132;
constexpr int R_QT = 0, R_KT = 64 * RL * 2, R_KD = 2 * 64 * RL * 2, R_V = 3 * 64 * RL * 2, R_SB = 4 * 64 * RL * 2;
constexpr int R_PS = R_SB + 128 * RL * 2;
constexpr int R_VEC = R_PS + 64 * PSL * 2;
constexpr int R_OB = R_KT;
constexpr int REC_LDS = R_VEC + 12288;
static_assert(64 * OBL * 4 <= 2 * 64 * RL * 2, "OB overlay");
constexpr int ST_STRIDE = 16384 + 256;

__device__ __forceinline__ bf16x8 ld_row_split(const LAS bf16_t* p) {
    const s16x4 a = *(const LAS s16x4*)p, b = *(const LAS s16x4*)(p + 16);
    bf16x8 r; r[0] = a[0]; r[1] = a[1]; r[2] = a[2]; r[3] = a[3]; r[4] = b[0]; r[5] = b[1]; r[6] = b[2]; r[7] = b[3];
    return r;
}
__device__ __forceinline__ float clamp80(float x) { return fminf(fmaxf(x, -80.f), 80.f); }
__device__ __forceinline__ float sigm(float x) { return __builtin_amdgcn_rcpf(1.f + __builtin_amdgcn_exp2f(x * -1.4426950408889634f)); }
__device__ __forceinline__ void st_bf16(LAS bf16_t* p, float v) { *p = (bf16_t)(pk2(v, 0.f) & 0xffffu); }

__device__ __forceinline__ void state_update(pg8::f32x4 (&acc)[8], const LAS bf16_t* KDm, const LAS bf16_t* Vm, int wave, int fq, int tq, int tp) {
    bf16x8 ka[2];
#pragma unroll
    for (int ks = 0; ks < 2; ++ks) { const LAS bf16_t* p = KDm + (ks * 32 + 4 * fq + tq) * RL + 16 * wave + 4 * tp; ka[ks] = tr_pair(p, p + 16 * RL); }
#pragma unroll
    for (int j = 0; j < 8; ++j)
#pragma unroll
        for (int ks = 0; ks < 2; ++ks) {
            const LAS bf16_t* p = Vm + (ks * 32 + 4 * fq + tq) * RL + 16 * j + 4 * tp;
            const bf16x8 vb = tr_pair(p, p + 16 * RL);
            acc[j] = __builtin_amdgcn_mfma_f32_16x16x32_bf16(ka[ks], vb, acc[j], 0, 0, 0);
        }
}
__device__ __forceinline__ void state_to_lds(const pg8::f32x4 (&acc)[8], const float (&rsc)[4], LAS bf16_t* SBm, int wave, int fr, int fq) {
#pragma unroll
    for (int j = 0; j < 8; ++j)
#pragma unroll
        for (int r = 0; r < 4; ++r) st_bf16(SBm + (16 * wave + 4 * fq + r) * RL + 16 * j + fr, acc[j][r] * rsc[r]);
}
__device__ __forceinline__ void state_to_lds_t(const pg8::f32x4 (&acc)[8], LAS bf16_t* SBt, int wave, int fr, int fq) {
#pragma unroll
    for (int j = 0; j < 8; ++j) { u32x2 w; w.x = pk2(acc[j][0], acc[j][1]); w.y = pk2(acc[j][2], acc[j][3]); *(LAS u32x2*)(SBt + (16 * j + fr) * RL + 16 * wave + 4 * fq) = w; }
}
__device__ __forceinline__ void score_tile(pg8::f32x4& acc, const LAS bf16_t* Am, const LAS bf16_t* Bm, int ti, int tj, int fr, int fq) {
    acc = (pg8::f32x4){0.f, 0.f, 0.f, 0.f};
#pragma unroll
    for (int ks = 0; ks < 4; ++ks) {
        const bf16x8 a = *(const LAS bf16x8*)(Am + (16 * ti + fr) * RL + ks * 32 + 8 * fq);
        const bf16x8 b = *(const LAS bf16x8*)(Bm + (16 * tj + fr) * RL + ks * 32 + 8 * fq);
        acc = __builtin_amdgcn_mfma_f32_16x16x32_bf16(a, b, acc, 0, 0, 0);
    }
}
struct TileRegs { u32x4 a, b; };
__device__ __forceinline__ TileRegs tile_load(const bf16_t* __restrict__ src, int tid) {
    const int row = tid >> 3, seg = tid & 7;
    const bf16_t* s = src + (size_t)row * NP + seg * 16;
    TileRegs t; t.a = *(const u32x4*)s; t.b = *(const u32x4*)(s + 8); return t;
}
__device__ __forceinline__ void tile_store(const TileRegs& t, LAS bf16_t* dst, int tid) {
    const int row = tid >> 3, seg = tid & 7;
    LAS bf16_t* d = dst + row * RL + seg * 16;
    *(LAS u32x4*)d = t.a; *(LAS u32x4*)(d + 8) = t.b;
}
__device__ __forceinline__ void state_store(const pg8::f32x4 (&acc)[8], float* __restrict__ dst, int wave, int lane) {
#pragma unroll
    for (int j = 0; j < 8; ++j)
#pragma unroll
        for (int r = 0; r < 4; ++r) dst[((wave * 8 + j) * 4 + r) * 64 + lane] = acc[j][r];
}

template <int PASS>
__device__ __forceinline__ void hgrn_unit(const bf16_t* __restrict__ P, const float* __restrict__ lb_logits, int layer, const float* __restrict__ gain_l,
                                          float* __restrict__ STB, bf16_t* __restrict__ Y, int unit, LAS unsigned char* lds, int tid, int lane, int wave) {
    const int chain = unit >> 3, g = unit & 7, b = chain >> 2, h = chain & 3;
    const int t0 = b * S + g * 512;
    const int fr = lane & 15, fq = lane >> 4, tq = (lane & 15) >> 2, tp = lane & 3;
    const int kp = tid & 63, rg = wave, c0 = 2 * kp;
    LAS bf16_t* QT = (LAS bf16_t*)(lds + R_QT); LAS bf16_t* KT = (LAS bf16_t*)(lds + R_KT); LAS bf16_t* KD = (LAS bf16_t*)(lds + R_KD);
    LAS bf16_t* VV = (LAS bf16_t*)(lds + R_V); LAS bf16_t* SB = (LAS bf16_t*)(lds + R_SB); LAS bf16_t* PS = (LAS bf16_t*)(lds + R_PS);
    LAS float* TOT = (LAS float*)(lds + R_VEC);
    LAS float* EREF = TOT + 1024; LAS float* ELAST = EREF + 128;
    LAS float* OB = (LAS float*)(lds + R_OB);
    float lb0 = 0.f, lb1 = 0.f;
    if (layer == 1) {
        const float a0 = lb_logits[h * 128 + c0], a1 = lb_logits[512 + h * 128 + c0], d0 = lb_logits[h * 128 + c0 + 1], d1 = lb_logits[512 + h * 128 + c0 + 1];
        const float m0 = fmaxf(a0, a1), m1 = fmaxf(d0, d1);
        lb0 = __expf(a1 - m0) / (__expf(a0 - m0) + __expf(a1 - m0));
        lb1 = __expf(d1 - m1) / (__expf(d0 - m1) + __expf(d1 - m1));
    }
    pg8::f32x4 acc[8];
#pragma unroll
    for (int j = 0; j < 8; ++j) acc[j] = (pg8::f32x4){0.f, 0.f, 0.f, 0.f};
    if (PASS == 2) {
        for (int jg = 0; jg < g; ++jg) {
            const float* sb = STB + (size_t)(chain * 8 + jg) * ST_STRIDE;
            float dk[4];
#pragma unroll
            for (int r = 0; r < 4; ++r) dk[r] = __expf(sb[16384 + 16 * wave + 4 * fq + r]);
#pragma unroll
            for (int j = 0; j < 8; ++j)
#pragma unroll
                for (int r = 0; r < 4; ++r) acc[j][r] = acc[j][r] * dk[r] + sb[((wave * 8 + j) * 4 + r) * 64 + lane];
        }
    }
    float gl0 = 0.f, gl1 = 0.f;
    unsigned fwn[8], qwn[8];
    {
#pragma unroll
        for (int i = 0; i < 8; ++i) { const bf16_t* pr = P + (size_t)(t0 + rg * 8 + i) * NP + h * 128 + c0; fwn[i] = *(const unsigned*)(pr + C_FH); if (PASS == 2) qwn[i] = *(const unsigned*)(pr + C_QH); }
    }
    TileRegs vnx = tile_load(P + (size_t)t0 * NP + C_IH + h * 128, tid);
#pragma unroll 1
    for (int c = 0; c < 8; ++c) {
        const int tr0 = t0 + c * 64;
        float lf0[8], lf1[8], kk0[8], kk1[8], qv0[8], qv1[8];
#pragma unroll
        for (int i = 0; i < 8; ++i) {
            const unsigned fw = fwn[i];
            const float z0 = bflo(fw), z1 = bfhi(fw);
            const float s0 = sigm(z0), s1 = sigm(z1);
            lf0[i] = __logf(fmaxf(lb0 + (1.f - lb0) * s0, 1e-30f)); lf1[i] = __logf(fmaxf(lb1 + (1.f - lb1) * s1, 1e-30f));
            kk0[i] = (1.f - lb0) * (1.f - s0); kk1[i] = (1.f - lb1) * (1.f - s1);
            if (PASS == 2) { const unsigned qw = qwn[i]; const float q0 = bflo(qw), q1 = bfhi(qw); qv0[i] = q0 * sigm(q0); qv1[i] = q1 * sigm(q1); }
        }
#pragma unroll
        for (int i = 1; i < 8; ++i) { lf0[i] += lf0[i - 1]; lf1[i] += lf1[i - 1]; }
        TOT[rg * 128 + c0] = lf0[7]; TOT[rg * 128 + c0 + 1] = lf1[7];
        tile_store(vnx, VV, tid);
        if (c < 7) vnx = tile_load(P + (size_t)(tr0 + 64) * NP + C_IH + h * 128, tid);
        if (c < 7) {
            const int trn = tr0 + 64;
#pragma unroll
            for (int i = 0; i < 8; ++i) { const bf16_t* pr = P + (size_t)(trn + rg * 8 + i) * NP + h * 128 + c0; fwn[i] = *(const unsigned*)(pr + C_FH); if (PASS == 2) qwn[i] = *(const unsigned*)(pr + C_QH); }
        }
        __syncthreads();
        {
            float pre0 = 0.f, pre1 = 0.f, ref0 = 0.f, ref1 = 0.f, la0 = 0.f, la1 = 0.f;
#pragma unroll
            for (int r = 0; r < 8; ++r) {
                const float a0 = TOT[r * 128 + c0], a1 = TOT[r * 128 + c0 + 1];
                if (r < rg) { pre0 += a0; pre1 += a1; }
                if (r < 4) { ref0 += a0; ref1 += a1; }
                la0 += a0; la1 += a1;
            }
#pragma unroll
            for (int i = 0; i < 8; ++i) {
                const int row = rg * 8 + i;
                const float cu0 = pre0 + lf0[i], cu1 = pre1 + lf1[i];
                if (PASS == 2) {
                    *(LAS unsigned*)(QT + row * RL + c0) = pk2(qv0[i] * __expf(clamp80(cu0 - ref0)), qv1[i] * __expf(clamp80(cu1 - ref1)));
                    *(LAS unsigned*)(KT + row * RL + c0) = pk2(kk0[i] * __expf(clamp80(ref0 - cu0)), kk1[i] * __expf(clamp80(ref1 - cu1)));
                }
                *(LAS unsigned*)(KD + row * RL + c0) = pk2(kk0[i] * __expf(la0 - cu0), kk1[i] * __expf(la1 - cu1));
            }
            if (rg == 0) { EREF[c0] = __expf(ref0); EREF[c0 + 1] = __expf(ref1); ELAST[c0] = __expf(la0); ELAST[c0 + 1] = __expf(la1); }
            gl0 += la0; gl1 += la1;
        }
        __syncthreads();
        TileRegs gcur = {};
        if (PASS == 2) gcur = tile_load(P + (size_t)tr0 * NP + C_GH + h * 128, tid);
        pg8::f32x4 o[4];
        if (PASS == 2) {
            { float rs[4];
#pragma unroll
              for (int r = 0; r < 4; ++r) rs[r] = EREF[16 * wave + 4 * fq + r];
#pragma unroll
              for (int j = 0; j < 8; ++j) { u32x2 w; w.x = pk2(acc[j][0] * rs[0], acc[j][1] * rs[1]); w.y = pk2(acc[j][2] * rs[2], acc[j][3] * rs[3]);
                  *(LAS u32x2*)(SB + (16 * j + fr) * RL + 16 * wave + 4 * fq) = w; } }
            { const int ti = wave >> 1;
#pragma unroll
              for (int tjj = 0; tjj < 2; ++tjj) {
                  const int tj = 2 * (wave & 1) + tjj;
                  pg8::f32x4 sa = {0.f, 0.f, 0.f, 0.f};
                  if (tj <= ti) score_tile(sa, QT, KT, ti, tj, fr, fq);
#pragma unroll
                  for (int r = 0; r < 4; ++r) {
                      const int t = 16 * ti + 4 * fq + r, s = 16 * tj + fr;
                      st_bf16(PS + t * PSL + s, (s <= t) ? sa[r] : 0.f);
                  }
              } }
        }
        {
#pragma unroll
            for (int r = 0; r < 4; ++r) { const float el = ELAST[16 * wave + 4 * fq + r];
#pragma unroll
                for (int j = 0; j < 8; ++j) acc[j][r] *= el; }
            state_update(acc, KD, VV, wave, fq, tq, tp);
        }
        if (PASS == 2) {
            __syncthreads();
            bf16x8 sbf[4], vbf[2];
#pragma unroll
            for (int ks = 0; ks < 4; ++ks) sbf[ks] = *(const LAS bf16x8*)(SB + (16 * wave + fr) * RL + ks * 32 + 8 * fq);
#pragma unroll
            for (int ks = 0; ks < 2; ++ks) { const LAS bf16_t* p = VV + (ks * 32 + 4 * fq + tq) * RL + 16 * wave + 4 * tp; vbf[ks] = tr_pair(p, p + 16 * RL); }
#pragma unroll
            for (int ti = 0; ti < 4; ++ti) {
                o[ti] = (pg8::f32x4){0.f, 0.f, 0.f, 0.f};
#pragma unroll
                for (int ks = 0; ks < 4; ++ks) o[ti] = __builtin_amdgcn_mfma_f32_16x16x32_bf16(*(const LAS bf16x8*)(QT + (16 * ti + fr) * RL + ks * 32 + 8 * fq), sbf[ks], o[ti], 0, 0, 0);
#pragma unroll
                for (int ks = 0; ks < 2; ++ks) o[ti] = __builtin_amdgcn_mfma_f32_16x16x32_bf16(ld_row_split(PS + (16 * ti + fr) * PSL + ks * 32 + 4 * fq), vbf[ks], o[ti], 0, 0, 0);
            }
        }
        if (PASS == 1) __syncthreads();
        if (PASS == 2) {
#pragma unroll
            for (int ti = 0; ti < 4; ++ti)
#pragma unroll
                for (int r = 0; r < 4; ++r) OB[(16 * ti + 4 * fq + r) * OBL + 16 * wave + fr] = o[ti][r];
            __syncthreads();
            const int t = tid >> 3, seg = tid & 7;
            float ov[16]; float ss = 0.f;
#pragma unroll
            for (int q = 0; q < 4; ++q) { const f32x4 a = *(const LAS f32x4*)(OB + t * OBL + seg * 16 + 4 * q); ov[4 * q] = a.x; ov[4 * q + 1] = a.y; ov[4 * q + 2] = a.z; ov[4 * q + 3] = a.w;
                ss += (a.x * a.x + a.y * a.y) + (a.z * a.z + a.w * a.w); }
            ss = sum8(ss);
            const float rn = rsqrtf(ss * (1.f / 128.f) + EPS);
            const u32x4 g0 = gcur.a, g1 = gcur.b;
            const float* gnp = gain_l + h * 128 + seg * 16;
            u32x4 y0, y1;
#pragma unroll
            for (int q = 0; q < 4; ++q) {
                const float ga = bflo(g0[q]), gb = bfhi(g0[q]), gc = bflo(g1[q]), gd = bfhi(g1[q]);
                y0[q] = pk2(ov[2 * q] * rn * gnp[2 * q] * (ga * sigm(ga)), ov[2 * q + 1] * rn * gnp[2 * q + 1] * (gb * sigm(gb)));
                y1[q] = pk2(ov[8 + 2 * q] * rn * gnp[8 + 2 * q] * (gc * sigm(gc)), ov[8 + 2 * q + 1] * rn * gnp[8 + 2 * q + 1] * (gd * sigm(gd)));
            }
            bf16_t* yp = Y + (size_t)(tr0 + t) * D + 1024 + h * 128 + seg * 16;
            *(u32x4*)yp = y0; *(u32x4*)(yp + 8) = y1;
        }
    }
    if (PASS == 1) {
        float* sb = STB + (size_t)(chain * 8 + g) * ST_STRIDE;
        state_store(acc, sb, wave, lane);
        if (rg == 0) { sb[16384 + c0] = gl0; sb[16384 + c0 + 1] = gl1; }
    }
}

template <int PASS>
__device__ __forceinline__ void mlstm_unit(const bf16_t* __restrict__ P, const float* __restrict__ conv_l, const float* __restrict__ ib_l, const float* __restrict__ fb_l,
                                           float* __restrict__ STB, bf16_t* __restrict__ Y, int unit, LAS unsigned char* lds, int tid, int lane, int wave) {
    const int chain = unit >> 3, g = unit & 7, b = chain >> 2, h = chain & 3;
    const int t0 = b * S + g * 512;
    const int fr = lane & 15, fq = lane >> 4, tq = (lane & 15) >> 2, tp = lane & 3;
    const int kp = tid & 63, rg = wave, c0 = 2 * kp;
    LAS bf16_t* QM = (LAS bf16_t*)(lds + R_QT); LAS bf16_t* KM = (LAS bf16_t*)(lds + R_KT); LAS bf16_t* KW = (LAS bf16_t*)(lds + R_KD);
    LAS bf16_t* VV = (LAS bf16_t*)(lds + R_V); LAS bf16_t* CB = (LAS bf16_t*)(lds + R_SB); LAS bf16_t* PS = (LAS bf16_t*)(lds + R_PS);
    LAS float* VEC = (LAS float*)(lds + R_VEC);
    LAS float* GA = VEC;
    LAS float* GPM = VEC + 512;
    LAS float* GCUM = VEC + 1024;
    LAS float* NV = VEC + 1536;
    LAS float* DENP = VEC + 1664;
    LAS float* DINT = VEC + 1792;
    LAS float* KSUM = VEC + 1856;
    LAS float* OB = (LAS float*)(lds + R_OB);
    float wq0[4], wq1[4], wk0[4], wk1[4];
#pragma unroll
    for (int j = 0; j < 4; ++j) {
        wq0[j] = conv_l[j * 1024 + h * 128 + c0]; wq1[j] = conv_l[j * 1024 + h * 128 + c0 + 1];
        wk0[j] = conv_l[j * 1024 + 512 + h * 128 + c0]; wk1[j] = conv_l[j * 1024 + 512 + h * 128 + c0 + 1];
    }
    {
        const bf16_t* pr = P + (size_t)(t0 + wave * 64 + lane) * NP;
        const float ip = bf2f(pr[C_IM + h]) + ib_l[h];
        const float z = bf2f(pr[C_FM + h]) + fb_l[h];
        const float lf = fminf(z, 0.f) - __logf(1.f + __expf(-fabsf(z)));
        float cu = lf;
#pragma unroll
        for (int o = 1; o < 64; o <<= 1) { const float t = __shfl_up(cu, o); if (lane >= o) cu += t; }
        const float a = ip - cu;
        float pm = a;
#pragma unroll
        for (int o = 1; o < 64; o <<= 1) { const float t = __shfl_up(pm, o); if (lane >= o) pm = fmaxf(pm, t); }
        GA[wave * 64 + lane] = a; GPM[wave * 64 + lane] = pm; GCUM[wave * 64 + lane] = cu;
    }
    pg8::f32x4 acc[8];
#pragma unroll
    for (int j = 0; j < 8; ++j) acc[j] = (pg8::f32x4){0.f, 0.f, 0.f, 0.f};
    float mprev = (PASS == 1) ? -1e30f : 0.f;
    float nreg = 0.f;
    float fsum = 0.f;
    if (PASS == 2) {
        for (int jg = 0; jg < g; ++jg) {
            const float* sb = STB + (size_t)(chain * 8 + jg) * ST_STRIDE;
            const float mE = sb[16384 + 128], F = sb[16384 + 129];
            const float mn = fmaxf(F + mprev, mE);
            const float s1 = __expf(F + mprev - mn), s2 = __expf(mE - mn);
#pragma unroll
            for (int j = 0; j < 8; ++j)
#pragma unroll
                for (int r = 0; r < 4; ++r) acc[j][r] = acc[j][r] * s1 + s2 * sb[((wave * 8 + j) * 4 + r) * 64 + lane];
            if (tid < 128) nreg = nreg * s1 + s2 * sb[16384 + tid];
            mprev = mn;
        }
    }
    if (tid < 128) NV[tid] = nreg;
    unsigned xqn[11], xkn[11];
#define MLSTM_FETCH(TR0, CC) do { _Pragma("unroll") for (int i = 0; i < 11; ++i) { \
            const int row_ = rg * 8 + i - 3; const int pos_ = g * 512 + (CC) * 64 + row_; unsigned wq_ = 0u, wk_ = 0u; \
            if (pos_ >= 0) { const bf16_t* pr_ = P + (size_t)((TR0) + row_) * NP + h * 128 + c0; if (PASS == 2) wq_ = *(const unsigned*)(pr_ + C_QM); wk_ = *(const unsigned*)(pr_ + C_KM); } \
            xqn[i] = wq_; xkn[i] = wk_; } \
        } while (0)
    MLSTM_FETCH(t0, 0);
    TileRegs vnx = tile_load(P + (size_t)t0 * NP + C_VM + h * 128, tid);
    __syncthreads();
#pragma unroll 1
    for (int c = 0; c < 8; ++c) {
        const int tr0 = t0 + c * 64;
        const LAS float* AV = GA + c * 64; const LAS float* PM = GPM + c * 64; const LAS float* CUM = GCUM + c * 64;
        const float M63 = fmaxf(PM[63], mprev), last = CUM[63];
        float ks0 = 0.f, ks1 = 0.f;
#pragma unroll
        for (int i = 0; i < 8; ++i) {
            const int row = rg * 8 + i;
            float k0v = 0.f, k1v = 0.f, q0v = 0.f, q1v = 0.f;
#pragma unroll
            for (int j = 0; j < 4; ++j) { k0v += wk0[j] * bflo(xkn[i + j]); k1v += wk1[j] * bfhi(xkn[i + j]); if (PASS == 2) { q0v += wq0[j] * bflo(xqn[i + j]); q1v += wq1[j] * bfhi(xqn[i + j]); } }
            k0v = k0v * sigm(k0v) * 0.08838834764831845f; k1v = k1v * sigm(k1v) * 0.08838834764831845f;
            const float wsr = __expf(AV[row] - M63);
            const unsigned kw = pk2(k0v * wsr, k1v * wsr);
            *(LAS unsigned*)(KW + row * RL + c0) = kw;
            ks0 += bflo(kw); ks1 += bfhi(kw);
            if (PASS == 2) {
                *(LAS unsigned*)(KM + row * RL + c0) = pk2(k0v, k1v);
                *(LAS unsigned*)(QM + row * RL + c0) = pk2(q0v * sigm(q0v), q1v * sigm(q1v));
            }
        }
        KSUM[rg * 128 + c0] = ks0; KSUM[rg * 128 + c0 + 1] = ks1;
        tile_store(vnx, VV, tid);
        if (c < 7) vnx = tile_load(P + (size_t)(tr0 + 64) * NP + C_VM + h * 128, tid);
        if (c < 7) MLSTM_FETCH(tr0 + 64, c + 1);
        const float decay = __expf(mprev - M63);
        pg8::f32x4 o1[4], o2[4];
        if (PASS == 2) {
            state_to_lds_t(acc, CB, wave, fr, fq);
        }
        __syncthreads();
        TileRegs ocur = {};
        if (PASS == 2) ocur = tile_load(P + (size_t)tr0 * NP + C_OM + h * 128, tid);
        if (PASS == 2) {
            { const int ti = wave >> 1;
              const f32x4 pm4 = *(const LAS f32x4*)(PM + 16 * ti + 4 * fq);
              float dp[4] = {0.f, 0.f, 0.f, 0.f};
#pragma unroll
              for (int tjj = 0; tjj < 2; ++tjj) {
                  const int tj = 2 * (wave & 1) + tjj;
                  pg8::f32x4 sa = {0.f, 0.f, 0.f, 0.f};
                  if (tj <= ti) score_tile(sa, QM, KM, ti, tj, fr, fq);
                  const int s = 16 * tj + fr;
                  const float as = AV[s];
#pragma unroll
                  for (int r = 0; r < 4; ++r) {
                      const int t = 16 * ti + 4 * fq + r;
                      const float w = (s <= t) ? sa[r] * __expf(as - fmaxf(pm4[r], mprev)) : 0.f;
                      st_bf16(PS + t * PSL + s, w);
                      dp[r] += w;
                  }
              }
#pragma unroll
              for (int r = 0; r < 4; ++r) {
                  const float v = sum16(dp[r]);
                  if (fr == 0) DENP[(16 * ti + 4 * fq + r) * 2 + (wave & 1)] = v;
              } }
            { const int t = tid >> 3, seg = tid & 7;
              const bf16x8 qa = *(const LAS bf16x8*)(QM + t * RL + seg * 16), qb = *(const LAS bf16x8*)(QM + t * RL + seg * 16 + 8);
              const LAS f32x4* nv4 = (const LAS f32x4*)(NV + seg * 16);
              const f32x4 n0 = nv4[0], n1 = nv4[1], n2 = nv4[2], n3 = nv4[3];
              const float nvv[16] = {n0.x, n0.y, n0.z, n0.w, n1.x, n1.y, n1.z, n1.w, n2.x, n2.y, n2.z, n2.w, n3.x, n3.y, n3.z, n3.w};
              float dsum = 0.f;
#pragma unroll
              for (int q = 0; q < 8; ++q) dsum += bf2f((unsigned short)qa[q]) * nvv[q] + bf2f((unsigned short)qb[q]) * nvv[8 + q];
              dsum = sum8(dsum);
              if (seg == 0) DINT[t] = dsum; }
            {
                bf16x8 cbf[4];
#pragma unroll
                for (int ks = 0; ks < 4; ++ks) cbf[ks] = *(const LAS bf16x8*)(CB + (16 * wave + fr) * RL + ks * 32 + 8 * fq);
#pragma unroll
                for (int ti = 0; ti < 4; ++ti) {
                    o2[ti] = (pg8::f32x4){0.f, 0.f, 0.f, 0.f};
#pragma unroll
                    for (int ks = 0; ks < 4; ++ks) o2[ti] = __builtin_amdgcn_mfma_f32_16x16x32_bf16(*(const LAS bf16x8*)(QM + (16 * ti + fr) * RL + ks * 32 + 8 * fq), cbf[ks], o2[ti], 0, 0, 0);
                }
            }
        }
        {
#pragma unroll
            for (int j = 0; j < 8; ++j) acc[j] = acc[j] * decay;
            state_update(acc, KW, VV, wave, fq, tq, tp);
            if (tid < 128) {
                float sumk = 0.f;
#pragma unroll
                for (int r8 = 0; r8 < 8; ++r8) sumk += KSUM[r8 * 128 + tid];
                nreg = nreg * decay + sumk;
            }
        }
        if (PASS == 2) {
            __syncthreads();
            bf16x8 vbf[2];
#pragma unroll
            for (int ks = 0; ks < 2; ++ks) { const LAS bf16_t* p = VV + (ks * 32 + 4 * fq + tq) * RL + 16 * wave + 4 * tp; vbf[ks] = tr_pair(p, p + 16 * RL); }
#pragma unroll
            for (int ti = 0; ti < 4; ++ti) {
                o1[ti] = (pg8::f32x4){0.f, 0.f, 0.f, 0.f};
#pragma unroll
                for (int ks = 0; ks < 2; ++ks) o1[ti] = __builtin_amdgcn_mfma_f32_16x16x32_bf16(ld_row_split(PS + (16 * ti + fr) * PSL + ks * 32 + 4 * fq), vbf[ks], o1[ti], 0, 0, 0);
            }
        }
        fsum += last;
        const float mnew = last + M63;
        if (tid < 128) NV[tid] = nreg;
        if (PASS == 2) {
#pragma unroll
            for (int ti = 0; ti < 4; ++ti) {
                const f32x4 pm4 = *(const LAS f32x4*)(PM + 16 * ti + 4 * fq);
#pragma unroll
                for (int r = 0; r < 4; ++r) {
                    const int t = 16 * ti + 4 * fq + r;
                    OB[t * OBL + 16 * wave + fr] = o1[ti][r] + __expf(mprev - fmaxf(pm4[r], mprev)) * o2[ti][r];
                }
            }
            __syncthreads();
            const int t = tid >> 3, seg = tid & 7;
            const float Mt = fmaxf(PM[t], mprev);
            const float wi = __expf(mprev - Mt);
            const float den = DENP[t * 2] + DENP[t * 2 + 1] + wi * DINT[t];
            const float hd = __builtin_amdgcn_rcpf(fmaxf(fabsf(den), __expf(-(CUM[t] + Mt))));
            const u32x4 g0 = ocur.a, g1 = ocur.b;
            const unsigned gw[8] = {g0[0], g0[1], g0[2], g0[3], g1[0], g1[1], g1[2], g1[3]};
            unsigned yw[8];
#pragma unroll
            for (int q = 0; q < 4; ++q) {
                const f32x4 a = *(const LAS f32x4*)(OB + t * OBL + seg * 16 + 4 * q);
                yw[2 * q] = pk2(a.x * hd * sigm(bflo(gw[2 * q])), a.y * hd * sigm(bfhi(gw[2 * q])));
                yw[2 * q + 1] = pk2(a.z * hd * sigm(bflo(gw[2 * q + 1])), a.w * hd * sigm(bfhi(gw[2 * q + 1])));
            }
            u32x4 y0, y1;
            y0[0] = yw[0]; y0[1] = yw[1]; y0[2] = yw[2]; y0[3] = yw[3]; y1[0] = yw[4]; y1[1] = yw[5]; y1[2] = yw[6]; y1[3] = yw[7];
            bf16_t* yp = Y + (size_t)(tr0 + t) * D + 1536 + h * 128 + seg * 16;
            *(u32x4*)yp = y0; *(u32x4*)(yp + 8) = y1;
        }
        mprev = mnew;
        __syncthreads();
    }
#undef MLSTM_FETCH
    if (PASS == 1) {
        float* sb = STB + (size_t)(chain * 8 + g) * ST_STRIDE;
        state_store(acc, sb, wave, lane);
        if (tid < 128) sb[16384 + tid] = nreg;
        if (tid == 0) { sb[16384 + 128] = mprev; sb[16384 + 129] = fsum; }
    }
}
}

namespace mk {
#define XB_TMO      128
#define XB_XCNT(j)  (256  + 64 * (j))
#define XB_XSUB(j)  (1280 + 64 * (j))
#define XB_XGEN(j)  (2304 + 64 * (j))
#define XB_TOP      3328
#define XB_TOPGEN   3392
#define XCD_BAR_WORDS 3456
#define XB_SPIN_CAP (1u << 18)

__device__ __forceinline__ unsigned xb_ld(unsigned* p)              { return __hip_atomic_load(p, __ATOMIC_RELAXED, __HIP_MEMORY_SCOPE_AGENT); }
__device__ __forceinline__ unsigned xb_add(unsigned* p, unsigned v) { return __hip_atomic_fetch_add(p, v, __ATOMIC_RELAXED, __HIP_MEMORY_SCOPE_AGENT); }
__device__ __forceinline__ unsigned xb_xcc_id() { return (unsigned)__builtin_amdgcn_s_getreg((3 << 11) | 20) & 0xFu; }
#define XB_SPIN(cond, bar) do { unsigned _sp = 0; while (cond) { __builtin_amdgcn_s_sleep(1); \
    if ((++_sp & 255u) == 0u) { if (xb_ld(&(bar)[XB_TMO])) break; if (_sp > XB_SPIN_CAP) { atomicAdd(&(bar)[XB_TMO], 1u); break; } } } } while (0)

struct XcdBarrier {
    unsigned* bar; unsigned x;
    volatile LAS unsigned* st;
};

__device__ __forceinline__ XcdBarrier xcd_barrier_post(unsigned* bar, volatile LAS unsigned* st) {
    XcdBarrier b; b.bar = bar; b.x = xb_xcc_id(); b.st = st;
    if (threadIdx.x == 0) (void)xb_add(&bar[XB_XCNT(b.x)], 1u);
    return b;
}
__device__ __forceinline__ void xcd_barrier_complete(unsigned* bar, unsigned x, unsigned& nloc, unsigned& nx) {
    const unsigned G = gridDim.x * gridDim.y * gridDim.z;
    unsigned sum, cnt, mine, sp = 0u;
    for (;;) {
        sum = 0u; cnt = 0u; mine = 0u;
#pragma unroll
        for (unsigned j = 0; j < 16; ++j) { const unsigned c = xb_ld(&bar[XB_XCNT(j)]); sum += c; cnt += (c > 0u) ? 1u : 0u; mine = (j == x) ? c : mine; }
        if (sum == G) break;
        __builtin_amdgcn_s_sleep(1);
        if ((++sp & 255u) == 0u) { if (xb_ld(&bar[XB_TMO])) break; if (sp > XB_SPIN_CAP) { atomicAdd(&bar[XB_TMO], 1u); break; } }
    }
    nloc = mine > 0u ? mine : 1u; nx = cnt > 0u ? cnt : 1u;
}

__device__ __forceinline__ void xcd_barrier(const XcdBarrier& b) {
    asm volatile("s_waitcnt vmcnt(0)" ::: "memory");
    __syncthreads();
    if (threadIdx.x == 0) {
        unsigned* bar = b.bar;
        __builtin_amdgcn_s_waitcnt(0);
        unsigned nloc = b.st[0], nx = b.st[1];
        if (nloc == 0u) { xcd_barrier_complete(bar, b.x, nloc, nx); b.st[0] = nloc; b.st[1] = nx; }
        const unsigned old = xb_add(&bar[XB_XSUB(b.x)], 1u);
        const unsigned gen = old / nloc;
        if (old + 1u == (gen + 1u) * nloc) {
            __builtin_amdgcn_fence(__ATOMIC_RELEASE, "agent");
            asm volatile("s_waitcnt vmcnt(0)" ::: "memory");
            const unsigned og = xb_add(&bar[XB_TOP], 1u);
            const unsigned tg = og / nx;
            if (og + 1u == (tg + 1u) * nx) xb_add(&bar[XB_TOPGEN], 1u);
            else XB_SPIN(xb_ld(&bar[XB_TOPGEN]) == tg, bar);
            __builtin_amdgcn_fence(__ATOMIC_ACQUIRE, "agent");
            xb_add(&bar[XB_XGEN(b.x)], 1u);
            asm volatile("s_waitcnt vmcnt(0)" ::: "memory");
        } else {
            XB_SPIN(xb_ld(&bar[XB_XGEN(b.x)]) == gen, bar);
            __builtin_amdgcn_fence(__ATOMIC_ACQUIRE, "agent");
            asm volatile("s_waitcnt vmcnt(0)" ::: "memory");
        }
    }
    __syncthreads();
}

}

namespace mk {
constexpr int NSLICE = 16, SLW = 128, TBLK = 128, NTB = T / TBLK;
constexpr int CTL_Q = 3584;

__device__ __forceinline__ f32x2 fma2(f32x2 a, f32x2 b, f32x2 c) { return __builtin_elementwise_fma(a, b, c); }

__device__ __forceinline__ int q_next(unsigned* cnt, LAS int* slot, int tid) {
    __syncthreads();
    if (tid == 0) *slot = (int)__hip_atomic_fetch_add(cnt, 1u, __ATOMIC_RELAXED, __HIP_MEMORY_SCOPE_AGENT);
    __syncthreads();
    const int v = *slot;
    return v < NTB ? v : -1;
}


constexpr int PL_IDX = 0, PL_AUX = TBLK * 128 * 4;
#define PEER_ISSUE(W, IDP) do { const LAS u32x4* ip_ = (const LAS u32x4*)(IDP); const u32x4 i0_ = ip_[0], i1_ = ip_[1], i2_ = ip_[2], i3_ = ip_[3]; \
        _Pragma("unroll") for (int k = 0; k < 4; ++k) { \
            W[k]      = __builtin_amdgcn_raw_buffer_load_b128(rs, (int)i0_[k] * SLW + c * 16, soff, 0); \
            W[4 + k]  = __builtin_amdgcn_raw_buffer_load_b128(rs, (int)i1_[k] * SLW + c * 16, soff, 0); \
            W[8 + k]  = __builtin_amdgcn_raw_buffer_load_b128(rs, (int)i2_[k] * SLW + c * 16, soff, 0); \
            W[12 + k] = __builtin_amdgcn_raw_buffer_load_b128(rs, (int)i3_[k] * SLW + c * 16, soff, 0); } } while (0)
constexpr float XS8 = 1.f;
typedef _Float16 h2_t __attribute__((ext_vector_type(2)));
template <int CTRL> __device__ __forceinline__ int dppi(int x) { return __builtin_amdgcn_mov_dpp(x, CTRL, 0xf, 0xf, true); }
template <int MODE>
__device__ __forceinline__ void u_compute(u32x4 (&w)[16], const LAS unsigned* xs, float* __restrict__ PART, int s, int t, int g, int c) {
    if (MODE == 1) { _Pragma("unroll") for (int k = 0; k < 16; ++k) asm volatile("" :: "v"(w[k])); return; }
    if (MODE == 2) { _Pragma("unroll") for (int k = 0; k < 16; ++k) asm volatile("" : "=v"(w[k])); }
    const u32x4 xi = *(const LAS u32x4*)xs;
    int r0 = 0, r1 = 0;
#pragma unroll
    for (int k = 0; k < 16; ++k) {
        int d = __builtin_amdgcn_sdot4((int)w[k][0], (int)xi[0], 0, false);
        d = __builtin_amdgcn_sdot4((int)w[k][1], (int)xi[1], d, false);
        d = __builtin_amdgcn_sdot4((int)w[k][2], (int)xi[2], d, false);
        d = __builtin_amdgcn_sdot4((int)w[k][3], (int)xi[3], d, false);
        d += dppi<DPP_XOR1>(d); d += dppi<DPP_XOR2>(d); d += dppi<DPP_HMIR>(d);
        if ((k >> 1) == c) { if (k & 1) r1 = d; else r0 = d; }
    }
    if (MODE == 2) { asm volatile("" :: "v"(r0), "v"(r1)); return; }
    ((unsigned*)PART)[((size_t)s * T + t) * 64 + 8 * g + c] = pk2((float)r0, (float)r1);
}
struct UStage { u32x4 id[8]; u32x4 x[4]; float am[4]; };
__device__ __forceinline__ void u_stage_load(UStage& r, int s, int tb, const bf16_t* __restrict__ XB, const int* __restrict__ IDX, const float* __restrict__ AMXP, int tid) {
    const u32x4* src = (const u32x4*)(IDX + (size_t)tb * TBLK * 128);
#pragma unroll
    for (int j = 0; j < 8; ++j) r.id[j] = src[tid + j * NTHR];
#pragma unroll
    for (int j = 0; j < 4; ++j) { const int e = tid + j * NTHR, tt = e >> 4, ch = e & 15; r.x[j] = *(const u32x4*)(XB + (size_t)(tb * TBLK + tt) * D + s * SLW + ch * 8);
        const float* ap = AMXP + (size_t)(tb * TBLK + tt) * 32 + 2 * ch; r.am[j] = fmaxf(ap[0], ap[1]); }
}
__device__ __forceinline__ void u_stage_store(const UStage& r, LAS unsigned char* lds, int tid) {
#pragma unroll
    for (int j = 0; j < 8; ++j) *(LAS u32x4*)(lds + PL_IDX + (size_t)(tid + j * NTHR) * 16) = r.id[j];
#pragma unroll
    for (int j = 0; j < 4; ++j) { const int e = tid + j * NTHR, tt = e >> 4, ch = e & 15;
        float am = r.am[j];
        am = fmaxf(am, dppf<DPP_XOR1>(am)); am = fmaxf(am, dppf<DPP_XOR2>(am)); am = fmaxf(am, dppf<DPP_HMIR>(am)); am = fmaxf(am, dppf<DPP_ROR8>(am));
        const float xs = am > 0.f ? 127.f * __builtin_amdgcn_rcpf(am) : 0.f;
        int lo, hi;
        lo = (__float2int_rn(bflo(r.x[j][0]) * xs) & 0xff) | ((__float2int_rn(bfhi(r.x[j][0]) * xs) & 0xff) << 8) | ((__float2int_rn(bflo(r.x[j][1]) * xs) & 0xff) << 16) | (__float2int_rn(bfhi(r.x[j][1]) * xs) << 24);
        hi = (__float2int_rn(bflo(r.x[j][2]) * xs) & 0xff) | ((__float2int_rn(bfhi(r.x[j][2]) * xs) & 0xff) << 8) | ((__float2int_rn(bflo(r.x[j][3]) * xs) & 0xff) << 16) | (__float2int_rn(bfhi(r.x[j][3]) * xs) << 24);
        u32x2 o; o.x = (unsigned)lo; o.y = (unsigned)hi;
        *(LAS u32x2*)(lds + PL_AUX + tt * 128 + ch * 8) = o; }
}
template <int MODE>
__device__ __forceinline__ void peer_u_run(int s, int tb, const unsigned char* __restrict__ U8, float* __restrict__ PART, LAS unsigned char* lds, int wave, int lane) {
    const int g = lane >> 3, c = lane & 7;
    const rsrc_t rs = make_rsrc(U8, (unsigned)((size_t)NE * D));
    const int soff = s * NE * SLW;
    constexpr int NTW = TBLK / NWAVES;
    const int tw = wave * NTW, t0 = tb * TBLK + tw;
    const LAS unsigned char* idb = lds + PL_IDX + (size_t)tw * 512 + g * 64;
    const LAS unsigned* xsb = (const LAS unsigned*)(lds + PL_AUX + (size_t)tw * 128) + c * 4;
    u32x4 wa[16], wb[16];
    if (MODE != 2) PEER_ISSUE(wa, idb);
#pragma unroll 1
    for (int i = 0; i < NTW; i += 2) {
        if (MODE != 2) PEER_ISSUE(wb, idb + (i + 1) * 512);
        u_compute<MODE>(wa, xsb + i * 32, PART, s, t0 + i, g, c);
        if (MODE != 2) PEER_ISSUE(wa, idb + min(i + 2, NTW - 1) * 512);
        u_compute<MODE>(wb, xsb + (i + 1) * 32, PART, s, t0 + i + 1, g, c);
    }
}
template <int MODE>
__device__ __forceinline__ void peer_u_block(int s, int tb, const bf16_t* __restrict__ XB, const int* __restrict__ IDX, const float* __restrict__ AMXP, const unsigned char* __restrict__ U8,
                                             float* __restrict__ PART, LAS unsigned char* lds, int tid, int wave, int lane) {
    UStage r; u_stage_load(r, s, tb, XB, IDX, AMXP, tid); u_stage_store(r, lds, tid);
    __syncthreads();
    peer_u_run<MODE>(s, tb, U8, PART, lds, wave, lane);
}

template <int NT>
__device__ __forceinline__ void peer_act_tokens(int t0, const float* __restrict__ PART, const float* __restrict__ ssp, const float* __restrict__ amxp, const int* __restrict__ IDX, const float* __restrict__ GATE,
                                                const f32x2* __restrict__ SC2, signed char* __restrict__ ACT, float* __restrict__ ASC, int lane) {
    unsigned w[NT][NSLICE]; u32x2 id[NT]; f32x2 gt[NT]; float sp[NT], xam[NT];
#pragma unroll
    for (int i = 0; i < NT; ++i) {
        const int t = t0 + i;
        id[i] = *(const u32x2*)(IDX + (size_t)t * 128 + 2 * lane);
        gt[i] = *(const f32x2*)(GATE + (size_t)t * 128 + 2 * lane);
        sp[i] = (lane < 32) ? ssp[(size_t)t * 32 + lane] : 0.f;
        xam[i] = (lane < 32) ? amxp[(size_t)t * 32 + lane] : 0.f;
#pragma unroll
        for (int s = 0; s < NSLICE; ++s) w[i][s] = ((const unsigned*)PART)[((size_t)s * T + t) * 64 + lane];
    }
    f32x2 c0[NT], c1[NT];
#pragma unroll
    for (int i = 0; i < NT; ++i) { c0[i] = SC2[id[i].x]; c1[i] = SC2[id[i].y]; }
#pragma unroll
    for (int i = 0; i < NT; ++i) {
        const int t = t0 + i;
        float s0 = 0.f, s1 = 0.f;
#pragma unroll
        for (int s = 0; s < NSLICE; ++s) { s0 += bflo(w[i][s]); s1 += bfhi(w[i][s]); }
        const float spt = wsum(sp[i]);
        const float xamt = wmax(xam[i]);
        const float rs1 = rsqrtf(spt * (1.f / D) + EPS) * (xamt * (1.f / 127.f));
        const float a0 = gelu_erf(s0 * c0[i].x * rs1) * gt[i].x * c0[i].y;
        const float a1 = gelu_erf(s1 * c1[i].x * rs1) * gt[i].y * c1[i].y;
        const float am = wmax(fmaxf(fabsf(a0), fabsf(a1)));
        const float qs = am > 0.f ? 127.f * __builtin_amdgcn_rcpf(am) : 0.f;
        const unsigned short pk = (unsigned short)((__float2int_rn(a0 * qs) & 0xff) | ((__float2int_rn(a1 * qs) & 0xff) << 8));
        *(unsigned short*)(ACT + (size_t)t * 128 + 2 * lane) = pk;
        if (lane == 0) ASC[t] = am * (1.f / 127.f);
    }
}

__device__ __forceinline__ float wsum_fast(float v) {
    v += dppf<DPP_XOR1>(v); v += dppf<DPP_XOR2>(v); v += dppf<DPP_HMIR>(v); v += dppf<DPP_ROR8>(v);
    { const auto s = __builtin_amdgcn_permlane16_swap(__float_as_uint(v), __float_as_uint(v), false, false); v = __uint_as_float(s[0]) + __uint_as_float(s[1]); }
    { const auto s = __builtin_amdgcn_permlane32_swap(__float_as_uint(v), __float_as_uint(v), false, false); v = __uint_as_float(s[0]) + __uint_as_float(s[1]); }
    return v;
}
__device__ __forceinline__ void tr4x4(unsigned d0, unsigned d1, unsigned d2, unsigned d3, unsigned (&t)[4]) {
    const unsigned x0 = __builtin_amdgcn_perm(d1, d0, 0x05010400u), x1 = __builtin_amdgcn_perm(d1, d0, 0x07030602u);
    const unsigned y0 = __builtin_amdgcn_perm(d3, d2, 0x05010400u), y1 = __builtin_amdgcn_perm(d3, d2, 0x07030602u);
    t[0] = __builtin_amdgcn_perm(y0, x0, 0x05040100u); t[1] = __builtin_amdgcn_perm(y0, x0, 0x07060302u);
    t[2] = __builtin_amdgcn_perm(y1, x1, 0x05040100u); t[3] = __builtin_amdgcn_perm(y1, x1, 0x07060302u);
}
template <int VMODE>
__device__ __forceinline__ void v_compute(u32x4 (&w)[16], const LAS unsigned* avp, float ascale, unsigned rw, bf16_t* __restrict__ XBio, float* __restrict__ OUT32,
                                          float* __restrict__ SS16, int s, int t, int g, int c, int lane) {
    const size_t off = (size_t)t * D + s * SLW + c * 16 + 2 * g;
    const f32x2 res = {bflo(rw), bfhi(rw)};
    const u32x4 a4 = *(const LAS u32x4*)avp;
    int acci[16];
#pragma unroll
    for (int i = 0; i < 16; ++i) acci[i] = 0;
#pragma unroll
    for (int k4 = 0; k4 < 4; ++k4)
#pragma unroll
        for (int q = 0; q < 4; ++q) {
            unsigned tt[4];
            tr4x4(w[4 * k4][q], w[4 * k4 + 1][q], w[4 * k4 + 2][q], w[4 * k4 + 3][q], tt);
#pragma unroll
            for (int j = 0; j < 4; ++j) acci[4 * q + j] = __builtin_amdgcn_sdot4((int)tt[j], (int)a4[k4], acci[4 * q + j], false);
        }
    int h4x[4], h4y[4];
#pragma unroll
    for (int q = 0; q < 4; ++q) {
        const auto sx = __builtin_amdgcn_permlane32_swap((unsigned)acci[2 * q], (unsigned)acci[2 * (4 + q)], false, false);
        const auto sy = __builtin_amdgcn_permlane32_swap((unsigned)acci[2 * q + 1], (unsigned)acci[2 * (4 + q) + 1], false, false);
        h4x[q] = (int)sx[0] + (int)sx[1]; h4y[q] = (int)sy[0] + (int)sy[1];
    }
    int h2x[2], h2y[2];
#pragma unroll
    for (int q = 0; q < 2; ++q) {
        const auto sx = __builtin_amdgcn_permlane16_swap((unsigned)h4x[q], (unsigned)h4x[2 + q], false, false);
        const auto sy = __builtin_amdgcn_permlane16_swap((unsigned)h4y[q], (unsigned)h4y[2 + q], false, false);
        h2x[q] = (int)sx[0] + (int)sx[1]; h2y[q] = (int)sy[0] + (int)sy[1];
    }
    const bool up = (g & 1) != 0;
    const int keepx = up ? h2x[1] : h2x[0], sendx = up ? h2x[0] : h2x[1], keepy = up ? h2y[1] : h2y[0], sendy = up ? h2y[0] : h2y[1];
    const int ix = keepx + dppi<DPP_ROR8>(sendx), iy = keepy + dppi<DPP_ROR8>(sendy);
    f32x2 o = {(float)ix * ascale + res.x, (float)iy * ascale + res.y};
    if (OUT32) *(f32x2*)(OUT32 + off) = o;
    else { const unsigned ow = pk2(o.x, o.y); *(unsigned*)(XBio + off) = ow; o = (f32x2){bflo(ow), bfhi(ow)}; }
    const float q2 = wsum_fast(o.x * o.x + o.y * o.y);
    if (lane == 0) SS16[(size_t)t * 16 + s] = q2;
}
constexpr int PLV_ACT = TBLK * 128 * 4;
constexpr int PLV_ASC = PLV_ACT + TBLK * 128;
struct VStage { u32x4 id[8]; u32x4 a[2]; float asc; };
__device__ __forceinline__ void v_stage_load(VStage& r, int tb, const signed char* __restrict__ ACT, const float* __restrict__ ASC, const int* __restrict__ IDX, int tid) {
    const u32x4* src = (const u32x4*)(IDX + (size_t)tb * TBLK * 128);
#pragma unroll
    for (int j = 0; j < 8; ++j) r.id[j] = src[tid + j * NTHR];
    const u32x4* srca = (const u32x4*)(ACT + (size_t)tb * TBLK * 128);
    r.a[0] = srca[tid]; r.a[1] = srca[tid + NTHR];
    r.asc = (tid < TBLK) ? ASC[(size_t)tb * TBLK + tid] : 0.f;
}
__device__ __forceinline__ void v_stage_store(const VStage& r, LAS unsigned char* lds, int tid) {
#pragma unroll
    for (int j = 0; j < 8; ++j) *(LAS u32x4*)(lds + PL_IDX + (size_t)(tid + j * NTHR) * 16) = r.id[j];
    *(LAS u32x4*)(lds + PLV_ACT + (size_t)tid * 16) = r.a[0]; *(LAS u32x4*)(lds + PLV_ACT + (size_t)(tid + NTHR) * 16) = r.a[1];
    if (tid < TBLK) *(LAS float*)(lds + PLV_ASC + tid * 4) = r.asc;
}
template <int VMODE>
__device__ __forceinline__ void peer_v_run(int s, int tb, const unsigned char* __restrict__ V8, bf16_t* __restrict__ XBio, float* __restrict__ OUT32, float* __restrict__ SS16,
                                           LAS unsigned char* lds, int wave, int lane) {
    const int g = lane >> 3, c = lane & 7;
    const rsrc_t rs = make_rsrc(V8, (unsigned)((size_t)NE * D));
    const int soff = s * NE * SLW;
    constexpr int NTW = TBLK / NWAVES;
    const int tw = wave * NTW, t0 = tb * TBLK + tw;
    const LAS unsigned char* idb = lds + PL_IDX + (size_t)tw * 512 + g * 64;
    const LAS unsigned* avb = (const LAS unsigned*)(lds + PLV_ACT + (size_t)tw * 128) + g * 4;
    const LAS float* ascb = (const LAS float*)(lds + PLV_ASC) + tw;
    const bf16_t* rbase = XBio + (size_t)t0 * D + s * SLW + c * 16 + 2 * g;
    u32x4 wa[16], wb[16];
    unsigned ra = *(const unsigned*)rbase, rb;
    PEER_ISSUE(wa, idb);
#pragma unroll 1
    for (int i = 0; i < NTW; i += 2) {
        rb = *(const unsigned*)(rbase + (size_t)(i + 1) * D);
        PEER_ISSUE(wb, idb + (i + 1) * 512);
        v_compute<VMODE>(wa, avb + i * 32, ascb[i], ra, XBio, OUT32, SS16, s, t0 + i, g, c, lane);
        ra = *(const unsigned*)(rbase + (size_t)min(i + 2, NTW - 1) * D);
        PEER_ISSUE(wa, idb + min(i + 2, NTW - 1) * 512);
        v_compute<VMODE>(wb, avb + (i + 1) * 32, ascb[i + 1], rb, XBio, OUT32, SS16, s, t0 + i + 1, g, c, lane);
    }
}
__device__ __forceinline__ void peer_v_block(int s, int tb, const signed char* __restrict__ ACT, const float* __restrict__ ASC, const int* __restrict__ IDX, const unsigned char* __restrict__ V8,
                                             bf16_t* __restrict__ XBio, float* __restrict__ OUT32, float* __restrict__ SS16,
                                             LAS unsigned char* lds, int tid, int wave, int lane) {
    VStage r; v_stage_load(r, tb, ACT, ASC, IDX, tid); v_stage_store(r, lds, tid);
    __syncthreads();
    peer_v_run<0>(s, tb, V8, XBio, OUT32, SS16, lds, wave, lane);
}

__device__ __forceinline__ void final_norm_rows2(const bf16_t* __restrict__ xrow, float* __restrict__ orow, const float* __restrict__ ss16, const float* __restrict__ g, int lane) {
    u32x2 xv[2][8]; float sp[2];
#pragma unroll
    for (int i = 0; i < 2; ++i) {
        sp[i] = (lane < 16) ? ss16[i * 16 + lane] : 0.f;
        const u32x2* xi = (const u32x2*)(xrow + (size_t)i * D) + lane;
#pragma unroll
        for (int j = 0; j < 8; ++j) xv[i][j] = xi[64 * j];
    }
    const f32x4* g4 = (const f32x4*)g + lane;
    f32x4 gg[8];
#pragma unroll
    for (int j = 0; j < 8; ++j) gg[j] = g4[64 * j];
#pragma unroll
    for (int i = 0; i < 2; ++i) {
        const float rf = rsqrtf(wsum(sp[i]) * (1.f / D) + EPS);
        f32x4* o = (f32x4*)(orow + (size_t)i * D) + lane;
#pragma unroll
        for (int j = 0; j < 8; ++j) { f32x4 v = {bflo(xv[i][j].x), bfhi(xv[i][j].x), bflo(xv[i][j].y), bfhi(xv[i][j].y)}; v = v * rf * gg[j]; o[64 * j] = v; }
    }
}

constexpr int TS_TOK = 64, TS_NTW = TS_TOK / NWAVES;
constexpr int TS_IDX = 0;
constexpr int TS_X0 = TS_IDX + TS_TOK * 512;
constexpr int TS_ACC = TS_X0 + 2 * TS_TOK * 128;
constexpr int TS_ACT = TS_ACC + TS_TOK * 512;
constexpr int TS_ASC = TS_ACT + TS_TOK * 128;
constexpr int TS_XSC = TS_ASC + 256;
constexpr int TS_XAM = TS_XSC + 256;
constexpr int TS_END = TS_XAM + 256;
static_assert(TS_END <= LDS_BYTES - 64, "token-stationary PEER LDS");
typedef int i32x2 __attribute__((ext_vector_type(2)));
__device__ __forceinline__ void lds_barrier() { asm volatile("s_waitcnt lgkmcnt(0)\n\ts_barrier" ::: "memory"); }
__device__ __forceinline__ void u_dots(const u32x4 (&w)[16], const LAS unsigned* xs, int c, int& r0, int& r1) {
    const u32x4 xi = *(const LAS u32x4*)xs;
    r0 = 0; r1 = 0;
#pragma unroll
    for (int k = 0; k < 16; ++k) {
        int d = __builtin_amdgcn_sdot4((int)w[k][0], (int)xi[0], 0, false);
        d = __builtin_amdgcn_sdot4((int)w[k][1], (int)xi[1], d, false);
        d = __builtin_amdgcn_sdot4((int)w[k][2], (int)xi[2], d, false);
        d = __builtin_amdgcn_sdot4((int)w[k][3], (int)xi[3], d, false);
        d += dppi<DPP_XOR1>(d); d += dppi<DPP_XOR2>(d); d += dppi<DPP_HMIR>(d);
        if ((k >> 1) == c) { if (k & 1) r1 = d; else r0 = d; }
    }
}
#define PEER_ISSUE_S(W, IDP, SOFF) do { const int soff = (SOFF); PEER_ISSUE(W, IDP); } while (0)
__device__ __forceinline__ void peer_token_stationary(bf16_t* __restrict__ XB, const int* __restrict__ IDX, const float* __restrict__ GATE, const float* __restrict__ AMXP, const float* __restrict__ SSP,
                                                      const unsigned char* __restrict__ U8, const unsigned char* __restrict__ V8, const f32x2* __restrict__ SC2, float* __restrict__ SS16,
                                                      float* __restrict__ OUT, const float* __restrict__ gfinal, LAS unsigned char* lds, int tid, int wave, int lane) {
    const int g = lane >> 3, c = lane & 7;
    const int tb0 = 2048 * ((int)blockIdx.x & 7) + TS_TOK * ((int)blockIdx.x >> 3), tw = wave * TS_NTW;
    const int srot = 2 * ((int)blockIdx.x & 7);
    LAS float* XSC = (LAS float*)(lds + TS_XSC); LAS float* XAM = (LAS float*)(lds + TS_XAM);
    __syncthreads();
    {
        const u32x4* src = (const u32x4*)(IDX + (size_t)tb0 * 128);
        u32x4 id[4]; float am[TS_NTW];
#pragma unroll
        for (int j = 0; j < 4; ++j) id[j] = src[tid + j * NTHR];
#pragma unroll
        for (int i = 0; i < TS_NTW; ++i) am[i] = (lane < 32) ? AMXP[(size_t)(tb0 + tw + i) * 32 + lane] : 0.f;
#pragma unroll
        for (int j = 0; j < 4; ++j) { *(LAS u32x4*)(lds + TS_IDX + (size_t)(tid + j * NTHR) * 16) = id[j]; *(LAS u32x4*)(lds + TS_ACC + (size_t)(tid + j * NTHR) * 16) = (u32x4){0u, 0u, 0u, 0u}; }
#pragma unroll
        for (int i = 0; i < TS_NTW; ++i) { const float a = wmax(am[i]); if (lane == 0) { XAM[tw + i] = a; XSC[tw + i] = a > 0.f ? 127.f * __builtin_amdgcn_rcpf(a) : 0.f; } }
    }
    __syncthreads();
    u32x4 xr[2];
#define TS_XLOAD(S) do { _Pragma("unroll") for (int j = 0; j < 2; ++j) { const int e_ = tid + j * NTHR, tt_ = e_ >> 4, ch_ = e_ & 15; \
        xr[j] = *(const u32x4*)(XB + (size_t)(tb0 + tt_) * D + (S) * SLW + ch_ * 8); } } while (0)
#define TS_XSTORE(BUF) do { _Pragma("unroll") for (int j = 0; j < 2; ++j) { const int e_ = tid + j * NTHR, tt_ = e_ >> 4, ch_ = e_ & 15; const float xs_ = XSC[tt_]; \
        const int lo_ = (__float2int_rn(bflo(xr[j][0]) * xs_) & 0xff) | ((__float2int_rn(bfhi(xr[j][0]) * xs_) & 0xff) << 8) | ((__float2int_rn(bflo(xr[j][1]) * xs_) & 0xff) << 16) | (__float2int_rn(bfhi(xr[j][1]) * xs_) << 24); \
        const int hi_ = (__float2int_rn(bflo(xr[j][2]) * xs_) & 0xff) | ((__float2int_rn(bfhi(xr[j][2]) * xs_) & 0xff) << 8) | ((__float2int_rn(bflo(xr[j][3]) * xs_) & 0xff) << 16) | (__float2int_rn(bfhi(xr[j][3]) * xs_) << 24); \
        u32x2 o_; o_.x = (unsigned)lo_; o_.y = (unsigned)hi_; *(LAS u32x2*)(lds + TS_X0 + (BUF) * (TS_TOK * 128) + tt_ * 128 + ch_ * 8) = o_; } } while (0)
    TS_XLOAD(srot & 15);
    TS_XSTORE(0);
    lds_barrier();
    const LAS unsigned char* idb = lds + TS_IDX + (size_t)tw * 512 + g * 64;
    {
        const rsrc_t rs = make_rsrc(U8, (unsigned)((size_t)NE * D));
        u32x4 wa[16], wb[16];
        PEER_ISSUE_S(wa, idb, (srot & 15) * NE * SLW);
#pragma unroll 1
        for (int js = 0; js < NSLICE; ++js) {
            const int s = (srot + js) & 15, sn = (srot + js + 1) & 15;
            const int so = s * NE * SLW, son = sn * NE * SLW;
            if (js < NSLICE - 1) TS_XLOAD(sn);
            const LAS unsigned* xsb = (const LAS unsigned*)(lds + TS_X0 + (js & 1) * (TS_TOK * 128) + (size_t)tw * 128) + c * 4;
#pragma unroll 1
            for (int i = 0; i < TS_NTW; i += 2) {
                PEER_ISSUE_S(wb, idb + (i + 1) * 512, so);
                { int r0, r1; u_dots(wa, xsb + i * 32, c, r0, r1);
                  LAS i32x2* ap = (LAS i32x2*)(lds + TS_ACC) + (tw + i) * 64 + lane; i32x2 a = *ap; a.x += r0; a.y += r1; *ap = a; }
                const bool more = (i + 2 < TS_NTW);
                const int nt = more ? i + 2 : ((js < NSLICE - 1) ? 0 : TS_NTW - 1);
                PEER_ISSUE_S(wa, idb + nt * 512, more ? so : son);
                { int r0, r1; u_dots(wb, xsb + (i + 1) * 32, c, r0, r1);
                  LAS i32x2* ap = (LAS i32x2*)(lds + TS_ACC) + (tw + i + 1) * 64 + lane; i32x2 a = *ap; a.x += r0; a.y += r1; *ap = a; }
            }
            if (js < NSLICE - 1) TS_XSTORE((js + 1) & 1);
            lds_barrier();
        }
        _Pragma("unroll") for (int k = 0; k < 16; ++k) asm volatile("" :: "v"(wa[k]));
    }
    {
        f32x2 gt[TS_NTW]; float sp[TS_NTW]; u32x2 id[TS_NTW];
#pragma unroll
        for (int i = 0; i < TS_NTW; ++i) {
            const int t = tb0 + tw + i;
            gt[i] = *(const f32x2*)(GATE + (size_t)t * 128 + 2 * lane);
            sp[i] = (lane < 32) ? SSP[(size_t)t * 32 + lane] : 0.f;
            id[i] = *(const LAS u32x2*)(lds + TS_IDX + (size_t)(tw + i) * 512 + lane * 8);
        }
        f32x2 c0[TS_NTW], c1[TS_NTW];
#pragma unroll
        for (int i = 0; i < TS_NTW; ++i) { c0[i] = SC2[id[i].x]; c1[i] = SC2[id[i].y]; }
#pragma unroll
        for (int i = 0; i < TS_NTW; ++i) {
            const i32x2 a = *((const LAS i32x2*)(lds + TS_ACC) + (tw + i) * 64 + lane);
            const float rs1 = rsqrtf(wsum(sp[i]) * (1.f / D) + EPS) * (XAM[tw + i] * (1.f / 127.f));
            const float a0 = gelu_erf((float)a.x * c0[i].x * rs1) * gt[i].x * c0[i].y;
            const float a1 = gelu_erf((float)a.y * c1[i].x * rs1) * gt[i].y * c1[i].y;
            const float am = wmax(fmaxf(fabsf(a0), fabsf(a1)));
            const float qs = am > 0.f ? 127.f * __builtin_amdgcn_rcpf(am) : 0.f;
            *(LAS unsigned short*)(lds + TS_ACT + (size_t)(tw + i) * 128 + 2 * lane) = (unsigned short)((__float2int_rn(a0 * qs) & 0xff) | ((__float2int_rn(a1 * qs) & 0xff) << 8));
            if (lane == 0) *((LAS float*)(lds + TS_ASC) + tw + i) = am * (1.f / 127.f);
        }
        __builtin_amdgcn_s_waitcnt(0xc07f);
        asm volatile("" ::: "memory");
    }
    {
        const rsrc_t rs = make_rsrc(V8, (unsigned)((size_t)NE * D));
        const LAS unsigned* avb = (const LAS unsigned*)(lds + TS_ACT + (size_t)tw * 128) + g * 4;
        const LAS float* ascb = (const LAS float*)(lds + TS_ASC) + tw;
        const bf16_t* rb0 = XB + (size_t)(tb0 + tw) * D + c * 16 + 2 * g;
        u32x4 wa[16], wb[16];
        unsigned ra = *(const unsigned*)(rb0 + (srot & 15) * SLW), rb;
        PEER_ISSUE_S(wa, idb, (srot & 15) * NE * SLW);
#pragma unroll 1
        for (int js = 0; js < NSLICE; ++js) {
            const int s = (srot + js) & 15, sn = (srot + js + 1) & 15;
            const int so = s * NE * SLW, son = sn * NE * SLW;
#pragma unroll 1
            for (int i = 0; i < TS_NTW; i += 2) {
                rb = *(const unsigned*)(rb0 + (size_t)(i + 1) * D + s * SLW);
                PEER_ISSUE_S(wb, idb + (i + 1) * 512, so);
                v_compute<0>(wa, avb + i * 32, ascb[i], ra, XB, (float*)nullptr, SS16, s, tb0 + tw + i, g, c, lane);
                const bool more = (i + 2 < TS_NTW);
                const int nt = more ? i + 2 : ((js < NSLICE - 1) ? 0 : TS_NTW - 1);
                const int ns = more ? s : ((js < NSLICE - 1) ? sn : s);
                ra = *(const unsigned*)(rb0 + (size_t)nt * D + ns * SLW);
                PEER_ISSUE_S(wa, idb + nt * 512, more ? so : son);
                v_compute<0>(wb, avb + (i + 1) * 32, ascb[i + 1], rb, XB, (float*)nullptr, SS16, s, tb0 + tw + i + 1, g, c, lane);
            }
        }
        _Pragma("unroll") for (int k = 0; k < 16; ++k) asm volatile("" :: "v"(wa[k]));
    }
    if (OUT) {
        asm volatile("s_waitcnt vmcnt(0)" ::: "memory");
        __builtin_amdgcn_fence(__ATOMIC_ACQUIRE, "agent");
#pragma unroll 1
        for (int i = 0; i < TS_NTW; i += 2) {
            const size_t t = (size_t)(tb0 + tw + i);
            final_norm_rows2(XB + t * D, OUT + t * D, SS16 + t * 16, gfinal, lane);
        }
    }
#undef TS_XLOAD
#undef TS_XSTORE
}

__device__ __forceinline__ int slice_of(int xcc, int j) { const int xx = (xcc + (j >> 1)) & 7; return xx + 8 * (j & 1); }

}

namespace mk {
#define IN(k) (lo <= (k) && (k) < hi)
#define GSYNC() do { if (coop) xcd_barrier(xb); } while (0)
__device__ __forceinline__ int xcd_rec_unit(int c, bool& is_mlstm) {
    const int x = c & 7, k = c >> 3;
    is_mlstm = k >= 16;
    const int kk = k & 15, h = kk & 3, g = 4 * (x & 1) + (kk >> 2), b = x >> 1;
    return (b * 4 + h) * 8 + g;
}
__device__ __forceinline__ int xcd_attn_unit(int c) {
    const int x = c & 7, k = c >> 3, b = x >> 1, n = 16 * (x & 1) + (k >> 1), kvh = k & 1;
    return b * 64 + n * 2 + kvh;
}
template <int l>
__device__ __forceinline__ void layer_body(const Params& p, LAS unsigned char* lds, unsigned char* ws, int G, int tid, int lane, int wave, int lo, int hi, bool coop, const XcdBarrier& xb) {

    if (IN(1)) _Pragma("unroll") for (int rep = 0; rep < REP1; ++rep) {
        const int nh = (G == 256) ? NHELP : 0, Gg = G - nh;
        if ((int)blockIdx.x < Gg) {
            pg8::Gemm g{(const bf16_t*)(ws + WS_XB), (const bf16_t*)(ws + WS_WINT) + (size_t)l * NP * D, T, NP, D};
            pg8::StaticOrder So; So.init(T, NP, Gg, (int)blockIdx.x);
            EpiScaleBf16<16> E{(bf16_t*)(ws + WS_P), NP, (const float*)(ws + WS_SS)};
            pg8::gemm_phase<EpiScaleBf16<16>, pg8::StaticOrder, true, true>(lds, g, So, E);
        } else {
            tables_convert(p, l, 0, HROWS, ((int)blockIdx.x - Gg) * NWAVES + wave, nh * NWAVES, lane);
        }
        GSYNC();
    }
    if (IN(2)) _Pragma("unroll") for (int rep = 0; rep < REP2; ++rep) {
        for (int u = blockIdx.x; u < 256; u += G) {
            int tq_ = tid; asm volatile("" : "+v"(tq_)); const int tid = tq_, lane = tq_ & 63, wave = __builtin_amdgcn_readfirstlane(tq_ >> 6);
            bool ml = u >= 128; int ru = ml ? u - 128 : u;
            if (G == 256) ru = xcd_rec_unit(u, ml);
            if (!ml) hgrn_unit<1>((const bf16_t*)(ws + WS_P), p.in[5], l, nullptr, (float*)(ws + WS_STH), nullptr, ru, lds, tid, lane, wave);
            else mlstm_unit<1>((const bf16_t*)(ws + WS_P), p.in[7] + (size_t)l * 4 * 1024, p.in[8] + l * 4, p.in[9] + l * 4, (float*)(ws + WS_STM), nullptr, ru, lds, tid, lane, wave);
            __syncthreads();
        }
        GSYNC();
    }
    if (IN(3)) {
        _Pragma("unroll") for (int rep = 0; rep < REP4; ++rep)
        for (int u = blockIdx.x; u < 256; u += G) {
            int tq_ = tid; asm volatile("" : "+v"(tq_)); const int tid = tq_, lane = tq_ & 63, wave = __builtin_amdgcn_readfirstlane(tq_ >> 6);
            bool ml = u >= 128; int ru = ml ? u - 128 : u;
            if (G == 256) ru = xcd_rec_unit(u, ml);
            if (!ml) hgrn_unit<2>((const bf16_t*)(ws + WS_P), p.in[5], l, p.in[6] + l * 512, (float*)(ws + WS_STH), (bf16_t*)(ws + WS_YB), ru, lds, tid, lane, wave);
            else mlstm_unit<2>((const bf16_t*)(ws + WS_P), p.in[7] + (size_t)l * 4 * 1024, p.in[8] + l * 4, p.in[9] + l * 4, (float*)(ws + WS_STM), (bf16_t*)(ws + WS_YB), ru, lds, tid, lane, wave);
            __syncthreads();
        }
        _Pragma("unroll") for (int rep = 0; rep < REP3; ++rep)
        for (int u = blockIdx.x; u < 256; u += G) {
            int tq_ = tid; asm volatile("" : "+v"(tq_)); const int tid = tq_, lane = tq_ & 63, wave = __builtin_amdgcn_readfirstlane(tq_ >> 6);
            attn_unit((const bf16_t*)(ws + WS_P), (const f32x2*)(ws + WS_ROPE), p.in[4] + l * 16, (bf16_t*)(ws + WS_YB), G == 256 ? xcd_attn_unit(u) : u, lds, tid, lane, wave);
            __syncthreads();
        }
        GSYNC();
    }
    if (IN(4)) {
        pg8::Gemm g{(const bf16_t*)(ws + WS_YB), (const bf16_t*)(ws + WS_WOUTT) + (size_t)l * D * D, T, D, D};
        pg8::StaticOrder So; So.init(T, D, G, (int)blockIdx.x);
        EpiX1 E{l == 0 ? p.in[0] : (const float*)nullptr, (bf16_t*)(ws + WS_XB), (float*)(ws + WS_SSP), (float*)(ws + WS_AMXP)};
        pg8::gemm_phase<EpiX1, pg8::StaticOrder, true, true>(lds, g, So, E);
        GSYNC();
    }
    if (IN(5)) _Pragma("unroll") for (int rep = 0; rep < REP5; ++rep) {
        pg8::Gemm g{(const bf16_t*)(ws + WS_XB), (const bf16_t*)(ws + WS_WQT) + (size_t)l * D * D, T, D, D};
        pg8::StaticOrder So; So.init(T, D, G, (int)blockIdx.x);
        EpiScaleBf16<32> E{(bf16_t*)(ws + WS_Q), D, (const float*)(ws + WS_SSP)};
        pg8::gemm_phase<EpiScaleBf16<32>, pg8::StaticOrder, true, true>(lds, g, So, E);
        pg8::Unit u;
        for (int i = 0; So.next(i, u); ++i)
            route_unit((const bf16_t*)(ws + WS_Q), (const bf16_t*)(ws + WS_SUBK) + (size_t)l * 2 * 8 * 128 * 128, u.pm, u.pn, (int*)(ws + WS_IDX), (int*)(ws + WS_IDXU), (float*)(ws + WS_GATE), lds, tid, wave, lane);
        GSYNC();
    }
    const bool ts = (G == 256);
    if (IN(6) && ts)
        peer_token_stationary((bf16_t*)(ws + WS_XB), (const int*)(ws + WS_IDX), (const float*)(ws + WS_GATE), (const float*)(ws + WS_AMXP), (const float*)(ws + WS_SSP),
                              ws + WS_U8 + (size_t)l * NE * D, ws + WS_V8 + (size_t)l * NE * D, (const f32x2*)(ws + WS_USC) + l * NE, (float*)(ws + WS_SS),
                              (l == 1 && IN(9)) ? p.out : (float*)nullptr, p.in[15], lds, tid, wave, lane);
    if (IN(6) && !ts) {

        LAS int* slot = (LAS int*)(lds + LDS_BYTES - 32);
        if (G == 256) {
            const int grp = (int)blockIdx.x & 7, rank = (int)blockIdx.x >> 3;
            _Pragma("unroll") for (int rr = 0; rr < REP6; ++rr) {
            UStage st; u_stage_load(st, grp, rank * 4, (const bf16_t*)(ws + WS_XB), (const int*)(ws + WS_IDX), (const float*)(ws + WS_AMXP), tid);
            for (int j = 0; j < 8; ++j) {
                const int s = grp + 8 * (j >> 2), tb = rank * 4 + (j & 3);
                __syncthreads();
                u_stage_store(st, lds, tid);
                __syncthreads();
                if (j < 7) u_stage_load(st, grp + 8 * ((j + 1) >> 2), rank * 4 + ((j + 1) & 3), (const bf16_t*)(ws + WS_XB), (const int*)(ws + WS_IDX), (const float*)(ws + WS_AMXP), tid);
                peer_u_run<0>(s, tb, ws + WS_U8 + (size_t)l * NE * D, (float*)(ws + WS_PART), lds, wave, lane);
            }
            }
        } else {
            const int xcc = (int)xb_xcc_id();
            unsigned* qc = (unsigned*)(ws + WS_CTL) + CTL_Q + ((l * 2 + 0) * 2 + 0) * 16;
            for (int j = 0; j < NSLICE; ++j) {
                const int s = slice_of(xcc, j);
                for (;;) {
                    const int tb = q_next(qc + s, slot, tid);
                    if (tb < 0) break;
                    peer_u_block<0>(s, tb, (const bf16_t*)(ws + WS_XB), (const int*)(ws + WS_IDX), (const float*)(ws + WS_AMXP), ws + WS_U8 + (size_t)l * NE * D, (float*)(ws + WS_PART), lds, tid, wave, lane);
                }
            }
        }
        GSYNC();
    }
    if (IN(7) && !ts) {

        const int gw = blockIdx.x * NWAVES + wave, ngw = G * NWAVES;
        _Pragma("unroll") for (int rep = 0; rep < REP7; ++rep)
        for (int t = 4 * gw; t < T; t += 4 * ngw)
            peer_act_tokens<4>(t, (const float*)(ws + WS_PART), (const float*)(ws + WS_SSP), (const float*)(ws + WS_AMXP), (const int*)(ws + WS_IDX), (const float*)(ws + WS_GATE),
                               (const f32x2*)(ws + WS_USC) + l * NE, (signed char*)(ws + WS_ACT), (float*)(ws + WS_ASC), lane);
        GSYNC();
    }
    if (IN(8) && !ts) {

        LAS int* slot = (LAS int*)(lds + LDS_BYTES - 32);
        if (G == 256) {
            const int grp = (int)blockIdx.x & 7, rank = (int)blockIdx.x >> 3;
            {
            VStage st; v_stage_load(st, rank * 4, (const signed char*)(ws + WS_ACT), (const float*)(ws + WS_ASC), (const int*)(ws + WS_IDX), tid);
            for (int j = 0; j < 8; ++j) {
                const int s = grp + 8 * (j >> 2), tb = rank * 4 + (j & 3);
                __syncthreads();
                v_stage_store(st, lds, tid);
                __syncthreads();
                if (j < 7) v_stage_load(st, rank * 4 + ((j + 1) & 3), (const signed char*)(ws + WS_ACT), (const float*)(ws + WS_ASC), (const int*)(ws + WS_IDX), tid);
                peer_v_run<0>(s, tb, ws + WS_V8 + (size_t)l * NE * D, (bf16_t*)(ws + WS_XB), (float*)nullptr, (float*)(ws + WS_SS), lds, wave, lane);
            }
            }
        } else {
            const int xcc = (int)xb_xcc_id();
            unsigned* qc = (unsigned*)(ws + WS_CTL) + CTL_Q + ((l * 2 + 1) * 2 + 0) * 16;
            for (int j = 0; j < NSLICE; ++j) {
                const int s = slice_of(xcc, j);
                for (;;) {
                    const int tb = q_next(qc + s, slot, tid);
                    if (tb < 0) break;
                    peer_v_block(s, tb, (const signed char*)(ws + WS_ACT), (const float*)(ws + WS_ASC), (const int*)(ws + WS_IDX), ws + WS_V8 + (size_t)l * NE * D, (bf16_t*)(ws + WS_XB),
                                 (float*)nullptr, (float*)(ws + WS_SS), lds, tid, wave, lane);
                }
            }
        }
    }
    if (l == 1 && IN(9) && !ts) {
        GSYNC();
        const int gw = blockIdx.x * NWAVES + wave, ngw = G * NWAVES;
        for (int t = 2 * gw; t < T; t += 2 * ngw) final_norm_rows2((const bf16_t*)(ws + WS_XB) + (size_t)t * D, p.out + (size_t)t * D, (const float*)(ws + WS_SS) + (size_t)t * 16, p.in[15], lane);
    }
}
__global__ void __launch_bounds__(NTHR, 2) mega(Params p) {
    extern __shared__ __attribute__((aligned(16))) unsigned char lds_raw[];
    LAS unsigned char* lds = (LAS unsigned char*)lds_raw;
    unsigned char* ws = p.ws;
    const int G = gridDim.x;
    const int tid = threadIdx.x, lane = tid & 63, wave = __builtin_amdgcn_readfirstlane(tid >> 6);
    const int lo = p.ph_lo, hi = p.ph_hi;
    const bool coop = p.pad != 0;
    volatile LAS unsigned* xst = (volatile LAS unsigned*)(lds + LDS_BYTES - 16);
    if (tid < 4) xst[tid] = 0u;
    __syncthreads();
    XcdBarrier xb; xb.bar = (unsigned*)(ws + WS_CTL); xb.x = 0; xb.st = xst;
    if (coop) xb = xcd_barrier_post((unsigned*)(ws + WS_CTL), xst);
    if (IN(0)) { const int hm = (G == 256 && NHELP > 0) ? 0x100 : 0; p0_prologue(p, lds, 0xff | hm); if (REP0 > 1) { if (coop) xcd_barrier(xb); p0_prologue(p, lds, REP0 | hm); } if (coop) xcd_barrier(xb); }
    if (p.layer <= 0 && 0 < p.layer_hi) { layer_body<0>(p, lds, ws, G, tid, lane, wave, lo, hi, coop, xb); if (1 < p.layer_hi) GSYNC(); }
    if (p.layer <= 1 && 1 < p.layer_hi) layer_body<1>(p, lds, ws, G, tid, lane, wave, lo, hi, coop, xb);

#undef IN
#undef GSYNC
}
__global__ __launch_bounds__(256) void shim_xprep_kernel(const float* __restrict__ X, bf16_t* __restrict__ XB, float* __restrict__ SS) {
    const int t = blockIdx.x * 4 + (threadIdx.x >> 6), lane = threadIdx.x & 63;
    xprep_row(X + (size_t)t * D, XB + (size_t)t * D, SS + t, lane);
}
}

extern "C" void kernel_launch(void* const* d_in, const int* in_sizes, int n_in, void* d_out, int out_size, void* d_ws, size_t ws_size, hipStream_t stream) {
    using namespace mk;
    static int grid = 0;
    if (grid == 0) {
        int dev = 0, cus = 0, per_cu = 0;
        (void)hipGetDevice(&dev); (void)hipDeviceGetAttribute(&cus, hipDeviceAttributeMultiprocessorCount, dev);
        if (hipFuncSetAttribute((const void*)mega, hipFuncAttributeMaxDynamicSharedMemorySize, LDS_BYTES) != hipSuccess) { fprintf(stderr, "kernel_launch: hipFuncSetAttribute failed\n"); grid = -1; return; }
        if (ws_size < WS_END) { fprintf(stderr, "kernel_launch: workspace too small: need %zu have %zu\n", (size_t)WS_END, ws_size); grid = -1; return; }
        if (hipOccupancyMaxActiveBlocksPerMultiprocessor(&per_cu, (const void*)mega, NTHR, LDS_BYTES) != hipSuccess || per_cu < 1) { fprintf(stderr, "kernel_launch: occupancy query says %d blocks per CU\n", per_cu); grid = -1; return; }
        grid = cus;
    }
    if (grid < 0) return;
    Params p{};
    for (int i = 0; i < 16; ++i) p.in[i] = (const float*)d_in[i];
    p.out = (float*)d_out; p.ws = (unsigned char*)d_ws;
    p.ph_lo = 0; p.ph_hi = 10; p.layer = 0; p.layer_hi = 2; p.pad = 1; p.pad2 = 0;
    if (hipMemsetAsync(d_ws, 0, 16384, stream) != hipSuccess) { fprintf(stderr, "kernel_launch: memset failed\n"); return; }
    void* args[] = {&p};
    hipError_t e = hipLaunchCooperativeKernel((const void*)mega, dim3(grid), dim3(NTHR), args, LDS_BYTES, stream);
    if (e != hipSuccess) fprintf(stderr, "kernel_launch: cooperative launch failed: %s (grid %d)\n", hipGetErrorString(e), grid);
}
```
